# Optimizing an MI355X kernel written in HIP

```python
import jax, jax.numpy as jnp
from jax import lax
import numpy as np

D_MODEL = 1024
BATCH = 4
SEQ = 8192
DEPTH = 2

CTX_LEN = 256
GRID_W = 64
POS_BASE = 10000.0
CHUNK = 128
GMLP_GROUPS = 8
GMLP_WIDTH = 512
GMLP_GDIM = GMLP_WIDTH // GMLP_GROUPS
LRU_HEADS = 8
LRU_WIDTH = 512
LRU_HDIM = LRU_WIDTH // LRU_HEADS
CONV_W = 4
CONV_LEFT = 2
LRU_C = 8.0
SPLIT_AT = (GMLP_WIDTH, 2 * GMLP_WIDTH, 2 * GMLP_WIDTH + LRU_WIDTH,
            2 * GMLP_WIDTH + 2 * LRU_WIDTH, 2 * GMLP_WIDTH + 2 * LRU_WIDTH + D_MODEL)
IN_WIDTH = 2 * GMLP_WIDTH + 2 * LRU_WIDTH + 2 * D_MODEL
N_EXPERTS = 64
TOP_K = 8
N_GROUPS = 8
TOPK_GROUPS = 4
EXPERT_DIM = 256
SHARED_DIM = 256
ROUTE_SCALE = 2.5
MOE_BLOCK = 256
RMS_EPS = 1e-6
LN_EPS = 1e-5

kernel_name = "hybrid_gmlp_rglru_moe_prefix_dit"


def rms_norm(x, g):
    xf = x.astype(jnp.float32)
    y = xf * lax.rsqrt(jnp.mean(xf * xf, axis=-1, keepdims=True) + RMS_EPS)
    return (y * g.astype(jnp.float32)).astype(x.dtype)


def layer_norm(x, g, b):
    xf = x.astype(jnp.float32)
    mu = jnp.mean(xf, axis=-1, keepdims=True)
    var = jnp.mean(jnp.square(xf - mu), axis=-1, keepdims=True)
    y = (xf - mu) * lax.rsqrt(var + LN_EPS) * g.astype(jnp.float32) + b.astype(jnp.float32)
    return y.astype(x.dtype)


def grid_pos_embed(n_tok):
    rows = n_tok // GRID_W
    quarter = D_MODEL // 4
    half = D_MODEL // 2
    omega = 1.0 / (POS_BASE ** (jnp.arange(quarter, dtype=jnp.float32) / quarter))

    def sincos(p):
        ang = p[:, None] * omega[None, :]
        return jnp.concatenate([jnp.sin(ang), jnp.cos(ang)], axis=-1)

    row_e = sincos(jnp.arange(rows, dtype=jnp.float32))
    col_e = sincos(jnp.arange(GRID_W, dtype=jnp.float32))
    pe = jnp.concatenate([jnp.broadcast_to(row_e[:, None, :], (rows, GRID_W, half)),
                          jnp.broadcast_to(col_e[None, :, :], (rows, GRID_W, half))], axis=-1)
    return pe.reshape(rows * GRID_W, D_MODEL)


def ada_params(cond, w_mod, b_mod):
    m = jnp.einsum('bd,de->be', jax.nn.silu(cond), w_mod) + b_mod
    return [t[:, None, :] for t in jnp.split(m, 6, axis=-1)]


def mixer_inputs(h, w_in):
    z = jnp.einsum('bld,de->ble', h, w_in)
    u, v, xb, gb, ga, gr = jnp.split(z, SPLIT_AT, axis=-1)
    return (jax.nn.gelu(u), jax.nn.gelu(v), xb, jax.nn.gelu(gb),
            jax.nn.sigmoid(ga), jax.nn.sigmoid(gr))


def gmlp_spatial(u, v, ln_g, ln_b, w_s, b_s):
    bsz, n, _ = v.shape
    vn = layer_norm(v, ln_g, ln_b).reshape(bsz, n // CHUNK, CHUNK, GMLP_GROUPS, GMLP_GDIM)
    mixed = jnp.einsum('gpq,bcqgd->bcpgd', w_s, vn) + b_s.T[:, :, None]
    return u * mixed.reshape(bsz, n, GMLP_WIDTH)


def short_conv(x, w, b):
    n = x.shape[1]
    xp = jnp.pad(x, ((0, 0), (CONV_LEFT, CONV_W - 1 - CONV_LEFT), (0, 0)))
    y = b + xp[:, 0:n] * w[0]
    for k in range(1, CONV_W):
        y = y + xp[:, k:k + n] * w[k]
    return y


def lru_coeffs(xc, w_a, b_a, w_x, b_x, lam):
    bsz, n, _ = xc.shape
    xh = xc.reshape(bsz, n, LRU_HEADS, LRU_HDIM)
    r = jax.nn.sigmoid(jnp.einsum('blhi,hij->blhj', xh, w_a) + b_a).reshape(bsz, n, LRU_WIDTH)
    i = jax.nn.sigmoid(jnp.einsum('blhi,hij->blhj', xh, w_x) + b_x).reshape(bsz, n, LRU_WIDTH)
    log_a = -LRU_C * r.astype(jnp.float32) * jax.nn.softplus(-lam.astype(jnp.float32))
    a = jnp.exp(log_a)
    drive = jnp.sqrt(-jnp.expm1(2.0 * log_a)) * (i * xc).astype(jnp.float32)
    return a, drive


def _lin_combine(left, right):
    a_l, b_l = left
    a_r, b_r = right
    return a_l * a_r, a_r * b_l + b_r


def linear_scan(a, drive, h0, reverse):
    if h0 is not None:
        edge = -1 if reverse else 0
        drive = drive.at[:, edge].add(a[:, edge] * h0)
    _, h = lax.associative_scan(_lin_combine, (a, drive), reverse=reverse, axis=1)
    return h


def rglru_branch(xb_c, xb_l, conv_w, conv_b, w_a, b_a, w_x, b_x, lam):
    xc_c = short_conv(xb_c, conv_w, conv_b)
    xc_l = short_conv(xb_l, conv_w, conv_b)
    hs_c, hs_l = [], []
    for d, rev in enumerate((False, True)):
        a, drv = lru_coeffs(xc_c, w_a[d], b_a[d], w_x[d], b_x[d], lam[d])
        h_c = linear_scan(a, drv, None, rev)
        h0 = h_c[:, 0] if rev else h_c[:, -1]
        a, drv = lru_coeffs(xc_l, w_a[d], b_a[d], w_x[d], b_x[d], lam[d])
        h_l = linear_scan(a, drv, h0, rev)
        hs_c.append(h_c)
        hs_l.append(h_l)
    return (hs_c[0] + hs_c[1]).astype(xb_c.dtype), (hs_l[0] + hs_l[1]).astype(xb_l.dtype)


def merge_branches(y_a, y_b, gate_a, gate_b, w_out_a, w_out_b, w_out):
    m = (gate_a * jnp.einsum('blc,cd->bld', y_a, w_out_a)
         + gate_b * jnp.einsum('blc,cd->bld', y_b, w_out_b))
    return jnp.einsum('bld,de->ble', m, w_out)


def swiglu(x, w_g, w_u, w_d):
    return jnp.einsum('nf,fd->nd', jax.nn.silu(x @ w_g) * (x @ w_u), w_d)


def route(h, router_w, router_bias):
    t = h.shape[0]
    s = jax.nn.sigmoid(jnp.einsum('td,de->te', h, router_w).astype(jnp.float32))
    sel = s + router_bias.astype(jnp.float32)
    grp_score = lax.top_k(sel.reshape(t, N_GROUPS, N_EXPERTS // N_GROUPS), 2)[0].sum(-1)
    _, top_g = lax.top_k(grp_score, TOPK_GROUPS)
    gmask = jnp.any(top_g[:, :, None] == jnp.arange(N_GROUPS)[None, None, :], axis=1)
    emask = jnp.repeat(gmask, N_EXPERTS // N_GROUPS, axis=1)
    _, idx = lax.top_k(jnp.where(emask, sel, -jnp.inf), TOP_K)
    w = jnp.take_along_axis(s, idx, axis=1)
    w = w / jnp.sum(w, axis=-1, keepdims=True) * ROUTE_SCALE
    return idx, w


def routed_experts(h, idx, wts, w_g, w_u, w_d):
    t, d = h.shape
    n_assign = t * TOP_K
    n_rows = -(-(n_assign + N_EXPERTS * (MOE_BLOCK - 1)) // MOE_BLOCK) * MOE_BLOCK
    n_blocks = n_rows // MOE_BLOCK
    e_flat = idx.reshape(-1)
    tok_flat = jnp.arange(n_assign, dtype=jnp.int32) // TOP_K
    order = jnp.argsort(e_flat)
    e_sorted = e_flat[order]
    counts = jnp.bincount(e_flat, length=N_EXPERTS)
    padded = (counts + MOE_BLOCK - 1) // MOE_BLOCK * MOE_BLOCK
    start = jnp.cumsum(counts) - counts
    pend = jnp.cumsum(padded)
    pstart = pend - padded
    dest = pstart[e_sorted] + jnp.arange(n_assign, dtype=jnp.int32) - start[e_sorted]
    row_tok = jnp.full((n_rows,), t, jnp.int32).at[dest].set(tok_flat[order])
    row_w = jnp.zeros((n_rows,), h.dtype).at[dest].set(wts.reshape(-1)[order].astype(h.dtype))
    blk_start = jnp.arange(n_blocks, dtype=jnp.int32) * MOE_BLOCK
    blk_exp = jnp.minimum(jnp.searchsorted(pend, blk_start, side='right'), N_EXPERTS - 1)
    h_pad = jnp.concatenate([h, jnp.zeros((1, d), h.dtype)], axis=0)

    def body(out, blk):
        toks, ws, e = blk
        y = swiglu(h_pad[toks], w_g[e], w_u[e], w_d[e]) * ws[:, None]
        return out.at[toks].add(y), None

    out, _ = lax.scan(body, jnp.zeros_like(h_pad),
                      (row_tok.reshape(n_blocks, MOE_BLOCK), row_w.reshape(n_blocks, MOE_BLOCK), blk_exp))
    return out[:t]


def moe_ffn(h, router_w, router_bias, e_g, e_u, e_d, s_g, s_u, s_d):
    bsz, n, d = h.shape
    hf = h.reshape(bsz * n, d)
    idx, w = route(hf, router_w, router_bias)
    y = swiglu(hf, s_g, s_u, s_d) + routed_experts(hf, idx, w, e_g, e_u, e_d)
    return y.reshape(bsz, n, d)


def setup_inputs(seed: int = 0) -> dict:
    key = jax.random.key(seed)
    ks = iter(jax.random.split(key, 48))
    f32 = jnp.float32
    D, L = D_MODEL, DEPTH

    def nrm(shape, scale):
        return jax.random.normal(next(ks), shape, f32) * scale

    lam_u = jax.random.uniform(next(ks), (L, 2, LRU_WIDTH), f32, 0.9, 0.999)
    a_base = lam_u ** (1.0 / LRU_C)
    lru_lambda = jnp.log(a_base) - jnp.log1p(-a_base)
    return {
        "x": nrm((BATCH, SEQ, D), 1.0),
        "c": nrm((BATCH, D), 1.0),
        "ctx": nrm((BATCH, CTX_LEN, D), 1.0),
        "c_ctx": nrm((D,), 1.0),
        "w_mod": nrm((L, D, 6 * D), 0.5 * D ** -0.5),
        "b_mod": nrm((L, 6 * D), 0.02),
        "g_pre_mix": 1.0 + nrm((L, D), 0.02),
        "g_post_mix": 1.0 + nrm((L, D), 0.02),
        "g_pre_ffn": 1.0 + nrm((L, D), 0.02),
        "g_post_ffn": 1.0 + nrm((L, D), 0.02),
        "w_in": nrm((L, D, IN_WIDTH), D ** -0.5),
        "gmlp_ln_g": 1.0 + nrm((L, GMLP_WIDTH), 0.02),
        "gmlp_ln_b": nrm((L, GMLP_WIDTH), 0.02),
        "gmlp_ws": nrm((L, GMLP_GROUPS, CHUNK, CHUNK), CHUNK ** -0.5),
        "gmlp_bs": 1.0 + nrm((L, GMLP_GROUPS, CHUNK), 0.02),
        "conv_w": nrm((L, CONV_W, LRU_WIDTH), CONV_W ** -0.5),
        "conv_b": nrm((L, LRU_WIDTH), 0.02),
        "lru_wa": nrm((L, 2, LRU_HEADS, LRU_HDIM, LRU_HDIM), LRU_HDIM ** -0.5),
        "lru_ba": nrm((L, 2, LRU_HEADS, LRU_HDIM), 0.02),
        "lru_wx": nrm((L, 2, LRU_HEADS, LRU_HDIM, LRU_HDIM), LRU_HDIM ** -0.5),
        "lru_bx": nrm((L, 2, LRU_HEADS, LRU_HDIM), 0.02),
        "lru_lambda": lru_lambda,
        "w_out_a": nrm((L, GMLP_WIDTH, D), GMLP_WIDTH ** -0.5),
        "w_out_b": nrm((L, LRU_WIDTH, D), LRU_WIDTH ** -0.5),
        "w_out": nrm((L, D, D), D ** -0.5),
        "router_w": nrm((L, D, N_EXPERTS), D ** -0.5),
        "router_bias": nrm((L, N_EXPERTS), 0.01),
        "exp_w_gate": nrm((L, N_EXPERTS, D, EXPERT_DIM), D ** -0.5),
        "exp_w_up": nrm((L, N_EXPERTS, D, EXPERT_DIM), D ** -0.5),
        "exp_w_down": nrm((L, N_EXPERTS, EXPERT_DIM, D), EXPERT_DIM ** -0.5),
        "sh_w_gate": nrm((L, D, SHARED_DIM), D ** -0.5),
        "sh_w_up": nrm((L, D, SHARED_DIM), D ** -0.5),
        "sh_w_down": nrm((L, SHARED_DIM, D), SHARED_DIM ** -0.5),
    }


def reference(x, c, ctx, c_ctx, w_mod, b_mod, g_pre_mix, g_post_mix, g_pre_ffn, g_post_ffn,
              w_in, gmlp_ln_g, gmlp_ln_b, gmlp_ws, gmlp_bs, conv_w, conv_b,
              lru_wa, lru_ba, lru_wx, lru_bx, lru_lambda, w_out_a, w_out_b, w_out,
              router_w, router_bias, exp_w_gate, exp_w_up, exp_w_down,
              sh_w_gate, sh_w_up, sh_w_down):
    xl = x + grid_pos_embed(x.shape[1]).astype(x.dtype)[None]
    xc = ctx
    for l in range(DEPTH):
        last = l == DEPTH - 1
        sh_t, sc_t, gt_t, sh_f, sc_f, gt_f = ada_params(c, w_mod[l], b_mod[l])
        csh_t, csc_t, cgt_t, csh_f, csc_f, cgt_f = ada_params(c_ctx[None, :], w_mod[l], b_mod[l])

        hl = rms_norm(xl, g_pre_mix[l]) * (1.0 + sc_t) + sh_t
        hc = rms_norm(xc, g_pre_mix[l]) * (1.0 + csc_t) + csh_t
        ul, vl, xbl, gbl, gal, grl = mixer_inputs(hl, w_in[l])
        uc, vc, xbc, gbc, gac, grc = mixer_inputs(hc, w_in[l])
        lru_c, lru_l = rglru_branch(xbc, xbl, conv_w[l], conv_b[l], lru_wa[l], lru_ba[l],
                                    lru_wx[l], lru_bx[l], lru_lambda[l])
        ya_l = gmlp_spatial(ul, vl, gmlp_ln_g[l], gmlp_ln_b[l], gmlp_ws[l], gmlp_bs[l])
        yl = merge_branches(ya_l, lru_l * gbl, gal, grl, w_out_a[l], w_out_b[l], w_out[l])
        xl = xl + gt_t * rms_norm(yl, g_post_mix[l])
        if not last:
            ya_c = gmlp_spatial(uc, vc, gmlp_ln_g[l], gmlp_ln_b[l], gmlp_ws[l], gmlp_bs[l])
            yc = merge_branches(ya_c, lru_c * gbc, gac, grc, w_out_a[l], w_out_b[l], w_out[l])
            xc = xc + cgt_t * rms_norm(yc, g_post_mix[l])

        hl = rms_norm(xl, g_pre_ffn[l]) * (1.0 + sc_f) + sh_f
        fl = moe_ffn(hl, router_w[l], router_bias[l], exp_w_gate[l], exp_w_up[l], exp_w_down[l],
                     sh_w_gate[l], sh_w_up[l], sh_w_down[l])
        xl = xl + gt_f * rms_norm(fl, g_post_ffn[l])
        if not last:
            hc = rms_norm(xc, g_pre_ffn[l]) * (1.0 + csc_f) + csh_f
            fc = moe_ffn(hc, router_w[l], router_bias[l], exp_w_gate[l], exp_w_up[l], exp_w_down[l],
                         sh_w_gate[l], sh_w_up[l], sh_w_down[l])
            xc = xc + cgt_f * rms_norm(fc, g_post_ffn[l])
    return xl
```

```cpp
#include <hip/hip_runtime.h>
#include <stdint.h>
#include <math.h>

typedef unsigned short bf16_t;
#define DEV __device__ __forceinline__
#define LAS __attribute__((address_space(3)))
#define GAS __attribute__((address_space(1)))
typedef short bf16x8 __attribute__((ext_vector_type(8)));
typedef float f32x4 __attribute__((ext_vector_type(4)));
typedef unsigned u32x4 __attribute__((ext_vector_type(4)));
typedef unsigned u32x2 __attribute__((ext_vector_type(2)));

constexpr int D = 1024, NBATCH = 4, SEQ = 8192, CTXL = 256;
constexpr int TL = NBATCH * SEQ, TC = NBATCH * CTXL, R = TL + TC;
constexpr int NE = 64, CAP = R;
constexpr int NCHUNK = R / 128;
constexpr size_t MiB = 1u << 20;
constexpr size_t WS_CTL = 0;
constexpr size_t WS_MOD = 1 * MiB, WS_XC = 2 * MiB, WS_TOPI = 6 * MiB, WS_TOPW = 7 * MiB + MiB / 2, WS_LISTA = 9 * MiB, WS_SUMM = 18 * MiB, WS_LOG = 21 * MiB;
constexpr size_t WS_W = 30 * MiB;
constexpr size_t WS_RY = 142 * MiB;
constexpr size_t WS_Z = 208 * MiB;
constexpr size_t WS_HM = 208 * MiB;
constexpr size_t WS_SH = 274 * MiB;
constexpr size_t WS_SLOTS = 348 * MiB;
constexpr size_t WS_RA = 472 * MiB;
constexpr size_t WS_END = 612 * MiB;
constexpr size_t WO_IN = 0, WO_AB = 8 * MiB, WO_OUT = 10 * MiB, WO_SR = 12 * MiB  , WO_SD = 14 * MiB  , WO_LRU = 15 * MiB  ,
                 WO_GWS = 15 * MiB + MiB / 2  , WO_EG = 16 * MiB  , WO_ED = 80 * MiB  ;
constexpr int CW_CNT = 64;
constexpr int CW_BAR = 4096;

struct Params {
    const float *x, *c, *ctx, *c_ctx, *w_mod, *b_mod, *g_pre_mix, *g_post_mix, *g_pre_ffn, *g_post_ffn, *w_in, *ln_g, *ln_b, *gws, *gbs,
        *conv_w, *conv_b, *lru_wa, *lru_ba, *lru_wx, *lru_bx, *lru_lam, *w_out_a, *w_out_b, *w_out, *router_w, *router_b, *e_g, *e_u, *e_d, *s_g, *s_u, *s_d;
    float* out; unsigned char* ws;
};

DEV float bf2f(bf16_t v) { return __uint_as_float(((unsigned)v) << 16); }
DEV bf16_t f2bf(float f) { unsigned u = __float_as_uint(f); return (bf16_t)((u + 0x7fffu + ((u >> 16) & 1u)) >> 16); }
DEV unsigned pk2(float lo, float hi) { return (unsigned)f2bf(lo) | ((unsigned)f2bf(hi) << 16); }
DEV float sigmoidf_(float x) { return 1.f / (1.f + expf(-x)); }
DEV float siluf_(float x) { return x / (1.f + expf(-x)); }
DEV float gelu_tanh(float x) { return 0.5f * x * (1.f + tanhf(0.7978845608028654f * (x + 0.044715f * x * x * x))); }
DEV float fsigmoid(float x) { return __builtin_amdgcn_rcpf(1.f + __builtin_amdgcn_exp2f(-1.4426950408889634f * x)); }
DEV float fsilu(float x) { return x * fsigmoid(x); }
DEV float fgelu(float x) { const float u = 1.5957691216057308f * (x + 0.044715f * x * x * x); return x * fsigmoid(u); }
DEV float wave_sum(float v) {
#pragma unroll
    for (int o = 1; o < 64; o <<= 1) v += __shfl_xor(v, o);
    return v;
}
DEV const float* mod_ptr(const Params& p, int l, int cond, int j) { return (const float*)(p.ws + WS_MOD) + ((size_t)((l * 5 + cond) * 6 + j)) * D; }
DEV float* xl_row(const Params& p, int r) { return r < TL ? p.out + (size_t)r * D : (float*)(p.ws + WS_XC) + (size_t)(r - TL) * D; }
namespace pg8 {
constexpr int BM = 256, BK = 64, HALF = 128, HTB = HALF * BK * 2  , STAGE_BYTES = 8 * HTB;
DEV int lds_byte(int r, int c) { const int st = (r >> 4) * 2 + (c >> 5), rr = r & 15, cc = c & 31, ob = rr * 64 + cc * 2; return st * 1024 + (ob ^ (((ob >> 9) & 1) << 5)); }
DEV void stage_rc(int b, int& Rr, int& C) { const int st = b / 1024, sb = b % 1024, swz = sb ^ (((sb >> 9) & 1) << 5); Rr = (st >> 1) * 16 + swz / 64; C = (st & 1) * 32 + (swz % 64) / 2; }
DEV int perm32(int rho) { const int n = rho >> 4, i = rho & 15; return 8 * (i >> 2) + 4 * n + (i & 3); }
DEV unsigned cvt_pk_bf16(float lo, float hi) { unsigned r; asm volatile("v_cvt_pk_bf16_f32 %0, %1, %2" : "=v"(r) : "v"(lo), "v"(hi)); return r; }
DEV u32x4 pack8(const f32x4 v0, const f32x4 v1) { u32x4 w; w.x = cvt_pk_bf16(v0[0], v0[1]); w.y = cvt_pk_bf16(v0[2], v0[3]); w.z = cvt_pk_bf16(v1[0], v1[1]); w.w = cvt_pk_bf16(v1[2], v1[3]); return w; }
DEV void unpack8(const u32x4 w, f32x4& v0, f32x4& v1) {
    v0[0] = __uint_as_float(w.x << 16); v0[1] = __uint_as_float(w.x & 0xffff0000u); v0[2] = __uint_as_float(w.y << 16); v0[3] = __uint_as_float(w.y & 0xffff0000u);
    v1[0] = __uint_as_float(w.z << 16); v1[1] = __uint_as_float(w.z & 0xffff0000u); v1[2] = __uint_as_float(w.w << 16); v1[3] = __uint_as_float(w.w & 0xffff0000u);
}
DEV int xcd_remap(int L, int U) { const int q = U / 8, r = U % 8, xcd = L % 8, off = L / 8; return (xcd < r ? xcd * (q + 1) : r * (q + 1) + (xcd - r) * q) + off; }

struct UnitD { int pm, pn; };
struct DenseSched {
    typedef UnitD Unit;
    const bf16_t* A; const bf16_t* Bt; int nM, nN, nwg, G, c, K;
    DEV void init(const bf16_t* A_, const bf16_t* Bt_, int M, int N, int K_, int G_, int c_) { A = A_; Bt = Bt_; nM = M / BM; nN = N / BM; nwg = nM * nN; G = G_; c = c_; K = K_; }
    DEV bool next(int i, Unit& u) const {
        const int L = i * G + c; if (L >= nwg) return false;
        const int wgid = xcd_remap(L, nwg);
        const int nig = 8 * nN, gid = wgid / nig, fm = gid * 8, gsz = (nM - fm) < 8 ? (nM - fm) : 8;
        u.pm = fm + ((wgid % nig) % gsz); u.pn = (wgid % nig) / gsz; return true;
    }
    DEV const char* abase(const Unit& u) const { return (const char*)A + (size_t)u.pm * BM * K * 2; }
    DEV const char* bbase(const Unit& u) const { return (const char*)Bt + (size_t)u.pn * BM * K * 2; }
    DEV void aoffs(const Unit&, int tid, unsigned (&v)[2][2]) const {
#pragma unroll
        for (int i = 0; i < 2; ++i) { int Rr, C; stage_rc(tid * 16 + i * 8192, Rr, C);
#pragma unroll
            for (int h = 0; h < 2; ++h) v[h][i] = (unsigned)((h * HALF + Rr) * K + C) * 2u; }
    }
};
struct UnitE { int e, row0, cnt, hmrow0, pn; };
struct ExpSched {
    typedef UnitE Unit;
    const LAS int* toff;
    const int* lista;
    const bf16_t* A;
    const bf16_t* Bt; size_t bstride;
    int ncol, U, G, c, K, gather, brow0;
    DEV bool next(int i, Unit& u) const {
        const int L = i * G + c; if (L >= U) return false;
        const int id = xcd_remap(L, U), tile = id / ncol; u.pn = id % ncol;
        int e = 0;
        for (int k = 1; k < NE; ++k) e += (toff[k] <= tile) ? 1 : 0;
        u.e = e; u.row0 = (tile - toff[e]) * BM; u.cnt = toff[80 + e]; u.hmrow0 = tile * BM; return true;
    }
    DEV const char* abase(const Unit& u) const { return gather ? (const char*)A : (const char*)A + (size_t)u.hmrow0 * K * 2; }
    DEV const char* bbase(const Unit& u) const { return (const char*)Bt + (size_t)u.e * bstride + (size_t)(brow0 + u.pn * BM) * K * 2; }
    DEV void aoffs(const Unit& u, int tid, unsigned (&v)[2][2]) const {
        asm volatile("" : "+v"(tid));
#pragma unroll
        for (int i = 0; i < 2; ++i) { int Rr, C; stage_rc(tid * 16 + i * 8192, Rr, C);
#pragma unroll
            for (int h = 0; h < 2; ++h) {
                const int lr = h * HALF + Rr;
                if (gather) { const int rr = u.row0 + lr; const int tok = (rr < u.cnt) ? (lista[(size_t)u.e * CAP + rr] >> 3) : 0; v[h][i] = (unsigned)(tok * K + C) * 2u; }
                else v[h][i] = (unsigned)(lr * K + C) * 2u;
            } }
    }
};

typedef f32x4 Acc[2][2][4][2];
#define EPI_ROWS(ai, m) for (int ai = 0; ai < 2; ++ai) _Pragma("unroll") for (int m = 0; m < 4; ++m)

struct EpiZ {
    static constexpr bool HAS_MID = false; static constexpr int MID_T = 0;
    bf16_t* Z;
    DEV void mid(Acc&, const UnitD&, int, int, int, int) const {}
    DEV void operator()(const Acc& acc, const UnitD& u, int wr, int wc, int fr, int fq) const {
        const int act = (u.pn < 4) ? 1 : (u.pn < 6 ? 0 : (u.pn < 8 ? 1 : 2));
        const int row0 = u.pm * BM + wr * 64 + fr, col0 = u.pn * BM + wc * 32 + 8 * fq;
#pragma unroll
        EPI_ROWS(ai, m) { bf16_t* rowp = Z + (size_t)(row0 + ai * HALF + m * 16) * 4096 + col0;
#pragma unroll
            for (int bj = 0; bj < 2; ++bj) { f32x4 v0 = acc[ai][bj][m][0], v1 = acc[ai][bj][m][1];
                if (act == 1) {
#pragma unroll
                    for (int i = 0; i < 4; ++i) { v0[i] = fgelu(v0[i]); v1[i] = fgelu(v1[i]); }
                } else if (act == 2) {
#pragma unroll
                    for (int i = 0; i < 4; ++i) { v0[i] = fsigmoid(v0[i]); v1[i] = fsigmoid(v1[i]); }
                }
                *(u32x4*)(rowp + bj * HALF) = pack8(v0, v1); } }
    }
};
struct EpiAB {
    static constexpr bool HAS_MID = true; static constexpr int MID_T = 8;
    const bf16_t* Z; bf16_t* M;
    DEV void mid(Acc& acc, const UnitD& u, int wr, int wc, int fr, int fq) const {
        int oz = 0; asm volatile("" : "+v"(oz));
        const int row0 = u.pm * BM + wr * 64 + fr + oz, col0 = u.pn * BM + wc * 32 + 8 * fq;
#pragma unroll
        EPI_ROWS(ai, m) { const bf16_t* zr = Z + (size_t)(row0 + ai * HALF + m * 16) * 4096 + col0;
#pragma unroll
            for (int bj = 0; bj < 2; ++bj) { f32x4 a0, a1, r0, r1; unpack8(*(const u32x4*)(zr + 2048 + bj * HALF), a0, a1); unpack8(*(const u32x4*)(zr + 3072 + bj * HALF), r0, r1);
#pragma unroll
                for (int i = 0; i < 4; ++i) { acc[ai][bj][m][0][i] *= a0[i] * __builtin_amdgcn_rcpf(r0[i]); acc[ai][bj][m][1][i] *= a1[i] * __builtin_amdgcn_rcpf(r1[i]); } }
            asm volatile("" ::: "memory"); }
    }
    DEV void operator()(const Acc& acc, const UnitD& u, int wr, int wc, int fr, int fq) const {
        const int row0 = u.pm * BM + wr * 64 + fr, col0 = u.pn * BM + wc * 32 + 8 * fq;
#pragma unroll
        EPI_ROWS(ai, m) { const int row = row0 + ai * HALF + m * 16; const bf16_t* zr = Z + (size_t)row * 4096 + 3072 + col0; bf16_t* rowp = M + (size_t)row * D + col0;
#pragma unroll
            for (int bj = 0; bj < 2; ++bj) { f32x4 r0, r1; unpack8(*(const u32x4*)(zr + bj * HALF), r0, r1);
                *(u32x4*)(rowp + bj * HALF) = pack8(acc[ai][bj][m][0] * r0, acc[ai][bj][m][1] * r1); }
            asm volatile("" ::: "memory"); }
    }
};
struct EpiPlain {
    static constexpr bool HAS_MID = false; static constexpr int MID_T = 0;
    bf16_t* C; int ldc;
    DEV void mid(Acc&, const UnitD&, int, int, int, int) const {}
    DEV void operator()(const Acc& acc, const UnitD& u, int wr, int wc, int fr, int fq) const {
        const int row0 = u.pm * BM + wr * 64 + fr, col0 = u.pn * BM + wc * 32 + 8 * fq;
#pragma unroll
        EPI_ROWS(ai, m) { bf16_t* rowp = C + (size_t)(row0 + ai * HALF + m * 16) * ldc + col0;
#pragma unroll
            for (int bj = 0; bj < 2; ++bj) *(u32x4*)(rowp + bj * HALF) = pack8(acc[ai][bj][m][0], acc[ai][bj][m][1]); }
    }
};
struct EpiSR {
    static constexpr bool HAS_MID = false; static constexpr int MID_T = 0;
    float* LOG; bf16_t* SH;
    DEV void mid(Acc&, const UnitD&, int, int, int, int) const {}
    DEV void operator()(const Acc& acc, const UnitD& u, int wr, int wc, int fr, int fq) const {
        const int row0 = u.pm * BM + wr * 64 + fr;
        if (u.pn == 0) {
            if (wc < 2) {
#pragma unroll
                EPI_ROWS(ai, m) { float* rowp = LOG + (size_t)(row0 + ai * HALF + m * 16) * 64 + wc * 32 + 8 * fq;
                    *(f32x4*)(rowp) = acc[ai][0][m][0]; *(f32x4*)(rowp + 4) = acc[ai][0][m][1]; }
            }
        } else {
            const int j0 = (u.pn - 1) * HALF + wc * 32 + 8 * fq;
#pragma unroll
            EPI_ROWS(ai, m) { f32x4 v0, v1;
#pragma unroll
                for (int i = 0; i < 4; ++i) { v0[i] = fsilu(acc[ai][0][m][0][i]) * acc[ai][1][m][0][i]; v1[i] = fsilu(acc[ai][0][m][1][i]) * acc[ai][1][m][1][i]; }
                *(u32x4*)(SH + (size_t)(row0 + ai * HALF + m * 16) * 256 + j0) = pack8(v0, v1); }
        }
    }
};
struct EpiEG {
    static constexpr bool HAS_MID = false; static constexpr int MID_T = 0;
    bf16_t* HM;
    DEV void mid(Acc&, const UnitE&, int, int, int, int) const {}
    DEV void operator()(const Acc& acc, const UnitE& u, int wr, int wc, int fr, int fq) const {
        const int j0 = u.pn * HALF + wc * 32 + 8 * fq;
#pragma unroll
        EPI_ROWS(ai, m) { f32x4 v0, v1;
#pragma unroll
            for (int i = 0; i < 4; ++i) { v0[i] = fsilu(acc[ai][0][m][0][i]) * acc[ai][1][m][0][i]; v1[i] = fsilu(acc[ai][0][m][1][i]) * acc[ai][1][m][1][i]; }
            *(u32x4*)(HM + (size_t)(u.hmrow0 + ai * HALF + wr * 64 + m * 16 + fr) * 256 + j0) = pack8(v0, v1); }
    }
};
struct EpiED {
    static constexpr bool HAS_MID = false; static constexpr int MID_T = 0;
    bf16_t* SLOTS; const int* lista; const float* topw;
    DEV void mid(Acc&, const UnitE&, int, int, int, int) const {}
    DEV void operator()(const Acc& acc, const UnitE& u, int wr, int wc, int fr, int fq) const {
        const int col0 = u.pn * BM + wc * 32 + 8 * fq;
#pragma unroll
        EPI_ROWS(ai, m) { const int rr = u.row0 + ai * HALF + wr * 64 + m * 16 + fr;
            if (rr < u.cnt) { const int aid = lista[(size_t)u.e * CAP + rr]; const float w = topw[aid]; bf16_t* rowp = SLOTS + (size_t)aid * 512 + col0;
#pragma unroll
                for (int bj = 0; bj < 2; ++bj) *(u32x4*)(rowp + bj * HALF) = pack8(acc[ai][bj][m][0] * w, acc[ai][bj][m][1] * w); } }
    }
};

template <class Epi, class Sched, bool ALIGN_EPI>
DEV void gemm_phase(LAS unsigned char* lds, const int tid, const Sched& S, const Epi& E) {
    typedef typename Sched::Unit Unit;
    const int wid = __builtin_amdgcn_readfirstlane(tid >> 6), lane = tid & 63, wr = wid >> 2, wc = wid & 3, fr = lane & 15, fq = lane >> 4;
    const int K = S.K, nt = K / BK;
    unsigned voffB[2];
#pragma unroll
    for (int i = 0; i < 2; ++i) { int Rr, C; stage_rc(tid * 16 + i * 8192, Rr, C); const int Rb = (Rr & ~31) + perm32(Rr & 31); voffB[i] = (unsigned)(Rb * K + C) * 2u; }
    const size_t kstep = (size_t)(BK * 2);
    const size_t hstepB = (size_t)HALF * K * 2;
    const unsigned ldsw = (unsigned)wid * 1024u;
    const int aoff = lds_byte(wr * 64 + fr, fq * 8), boff = lds_byte(wc * 32 + fr, fq * 8);
#define PG8_SA(b, h) (((b) * 2 + (h)) * HTB)
#define PG8_SB(b, h) ((4 + (b) * 2 + (h)) * HTB)
#define PG8_STAGE2(bufoff, gbase, o0, o1) do { \
        __builtin_amdgcn_global_load_lds((const unsigned*)((const char*)(gbase) + (o0)), (LAS unsigned*)(lds + (bufoff) + ldsw), 16, 0, 0); \
        __builtin_amdgcn_global_load_lds((const unsigned*)((const char*)(gbase) + (o1)), (LAS unsigned*)(lds + (bufoff) + ldsw + 8192), 16, 0, 0); } while (0)
#define PG8_STAGEB(bufoff, gbase) PG8_STAGE2(bufoff, gbase, voffB[0], voffB[1])
#define PG8_LDA(dst, b, h) do { _Pragma("unroll") for (int m = 0; m < 4; ++m) _Pragma("unroll") for (int k = 0; k < 2; ++k) dst[m][k] = *(const LAS bf16x8*)(lds + PG8_SA(b, h) + aoff + m * 2048 + k * 1024); } while (0)
#define PG8_LDB(dst, b, h) do { _Pragma("unroll") for (int n = 0; n < 2; ++n) _Pragma("unroll") for (int k = 0; k < 2; ++k) dst[n][k] = *(const LAS bf16x8*)(lds + PG8_SB(b, h) + boff + n * 2048 + k * 1024); } while (0)
#define PG8_MMA(ai, bj, At, Bt) do { __builtin_amdgcn_s_setprio(1); _Pragma("unroll") for (int m = 0; m < 4; ++m) _Pragma("unroll") for (int n = 0; n < 2; ++n) _Pragma("unroll") for (int k = 0; k < 2; ++k) \
        acc[ai][bj][m][n] = __builtin_amdgcn_mfma_f32_16x16x32_bf16(Bt[n][k], At[m][k], acc[ai][bj][m][n], 0, 0, 0); __builtin_amdgcn_s_setprio(0); } while (0)
#define PG8_WAIT_V(n) asm volatile("s_waitcnt vmcnt(" #n ")" ::: "memory")
#define PG8_WAIT_L(n) asm volatile("s_waitcnt lgkmcnt(" #n ")" ::: "memory")
#define PG8_BAR __builtin_amdgcn_s_barrier()
#define PG8_SCHED __builtin_amdgcn_sched_barrier(0)
    Unit cur, nxt; int ui = 0;
    if (!S.next(0, cur)) return;
    Acc acc;
#pragma unroll
    for (int a = 0; a < 2; ++a)
#pragma unroll
        for (int b = 0; b < 2; ++b)
#pragma unroll
            for (int m = 0; m < 4; ++m)
#pragma unroll
                for (int n = 0; n < 2; ++n) acc[a][b][m][n] = (f32x4){0.f, 0.f, 0.f, 0.f};
    bf16x8 At[4][2], B0[2][2], B1[2][2];
    unsigned vA[2][2];
    S.aoffs(cur, tid, vA);
    const char* cA = S.abase(cur); const char* cB = S.bbase(cur);
    PG8_STAGEB(PG8_SB(0, 0), cB); PG8_STAGEB(PG8_SB(0, 1), cB + hstepB); PG8_STAGE2(PG8_SA(0, 0), cA, vA[0][0], vA[0][1]); PG8_STAGE2(PG8_SA(0, 1), cA, vA[1][0], vA[1][1]);
    if (wr == 1) PG8_BAR;
    PG8_WAIT_V(2); PG8_BAR;
    PG8_STAGEB(PG8_SB(1, 0), cB + kstep); PG8_STAGE2(PG8_SA(1, 0), cA + kstep, vA[0][0], vA[0][1]); PG8_STAGEB(PG8_SB(1, 1), cB + hstepB + kstep);
    PG8_WAIT_V(6); PG8_BAR;
    for (;;) {
        const bool has_next = S.next(ui + 1, nxt);
        const char* nA = cA; const char* nB = cB;
        if (has_next) { nA = S.abase(nxt); nB = S.bbase(nxt); }
        for (int t = 0; t < nt; t += 2) {
            const bool last = (t == nt - 2);
            if constexpr (Epi::HAS_MID) { if (t == Epi::MID_T) E.mid(acc, cur, wr, wc, fr, fq); }
            const char* a1 = cA + (size_t)(t + 1) * kstep;
            const char* a2 = last ? nA : cA + (size_t)(t + 2) * kstep; const char* b2 = last ? nB : cB + (size_t)(t + 2) * kstep;
            const char* a3 = a2 + kstep; const char* b3 = b2 + kstep;
            PG8_LDB(B0, 0, 0); PG8_LDB(B1, 0, 1); PG8_SCHED; PG8_LDA(At, 0, 0); PG8_STAGE2(PG8_SA(1, 1), a1, vA[1][0], vA[1][1]);
            if (last && has_next) S.aoffs(nxt, tid, vA);
            PG8_WAIT_V(8); PG8_WAIT_L(0); PG8_BAR; PG8_MMA(0, 0, At, B0); PG8_MMA(0, 1, At, B1); PG8_BAR; PG8_SCHED;
            PG8_LDA(At, 0, 1); PG8_STAGEB(PG8_SB(0, 0), b2); PG8_STAGEB(PG8_SB(0, 1), b2 + hstepB); PG8_STAGE2(PG8_SA(0, 0), a2, vA[0][0], vA[0][1]);
            PG8_WAIT_V(8); PG8_WAIT_L(0); PG8_BAR; PG8_MMA(1, 0, At, B0); PG8_MMA(1, 1, At, B1); PG8_BAR; PG8_SCHED;
            PG8_LDB(B0, 1, 0); PG8_LDB(B1, 1, 1); PG8_SCHED; PG8_LDA(At, 1, 0); PG8_STAGE2(PG8_SA(0, 1), a2, vA[1][0], vA[1][1]);
            PG8_WAIT_V(8); PG8_WAIT_L(0); PG8_BAR; PG8_MMA(0, 0, At, B0); PG8_MMA(0, 1, At, B1); PG8_BAR; PG8_SCHED;
            PG8_LDA(At, 1, 1); PG8_STAGEB(PG8_SB(1, 0), b3); PG8_STAGEB(PG8_SB(1, 1), b3 + hstepB); PG8_STAGE2(PG8_SA(1, 0), a3, vA[0][0], vA[0][1]);
            PG8_WAIT_V(8); PG8_WAIT_L(0); PG8_BAR; PG8_MMA(1, 0, At, B0); PG8_MMA(1, 1, At, B1); PG8_BAR; PG8_SCHED;
        }
        if constexpr (ALIGN_EPI) { if (wr == 0) PG8_BAR; }
        E(acc, cur, wr, wc, fr, fq);
        if (!has_next) break;
#pragma unroll
        for (int a = 0; a < 2; ++a)
#pragma unroll
            for (int b = 0; b < 2; ++b)
#pragma unroll
                for (int m = 0; m < 4; ++m)
#pragma unroll
                    for (int n = 0; n < 2; ++n) acc[a][b][m][n] = (f32x4){0.f, 0.f, 0.f, 0.f};
        cur = nxt; cA = nA; cB = nB; ++ui;
        if constexpr (ALIGN_EPI) { if (wr == 1) PG8_BAR; }
    }
    PG8_WAIT_V(0);
    if constexpr (!ALIGN_EPI) { if (wr == 0) PG8_BAR; }
    PG8_BAR;
#undef PG8_SA
#undef PG8_SB
#undef PG8_STAGE2
#undef PG8_STAGEB
#undef PG8_LDA
#undef PG8_LDB
#undef PG8_MMA
#undef PG8_WAIT_V
#undef PG8_WAIT_L
#undef PG8_BAR
#undef PG8_SCHED
}
}
constexpr int NWAVES = 8;
constexpr int RING_BYTES = 131072;
constexpr int MISC_OFF = RING_BYTES;
constexpr int LDS_BYTES = 147456;

#define XB_TMO      128
#define XB_XCNT(j)  (256  + 64 * (j))
#define XB_XSUB(j)  (1280 + 64 * (j))
#define XB_XGEN(j)  (2304 + 64 * (j))
#define XB_TOP      3328
#define XB_TOPGEN   3392
#define XCD_BAR_WORDS 3456
#define XB_SPIN_CAP (1u << 22)
DEV unsigned xb_ld(unsigned* p) { return __hip_atomic_load(p, __ATOMIC_RELAXED, __HIP_MEMORY_SCOPE_AGENT); }
DEV unsigned xb_add(unsigned* p, unsigned v) { return __hip_atomic_fetch_add(p, v, __ATOMIC_RELAXED, __HIP_MEMORY_SCOPE_AGENT); }
DEV unsigned xb_xcc_id() { return (unsigned)__builtin_amdgcn_s_getreg((3 << 11) | 20) & 0xFu; }
#define XB_SPIN(cond, bar) do { unsigned _sp = 0; while (cond) { __builtin_amdgcn_s_sleep(1); \
    if ((++_sp & 255u) == 0u) { if (xb_ld(&(bar)[XB_TMO])) break; if (_sp > XB_SPIN_CAP) { atomicAdd(&(bar)[XB_TMO], 1u); break; } } } } while (0)
struct XcdBarrier { unsigned* bar; unsigned x; volatile LAS unsigned* st; };
DEV XcdBarrier xcd_barrier_post(unsigned* bar, volatile LAS unsigned* st) {
    XcdBarrier b; b.bar = bar; b.x = xb_xcc_id(); b.st = st;
    if (threadIdx.x == 0) (void)xb_add(&bar[XB_XCNT(b.x)], 1u);
    return b;
}
DEV void xcd_barrier_complete(unsigned* bar, unsigned x, unsigned& nloc, unsigned& nx) {
    const unsigned G = gridDim.x * gridDim.y * gridDim.z;
    unsigned sum, cnt, mine, sp = 0u;
    for (;;) {
        sum = 0u; cnt = 0u; mine = 0u;
#pragma unroll
        for (unsigned j = 0; j < 16; ++j) { const unsigned c = xb_ld(&bar[XB_XCNT(j)]); sum += c; cnt += (c > 0u) ? 1u : 0u; mine = (j == x) ? c : mine; }
        if (sum == G) break;
        __builtin_amdgcn_s_sleep(1);
        if ((++sp & 255u) == 0u) { if (xb_ld(&bar[XB_TMO])) break; if (sp > XB_SPIN_CAP) { atomicAdd(&bar[XB_TMO], 1u); break; } }
    }
    nloc = mine > 0u ? mine : 1u; nx = cnt > 0u ? cnt : 1u;
}
DEV void xcd_barrier(const XcdBarrier& b) {
    asm volatile("s_waitcnt vmcnt(0)" ::: "memory");
    __syncthreads();
    if (threadIdx.x == 0) {
        unsigned* bar = b.bar;
        __builtin_amdgcn_s_waitcnt(0);
        unsigned nloc = b.st[0], nx = b.st[1];
        if (nloc == 0u) { xcd_barrier_complete(bar, b.x, nloc, nx); b.st[0] = nloc; b.st[1] = nx; }
        const unsigned old = xb_add(&bar[XB_XSUB(b.x)], 1u);
        const unsigned gen = old / nloc;
        if (old + 1u == (gen + 1u) * nloc) {
            __builtin_amdgcn_fence(__ATOMIC_RELEASE, "agent");
            asm volatile("s_waitcnt vmcnt(0)" ::: "memory");
            const unsigned og = xb_add(&bar[XB_TOP], 1u);
            const unsigned tg = og / nx;
            if (og + 1u == (tg + 1u) * nx) xb_add(&bar[XB_TOPGEN], 1u);
            else XB_SPIN(xb_ld(&bar[XB_TOPGEN]) == tg, bar);
            __builtin_amdgcn_fence(__ATOMIC_ACQUIRE, "agent");
            xb_add(&bar[XB_XGEN(b.x)], 1u);
            asm volatile("s_waitcnt vmcnt(0)" ::: "memory");
        } else {
            XB_SPIN(xb_ld(&bar[XB_XGEN(b.x)]) == gen, bar);
            __builtin_amdgcn_fence(__ATOMIC_ACQUIRE, "agent");
            asm volatile("s_waitcnt vmcnt(0)" ::: "memory");
        }
    }
    __syncthreads();
}

struct Frame { LAS unsigned char* lds; unsigned char* ldsg; int tid, lane, wave, G, bx; };

DEV void transpose_item(const float* W, int N, bf16_t* WT, int dK, int koff, int rbase, int rhi, LAS float* scr, int kb, int nb, int lane) {
    const int k0 = 64 * kb, n0 = 32 * nb;
#pragma unroll 8
    for (int i = 0; i < 32; ++i) { const int kk = 2 * i + (lane >> 5); scr[kk * 33 + (lane & 31)] = W[(size_t)(k0 + kk) * N + n0 + (lane & 31)]; }
    asm volatile("s_waitcnt lgkmcnt(0)" ::: "memory");
    const int cc = lane & 7;
#pragma unroll
    for (int j = 0; j < 4; ++j) { const int nl = (lane >> 3) + 8 * j, n = n0 + nl; const LAS float* s = scr + (8 * cc) * 33 + nl;
        u32x4 o; o.x = pk2(s[0 * 33], s[1 * 33]); o.y = pk2(s[2 * 33], s[3 * 33]); o.z = pk2(s[4 * 33], s[5 * 33]); o.w = pk2(s[6 * 33], s[7 * 33]);
        const int drow = rbase + (n >> 7) * rhi + (n & 127);
        *(u32x4*)(WT + (size_t)drow * dK + koff + k0 + 8 * cc) = o; }
    asm volatile("s_waitcnt lgkmcnt(0)" ::: "memory");
}
DEV void convert_weights(const Params& p, const Frame& F, int l) {
    LAS float* scr = (LAS float*)(F.lds + F.wave * 16384);
    unsigned char* W = p.ws + WS_W;
    const int gw = F.bx * NWAVES + F.wave, NGW = F.G * NWAVES, lane = F.lane;
    constexpr int I_IN = 16 * 128, I_OA = 8 * 32, I_OUT = 16 * 32, I_RT = 16 * 2, I_SG = 16 * 8, I_SD = 4 * 32, I_EG = NE * 16 * 8, I_ED = NE * 4 * 32, I_LRU = 32 * 2;
    constexpr int NITEMS = I_IN + 2 * I_OA + I_OUT + I_RT + 2 * I_SG + I_SD + 2 * I_EG + I_ED + I_LRU;
    for (int it = gw; it < NITEMS; it += NGW) {
        int r = it;
        if (r < I_IN) { transpose_item(p.w_in + (size_t)l * D * 4096, 4096, (bf16_t*)(W + WO_IN), D, 0, 0, 128, scr, r / 128, r % 128, lane); continue; } r -= I_IN;
        if (r < I_OA) { transpose_item(p.w_out_a + (size_t)l * 512 * D, D, (bf16_t*)(W + WO_AB), D, 0, 0, 128, scr, r / 32, r % 32, lane); continue; } r -= I_OA;
        if (r < I_OA) { transpose_item(p.w_out_b + (size_t)l * 512 * D, D, (bf16_t*)(W + WO_AB), D, 512, 0, 128, scr, r / 32, r % 32, lane); continue; } r -= I_OA;
        if (r < I_OUT) { transpose_item(p.w_out + (size_t)l * D * D, D, (bf16_t*)(W + WO_OUT), D, 0, 0, 128, scr, r / 32, r % 32, lane); continue; } r -= I_OUT;
        if (r < I_RT) { transpose_item(p.router_w + (size_t)l * D * 64, 64, (bf16_t*)(W + WO_SR), D, 0, 0, 128, scr, r / 2, r % 2, lane); continue; } r -= I_RT;
        if (r < I_SG) { transpose_item(p.s_g + (size_t)l * D * 256, 256, (bf16_t*)(W + WO_SR), D, 0, 256, 256, scr, r / 8, r % 8, lane); continue; } r -= I_SG;
        if (r < I_SG) { transpose_item(p.s_u + (size_t)l * D * 256, 256, (bf16_t*)(W + WO_SR), D, 0, 256 + 128, 256, scr, r / 8, r % 8, lane); continue; } r -= I_SG;
        if (r < I_SD) { transpose_item(p.s_d + (size_t)l * 256 * D, D, (bf16_t*)(W + WO_SD), 256, 0, 0, 128, scr, r / 32, r % 32, lane); continue; } r -= I_SD;
        if (r < I_EG) { const int e = r / 128, q = r % 128; transpose_item(p.e_g + ((size_t)(l * NE + e) * D) * 256, 256, (bf16_t*)(W + WO_EG) + (size_t)e * 512 * D, D, 0, 0, 256, scr, q / 8, q % 8, lane); continue; } r -= I_EG;
        if (r < I_EG) { const int e = r / 128, q = r % 128; transpose_item(p.e_u + ((size_t)(l * NE + e) * D) * 256, 256, (bf16_t*)(W + WO_EG) + (size_t)e * 512 * D, D, 0, 128, 256, scr, q / 8, q % 8, lane); continue; } r -= I_EG;
        if (r < I_ED) { const int e = r / 128, q = r % 128; transpose_item(p.e_d + ((size_t)(l * NE + e) * 256) * D, D, (bf16_t*)(W + WO_ED) + (size_t)e * D * 256, 256, 0, 0, 128, scr, q / 32, q % 32, lane); continue; } r -= I_ED;
        { const int mat = r / 2, nb = r % 2, type = mat >> 4, dh = mat & 15;
          const float* src = (type ? p.lru_wx : p.lru_wa) + (size_t)((l * 2) * 8 + dh) * 4096;
          transpose_item(src, 64, (bf16_t*)(W + WO_LRU) + (size_t)mat * 4096, 64, 0, 0, 128, scr, 0, nb, lane); }
    }
    const int gt = F.bx * NWAVES * 64 + F.tid, NT = F.G * NWAVES * 64;
    for (int i = gt; i < 192 * D / 8; i += NT) *(u32x4*)((bf16_t*)(W + WO_SR) + (size_t)64 * D + (size_t)i * 8) = (u32x4){0u, 0u, 0u, 0u};
    for (int i = gt; i < 8 * 128 * 128 / 4; i += NT) { const float4 v = *(const float4*)(p.gws + (size_t)l * 8 * 128 * 128 + (size_t)i * 4);
        u32x2 o; o.x = pk2(v.x, v.y); o.y = pk2(v.z, v.w); *(u32x2*)((bf16_t*)(W + WO_GWS) + (size_t)i * 4) = o; }
}
DEV void mod_items(const Params& p, const Frame& F) {
    LAS float* part = (LAS float*)(F.lds);
    for (int it = F.bx; it < 2 * 96; it += F.G) {
        const int l = it / 96, e = (it % 96) * 64 + F.lane;
        const float* w = p.w_mod + (size_t)l * D * 6 * D + e;
        float acc[5] = {0.f, 0.f, 0.f, 0.f, 0.f};
        const int d0 = F.wave * 128;
#pragma unroll 8
        for (int d = d0; d < d0 + 128; ++d) { const float wv = w[(size_t)d * 6 * D];
#pragma unroll
            for (int cnd = 0; cnd < 5; ++cnd) { const float cv = cnd < 4 ? p.c[cnd * D + d] : p.c_ctx[d]; acc[cnd] += siluf_(cv) * wv; } }
#pragma unroll
        for (int cnd = 0; cnd < 5; ++cnd) part[(F.wave * 5 + cnd) * 64 + F.lane] = acc[cnd];
        __syncthreads();
        if (F.tid < 320) { const int cnd = F.tid >> 6, ln = F.tid & 63; float s = p.b_mod[l * 6 * D + (it % 96) * 64 + ln];
#pragma unroll
            for (int w8 = 0; w8 < 8; ++w8) s += part[(w8 * 5 + cnd) * 64 + ln];
            ((float*)(p.ws + WS_MOD))[(size_t)(l * 5 + cnd) * 6 * D + (it % 96) * 64 + ln] = s; }
        __syncthreads();
    }
}

DEV void row_pass_A(const Params& p, int l, int wave, int nw, int lane) {
    const int nrows = (l == 2) ? TL : R;
    const bf16_t* FL = (const bf16_t*)(p.ws + WS_RY);
    bf16_t* H = (bf16_t*)(p.ws + WS_RA);
    for (int r = wave; r < nrows; r += nw) {
        float* xr = xl_row(p, r);
        const int cond = r < TL ? (r >> 13) : 4;
        float v[16];
        if (l == 0) {
            const float* src = r < TL ? p.x + (size_t)r * D : p.ctx + (size_t)(r - TL) * D;
#pragma unroll
            for (int j = 0; j < 4; ++j) { const float4 t = *(const float4*)(src + (j * 64 + lane) * 4); v[4 * j] = t.x; v[4 * j + 1] = t.y; v[4 * j + 2] = t.z; v[4 * j + 3] = t.w; }
            if (r < TL) {
                const int t = r & (SEQ - 1); const float prow = (float)(t >> 6), pcol = (float)(t & 63);
#pragma unroll
                for (int j = 0; j < 4; ++j)
#pragma unroll
                    for (int i = 0; i < 4; ++i) {
                        const int d = (j * 64 + lane) * 4 + i, sec = d >> 8, q = d & 255;
                        const float omega = 1.0f / powf(10000.0f, (float)q / 256.0f);
                        const float ang = ((sec < 2) ? prow : pcol) * omega;
                        v[4 * j + i] += (sec & 1) ? cosf(ang) : sinf(ang);
                    }
            }
        } else {
            float f[16]; float ss = 0.f;
#pragma unroll
            for (int j = 0; j < 4; ++j) {
                const float4 t = *(const float4*)(xr + (j * 64 + lane) * 4); v[4 * j] = t.x; v[4 * j + 1] = t.y; v[4 * j + 2] = t.z; v[4 * j + 3] = t.w;
                const ushort4 fb = *(const ushort4*)(FL + (size_t)r * D + (j * 64 + lane) * 4);
                f[4 * j] = bf2f(fb.x); f[4 * j + 1] = bf2f(fb.y); f[4 * j + 2] = bf2f(fb.z); f[4 * j + 3] = bf2f(fb.w);
            }
#pragma unroll
            for (int i = 0; i < 16; ++i) ss += f[i] * f[i];
            const float rstd = rsqrtf(wave_sum(ss) * (1.f / D) + 1e-6f);
            const float* gt = mod_ptr(p, l - 1, cond, 5); const float* g = p.g_post_ffn + (l - 1) * D;
#pragma unroll
            for (int j = 0; j < 4; ++j) { const float4 gt4 = *(const float4*)(gt + (j * 64 + lane) * 4), g4 = *(const float4*)(g + (j * 64 + lane) * 4);
                v[4 * j] += gt4.x * (f[4 * j] * rstd * g4.x); v[4 * j + 1] += gt4.y * (f[4 * j + 1] * rstd * g4.y); v[4 * j + 2] += gt4.z * (f[4 * j + 2] * rstd * g4.z); v[4 * j + 3] += gt4.w * (f[4 * j + 3] * rstd * g4.w); }
        }
#pragma unroll
        for (int j = 0; j < 4; ++j) *(float4*)(xr + (j * 64 + lane) * 4) = make_float4(v[4 * j], v[4 * j + 1], v[4 * j + 2], v[4 * j + 3]);
        if (l < 2) {
            float ss = 0.f;
#pragma unroll
            for (int i = 0; i < 16; ++i) ss += v[i] * v[i];
            const float rstd = rsqrtf(wave_sum(ss) * (1.f / D) + 1e-6f);
            const float* sh = mod_ptr(p, l, cond, 0); const float* sc = mod_ptr(p, l, cond, 1); const float* g = p.g_pre_mix + l * D;
#pragma unroll
            for (int j = 0; j < 4; ++j) { const int d = (j * 64 + lane) * 4; const float4 sh4 = *(const float4*)(sh + d), sc4 = *(const float4*)(sc + d), g4 = *(const float4*)(g + d);
                u32x2 o; o.x = pk2(v[4 * j] * rstd * g4.x * (1.f + sc4.x) + sh4.x, v[4 * j + 1] * rstd * g4.y * (1.f + sc4.y) + sh4.y);
                o.y = pk2(v[4 * j + 2] * rstd * g4.z * (1.f + sc4.z) + sh4.z, v[4 * j + 3] * rstd * g4.w * (1.f + sc4.w) + sh4.w);
                *(u32x2*)(H + (size_t)r * D + d) = o; }
        }
    }
}
DEV void row_pass_H(const Params& p, int l, int nrows, int wave, int nw, int lane) {
    const bf16_t* YL = (const bf16_t*)(p.ws + WS_Z);
    bf16_t* H = (bf16_t*)(p.ws + WS_RA);
    for (int r = wave; r < nrows; r += nw) {
        float* xr = xl_row(p, r);
        const int cond = r < TL ? (r >> 13) : 4;
        float v[16], f[16]; float ss = 0.f;
#pragma unroll
        for (int j = 0; j < 4; ++j) {
            const float4 t = *(const float4*)(xr + (j * 64 + lane) * 4); v[4 * j] = t.x; v[4 * j + 1] = t.y; v[4 * j + 2] = t.z; v[4 * j + 3] = t.w;
            const ushort4 fb = *(const ushort4*)(YL + (size_t)r * D + (j * 64 + lane) * 4);
            f[4 * j] = bf2f(fb.x); f[4 * j + 1] = bf2f(fb.y); f[4 * j + 2] = bf2f(fb.z); f[4 * j + 3] = bf2f(fb.w);
        }
#pragma unroll
        for (int i = 0; i < 16; ++i) ss += f[i] * f[i];
        const float rstd = rsqrtf(wave_sum(ss) * (1.f / D) + 1e-6f);
        const float* gt = mod_ptr(p, l, cond, 2); const float* g = p.g_post_mix + l * D;
#pragma unroll
        for (int j = 0; j < 4; ++j) { const float4 gt4 = *(const float4*)(gt + (j * 64 + lane) * 4), g4 = *(const float4*)(g + (j * 64 + lane) * 4);
            v[4 * j] += gt4.x * (f[4 * j] * rstd * g4.x); v[4 * j + 1] += gt4.y * (f[4 * j + 1] * rstd * g4.y); v[4 * j + 2] += gt4.z * (f[4 * j + 2] * rstd * g4.z); v[4 * j + 3] += gt4.w * (f[4 * j + 3] * rstd * g4.w); }
#pragma unroll
        for (int j = 0; j < 4; ++j) *(float4*)(xr + (j * 64 + lane) * 4) = make_float4(v[4 * j], v[4 * j + 1], v[4 * j + 2], v[4 * j + 3]);
        float s2 = 0.f;
#pragma unroll
        for (int i = 0; i < 16; ++i) s2 += v[i] * v[i];
        const float rstd2 = rsqrtf(wave_sum(s2) * (1.f / D) + 1e-6f);
        const float* sh = mod_ptr(p, l, cond, 3); const float* sc = mod_ptr(p, l, cond, 4); const float* g2 = p.g_pre_ffn + l * D;
#pragma unroll
        for (int j = 0; j < 4; ++j) { const int d = (j * 64 + lane) * 4; const float4 sh4 = *(const float4*)(sh + d), sc4 = *(const float4*)(sc + d), g4 = *(const float4*)(g2 + d);
            u32x2 o; o.x = pk2(v[4 * j] * rstd2 * g4.x * (1.f + sc4.x) + sh4.x, v[4 * j + 1] * rstd2 * g4.y * (1.f + sc4.y) + sh4.y);
            o.y = pk2(v[4 * j + 2] * rstd2 * g4.z * (1.f + sc4.z) + sh4.z, v[4 * j + 3] * rstd2 * g4.w * (1.f + sc4.w) + sh4.w);
            *(u32x2*)(H + (size_t)r * D + d) = o; }
    }
}

DEV void route_token(const Params& p, int l, int r, int lane, int& myi, float& myw) {
    const float* LOG = (const float*)(p.ws + WS_LOG);
    const float s = sigmoidf_(LOG[(size_t)r * 64 + lane]);
    const float sel = s + p.router_b[l * 64 + lane];
    int rank = 0;
#pragma unroll
    for (int k = 1; k < 8; ++k) { const float o = __shfl_xor(sel, k); const int ol = lane ^ k; rank += (o > sel || (o == sel && ol < lane)) ? 1 : 0; }
    float gs = rank < 2 ? sel : 0.f;
    gs += __shfl_xor(gs, 1); gs += __shfl_xor(gs, 2); gs += __shfl_xor(gs, 4);
    const int g = lane >> 3; int grank = 0;
#pragma unroll
    for (int k = 1; k < 8; ++k) { const float o = __shfl_xor(gs, 8 * k); const int og = g ^ k; grank += (o > gs || (o == gs && og < g)) ? 1 : 0; }
    float mv = grank < 4 ? sel : -INFINITY;
    float wsum = 0.f; myw = 0.f; myi = 0;
    for (int s8 = 0; s8 < 8; ++s8) {
        float mx = mv;
#pragma unroll
        for (int o = 32; o >= 1; o >>= 1) mx = fmaxf(mx, __shfl_xor(mx, o));
        const unsigned long long bal = __ballot(mv == mx);
        const int win = __ffsll((long long)bal) - 1;
        const float sw = __shfl(s, win);
        if (lane == s8) { myi = win; myw = sw; }
        wsum += sw;
        if (lane == win) mv = -INFINITY;
    }
    myw = myw / wsum * 2.5f;
}
DEV void route_pass(const Params& p, const Frame& F, int l, int nrows) {
    int* hist = (int*)(F.ldsg); int* base = hist + 64; int* loc = hist + 128;
    int* TOPI = (int*)(p.ws + WS_TOPI); float* TOPW = (float*)(p.ws + WS_TOPW); int* LISTA = (int*)(p.ws + WS_LISTA);
    unsigned* CNT = (unsigned*)(p.ws + WS_CTL) + CW_CNT + l * 64;
    const int rpw = nrows / F.G, r0 = F.bx * rpw;
    if (F.tid < 64) hist[F.tid] = 0;
    __syncthreads();
    for (int i = F.wave; i < rpw; i += NWAVES) {
        int myi; float myw; route_token(p, l, r0 + i, F.lane, myi, myw);
        if (F.lane < 8) { TOPI[(size_t)(r0 + i) * 8 + F.lane] = myi; TOPW[(size_t)(r0 + i) * 8 + F.lane] = myw;
            const int rk = atomicAdd(&hist[myi], 1); loc[i * 8 + F.lane] = (myi << 16) | rk; }
    }
    __syncthreads();
    if (F.tid < 64) base[F.tid] = (int)__hip_atomic_fetch_add(CNT + F.tid, (unsigned)hist[F.tid], __ATOMIC_RELAXED, __HIP_MEMORY_SCOPE_AGENT);
    __syncthreads();
    for (int idx = F.tid; idx < rpw * 8; idx += NWAVES * 64) { const int v = loc[idx], e = v >> 16, rk = v & 0xffff;
        LISTA[(size_t)e * CAP + base[e] + rk] = (r0 + (idx >> 3)) * 8 + (idx & 7); }
    __syncthreads();
}
DEV void combine_pass(const Params& p, int hf, int nrows, int wave, int nw, int lane) {
    bf16_t* FS = (bf16_t*)(p.ws + WS_RY); const bf16_t* SL = (const bf16_t*)(p.ws + WS_SLOTS);
    for (int r = wave; r < nrows; r += nw) {
        bf16_t* fp = FS + (size_t)r * D + hf * 512 + lane * 8;
        f32x4 a0, a1; pg8::unpack8(*(const u32x4*)fp, a0, a1);
        u32x4 sv[8];
#pragma unroll
        for (int s = 0; s < 8; ++s) sv[s] = *(const u32x4*)(SL + ((size_t)r * 8 + s) * 512 + lane * 8);
#pragma unroll
        for (int s = 0; s < 8; ++s) { f32x4 b0, b1; pg8::unpack8(sv[s], b0, b1); a0 += b0; a1 += b1; }
        *(u32x4*)fp = pg8::pack8(a0, a1);
    }
}
DEV size_t summ_idx(int dir, int b, int pos, int which, int ch) { return ((((size_t)dir * 4 + b) * 66 + pos) * 2 + which) * 512 + ch; }
DEV f32x4 mfma16(bf16x8 a, bf16x8 b, f32x4 c) { return __builtin_amdgcn_mfma_f32_16x16x32_bf16(a, b, c, 0, 0, 0); }

template <int PASS>
DEV void chunk_pass(const Params& p, const Frame& F, int l_in, int c, bool do_gmlp) {
    int oz = 0; asm volatile("" : "+s"(oz));
    const int l = l_in + oz;
    const int lane = F.lane, h = F.wave, fr = lane & 15, fq = lane >> 4;
    const bf16_t* Z = (const bf16_t*)(p.ws + WS_Z); bf16_t* Y = (bf16_t*)(p.ws + WS_RY); float* SUMM = (float*)(p.ws + WS_SUMM);
    const unsigned char* W = p.ws + WS_W + oz;
    int r0, t0, n, b, posf, posb;
    if (c < 256) { b = c >> 6; const int k = c & 63; r0 = b * SEQ + k * 128; t0 = k * 128; n = SEQ; posf = 2 + k; posb = 2 + (63 - k); }
    else { const int cc = c - 256; b = cc >> 1; const int k = cc & 1; r0 = TL + b * CTXL + k * 128; t0 = k * 128; n = CTXL; posf = k; posb = 1 - k; }
    {
        LAS bf16_t* xcs = (LAS bf16_t*)(F.lds + h * 16384);
        {
            const int cg = lane & 7, rsub = lane >> 3, ch0 = h * 64 + cg * 8;
            float w[4][8], cb[8];
#pragma unroll
            for (int k = 0; k < 4; ++k) { const float4 a = *(const float4*)(p.conv_w + (size_t)(l * 4 + k) * 512 + ch0), bb = *(const float4*)(p.conv_w + (size_t)(l * 4 + k) * 512 + ch0 + 4);
                w[k][0] = a.x; w[k][1] = a.y; w[k][2] = a.z; w[k][3] = a.w; w[k][4] = bb.x; w[k][5] = bb.y; w[k][6] = bb.z; w[k][7] = bb.w; }
            { const float4 a = *(const float4*)(p.conv_b + l * 512 + ch0), bb = *(const float4*)(p.conv_b + l * 512 + ch0 + 4);
                cb[0] = a.x; cb[1] = a.y; cb[2] = a.z; cb[3] = a.w; cb[4] = bb.x; cb[5] = bb.y; cb[6] = bb.z; cb[7] = bb.w; }
#pragma unroll 2
            for (int it = 0; it < 16; ++it) {
                const int tl = it * 8 + rsub;
                float y[8];
#pragma unroll
                for (int j = 0; j < 8; ++j) y[j] = cb[j];
#pragma unroll
                for (int k = 0; k < 4; ++k) { const int tt = t0 + tl + k - 2;
                    if (tt >= 0 && tt < n) { const u32x4 raw = *(const u32x4*)(Z + (size_t)(r0 + tl + k - 2) * 4096 + 1024 + ch0); f32x4 x0, x1; pg8::unpack8(raw, x0, x1);
#pragma unroll
                        for (int j = 0; j < 4; ++j) { y[j] += w[k][j] * x0[j]; y[4 + j] += w[k][4 + j] * x1[j]; } } }
                *(LAS u32x4*)(xcs + tl * 64 + cg * 8) = pg8::pack8((f32x4){y[0], y[1], y[2], y[3]}, (f32x4){y[4], y[5], y[6], y[7]});
            }
        }
        asm volatile("s_waitcnt lgkmcnt(0)" ::: "memory");
        float carry0 = 0.f, carry1 = 0.f;
        if (PASS == 1) {
            const int chl = h * 64 + lane;
            for (int q = 0; q < posf; ++q) { const float a = SUMM[summ_idx(0, b, q, 0, chl)], hh = SUMM[summ_idx(0, b, q, 1, chl)]; carry0 = a * carry0 + hh; }
            for (int q = 0; q < posb; ++q) { const float a = SUMM[summ_idx(1, b, q, 0, chl)], hh = SUMM[summ_idx(1, b, q, 1, chl)]; carry1 = a * carry1 + hh; }
        }
#pragma unroll 1
        for (int ct = 0; ct < 4; ++ct) {
            const int chc = h * 64 + ct * 16 + fr;
#pragma unroll
            for (int dir = 0; dir < 2; ++dir) {
                const bf16_t* wa = (const bf16_t*)(W + WO_LRU) + (size_t)(0 * 16 + dir * 8 + h) * 4096 + (size_t)(ct * 16 + fr) * 64 + 8 * fq;
                const bf16_t* wx = (const bf16_t*)(W + WO_LRU) + (size_t)(1 * 16 + dir * 8 + h) * 4096 + (size_t)(ct * 16 + fr) * 64 + 8 * fq;
                const bf16x8 ba0 = *(const bf16x8*)(wa), ba1 = *(const bf16x8*)(wa + 32), bx0 = *(const bf16x8*)(wx), bx1 = *(const bf16x8*)(wx + 32);
                const float bias_a = p.lru_ba[(l * 2 + dir) * 512 + chc], bias_x = p.lru_bx[(l * 2 + dir) * 512 + chc];
                const float lam = p.lru_lam[(l * 2 + dir) * 512 + chc];
                const float spc = -8.0f * log1pf(expf(-lam)) * 1.4426950408889634f;
                float Hrun = 0.f, Arun = 1.f;
                if (PASS == 1) Hrun = __shfl(dir ? carry1 : carry0, ct * 16 + fr);
                const int mypos = dir ? 3 - fq : fq;
#pragma unroll 1
                for (int rr = 0; rr < 8; ++rr) {
                    const int rt = dir ? 7 - rr : rr;
                    const bf16x8 f0 = *(const LAS bf16x8*)(xcs + (rt * 16 + fr) * 64 + 8 * fq), f1 = *(const LAS bf16x8*)(xcs + (rt * 16 + fr) * 64 + 32 + 8 * fq);
                    f32x4 aa = {0.f, 0.f, 0.f, 0.f}, ax = {0.f, 0.f, 0.f, 0.f};
                    aa = mfma16(f0, ba0, aa); aa = mfma16(f1, ba1, aa);
                    ax = mfma16(f0, bx0, ax); ax = mfma16(f1, bx1, ax);
                    float av[4], dv[4];
#pragma unroll
                    for (int i = 0; i < 4; ++i) {
                        const float xc = bf2f(xcs[(rt * 16 + 4 * fq + i) * 64 + ct * 16 + fr]);
                        const float rg = fsigmoid(aa[i] + bias_a), ig = fsigmoid(ax[i] + bias_x);
                        const float a = __builtin_amdgcn_exp2f(spc * rg);
                        av[i] = a; dv[i] = __builtin_amdgcn_sqrtf(fmaxf(1.f - a * a, 0.f)) * (ig * xc);
                    }
                    float Al = 1.f, Hl = 0.f;
#pragma unroll
                    for (int s = 0; s < 4; ++s) { const int i = dir ? 3 - s : s; Hl = av[i] * Hl + dv[i]; Al = av[i] * Al; }
                    float Ap = 1.f, Hp = 0.f, At = 1.f, Ht = 0.f;
#pragma unroll
                    for (int s = 0; s < 4; ++s) { const int g = dir ? 3 - s : s; const float Ag = __shfl(Al, fr + 16 * g), Hg = __shfl(Hl, fr + 16 * g);
                        Ht = Ag * Ht + Hg; At = Ag * At;
                        const bool before = s < mypos; Hp = before ? Ag * Hp + Hg : Hp; Ap = before ? Ag * Ap : Ap; }
                    if (PASS == 1) {
                        float hc = Ap * Hrun + Hp; float hv[4];
#pragma unroll
                        for (int s = 0; s < 4; ++s) { const int i = dir ? 3 - s : s; hc = av[i] * hc + dv[i]; hv[i] = hc; }
#pragma unroll
                        for (int i = 0; i < 4; ++i) { const size_t row = (size_t)(r0 + rt * 16 + 4 * fq + i); bf16_t* yp = Y + row * D + 512 + chc;
                            if (dir == 0) *yp = f2bf(hv[i]);
                            else *yp = f2bf((bf2f(*yp) + hv[i]) * bf2f(Z[row * 4096 + 1536 + chc])); }
                    }
                    Hrun = At * Hrun + Ht; Arun = At * Arun;
                }
                if (PASS == 0 && fq == 0) { const int pos = dir ? posb : posf; SUMM[summ_idx(dir, b, pos, 0, chc)] = Arun; SUMM[summ_idx(dir, b, pos, 1, chc)] = Hrun; }
            }
        }
    }
    if (PASS == 0 && do_gmlp) {
        typedef float f32x2 __attribute__((ext_vector_type(2)));
        __syncthreads();
        LAS f32x2* stats = (LAS f32x2*)F.lds;
#pragma unroll 1
        for (int i = 0; i < 16; ++i) { const int tl = F.wave * 16 + i;
            f32x4 v0, v1; pg8::unpack8(*(const u32x4*)(Z + (size_t)(r0 + tl) * 4096 + 512 + lane * 8), v0, v1);
            const float mu = wave_sum((v0[0] + v0[1]) + (v0[2] + v0[3]) + (v1[0] + v1[1]) + (v1[2] + v1[3])) * (1.f / 512.f);
            v0 -= mu; v1 -= mu;
            const float var = wave_sum((v0[0] * v0[0] + v0[1] * v0[1]) + (v0[2] * v0[2] + v0[3] * v0[3]) + (v1[0] * v1[0] + v1[1] * v1[1]) + (v1[2] * v1[2] + v1[3] * v1[3])) * (1.f / 512.f);
            if (lane == 0) stats[tl] = (f32x2){mu, rsqrtf(var + 1e-5f)}; }
        __syncthreads();
        const int g = F.wave;
        const bf16_t* Wg = (const bf16_t*)(W + WO_GWS) + (size_t)g * 128 * 128;
#pragma unroll 1
        for (int ct = 0; ct < 4; ++ct) {
            const int ch = g * 64 + ct * 16 + fr;
            const float lng = p.ln_g[l * 512 + ch], lnb = p.ln_b[l * 512 + ch];
            bf16x8 bfr[4];
#pragma unroll
            for (int ks = 0; ks < 4; ++ks) { float vv[8];
#pragma unroll
                for (int j = 0; j < 8; ++j) { const int q = ks * 32 + 8 * fq + j; const f32x2 st = stats[q];
                    vv[j] = (bf2f(Z[(size_t)(r0 + q) * 4096 + 512 + ch]) - st.x) * st.y * lng + lnb; }
                const u32x4 pk = pg8::pack8((f32x4){vv[0], vv[1], vv[2], vv[3]}, (f32x4){vv[4], vv[5], vv[6], vv[7]});
                bfr[ks] = __builtin_bit_cast(bf16x8, pk); }
#pragma unroll 1
            for (int rt = 0; rt < 8; ++rt) {
                f32x4 acc = {0.f, 0.f, 0.f, 0.f};
#pragma unroll
                for (int ks = 0; ks < 4; ++ks) { const bf16x8 af = *(const bf16x8*)(Wg + (size_t)(rt * 16 + fr) * 128 + ks * 32 + 8 * fq); acc = mfma16(af, bfr[ks], acc); }
#pragma unroll
                for (int i = 0; i < 4; ++i) { const int pp = rt * 16 + 4 * fq + i; const size_t row = (size_t)(r0 + pp);
                    const float val = acc[i] + p.gbs[(l * 8 + g) * 128 + pp];
                    Y[row * D + ch] = f2bf(bf2f(Z[row * 4096 + ch]) * val); }
            }
        }
    }
    __syncthreads();
}
constexpr int NPL = 15, PH_FINAL = 1 + 2 * NPL, PH_END = PH_FINAL + 1;
struct Args { Params p; int ph_lo, ph_hi; };

DEV void build_toff(const Params& p, const Frame& F, int l, LAS int* toff) {
    if (F.tid == 0) { const unsigned* CNT = (const unsigned*)(p.ws + WS_CTL) + CW_CNT + l * 64; int acc = 0;
        for (int e = 0; e < NE; ++e) { const int cn = (int)__hip_atomic_load(CNT + e, __ATOMIC_RELAXED, __HIP_MEMORY_SCOPE_AGENT); toff[e] = acc; toff[80 + e] = cn; acc += (cn + 255) >> 8; }
        toff[64] = acc; }
    __syncthreads();
}

DEV void run_phase(const Params& p, const Frame& F0, int ph) {
    Frame F = F0; asm volatile("" : "+v"(F.tid)); F.lane = F.tid & 63;
    asm volatile("" : "+s"(F.G), "+s"(F.bx));
    unsigned char* ws = p.ws; asm volatile("" : "+s"(ws)); unsigned char* W = ws + WS_W;
    LAS int* toff = (LAS int*)(F.lds + MISC_OFF + 256);
    const int gw = F.bx * NWAVES + F.wave, NGW = F.G * NWAVES;
#ifndef NOPRO
    if (ph >= 100) { convert_weights(p, F, ph - 100); return; }
    if (ph == 0) { mod_items(p, F); __syncthreads(); convert_weights(p, F, 0); return; }
    if (ph == PH_FINAL) { row_pass_A(p, 2, gw, NGW, F.lane); return; }
#endif
    const int l = (ph - 1) / NPL, k = (ph - 1) % NPL;
    const int nr = (l == 0) ? R : TL;
#ifndef PMASK
#define PMASK 0xffff
#endif
#define PON(k_) ((PMASK >> (k_)) & 1)
    switch (k) {
    case 0: if (PON(0)) { if (l > 0) convert_weights(p, F, l); row_pass_A(p, l, gw, NGW, F.lane); } break;
    case 1: if (PON(1)) { pg8::DenseSched S; S.init((const bf16_t*)(ws + WS_RA), (const bf16_t*)(W + WO_IN), R, 4096, D, F.G, F.bx); pg8::EpiZ E{(bf16_t*)(ws + WS_Z)};
        pg8::gemm_phase<pg8::EpiZ, pg8::DenseSched, true>(F.lds, F.tid, S, E); } break;
    case 2: if (PON(2)) for (int c = F.bx; c < NCHUNK; c += F.G) chunk_pass<0>(p, F, l, c, l == 0 || c < 256); break;
    case 3: if (PON(3)) for (int c = F.bx; c < (l == 0 ? NCHUNK : 256); c += F.G) chunk_pass<1>(p, F, l, c, false); break;
    case 4: if (PON(4)) { pg8::DenseSched S; S.init((const bf16_t*)(ws + WS_RY), (const bf16_t*)(W + WO_AB), nr, D, D, F.G, F.bx); pg8::EpiAB E{(const bf16_t*)(ws + WS_Z), (bf16_t*)(ws + WS_RA)};
        pg8::gemm_phase<pg8::EpiAB, pg8::DenseSched, true>(F.lds, F.tid, S, E); } break;
    case 5: if (PON(5)) { pg8::DenseSched S; S.init((const bf16_t*)(ws + WS_RA), (const bf16_t*)(W + WO_OUT), nr, D, D, F.G, F.bx); pg8::EpiPlain E{(bf16_t*)(ws + WS_Z), D};
        pg8::gemm_phase<pg8::EpiPlain, pg8::DenseSched, true>(F.lds, F.tid, S, E); } break;
    case 6: if (PON(6)) row_pass_H(p, l, nr, gw, NGW, F.lane); break;
    case 7: if (PON(7)) { pg8::DenseSched S; S.init((const bf16_t*)(ws + WS_RA), (const bf16_t*)(W + WO_SR), nr, 768, D, F.G, F.bx); pg8::EpiSR E{(float*)(ws + WS_LOG), (bf16_t*)(ws + WS_SH)};
        pg8::gemm_phase<pg8::EpiSR, pg8::DenseSched, true>(F.lds, F.tid, S, E); } break;
    case 8: if (PON(8)) route_pass(p, F, l, nr); break;
    case 9: if (PON(9)) { pg8::DenseSched S; S.init((const bf16_t*)(ws + WS_SH), (const bf16_t*)(W + WO_SD), nr, D, 256, F.G, F.bx); pg8::EpiPlain E{(bf16_t*)(ws + WS_RY), D};
        pg8::gemm_phase<pg8::EpiPlain, pg8::DenseSched, true>(F.lds, F.tid, S, E); } break;
    case 10: if (PON(10)) { build_toff(p, F, l, toff);
        pg8::ExpSched S; S.toff = toff; S.lista = (const int*)(ws + WS_LISTA); S.A = (const bf16_t*)(ws + WS_RA); S.Bt = (const bf16_t*)(W + WO_EG); S.bstride = (size_t)512 * D * 2;
        S.ncol = 2; S.U = toff[64] * 2; S.G = F.G; S.c = F.bx; S.K = D; S.gather = 1; S.brow0 = 0;
        pg8::EpiEG E{(bf16_t*)(ws + WS_HM)};
        pg8::gemm_phase<pg8::EpiEG, pg8::ExpSched, true>(F.lds, F.tid, S, E); } break;
    case 11: case 13: if (PON(11)) { build_toff(p, F, l, toff); const int hf = (k == 13);
        pg8::ExpSched S; S.toff = toff; S.lista = (const int*)(ws + WS_LISTA); S.A = (const bf16_t*)(ws + WS_HM); S.Bt = (const bf16_t*)(W + WO_ED); S.bstride = (size_t)D * 256 * 2;
        S.ncol = 2; S.U = toff[64] * 2; S.G = F.G; S.c = F.bx; S.K = 256; S.gather = 0; S.brow0 = hf * 512;
        pg8::EpiED E{(bf16_t*)(ws + WS_SLOTS), (const int*)(ws + WS_LISTA), (const float*)(ws + WS_TOPW)};
        pg8::gemm_phase<pg8::EpiED, pg8::ExpSched, true>(F.lds, F.tid, S, E); } break;
    case 12: case 14: if (PON(12)) combine_pass(p, k == 14, nr, gw, NGW, F.lane); break;
    }
}

__global__ void __launch_bounds__(NWAVES * 64, 2) mk_fwd(Args a) {
    extern __shared__ __attribute__((aligned(16))) unsigned char lds_raw[];
    Frame F; F.lds = (LAS unsigned char*)lds_raw; F.ldsg = lds_raw; F.tid = threadIdx.x; F.lane = F.tid & 63; F.wave = __builtin_amdgcn_readfirstlane(F.tid >> 6); F.G = gridDim.x; F.bx = blockIdx.x;
    volatile LAS unsigned* MISC = (volatile LAS unsigned*)(F.lds + MISC_OFF);
    for (int u = F.tid; u < (LDS_BYTES - MISC_OFF) / 4; u += NWAVES * 64) MISC[u] = 0u;
    __syncthreads();
    XcdBarrier bar; bar.bar = (unsigned*)(a.p.ws + WS_CTL) + CW_BAR; bar.x = 0; bar.st = nullptr;
    const bool multi = a.ph_hi - a.ph_lo > 1;
    if (multi) bar = xcd_barrier_post((unsigned*)(a.p.ws + WS_CTL) + CW_BAR, MISC);
    for (int ph = a.ph_lo; ph < a.ph_hi; ++ph) {
        run_phase(a.p, F, ph);
        if (ph + 1 < a.ph_hi) xcd_barrier(bar);
    }
}
#ifndef FAST
#define FAST 0x1ff
#endif
#if FAST != 0x1ff
constexpr size_t WS_NV1 = 538 * MiB;
constexpr size_t WS_NSG = 291 * MiB, WS_NFLS = 324 * MiB;
__global__ void __launch_bounds__(256) k_mod(Params p) {
    const int e = blockIdx.x * 256 + threadIdx.x, cond = blockIdx.y, l = blockIdx.z;
    const float* cv = cond < 4 ? p.c + cond * D : p.c_ctx;
    const float* w = p.w_mod + (size_t)l * D * 6 * D;
    float acc = p.b_mod[l * 6 * D + e];
    for (int d = 0; d < D; ++d) acc += siluf_(cv[d]) * w[(size_t)d * 6 * D + e];
    ((float*)(p.ws + WS_MOD))[(size_t)(l * 5 + cond) * 6 * D + e] = acc;
}
__global__ void __launch_bounds__(256) k_rowA(Params p, int l) { row_pass_A(p, l, (blockIdx.x * 256 + threadIdx.x) >> 6, (gridDim.x * 256) >> 6, threadIdx.x & 63); }
__global__ void __launch_bounds__(256) k_rowH(Params p, int l, int nrows) { row_pass_H(p, l, nrows, (blockIdx.x * 256 + threadIdx.x) >> 6, (gridDim.x * 256) >> 6, threadIdx.x & 63); }
struct ABf16 { const bf16_t* A; int lda, coff; DEV float operator()(int m, int k) const { return bf2f(A[(size_t)m * lda + coff + k]); } };
struct BF32 { const float* B; int ldb, pad; DEV float operator()(int k, int n) const { return B[(size_t)k * ldb + n]; } };
struct BAB { const float* Ba; const float* Bb; DEV float operator()(int k, int n) const { return k < 512 ? Ba[(size_t)k * D + n] : Bb[(size_t)(k - 512) * D + n]; } };
struct NEpiZ { bf16_t* Z; DEV void operator()(int m, int n, float v, float) const {
    float o; if (n < 1024) o = gelu_tanh(v); else if (n < 1536) o = v; else if (n < 2048) o = gelu_tanh(v); else o = sigmoidf_(v);
    Z[(size_t)m * 4096 + n] = f2bf(o); } };
struct NEpiF32 { float* C; int ldc, pad; DEV void operator()(int m, int n, float v, float) const { C[(size_t)m * ldc + n] = v; } };
struct NEpiBf { bf16_t* C; int ldc, pad; DEV void operator()(int m, int n, float v, float) const { C[(size_t)m * ldc + n] = f2bf(v); } };
struct NEpiMerge { const bf16_t* Z; bf16_t* M; DEV void operator()(int m, int n, float vb, float va) const {
    const float ga = bf2f(Z[(size_t)m * 4096 + 2048 + n]), gr = bf2f(Z[(size_t)m * 4096 + 3072 + n]);
    M[(size_t)m * D + n] = f2bf(ga * va + gr * vb); } };
struct NEpiSwi { const float* SG; bf16_t* SH; DEV void operator()(int m, int n, float v, float) const { SH[(size_t)m * 256 + n] = f2bf(siluf_(SG[(size_t)m * 256 + n]) * v); } };
template <class AL, class BL, class EP, int SPLIT>
__global__ void __launch_bounds__(256) k_gemm(AL al, BL bl, EP ep, int K) {
    __shared__ __attribute__((aligned(16))) float As[16][68];
    __shared__ __attribute__((aligned(16))) float Bs[16][68];
    const int tid = threadIdx.x, tx = tid & 15, ty = tid >> 4, m0 = blockIdx.y * 64, n0 = blockIdx.x * 64;
    float acc[4][4], acc2[4][4];
#pragma unroll
    for (int i = 0; i < 4; ++i)
#pragma unroll
        for (int j = 0; j < 4; ++j) { acc[i][j] = 0.f; acc2[i][j] = 0.f; }
    for (int k0 = 0; k0 < K; k0 += 16) {
        if (SPLIT && k0 == SPLIT) {
#pragma unroll
            for (int i = 0; i < 4; ++i)
#pragma unroll
                for (int j = 0; j < 4; ++j) { acc2[i][j] = acc[i][j]; acc[i][j] = 0.f; }
        }
#pragma unroll
        for (int i = 0; i < 4; ++i) { const int e = tid + 256 * i, kk = e & 15, mm = e >> 4; As[kk][mm] = al(m0 + mm, k0 + kk); }
#pragma unroll
        for (int i = 0; i < 4; ++i) { const int e = tid + 256 * i, nn = e & 63, kk = e >> 6; Bs[kk][nn] = bl(k0 + kk, n0 + nn); }
        __syncthreads();
#pragma unroll
        for (int kk = 0; kk < 16; ++kk) {
            const float4 a = *(const float4*)&As[kk][ty * 4]; const float4 b = *(const float4*)&Bs[kk][tx * 4];
            const float av[4] = {a.x, a.y, a.z, a.w}, bv[4] = {b.x, b.y, b.z, b.w};
#pragma unroll
            for (int i = 0; i < 4; ++i)
#pragma unroll
                for (int j = 0; j < 4; ++j) acc[i][j] += av[i] * bv[j];
        }
        __syncthreads();
    }
#pragma unroll
    for (int i = 0; i < 4; ++i)
#pragma unroll
        for (int j = 0; j < 4; ++j) ep(m0 + ty * 4 + i, n0 + tx * 4 + j, acc[i][j], acc2[i][j]);
}
__global__ void __launch_bounds__(256) k_conv(Params p, int l) {
    const size_t idx = (size_t)blockIdx.x * 256 + threadIdx.x; const int r = (int)(idx >> 9), ch = (int)(idx & 511);
    const bf16_t* Z = (const bf16_t*)(p.ws + WS_Z); float* XCONV = (float*)(p.ws + WS_NV1);
    int t, n; if (r < TL) { t = r & (SEQ - 1); n = SEQ; } else { t = (r - TL) & (CTXL - 1); n = CTXL; }
    const int base = r - t;
    float y = p.conv_b[l * 512 + ch];
#pragma unroll
    for (int k = 0; k < 4; ++k) { const int tt = t + k - 2; if (tt >= 0 && tt < n) y += p.conv_w[(l * 4 + k) * 512 + ch] * bf2f(Z[(size_t)(base + tt) * 4096 + 1024 + ch]); }
    XCONV[(size_t)r * 512 + ch] = y;
}
__global__ void __launch_bounds__(64) k_scan(Params p, int l, int dir) {
    const int b = blockIdx.x >> 3, h = blockIdx.x & 7, j = threadIdx.x, ch = h * 64 + j;
    const float* XCONV = (const float*)(p.ws + WS_NV1); float* HS = (float*)(p.ws + WS_RA);
    const float* wa = p.lru_wa + (size_t)((l * 2 + dir) * 8 + h) * 4096; const float* wx = p.lru_wx + (size_t)((l * 2 + dir) * 8 + h) * 4096;
    float wac[64], wxc[64];
#pragma unroll
    for (int i = 0; i < 64; ++i) { wac[i] = wa[i * 64 + j]; wxc[i] = wx[i * 64 + j]; }
    const float ba = p.lru_ba[(l * 2 + dir) * 512 + ch], bx = p.lru_bx[(l * 2 + dir) * 512 + ch];
    const float sp = log1pf(expf(-p.lru_lam[(l * 2 + dir) * 512 + ch]));
    float hst = 0.f;
    for (int step = 0; step < CTXL + SEQ; ++step) {
        int r;
        if (dir == 0) r = step < CTXL ? TL + b * CTXL + step : b * SEQ + (step - CTXL);
        else r = step < CTXL ? TL + b * CTXL + (CTXL - 1 - step) : b * SEQ + (SEQ - 1 - (step - CTXL));
        const float* xr = XCONV + (size_t)r * 512 + h * 64;
        float pr = ba, px = bx;
#pragma unroll
        for (int i = 0; i < 16; ++i) { const float4 xv = *(const float4*)(xr + 4 * i);
            pr += xv.x * wac[4 * i] + xv.y * wac[4 * i + 1] + xv.z * wac[4 * i + 2] + xv.w * wac[4 * i + 3];
            px += xv.x * wxc[4 * i] + xv.y * wxc[4 * i + 1] + xv.z * wxc[4 * i + 2] + xv.w * wxc[4 * i + 3]; }
        const float rg = sigmoidf_(pr), ig = sigmoidf_(px);
        const float log_a = -8.0f * rg * sp;
        const float a = expf(log_a), drv = sqrtf(-expm1f(2.0f * log_a)) * (ig * xr[j]);
        hst = a * hst + drv;
        if (dir == 0) HS[(size_t)r * 512 + ch] = hst; else HS[(size_t)r * 512 + ch] += hst;
    }
}
__global__ void __launch_bounds__(256) k_yb(Params p) {
    const size_t idx = (size_t)blockIdx.x * 256 + threadIdx.x; const int r = (int)(idx >> 9), ch = (int)(idx & 511);
    const bf16_t* Z = (const bf16_t*)(p.ws + WS_Z); const float* HS = (const float*)(p.ws + WS_RA); bf16_t* Y = (bf16_t*)(p.ws + WS_RY);
    Y[(size_t)r * D + 512 + ch] = f2bf(HS[(size_t)r * 512 + ch] * bf2f(Z[(size_t)r * 4096 + 1536 + ch]));
}
__global__ void __launch_bounds__(256) k_ln(Params p, int l, int nrows) {
    const int lane = threadIdx.x & 63, wave = (blockIdx.x * 256 + threadIdx.x) >> 6, nw = (gridDim.x * 256) >> 6;
    const bf16_t* Z = (const bf16_t*)(p.ws + WS_Z); float* VN = (float*)(p.ws + WS_NV1);
    for (int r = wave; r < nrows; r += nw) {
        float v[8]; float s = 0.f;
#pragma unroll
        for (int i = 0; i < 8; ++i) { v[i] = bf2f(Z[(size_t)r * 4096 + 512 + i * 64 + lane]); s += v[i]; }
        const float mu = wave_sum(s) * (1.f / 512.f); float q = 0.f;
#pragma unroll
        for (int i = 0; i < 8; ++i) { v[i] -= mu; q += v[i] * v[i]; }
        const float rstd = rsqrtf(wave_sum(q) * (1.f / 512.f) + 1e-5f);
#pragma unroll
        for (int i = 0; i < 8; ++i) { const int cch = i * 64 + lane; VN[(size_t)r * 512 + cch] = v[i] * rstd * p.ln_g[l * 512 + cch] + p.ln_b[l * 512 + cch]; }
    }
}
__global__ void __launch_bounds__(256) k_mix(Params p, int l) {
    const size_t idx = (size_t)blockIdx.x * 256 + threadIdx.x; const int r = (int)(idx >> 9), ch = (int)(idx & 511), g = ch >> 6;
    const bf16_t* Z = (const bf16_t*)(p.ws + WS_Z); const float* VN = (const float*)(p.ws + WS_NV1); bf16_t* Y = (bf16_t*)(p.ws + WS_RY);
    const int base = r & ~127, pp = r & 127;
    const float* w = p.gws + ((size_t)(l * 8 + g) * 128 + pp) * 128;
    float acc = p.gbs[(l * 8 + g) * 128 + pp];
    for (int q = 0; q < 128; ++q) acc += w[q] * VN[(size_t)(base + q) * 512 + ch];
    Y[(size_t)r * D + ch] = f2bf(bf2f(Z[(size_t)r * 4096 + ch]) * acc);
}
__global__ void __launch_bounds__(256) k_route(Params p, int l, int nrows) {
    const int lane = threadIdx.x & 63, wave = (blockIdx.x * 256 + threadIdx.x) >> 6, nw = (gridDim.x * 256) >> 6;
    int* TOPI = (int*)(p.ws + WS_TOPI); float* TOPW = (float*)(p.ws + WS_TOPW);
    for (int r = wave; r < nrows; r += nw) { int myi; float myw; route_token(p, l, r, lane, myi, myw);
        if (lane < 8) { TOPI[(size_t)r * 8 + lane] = myi; TOPW[(size_t)r * 8 + lane] = myw; } }
}
__global__ void __launch_bounds__(256) k_routed(Params p, int l) {
    __shared__ float hs[D]; __shared__ float hm[256];
    const int r = blockIdx.x, tid = threadIdx.x;
    const bf16_t* H2 = (const bf16_t*)(p.ws + WS_RA); const int* TOPI = (const int*)(p.ws + WS_TOPI); const float* TOPW = (const float*)(p.ws + WS_TOPW);
    const float* FLs = (const float*)(p.ws + WS_NFLS); bf16_t* FL = (bf16_t*)(p.ws + WS_RY);
#pragma unroll
    for (int i = 0; i < 4; ++i) hs[tid + 256 * i] = bf2f(H2[(size_t)r * D + tid + 256 * i]);
    float acc[4] = {0.f, 0.f, 0.f, 0.f};
    __syncthreads();
    for (int s = 0; s < 8; ++s) {
        const int e = TOPI[(size_t)r * 8 + s]; const float w = TOPW[(size_t)r * 8 + s];
        const float* wg = p.e_g + ((size_t)(l * NE + e) * D) * 256; const float* wu = p.e_u + ((size_t)(l * NE + e) * D) * 256;
        float g = 0.f, u = 0.f;
        for (int k = 0; k < D; ++k) { const float hv = hs[k]; g += hv * wg[(size_t)k * 256 + tid]; u += hv * wu[(size_t)k * 256 + tid]; }
        hm[tid] = siluf_(g) * u;
        __syncthreads();
        const float* wd = p.e_d + ((size_t)(l * NE + e) * 256) * D;
        float o[4] = {0.f, 0.f, 0.f, 0.f};
        for (int j = 0; j < 256; ++j) { const float hv = hm[j];
#pragma unroll
            for (int i = 0; i < 4; ++i) o[i] += hv * wd[(size_t)j * D + tid + 256 * i]; }
#pragma unroll
        for (int i = 0; i < 4; ++i) acc[i] += w * o[i];
        __syncthreads();
    }
#pragma unroll
    for (int i = 0; i < 4; ++i) FL[(size_t)r * D + tid + 256 * i] = f2bf(FLs[(size_t)r * D + tid + 256 * i] + acc[i]);
}
template <int SPLIT, class AL, class BL, class EP>
static void ngemm(hipStream_t st, int M, int N, int K, AL al, BL bl, EP ep) { hipLaunchKernelGGL((k_gemm<AL, BL, EP, SPLIT>), dim3(N / 64, M / 64), dim3(256), 0, st, al, bl, ep, K); }
#endif

static void mk(hipStream_t st, const Params& p, int lo, int hi) { Args a{}; a.p = p; a.ph_lo = lo; a.ph_hi = hi; hipLaunchKernelGGL(mk_fwd, dim3(256), dim3(NWAVES * 64), LDS_BYTES, st, a); }

extern "C" void kernel_launch(void* const* d_in, const int* in_sizes, int n_in, void* d_out, int out_size, void* d_ws, size_t ws_size, hipStream_t stream) {
    static int ready = 0;
    if (ready == 0) {
        ready = -1;
        if (n_in != 33 || ws_size < WS_END || out_size != TL * D) return;
        int dev = 0, cus = 0;
        if (hipGetDevice(&dev) != hipSuccess || hipDeviceGetAttribute(&cus, hipDeviceAttributeMultiprocessorCount, dev) != hipSuccess || cus < 256) return;
        if (hipFuncSetAttribute((const void*)mk_fwd, hipFuncAttributeMaxDynamicSharedMemorySize, LDS_BYTES) != hipSuccess) return;
        ready = 1;
    }
    if (ready < 0) return;
    Params p{};
    const float** pp = (const float**)&p;
    for (int i = 0; i < 33; ++i) pp[i] = (const float*)d_in[i];
    p.out = (float*)d_out; p.ws = (unsigned char*)d_ws;
    (void)hipMemsetAsync((char*)d_ws + WS_CTL, 0, 1 * MiB, stream);
#if FAST == 0x1ff && !defined(MK_PER_PHASE)
    mk(stream, p, 0, PH_END);
#elif FAST == 0x1ff
    for (int ph = 0; ph < PH_END; ++ph) mk(stream, p, ph, ph + 1);
#else
    unsigned char* ws = p.ws;
    bf16_t* RA = (bf16_t*)(ws + WS_RA); bf16_t* Z = (bf16_t*)(ws + WS_Z); bf16_t* RY = (bf16_t*)(ws + WS_RY);
    float* LOG = (float*)(ws + WS_LOG); float* SG = (float*)(ws + WS_NSG); bf16_t* SH = (bf16_t*)(ws + WS_SH); float* FLs = (float*)(ws + WS_NFLS);
    mk(stream, p, 0, 1);
    if (!(FAST & 1)) hipLaunchKernelGGL(k_mod, dim3(24, 5, 2), dim3(256), 0, stream, p);
    for (int l = 0; l < 2; ++l) {
        const int nr = (l == 0) ? R : TL, b0 = 1 + l * NPL;
        if (FAST & 2) mk(stream, p, b0 + 0, b0 + 1); else { if (l > 0) mk(stream, p, 100 + l, 101 + l); hipLaunchKernelGGL(k_rowA, dim3(2048), dim3(256), 0, stream, p, l); }
        if (FAST & 4) mk(stream, p, b0 + 1, b0 + 2); else ngemm<0>(stream, R, 4096, D, ABf16{RA, D, 0}, BF32{p.w_in + (size_t)l * D * 4096, 4096, 0}, NEpiZ{Z});
        if (FAST & 8) { mk(stream, p, b0 + 2, b0 + 3); mk(stream, p, b0 + 3, b0 + 4); }
        else {
            hipLaunchKernelGGL(k_conv, dim3(R * 512 / 256), dim3(256), 0, stream, p, l);
            for (int dir = 0; dir < 2; ++dir) hipLaunchKernelGGL(k_scan, dim3(NBATCH * 8), dim3(64), 0, stream, p, l, dir);
            hipLaunchKernelGGL(k_yb, dim3(nr * 512 / 256), dim3(256), 0, stream, p);
            hipLaunchKernelGGL(k_ln, dim3(2048), dim3(256), 0, stream, p, l, nr);
            hipLaunchKernelGGL(k_mix, dim3(nr * 512 / 256), dim3(256), 0, stream, p, l);
        }
        if (FAST & 16) mk(stream, p, b0 + 4, b0 + 5); else ngemm<512>(stream, nr, D, D, ABf16{RY, D, 0}, BAB{p.w_out_a + (size_t)l * 512 * D, p.w_out_b + (size_t)l * 512 * D}, NEpiMerge{Z, RA});
        if (FAST & 32) mk(stream, p, b0 + 5, b0 + 6); else ngemm<0>(stream, nr, D, D, ABf16{RA, D, 0}, BF32{p.w_out + (size_t)l * D * D, D, 0}, NEpiBf{Z, D, 0});
        if (FAST & 64) mk(stream, p, b0 + 6, b0 + 7); else hipLaunchKernelGGL(k_rowH, dim3(2048), dim3(256), 0, stream, p, l, nr);
        if (FAST & 128) { mk(stream, p, b0 + 7, b0 + 8); mk(stream, p, b0 + 8, b0 + 9); }
        else {
            ngemm<0>(stream, nr, 64, D, ABf16{RA, D, 0}, BF32{p.router_w + (size_t)l * D * 64, 64, 0}, NEpiF32{LOG, 64, 0});
            hipLaunchKernelGGL(k_route, dim3(2048), dim3(256), 0, stream, p, l, nr);
            ngemm<0>(stream, nr, 256, D, ABf16{RA, D, 0}, BF32{p.s_g + (size_t)l * D * 256, 256, 0}, NEpiF32{SG, 256, 0});
            ngemm<0>(stream, nr, 256, D, ABf16{RA, D, 0}, BF32{p.s_u + (size_t)l * D * 256, 256, 0}, NEpiSwi{SG, SH});
        }
        if (FAST & 256) { for (int k = 9; k < NPL; ++k) mk(stream, p, b0 + k, b0 + k + 1); }
        else {
            ngemm<0>(stream, nr, D, 256, ABf16{SH, 256, 0}, BF32{p.s_d + (size_t)l * 256 * D, D, 0}, NEpiF32{FLs, D, 0});
            hipLaunchKernelGGL(k_routed, dim3(nr), dim3(256), 0, stream, p, l);
        }
    }
    if (FAST & 2) mk(stream, p, PH_FINAL, PH_END); else hipLaunchKernelGGL(k_rowA, dim3(2048), dim3(256), 0, stream, p, 2);
#endif
}
```

```cpp
#include <hip/hip_runtime.h>
#include <stdint.h>
#include <math.h>

#ifndef GIN_FP8
#define GIN_FP8 1
#endif
#ifndef GED_FP8
#define GED_FP8 1
#endif
typedef unsigned short bf16_t;
#define DEV __device__ __forceinline__
#define LAS __attribute__((address_space(3)))
#define GAS __attribute__((address_space(1)))
typedef short bf16x8 __attribute__((ext_vector_type(8)));
typedef float f32x4 __attribute__((ext_vector_type(4)));
typedef unsigned u32x4 __attribute__((ext_vector_type(4)));
typedef unsigned u32x2 __attribute__((ext_vector_type(2)));

constexpr int D = 1024, NBATCH = 4, SEQ = 8192, CTXL = 256;
constexpr int TL = NBATCH * SEQ, TC = NBATCH * CTXL, R = TL + TC;
constexpr int NE = 64, CAP = R;
constexpr int NCHUNK = R / 128;
constexpr size_t MiB = 1u << 20;
constexpr size_t WS_CTL = 0;
constexpr size_t WS_PE = 1 * MiB + 512 * 1024  ;
constexpr size_t WS_MOD = 1 * MiB, WS_H8 = 2 * MiB  , WS_LISTA = 6 * MiB  , WS_LISTW = 15 * MiB  , WS_SUMM = 24 * MiB, WS_LOG = 27 * MiB;
constexpr size_t WS_TOPI = WS_LOG, WS_TOPW = WS_LOG;
constexpr size_t WS_W = 36 * MiB;
constexpr size_t WS_XC = 84 * MiB;
constexpr size_t WS_RY = 148 * MiB;
constexpr size_t WS_Z = 214 * MiB;
constexpr size_t WS_HM = 214 * MiB;
constexpr size_t WS_SH = 354 * MiB;
constexpr size_t WS_SLOTS = 354 * MiB;
constexpr size_t WS_RA = 478 * MiB;
constexpr size_t WS_LR = 478 * MiB;
constexpr size_t WS_XCT = 478 * MiB;
constexpr size_t WS_H2E = 544 * MiB;
constexpr size_t WS_END = 618 * MiB;
constexpr size_t WO_IN = 0, WO_AB = 8 * MiB, WO_OUT = 10 * MiB, WO_SR = 12 * MiB  , WO_SD = 14 * MiB  , WO_LRU = 15 * MiB  ,
                 WO_GWS = 15 * MiB + MiB / 2  , WO_EG = 16 * MiB  , WO_ED = 80 * MiB  ;
constexpr int CW_CNT = 64;
constexpr int CW_BAR = 4096;

struct Params {
    const float *x, *c, *ctx, *c_ctx, *w_mod, *b_mod, *g_pre_mix, *g_post_mix, *g_pre_ffn, *g_post_ffn, *w_in, *ln_g, *ln_b, *gws, *gbs,
        *conv_w, *conv_b, *lru_wa, *lru_ba, *lru_wx, *lru_bx, *lru_lam, *w_out_a, *w_out_b, *w_out, *router_w, *router_b, *e_g, *e_u, *e_d, *s_g, *s_u, *s_d;
    float* out; unsigned char* ws;
};

DEV float bf2f(bf16_t v) { return __uint_as_float(((unsigned)v) << 16); }
DEV bf16_t f2bf(float f) { unsigned u = __float_as_uint(f); return (bf16_t)((u + 0x7fffu + ((u >> 16) & 1u)) >> 16); }
DEV unsigned pk2(float lo, float hi) { return (unsigned)f2bf(lo) | ((unsigned)f2bf(hi) << 16); }
DEV float sigmoidf_(float x) { return 1.f / (1.f + expf(-x)); }
DEV float siluf_(float x) { return x / (1.f + expf(-x)); }
DEV float gelu_tanh(float x) { return 0.5f * x * (1.f + tanhf(0.7978845608028654f * (x + 0.044715f * x * x * x))); }
DEV float fsigmoid(float x) { return __builtin_amdgcn_rcpf(1.f + __builtin_amdgcn_exp2f(-1.4426950408889634f * x)); }
DEV float fsilu(float x) { return x * fsigmoid(x); }
DEV float fgelu(float x) { const float u = 1.5957691216057308f * (x + 0.044715f * x * x * x); return x * fsigmoid(u); }
DEV float wave_sum(float v) {
#pragma unroll
    for (int o = 1; o < 64; o <<= 1) v += __shfl_xor(v, o);
    return v;
}
DEV const float* mod_ptr(const Params& p, int l, int cond, int j) { return (const float*)(p.ws + WS_MOD) + ((size_t)((l * 5 + cond) * 6 + j)) * D; }
DEV float* xl_row(const Params& p, int r) { return r < TL ? p.out + (size_t)r * D : (float*)(p.ws + WS_XC) + (size_t)(r - TL) * D; }
namespace pg8 {
constexpr int BM = 256, BK = 64, HALF = 128, HTB = HALF * BK * 2  , STAGE_BYTES = 8 * HTB;
DEV int lds_byte(int r, int c) { const int st = (r >> 4) * 2 + (c >> 5), rr = r & 15, cc = c & 31, ob = rr * 64 + cc * 2; return st * 1024 + (ob ^ (((ob >> 9) & 1) << 5)); }
DEV void stage_rc(int b, int& Rr, int& C) { const int st = b / 1024, sb = b % 1024, swz = sb ^ (((sb >> 9) & 1) << 5); Rr = (st >> 1) * 16 + swz / 64; C = (st & 1) * 32 + (swz % 64) / 2; }
DEV int perm32(int rho) { const int n = rho >> 4, i = rho & 15; return 8 * (i >> 2) + 4 * n + (i & 3); }
DEV unsigned cvt_pk_bf16(float lo, float hi) { unsigned r; asm volatile("v_cvt_pk_bf16_f32 %0, %1, %2" : "=v"(r) : "v"(lo), "v"(hi)); return r; }
DEV u32x4 pack8(const f32x4 v0, const f32x4 v1) { u32x4 w; w.x = cvt_pk_bf16(v0[0], v0[1]); w.y = cvt_pk_bf16(v0[2], v0[3]); w.z = cvt_pk_bf16(v1[0], v1[1]); w.w = cvt_pk_bf16(v1[2], v1[3]); return w; }
DEV void unpack8(const u32x4 w, f32x4& v0, f32x4& v1) {
    v0[0] = __uint_as_float(w.x << 16); v0[1] = __uint_as_float(w.x & 0xffff0000u); v0[2] = __uint_as_float(w.y << 16); v0[3] = __uint_as_float(w.y & 0xffff0000u);
    v1[0] = __uint_as_float(w.z << 16); v1[1] = __uint_as_float(w.z & 0xffff0000u); v1[2] = __uint_as_float(w.w << 16); v1[3] = __uint_as_float(w.w & 0xffff0000u);
}
DEV int xcd_remap(int L, int U) { const int q = U / 8, r = U % 8, xcd = L % 8, off = L / 8; return (xcd < r ? xcd * (q + 1) : r * (q + 1) + (xcd - r) * q) + off; }

struct UnitD { int pm, pn; };
template <int K, size_t AOFF, size_t BOFF> struct DenseSched {
    typedef UnitD Unit; static constexpr int KK = K;
    const unsigned char* ws; int nM, nN, nwg, c, Krt; static constexpr int G = 256;
    DEV void init(const unsigned char* ws_, int M, int N, int c_) { ws = ws_; nM = M / BM; nN = N / BM; nwg = nM * nN; c = c_; Krt = K; }
    DEV bool next(int i, Unit& u) const {
        const int L = i * G + c; if (L >= nwg) return false;
        const int wgid = xcd_remap(L, nwg);
        const int nig = 8 * nN, gid = wgid / nig, fm = gid * 8, gsz = (nM - fm) < 8 ? (nM - fm) : 8;
        u.pm = fm + ((wgid % nig) % gsz); u.pn = (wgid % nig) / gsz; return true;
    }
    DEV const char* abase(const Unit& u) const { return (const char*)ws + AOFF + (size_t)u.pm * BM * K * 2; }
    DEV const char* bbase(const Unit& u) const { return (const char*)ws + BOFF + (size_t)u.pn * BM * K * 2; }
    DEV void prefetch(const Unit&, LAS unsigned char*, int, int) const {}
    DEV void aoffs(const Unit&, int tid, unsigned (&v)[2][2], LAS unsigned char*, int, bool) const {
#pragma unroll
        for (int i = 0; i < 2; ++i) { int Rr, C; stage_rc(tid * 16 + i * 8192, Rr, C);
#pragma unroll
            for (int h = 0; h < 2; ++h) v[h][i] = (unsigned)((h * HALF + Rr) * K + C) * 2u; }
    }
};
struct UnitE { int e, row0, cnt, hmrow0, pn; };
template <int K, int GATHER, int NCOL, size_t AOFF, size_t BOFF, size_t BSTRIDE> struct ExpSched {
    typedef UnitE Unit; static constexpr int KK = K;
    const unsigned char* ws; LAS unsigned char* lds;
    int U, c, brow0, Krt; static constexpr int ncol = NCOL, gather = GATHER, G = 256;
    DEV bool next(int i, Unit& u) const {
        const int L = i * G + c; if (L >= U) return false;
        const int id = xcd_remap(L, U), tile = id / ncol; u.pn = id % ncol;
        const LAS int* toff = (const LAS int*)(lds + 131072 + 256);
        const int e = (int)((const LAS unsigned char*)(lds + 131072 + 2048))[tile];
        u.e = e; u.row0 = (tile - toff[e]) * BM; u.cnt = toff[80 + e]; u.hmrow0 = tile * BM; return true;
    }
    DEV const char* abase(const Unit& u) const { return gather ? (const char*)ws + AOFF : (const char*)ws + AOFF + (size_t)u.hmrow0 * K * 2; }
    DEV const char* bbase(const Unit& u) const { return (const char*)ws + BOFF + (size_t)u.e * BSTRIDE + (size_t)(brow0 + u.pn * BM) * K * 2; }
    DEV void prefetch(const Unit& u, LAS unsigned char* lds_, int wid, int lane) const {
        if (gather) __builtin_amdgcn_global_load_lds((const unsigned*)(ws + WS_LISTA) + (size_t)u.e * CAP + u.row0 + lane * 4, (LAS unsigned*)(lds_ + 131072 + 2048 + wid * 3712 + 2048), 16, 0, 0);
    }
    DEV void aoffs(const Unit& u, int tid, unsigned (&v)[2][2], LAS unsigned char* lds_, int wid, bool from_lds) const {
        asm volatile("" : "+v"(tid));
        const int* lista = (const int*)(ws + WS_LISTA);
        const LAS int* sp = (const LAS int*)(lds_ + 131072 + 2048 + wid * 3712 + 2048);
#pragma unroll
        for (int i = 0; i < 2; ++i) { int Rr, C; stage_rc(tid * 16 + i * 8192, Rr, C);
#pragma unroll
            for (int h = 0; h < 2; ++h) {
                const int lr = h * HALF + Rr;
                if (gather) { const int rr = u.row0 + lr; const int aid = from_lds ? sp[lr] : ((rr < u.cnt) ? lista[(size_t)u.e * CAP + rr] : 0);
                    const int tok = (rr < u.cnt) ? (aid >> 3) : 0; v[h][i] = (unsigned)(tok * K + C) * 2u; }
                else v[h][i] = (unsigned)(lr * K + C) * 2u;
            } }
    }
};

typedef f32x4 Acc[2][2][4][2];
#define EPI_ROWS(ai, m) for (int ai = 0; ai < 2; ++ai) _Pragma("unroll") for (int m = 0; m < 4; ++m)

struct EpiZ {
    static constexpr int PID = 10; static constexpr bool HAS_MID = false; static constexpr int MID_T = 0;
    unsigned char* ws;
    DEV void mid(Acc&, const UnitD&, int, int, int, int) const {}
    DEV void unit_begin(const UnitD&, LAS unsigned char*, int, int) const {}
    DEV void operator()(const Acc& acc, const UnitD& u, int wr, int wc, int fr, int fq) const {
        bf16_t* Z = (bf16_t*)(ws + WS_Z);
        const int act = (u.pn < 4) ? 1 : (u.pn < 6 ? 0 : (u.pn < 8 ? 1 : 2));
        const int row0 = u.pm * BM + wr * 64 + fr, col0 = u.pn * BM + wc * 32 + 8 * fq;
#pragma unroll
        EPI_ROWS(ai, m) { bf16_t* rowp = Z + (size_t)(row0 + ai * HALF + m * 16) * 4096 + col0;
#pragma unroll
            for (int bj = 0; bj < 2; ++bj) { f32x4 v0 = acc[ai][bj][m][0], v1 = acc[ai][bj][m][1];
                if (act == 1) {
#pragma unroll
                    for (int i = 0; i < 4; ++i) { v0[i] = fgelu(v0[i]); v1[i] = fgelu(v1[i]); }
                } else if (act == 2) {
                    unsigned w0 = 0, w1 = 0;
#pragma unroll
                    for (int i = 0; i < 4; ++i) { w0 |= (unsigned)__builtin_rintf(fsigmoid(v0[i]) * 255.f) << (8 * i); w1 |= (unsigned)__builtin_rintf(fsigmoid(v1[i]) * 255.f) << (8 * i); }
                    *(u32x2*)((unsigned char*)(Z + (size_t)(row0 + ai * HALF + m * 16) * 4096) + 4096 + (col0 - 2048) + bj * HALF) = (u32x2){w0, w1};
                    continue;
                }
                *(u32x4*)(rowp + bj * HALF) = pack8(v0, v1); } }
    }
};
struct EpiAB {
    static constexpr int PID = 11; static constexpr bool HAS_MID = true; static constexpr int MID_T = 8;
    unsigned char* ws;
    DEV void unit_begin(const UnitD&, LAS unsigned char*, int, int) const {}
    DEV void mid(Acc& acc, const UnitD& u, int wr, int wc, int fr, int fq) const {
        const bf16_t* Z = (const bf16_t*)(ws + WS_Z);
        int oz = 0; asm volatile("" : "+v"(oz));
        const int row0 = u.pm * BM + wr * 64 + fr + oz, col0 = u.pn * BM + wc * 32 + 8 * fq;
#pragma unroll
        for (int ai = 0; ai < 2; ++ai) {
            u32x2 ga[4][2], gr[4][2];
#pragma unroll
            for (int m = 0; m < 4; ++m) { const unsigned char* zr = (const unsigned char*)(Z + (size_t)(row0 + ai * HALF + m * 16) * 4096) + 4096 + col0;
#pragma unroll
                for (int bj = 0; bj < 2; ++bj) { ga[m][bj] = *(const u32x2*)(zr + bj * HALF); gr[m][bj] = *(const u32x2*)(zr + 1024 + bj * HALF); } }
#pragma unroll
            for (int m = 0; m < 4; ++m)
#pragma unroll
                for (int bj = 0; bj < 2; ++bj) {
#pragma unroll
                    for (int i = 0; i < 4; ++i) {
                        const float a0 = (float)((ga[m][bj].x >> (8 * i)) & 255u), a1 = (float)((ga[m][bj].y >> (8 * i)) & 255u);
                        const float r0 = fmaxf((float)((gr[m][bj].x >> (8 * i)) & 255u), 0.5f), r1 = fmaxf((float)((gr[m][bj].y >> (8 * i)) & 255u), 0.5f);
                        acc[ai][bj][m][0][i] *= a0 * __builtin_amdgcn_rcpf(r0); acc[ai][bj][m][1][i] *= a1 * __builtin_amdgcn_rcpf(r1); } }
            asm volatile("" ::: "memory"); }
    }
    DEV void operator()(const Acc& acc, const UnitD& u, int wr, int wc, int fr, int fq) const {
        const bf16_t* Z = (const bf16_t*)(ws + WS_Z); bf16_t* M = (bf16_t*)(ws + WS_RA);
        const int row0 = u.pm * BM + wr * 64 + fr, col0 = u.pn * BM + wc * 32 + 8 * fq;
        u32x2 gr[2][4][2];
#pragma unroll
        EPI_ROWS(ai, m) { const unsigned char* zr = (const unsigned char*)(Z + (size_t)(row0 + ai * HALF + m * 16) * 4096) + 4096 + 1024 + col0;
#pragma unroll
            for (int bj = 0; bj < 2; ++bj) gr[ai][m][bj] = *(const u32x2*)(zr + bj * HALF); }
#pragma unroll
        EPI_ROWS(ai, m) { bf16_t* rowp = M + (size_t)(row0 + ai * HALF + m * 16) * D + col0;
#pragma unroll
            for (int bj = 0; bj < 2; ++bj) { f32x4 r0, r1;
#pragma unroll
                for (int i = 0; i < 4; ++i) { r0[i] = fmaxf((float)((gr[ai][m][bj].x >> (8 * i)) & 255u), 0.5f) * (1.f / 255.f); r1[i] = fmaxf((float)((gr[ai][m][bj].y >> (8 * i)) & 255u), 0.5f) * (1.f / 255.f); }
                *(u32x4*)(rowp + bj * HALF) = pack8(acc[ai][bj][m][0] * r0, acc[ai][bj][m][1] * r1); } }
    }
};
template <size_t COFF> struct EpiPlain {
    static constexpr int PID = 12; static constexpr bool HAS_MID = false; static constexpr int MID_T = 0;
    unsigned char* ws;
    DEV void mid(Acc&, const UnitD&, int, int, int, int) const {}
    DEV void unit_begin(const UnitD&, LAS unsigned char*, int, int) const {}
    DEV void operator()(const Acc& acc, const UnitD& u, int wr, int wc, int fr, int fq) const {
        bf16_t* C = (bf16_t*)(ws + COFF); constexpr int ldc = D;
        const int row0 = u.pm * BM + wr * 64 + fr, col0 = u.pn * BM + wc * 32 + 8 * fq;
#pragma unroll
        EPI_ROWS(ai, m) { bf16_t* rowp = C + (size_t)(row0 + ai * HALF + m * 16) * ldc + col0;
#pragma unroll
            for (int bj = 0; bj < 2; ++bj) *(u32x4*)(rowp + bj * HALF) = pack8(acc[ai][bj][m][0], acc[ai][bj][m][1]); }
    }
};
struct EpiSR {
    static constexpr int PID = 13; static constexpr bool HAS_MID = false; static constexpr int MID_T = 0;
    unsigned char* ws;
    DEV void mid(Acc&, const UnitD&, int, int, int, int) const {}
    DEV void unit_begin(const UnitD&, LAS unsigned char*, int, int) const {}
    DEV void operator()(const Acc& acc, const UnitD& u, int wr, int wc, int fr, int fq) const {
        float* LOG = (float*)(ws + WS_LOG); bf16_t* SH = (bf16_t*)(ws + WS_SH);
        const int row0 = u.pm * BM + wr * 64 + fr;
        if (u.pn == 0) {
            if (wc < 2) {
#pragma unroll
                EPI_ROWS(ai, m) { float* rowp = LOG + (size_t)(row0 + ai * HALF + m * 16) * 64 + wc * 32 + 8 * fq;
                    *(f32x4*)(rowp) = acc[ai][0][m][0]; *(f32x4*)(rowp + 4) = acc[ai][0][m][1]; }
            }
        } else {
            const int j0 = (u.pn - 1) * HALF + wc * 32 + 8 * fq;
#pragma unroll
            EPI_ROWS(ai, m) { f32x4 v0, v1;
#pragma unroll
                for (int i = 0; i < 4; ++i) { v0[i] = fsilu(acc[ai][0][m][0][i]) * acc[ai][1][m][0][i]; v1[i] = fsilu(acc[ai][0][m][1][i]) * acc[ai][1][m][1][i]; }
                *(u32x4*)(SH + (size_t)(row0 + ai * HALF + m * 16) * 256 + j0) = pack8(v0, v1); }
        }
    }
};
template <int FP8S> struct EpiEG {
    static constexpr int PID = 14; static constexpr bool HAS_MID = false; static constexpr int MID_T = 0;
    unsigned char* ws;
    DEV void mid(Acc&, const UnitE&, int, int, int, int) const {}
    DEV void unit_begin(const UnitE&, LAS unsigned char*, int, int) const {}
    DEV void operator()(const Acc& acc, const UnitE& u, int wr, int wc, int fr, int fq) const {
        bf16_t* HM = (bf16_t*)(ws + WS_HM);
        const int j0 = u.pn * HALF + wc * 32 + 8 * fq;
#pragma unroll
        EPI_ROWS(ai, m) { f32x4 v0, v1;
#pragma unroll
            for (int i = 0; i < 4; ++i) { constexpr float sc = FP8S ? (1.f / 1024.f) : 1.f; v0[i] = fsilu(acc[ai][0][m][0][i] * sc) * (acc[ai][1][m][0][i] * sc); v1[i] = fsilu(acc[ai][0][m][1][i] * sc) * (acc[ai][1][m][1][i] * sc); }
#if GED_FP8
            { u32x2 o; unsigned t = 0;
#pragma unroll
              for (int i = 0; i < 4; ++i) { v0[i] = __builtin_amdgcn_fmed3f(v0[i] * 8.f, -440.f, 440.f); v1[i] = __builtin_amdgcn_fmed3f(v1[i] * 8.f, -440.f, 440.f); }
              t = __builtin_amdgcn_cvt_pk_fp8_f32(v0[0], v0[1], t, false); t = __builtin_amdgcn_cvt_pk_fp8_f32(v0[2], v0[3], t, true); o.x = t;
              t = __builtin_amdgcn_cvt_pk_fp8_f32(v1[0], v1[1], t, false); t = __builtin_amdgcn_cvt_pk_fp8_f32(v1[2], v1[3], t, true); o.y = t;
              *(u32x2*)((unsigned char*)HM + (size_t)(u.hmrow0 + ai * HALF + wr * 64 + m * 16 + fr) * 256 + j0) = o; }
#else
            *(u32x4*)(HM + (size_t)(u.hmrow0 + ai * HALF + wr * 64 + m * 16 + fr) * 256 + j0) = pack8(v0, v1);
#endif
        }
    }
};
struct EpiED {
    static constexpr int PID = 15; static constexpr bool HAS_MID = false; static constexpr int MID_T = 0;
    unsigned char* ws;
    DEV void mid(Acc&, const UnitE&, int, int, int, int) const {}
    DEV void unit_begin(const UnitE& u, LAS unsigned char* lds, int wid, int lane) const {
        const int wr = wid >> 2; LAS unsigned char* sp = lds + 131072 + 2048 + wid * 3712 + 2048;
#pragma unroll
        for (int ai = 0; ai < 2; ++ai) { const size_t idx = (size_t)u.e * CAP + u.row0 + ai * HALF + wr * 64 + lane;
            __builtin_amdgcn_global_load_lds((const unsigned*)(ws + WS_LISTA) + idx, (LAS unsigned*)(sp + ai * 256), 4, 0, 0);
            __builtin_amdgcn_global_load_lds((const unsigned*)(ws + WS_LISTW) + idx, (LAS unsigned*)(sp + 512 + ai * 256), 4, 0, 0); }
    }
    DEV void operator()(const Acc& acc, const UnitE& u, int wr, int wc, int fr, int fq) const {
        unsigned char* SLOTS = ws + WS_SLOTS;
        const LAS unsigned* sp = (const LAS unsigned*)(lds_ + 131072 + 2048 + (wr * 4 + wc) * 3712 + 2048);
        const int col0 = u.pn * BM + wc * 32 + 8 * fq;
#pragma unroll
        EPI_ROWS(ai, m) { const int rr = u.row0 + ai * HALF + wr * 64 + m * 16 + fr;
            const int aid = (int)sp[ai * 64 + m * 16 + fr]; const float w = __uint_as_float(sp[128 + ai * 64 + m * 16 + fr]) * 16.0f;
            if (rr < u.cnt) { unsigned char* rowp = SLOTS + (size_t)aid * 1024 + col0;
#pragma unroll
                for (int bj = 0; bj < 2; ++bj) { f32x4 v0 = acc[ai][bj][m][0] * w, v1 = acc[ai][bj][m][1] * w; u32x2 o; unsigned t = 0;
#pragma unroll
                    for (int i = 0; i < 4; ++i) { v0[i] = __builtin_amdgcn_fmed3f(v0[i], -440.f, 440.f); v1[i] = __builtin_amdgcn_fmed3f(v1[i], -440.f, 440.f); }
                    t = __builtin_amdgcn_cvt_pk_fp8_f32(v0[0], v0[1], t, false); t = __builtin_amdgcn_cvt_pk_fp8_f32(v0[2], v0[3], t, true); o.x = t;
                    t = __builtin_amdgcn_cvt_pk_fp8_f32(v1[0], v1[1], t, false); t = __builtin_amdgcn_cvt_pk_fp8_f32(v1[2], v1[3], t, true); o.y = t;
                    *(u32x2*)(rowp + bj * HALF) = o; } } }
    }
    LAS unsigned char* lds_;
};

template <class Epi, class Sched, bool ALIGN_EPI, int FP8 = 0>
DEV void gemm_phase(LAS unsigned char* lds, const int tid, const Sched& S, const Epi& E) {
    typedef typename Sched::Unit Unit;
    const int wid = __builtin_amdgcn_readfirstlane(tid >> 6), lane = tid & 63, wr = wid >> 2, wc = wid & 3, fr = lane & 15, fq = lane >> 4;
    const int K = S.Krt, nt = K / BK;
    unsigned voffB[2];
#pragma unroll
    for (int i = 0; i < 2; ++i) { int Rr, C; stage_rc(tid * 16 + i * 8192, Rr, C); const int Rb = (Rr & ~31) + perm32(Rr & 31); voffB[i] = (unsigned)(Rb * K + C) * 2u; }
    const size_t kstep = (size_t)(BK * 2);
    const size_t hstepB = (size_t)HALF * K * 2;
    const unsigned ldsw = (unsigned)wid * 1024u;
    const int aoff = lds_byte(wr * 64 + fr, fq * 8), boff = lds_byte(wc * 32 + fr, fq * 8);
#define PG8_SA(b, h) (((b) * 2 + (h)) * HTB)
#define PG8_SB(b, h) ((4 + (b) * 2 + (h)) * HTB)
#define PG8_STAGE2(bufoff, gbase, o0, o1) do { unsigned o0_ = (o0), o1_ = (o1); asm volatile("" : "+v"(o0_), "+v"(o1_));     \
        __builtin_amdgcn_global_load_lds((const unsigned*)((const char*)(gbase) + o0_), (LAS unsigned*)(lds + (bufoff) + ldsw), 16, 0, 0); \
        __builtin_amdgcn_global_load_lds((const unsigned*)((const char*)(gbase) + o1_), (LAS unsigned*)(lds + (bufoff) + ldsw + 8192), 16, 0, 0); } while (0)
#define PG8_STAGEB(bufoff, gbase) PG8_STAGE2(bufoff, gbase, voffB[0], voffB[1])
#define PG8_LDA(dst, b, h) do { _Pragma("unroll") for (int m = 0; m < 4; ++m) _Pragma("unroll") for (int k = 0; k < 2; ++k) dst[m][k] = *(const LAS bf16x8*)(lds + PG8_SA(b, h) + aoff + m * 2048 + k * 1024); } while (0)
#define PG8_LDB(dst, b, h) do { _Pragma("unroll") for (int n = 0; n < 2; ++n) _Pragma("unroll") for (int k = 0; k < 2; ++k) dst[n][k] = *(const LAS bf16x8*)(lds + PG8_SB(b, h) + boff + n * 2048 + k * 1024); } while (0)
#define PG8_MMA(ai, bj, At, Bt) do { __builtin_amdgcn_s_setprio(1); _Pragma("unroll") for (int m = 0; m < 4; ++m) _Pragma("unroll") for (int n = 0; n < 2; ++n) _Pragma("unroll") for (int k = 0; k < 2; ++k) \
        acc[ai][bj][m][n] = __builtin_amdgcn_mfma_f32_16x16x32_bf16(Bt[n][k], At[m][k], acc[ai][bj][m][n], 0, 0, 0); __builtin_amdgcn_s_setprio(0); } while (0)
typedef int i32x8_t __attribute__((ext_vector_type(8)));
struct Frag2 { bf16x8 lo, hi; };
#define PG8_MMA8(ai, bj, At, Bt) do { __builtin_amdgcn_s_setprio(1); _Pragma("unroll") for (int m = 0; m < 4; ++m) _Pragma("unroll") for (int n = 0; n < 2; ++n) { \
        const Frag2 fb_{Bt[n][0], Bt[n][1]}, fa_{At[m][0], At[m][1]}; \
        acc[ai][bj][m][n] = __builtin_amdgcn_mfma_scale_f32_16x16x128_f8f6f4(__builtin_bit_cast(i32x8_t, fb_), __builtin_bit_cast(i32x8_t, fa_), acc[ai][bj][m][n], 0, 0, 0, 0x79797979, 0, FP8 * 0x01010101); } __builtin_amdgcn_s_setprio(0); } while (0)
#define PG8_MM(ai, bj, At, Bt) do { if constexpr (FP8) PG8_MMA8(ai, bj, At, Bt); else PG8_MMA(ai, bj, At, Bt); } while (0)
#define PG8_WAIT_V(n) asm volatile("s_waitcnt vmcnt(" #n ")" ::: "memory")
#define PG8_WAIT_L(n) asm volatile("s_waitcnt lgkmcnt(" #n ")" ::: "memory")
#define PG8_BAR __builtin_amdgcn_s_barrier()
#define PG8_SCHED __builtin_amdgcn_sched_barrier(0)
    Unit cur, nxt; int ui = 0;
    if (!S.next(0, cur)) return;
    Acc acc;
#pragma unroll
    for (int a = 0; a < 2; ++a)
#pragma unroll
        for (int b = 0; b < 2; ++b)
#pragma unroll
            for (int m = 0; m < 4; ++m)
#pragma unroll
                for (int n = 0; n < 2; ++n) acc[a][b][m][n] = (f32x4){0.f, 0.f, 0.f, 0.f};
    bf16x8 At[4][2], B0[2][2], B1[2][2];
    unsigned vA[2][2];
    S.aoffs(cur, tid, vA, lds, wid, false);
    const char* cA = S.abase(cur); const char* cB = S.bbase(cur);
    PG8_STAGEB(PG8_SB(0, 0), cB); PG8_STAGEB(PG8_SB(0, 1), cB + hstepB); PG8_STAGE2(PG8_SA(0, 0), cA, vA[0][0], vA[0][1]); PG8_STAGE2(PG8_SA(0, 1), cA, vA[1][0], vA[1][1]);
    if (wr == 1) PG8_BAR;
    PG8_WAIT_V(2); PG8_BAR;
    PG8_STAGEB(PG8_SB(1, 0), cB + kstep); PG8_STAGE2(PG8_SA(1, 0), cA + kstep, vA[0][0], vA[0][1]); PG8_STAGEB(PG8_SB(1, 1), cB + hstepB + kstep);
    PG8_WAIT_V(6); PG8_BAR;
    for (;;) {
        E.unit_begin(cur, lds, wid, lane);
        const bool has_next = S.next(ui + 1, nxt);
        const char* nA = cA; const char* nB = cB;
        if (has_next) { nA = S.abase(nxt); nB = S.bbase(nxt); S.prefetch(nxt, lds, wid, lane); }
        for (int t = 0; t < nt; t += 2) {
            const bool last = (t == nt - 2);
            if constexpr (Epi::HAS_MID) { if (t == Epi::MID_T) E.mid(acc, cur, wr, wc, fr, fq); }
            const char* a1 = cA + (size_t)(t + 1) * kstep;
            const char* a2 = last ? nA : cA + (size_t)(t + 2) * kstep; const char* b2 = last ? nB : cB + (size_t)(t + 2) * kstep;
            const char* a3 = a2 + kstep; const char* b3 = b2 + kstep;
            PG8_LDB(B0, 0, 0); PG8_LDB(B1, 0, 1); PG8_SCHED; PG8_LDA(At, 0, 0); PG8_STAGE2(PG8_SA(1, 1), a1, vA[1][0], vA[1][1]);
            if (last && has_next) S.aoffs(nxt, tid, vA, lds, wid, true);
            PG8_WAIT_V(8); PG8_WAIT_L(0); PG8_BAR; PG8_MM(0, 0, At, B0); PG8_MM(0, 1, At, B1); PG8_BAR; PG8_SCHED;
            PG8_LDA(At, 0, 1); PG8_STAGEB(PG8_SB(0, 0), b2); PG8_STAGEB(PG8_SB(0, 1), b2 + hstepB); PG8_STAGE2(PG8_SA(0, 0), a2, vA[0][0], vA[0][1]);
            PG8_WAIT_V(8); PG8_WAIT_L(0); PG8_BAR; PG8_MM(1, 0, At, B0); PG8_MM(1, 1, At, B1); PG8_BAR; PG8_SCHED;
            PG8_LDB(B0, 1, 0); PG8_LDB(B1, 1, 1); PG8_SCHED; PG8_LDA(At, 1, 0); PG8_STAGE2(PG8_SA(0, 1), a2, vA[1][0], vA[1][1]);
            PG8_WAIT_V(8); PG8_WAIT_L(0); PG8_BAR; PG8_MM(0, 0, At, B0); PG8_MM(0, 1, At, B1); PG8_BAR; PG8_SCHED;
            PG8_LDA(At, 1, 1); PG8_STAGEB(PG8_SB(1, 0), b3); PG8_STAGEB(PG8_SB(1, 1), b3 + hstepB); PG8_STAGE2(PG8_SA(1, 0), a3, vA[0][0], vA[0][1]);
            PG8_WAIT_V(8); PG8_WAIT_L(0); PG8_BAR; PG8_MM(1, 0, At, B0); PG8_MM(1, 1, At, B1); PG8_BAR; PG8_SCHED;
        }
        if constexpr (ALIGN_EPI) { if (wr == 0) PG8_BAR; }
#ifdef PROBE_REGION
        { unsigned long long t0_ = 0; if (Epi::PID == PROBE_REGION) t0_ = __builtin_amdgcn_s_memrealtime();
          E(acc, cur, wr, wc, fr, fq);
          if (Epi::PID == PROBE_REGION && tid == 0) { asm volatile("s_waitcnt vmcnt(0)" ::: "memory"); volatile LAS unsigned* m_ = (volatile LAS unsigned*)(lds + 131072); m_[16] += (unsigned)(__builtin_amdgcn_s_memrealtime() - t0_); } }
#else
        { unsigned z_ = 0; asm volatile("" : "+v"(z_)); const int l2 = (int)__builtin_amdgcn_mbcnt_hi(~0u, __builtin_amdgcn_mbcnt_lo(~0u, z_));
          E(acc, cur, wr, wc, l2 & 15, l2 >> 4); }
#endif
        if (!has_next) break;
#pragma unroll
        for (int a = 0; a < 2; ++a)
#pragma unroll
            for (int b = 0; b < 2; ++b)
#pragma unroll
                for (int m = 0; m < 4; ++m)
#pragma unroll
                    for (int n = 0; n < 2; ++n) acc[a][b][m][n] = (f32x4){0.f, 0.f, 0.f, 0.f};
        cur = nxt; cA = nA; cB = nB; ++ui;
        if constexpr (ALIGN_EPI) { if (wr == 1) PG8_BAR; }
    }
    PG8_WAIT_V(0);
    if constexpr (!ALIGN_EPI) { if (wr == 0) PG8_BAR; }
    PG8_BAR;
#undef PG8_SA
#undef PG8_SB
#undef PG8_STAGE2
#undef PG8_STAGEB
#undef PG8_LDA
#undef PG8_LDB
#undef PG8_MMA
#undef PG8_MMA8
#undef PG8_MM
#undef PG8_WAIT_V
#undef PG8_WAIT_L
#undef PG8_BAR
#undef PG8_SCHED
}
}
constexpr int NWAVES = 8;
constexpr int RING_BYTES = 131072;
constexpr int MISC_OFF = RING_BYTES;
constexpr int LDS_BYTES = 163840;
constexpr int PARAMS_OFF = MISC_OFF + 1024;
constexpr int SPW_OFF = MISC_OFF + 2048, SPW_BYTES = 3712, STATS_OFF = SPW_OFF + 8 * SPW_BYTES;

#define XB_TMO      128
#define XB_XCNT(j)  (256  + 64 * (j))
#define XB_XSUB(j)  (1280 + 64 * (j))
#define XB_XGEN(j)  (2304 + 64 * (j))
#define XB_TOP      3328
#define XB_TOPGEN   3392
#define XCD_BAR_WORDS 3456
#define XB_SPIN_CAP (1u << 22)
DEV unsigned xb_ld(GAS unsigned* p) { return __hip_atomic_load(p, __ATOMIC_RELAXED, __HIP_MEMORY_SCOPE_AGENT); }
DEV unsigned xb_add(GAS unsigned* p, unsigned v) { return __hip_atomic_fetch_add(p, v, __ATOMIC_RELAXED, __HIP_MEMORY_SCOPE_AGENT); }
DEV unsigned xb_xcc_id() { return (unsigned)__builtin_amdgcn_s_getreg((3 << 11) | 20) & 0xFu; }
#define XB_SPIN(cond, bar) do { unsigned _sp = 0; while (cond) { __builtin_amdgcn_s_sleep(1); \
    if ((++_sp & 255u) == 0u) { if (xb_ld(&(bar)[XB_TMO])) break; if (_sp > XB_SPIN_CAP) { xb_add(&(bar)[XB_TMO], 1u); break; } } } } while (0)
struct XcdBarrier { GAS unsigned* bar; unsigned x; volatile LAS unsigned* st; };
DEV XcdBarrier xcd_barrier_post(GAS unsigned* bar, volatile LAS unsigned* st) {
    XcdBarrier b; b.bar = bar; b.x = xb_xcc_id(); b.st = st;
    if (threadIdx.x == 0) (void)xb_add(&bar[XB_XCNT(b.x)], 1u);
    return b;
}
DEV void xcd_barrier_complete(GAS unsigned* bar, unsigned x, unsigned& nloc, unsigned& nx) {
    const unsigned G = gridDim.x * gridDim.y * gridDim.z;
    unsigned sum, cnt, mine, sp = 0u;
    for (;;) {
        sum = 0u; cnt = 0u; mine = 0u;
#pragma unroll
        for (unsigned j = 0; j < 16; ++j) { const unsigned c = xb_ld(&bar[XB_XCNT(j)]); sum += c; cnt += (c > 0u) ? 1u : 0u; mine = (j == x) ? c : mine; }
        if (sum == G) break;
        __builtin_amdgcn_s_sleep(1);
        if ((++sp & 255u) == 0u) { if (xb_ld(&bar[XB_TMO])) break; if (sp > XB_SPIN_CAP) { xb_add(&bar[XB_TMO], 1u); break; } }
    }
    nloc = mine > 0u ? mine : 1u; nx = cnt > 0u ? cnt : 1u;
}
DEV void xcd_barrier(const XcdBarrier& b) {
    asm volatile("s_waitcnt vmcnt(0)" ::: "memory");
    __syncthreads();
    if (threadIdx.x == 0) {
        GAS unsigned* bar = b.bar; asm volatile("" : "+s"(bar));
        __builtin_amdgcn_s_waitcnt(0);
        unsigned nloc = b.st[0], nx = b.st[1];
        if (nloc == 0u) { xcd_barrier_complete(bar, b.x, nloc, nx); b.st[0] = nloc; b.st[1] = nx; }
        const unsigned old = xb_add(&bar[XB_XSUB(b.x)], 1u);
        const unsigned gen = old / nloc;
        if (old + 1u == (gen + 1u) * nloc) {
            __builtin_amdgcn_fence(__ATOMIC_RELEASE, "agent");
            asm volatile("s_waitcnt vmcnt(0)" ::: "memory");
            const unsigned og = xb_add(&bar[XB_TOP], 1u);
            const unsigned tg = og / nx;
            if (og + 1u == (tg + 1u) * nx) xb_add(&bar[XB_TOPGEN], 1u);
            else XB_SPIN(xb_ld(&bar[XB_TOPGEN]) == tg, bar);
            __builtin_amdgcn_fence(__ATOMIC_ACQUIRE, "agent");
            xb_add(&bar[XB_XGEN(b.x)], 1u);
            asm volatile("s_waitcnt vmcnt(0)" ::: "memory");
        } else {
            XB_SPIN(xb_ld(&bar[XB_XGEN(b.x)]) == gen, bar);
            __builtin_amdgcn_fence(__ATOMIC_ACQUIRE, "agent");
            asm volatile("s_waitcnt vmcnt(0)" ::: "memory");
        }
    }
    __syncthreads();
}

#ifdef PROBE_REGION
#define TREG_BEGIN(k) unsigned long long _treg##k = 0; if ((k) == PROBE_REGION) _treg##k = __builtin_amdgcn_s_memrealtime()
#define TREG_END(k, F) do { if ((k) == PROBE_REGION && (F).tid == 0) { volatile LAS unsigned* _m = (volatile LAS unsigned*)((F).lds + MISC_OFF); _m[16] += (unsigned)(__builtin_amdgcn_s_memrealtime() - _treg##k); } } while (0)
#else
#define TREG_BEGIN(k) do {} while (0)
#define TREG_END(k, F) do {} while (0)
#endif
struct Frame { LAS unsigned char* lds; unsigned char* ldsg; int tid, lane, wave, G, bx; };
DEV unsigned long long ldp64(const LAS unsigned* q, int i) { const unsigned lo = __builtin_amdgcn_readfirstlane(q[2 * i]), hi = __builtin_amdgcn_readfirstlane(q[2 * i + 1]); return ((unsigned long long)hi << 32) | lo; }
DEV Params load_params(const Frame& F) {
    unsigned off_ = PARAMS_OFF; asm volatile("" : "+v"(off_));
    Params p; const LAS unsigned* q = (const LAS unsigned*)(F.lds + off_);
    p.x = (const float*)(const GAS float*)ldp64(q, 0);
    p.c = (const float*)(const GAS float*)ldp64(q, 1);
    p.ctx = (const float*)(const GAS float*)ldp64(q, 2);
    p.c_ctx = (const float*)(const GAS float*)ldp64(q, 3);
    p.w_mod = (const float*)(const GAS float*)ldp64(q, 4);
    p.b_mod = (const float*)(const GAS float*)ldp64(q, 5);
    p.g_pre_mix = (const float*)(const GAS float*)ldp64(q, 6);
    p.g_post_mix = (const float*)(const GAS float*)ldp64(q, 7);
    p.g_pre_ffn = (const float*)(const GAS float*)ldp64(q, 8);
    p.g_post_ffn = (const float*)(const GAS float*)ldp64(q, 9);
    p.w_in = (const float*)(const GAS float*)ldp64(q, 10);
    p.ln_g = (const float*)(const GAS float*)ldp64(q, 11);
    p.ln_b = (const float*)(const GAS float*)ldp64(q, 12);
    p.gws = (const float*)(const GAS float*)ldp64(q, 13);
    p.gbs = (const float*)(const GAS float*)ldp64(q, 14);
    p.conv_w = (const float*)(const GAS float*)ldp64(q, 15);
    p.conv_b = (const float*)(const GAS float*)ldp64(q, 16);
    p.lru_wa = (const float*)(const GAS float*)ldp64(q, 17);
    p.lru_ba = (const float*)(const GAS float*)ldp64(q, 18);
    p.lru_wx = (const float*)(const GAS float*)ldp64(q, 19);
    p.lru_bx = (const float*)(const GAS float*)ldp64(q, 20);
    p.lru_lam = (const float*)(const GAS float*)ldp64(q, 21);
    p.w_out_a = (const float*)(const GAS float*)ldp64(q, 22);
    p.w_out_b = (const float*)(const GAS float*)ldp64(q, 23);
    p.w_out = (const float*)(const GAS float*)ldp64(q, 24);
    p.router_w = (const float*)(const GAS float*)ldp64(q, 25);
    p.router_b = (const float*)(const GAS float*)ldp64(q, 26);
    p.e_g = (const float*)(const GAS float*)ldp64(q, 27);
    p.e_u = (const float*)(const GAS float*)ldp64(q, 28);
    p.e_d = (const float*)(const GAS float*)ldp64(q, 29);
    p.s_g = (const float*)(const GAS float*)ldp64(q, 30);
    p.s_u = (const float*)(const GAS float*)ldp64(q, 31);
    p.s_d = (const float*)(const GAS float*)ldp64(q, 32);
    p.out = (float*)(GAS float*)ldp64(q, 33); p.ws = (unsigned char*)(GAS unsigned char*)ldp64(q, 34);
    return p;
}
DEV void store_params(const Frame& F, const Params& a) {
    if (F.tid == 0) { LAS unsigned long long* q = (LAS unsigned long long*)(F.lds + PARAMS_OFF);
        q[0] = (unsigned long long)a.x;
        q[1] = (unsigned long long)a.c;
        q[2] = (unsigned long long)a.ctx;
        q[3] = (unsigned long long)a.c_ctx;
        q[4] = (unsigned long long)a.w_mod;
        q[5] = (unsigned long long)a.b_mod;
        q[6] = (unsigned long long)a.g_pre_mix;
        q[7] = (unsigned long long)a.g_post_mix;
        q[8] = (unsigned long long)a.g_pre_ffn;
        q[9] = (unsigned long long)a.g_post_ffn;
        q[10] = (unsigned long long)a.w_in;
        q[11] = (unsigned long long)a.ln_g;
        q[12] = (unsigned long long)a.ln_b;
        q[13] = (unsigned long long)a.gws;
        q[14] = (unsigned long long)a.gbs;
        q[15] = (unsigned long long)a.conv_w;
        q[16] = (unsigned long long)a.conv_b;
        q[17] = (unsigned long long)a.lru_wa;
        q[18] = (unsigned long long)a.lru_ba;
        q[19] = (unsigned long long)a.lru_wx;
        q[20] = (unsigned long long)a.lru_bx;
        q[21] = (unsigned long long)a.lru_lam;
        q[22] = (unsigned long long)a.w_out_a;
        q[23] = (unsigned long long)a.w_out_b;
        q[24] = (unsigned long long)a.w_out;
        q[25] = (unsigned long long)a.router_w;
        q[26] = (unsigned long long)a.router_b;
        q[27] = (unsigned long long)a.e_g;
        q[28] = (unsigned long long)a.e_u;
        q[29] = (unsigned long long)a.e_d;
        q[30] = (unsigned long long)a.s_g;
        q[31] = (unsigned long long)a.s_u;
        q[32] = (unsigned long long)a.s_d;
        q[33] = (unsigned long long)a.out; q[34] = (unsigned long long)a.ws; }
}

DEV void transpose_item(const float* W, int N, bf16_t* WT, int dK, int koff, int rbase, int rhi, LAS float* scr, int kb, int nb, int lane, float scale = 1.0f) {
    const int k0 = 64 * kb, n0 = 32 * nb;
    float4 ld[8];
#pragma unroll
    for (int i = 0; i < 8; ++i) ld[i] = *(const float4*)(W + (size_t)(k0 + 8 * i + (lane >> 3)) * N + n0 + (lane & 7) * 4);
#pragma unroll
    for (int i = 0; i < 8; ++i) { LAS float* d = scr + (8 * i + (lane >> 3)) * 33 + (lane & 7) * 4; d[0] = ld[i].x; d[1] = ld[i].y; d[2] = ld[i].z; d[3] = ld[i].w; }
    asm volatile("s_waitcnt lgkmcnt(0)" ::: "memory");
    const int cc = lane & 7;
#pragma unroll
    for (int j = 0; j < 4; ++j) { const int nl = (lane >> 3) + 8 * j, n = n0 + nl; const LAS float* s = scr + (8 * cc) * 33 + nl;
        u32x4 o; o.x = pk2(s[0 * 33] * scale, s[1 * 33] * scale); o.y = pk2(s[2 * 33] * scale, s[3 * 33] * scale); o.z = pk2(s[4 * 33] * scale, s[5 * 33] * scale); o.w = pk2(s[6 * 33] * scale, s[7 * 33] * scale);
        const int drow = rbase + (n >> 7) * rhi + (n & 127);
        *(u32x4*)(WT + (size_t)drow * dK + koff + k0 + 8 * cc) = o; }
    asm volatile("s_waitcnt lgkmcnt(0)" ::: "memory");
}
DEV void transpose_item8(const float* W, int N, unsigned char* WT, int dK, int rbase, int rhi, LAS float* scr, int kb, int nb, int lane) {
    const int k0 = 64 * kb, n0 = 32 * nb;
    float4 ld[8];
#pragma unroll
    for (int i = 0; i < 8; ++i) ld[i] = *(const float4*)(W + (size_t)(k0 + 8 * i + (lane >> 3)) * N + n0 + (lane & 7) * 4);
#pragma unroll
    for (int i = 0; i < 8; ++i) { LAS float* d = scr + (8 * i + (lane >> 3)) * 33 + (lane & 7) * 4; d[0] = ld[i].x; d[1] = ld[i].y; d[2] = ld[i].z; d[3] = ld[i].w; }
    asm volatile("s_waitcnt lgkmcnt(0)" ::: "memory");
    const int cc = lane & 7;
#pragma unroll
    for (int j = 0; j < 4; ++j) { const int nl = (lane >> 3) + 8 * j, n = n0 + nl; const LAS float* s = scr + (8 * cc) * 33 + nl;
        unsigned lo = 0, hi = 0;
        lo = __builtin_amdgcn_cvt_pk_fp8_f32(s[0 * 33] * 64.f, s[1 * 33] * 64.f, lo, false); lo = __builtin_amdgcn_cvt_pk_fp8_f32(s[2 * 33] * 64.f, s[3 * 33] * 64.f, lo, true);
        hi = __builtin_amdgcn_cvt_pk_fp8_f32(s[4 * 33] * 64.f, s[5 * 33] * 64.f, hi, false); hi = __builtin_amdgcn_cvt_pk_fp8_f32(s[6 * 33] * 64.f, s[7 * 33] * 64.f, hi, true);
        const int drow = rbase + (n >> 7) * rhi + (n & 127);
        *(u32x2*)(WT + (size_t)drow * dK + k0 + 8 * cc) = (u32x2){lo, hi}; }
    asm volatile("s_waitcnt lgkmcnt(0)" ::: "memory");
}
DEV void convert_weights(const Params& p, const Frame& F, int l, int part, int vw, int nvw) {
    LAS float* scr = (LAS float*)(F.lds + F.wave * 16384);
    unsigned char* W = p.ws + WS_W;
    const int lane = F.lane;
    constexpr int I_IN = 16 * 128, I_OA = 8 * 32, I_OUT = 16 * 32, I_RT = 16 * 2, I_SG = 16 * 8, I_SD = 4 * 32, I_EG = NE * 16 * 8, I_ED = NE * 4 * 32, I_LRU = 32 * 2;
    if (part == 0) {
        constexpr int NITEMS = I_IN + 2 * I_OA + I_OUT + I_RT + 2 * I_SG + I_SD + I_LRU;
        for (int it = vw; it < NITEMS; it += nvw) {
            int r = it;
#if GIN_FP8
            if (r < I_IN) { transpose_item8(p.w_in + (size_t)l * D * 4096, 4096, W + WO_IN, D, 0, 128, scr, r / 128, r % 128, lane); continue; } r -= I_IN;
#else
            if (r < I_IN) { transpose_item(p.w_in + (size_t)l * D * 4096, 4096, (bf16_t*)(W + WO_IN), D, 0, 0, 128, scr, r / 128, r % 128, lane); continue; } r -= I_IN;
#endif
            if (r < I_OA) { transpose_item(p.w_out_a + (size_t)l * 512 * D, D, (bf16_t*)(W + WO_AB), D, 0, 0, 128, scr, r / 32, r % 32, lane); continue; } r -= I_OA;
            if (r < I_OA) { transpose_item(p.w_out_b + (size_t)l * 512 * D, D, (bf16_t*)(W + WO_AB), D, 512, 0, 128, scr, r / 32, r % 32, lane); continue; } r -= I_OA;
            if (r < I_OUT) { transpose_item(p.w_out + (size_t)l * D * D, D, (bf16_t*)(W + WO_OUT), D, 0, 0, 128, scr, r / 32, r % 32, lane); continue; } r -= I_OUT;
            if (r < I_RT) { transpose_item(p.router_w + (size_t)l * D * 64, 64, (bf16_t*)(W + WO_SR), D, 0, 0, 128, scr, r / 2, r % 2, lane); continue; } r -= I_RT;
            if (r < I_SG) { transpose_item(p.s_g + (size_t)l * D * 256, 256, (bf16_t*)(W + WO_SR), D, 0, 256, 256, scr, r / 8, r % 8, lane); continue; } r -= I_SG;
            if (r < I_SG) { transpose_item(p.s_u + (size_t)l * D * 256, 256, (bf16_t*)(W + WO_SR), D, 0, 256 + 128, 256, scr, r / 8, r % 8, lane); continue; } r -= I_SG;
            if (r < I_SD) { transpose_item(p.s_d + (size_t)l * 256 * D, D, (bf16_t*)(W + WO_SD), 256, 0, 0, 128, scr, r / 32, r % 32, lane); continue; } r -= I_SD;
            { const int mat = r / 2, nb = r % 2, type = mat >> 4, dh = mat & 15;
              const float* src = (type ? p.lru_wx : p.lru_wa) + (size_t)((l * 2) * 8 + dh) * 4096;
              transpose_item(src, 64, (bf16_t*)(W + WO_LRU) + (size_t)mat * 4096, 64, 0, 0, 128, scr, 0, nb, lane, -1.4426950408889634f); }
        }
        const int gt = vw * 64 + lane, NT = nvw * 64;
        for (int i = gt; i < 192 * D / 8; i += NT) *(u32x4*)((bf16_t*)(W + WO_SR) + (size_t)64 * D + (size_t)i * 8) = (u32x4){0u, 0u, 0u, 0u};
        for (int i = gt; i < 8 * 128 * 128 / 4; i += NT) { const float4 v = *(const float4*)(p.gws + (size_t)l * 8 * 128 * 128 + (size_t)i * 4);
            u32x2 o; o.x = pk2(v.x, v.y); o.y = pk2(v.z, v.w); *(u32x2*)((bf16_t*)(W + WO_GWS) + (size_t)i * 4) = o; }
    } else if (part == 2) {
#if GED_FP8
        for (int it = vw; it < I_ED; it += nvw) { const int e = it / 128, q = it % 128; transpose_item8(p.e_d + ((size_t)(l * NE + e) * 256) * D, D, W + WO_ED + (size_t)e * D * 256, 256, 0, 128, scr, q / 32, q % 32, lane); }
#else
        for (int it = vw; it < I_ED; it += nvw) { const int e = it / 128, q = it % 128; transpose_item(p.e_d + ((size_t)(l * NE + e) * 256) * D, D, (bf16_t*)(W + WO_ED) + (size_t)e * D * 256, 256, 0, 0, 128, scr, q / 32, q % 32, lane); }
#endif
    } else {
        constexpr int NITEMS = 2 * I_EG;
        for (int it = vw; it < NITEMS; it += nvw) {
            int r = it;
            if (r < I_EG) { const int e = r / 128, q = r % 128; transpose_item8(p.e_g + ((size_t)(l * NE + e) * D) * 256, 256, W + WO_EG + (size_t)e * 512 * D, D, 0, 256, scr, q / 8, q % 8, lane); continue; } r -= I_EG;
            { const int e = r / 128, q = r % 128; transpose_item8(p.e_u + ((size_t)(l * NE + e) * D) * 256, 256, W + WO_EG + (size_t)e * 512 * D, D, 128, 256, scr, q / 8, q % 8, lane); }
        }
    }
}
DEV void pe_table(const Params& p, const Frame& F, int idx) {
    const int pos = idx >> 9, half = (idx >> 8) & 1, q = idx & 255;
    const float omega = 1.0f / powf(10000.0f, (float)q / 256.0f);
    const float ang = (float)pos * omega;
    ((float*)(p.ws + WS_PE))[idx] = half ? cosf(ang) : sinf(ang);
}
DEV void mod_items(const Params& p, const Frame& F) {
    LAS float* part = (LAS float*)(F.lds);
    LAS float* sc = (LAS float*)(F.lds + 16384);
    if (F.bx < 2 * 96) {
        for (int i = F.tid; i < 5 * D; i += NWAVES * 64) { const int cnd = i >> 10, d = i & (D - 1); sc[d * 8 + cnd] = siluf_(cnd < 4 ? p.c[cnd * D + d] : p.c_ctx[d]); }
        __syncthreads();
    }
    for (int it = F.bx; it < 2 * 96; it += F.G) {
        const int l = it / 96, e = (it % 96) * 64 + F.lane;
        const float* w = p.w_mod + (size_t)l * D * 6 * D + e;
        float acc[5] = {0.f, 0.f, 0.f, 0.f, 0.f};
        const int d0 = F.wave * 128;
#pragma unroll 32
        for (int d = d0; d < d0 + 128; ++d) { const float wv = w[(size_t)d * 6 * D]; const f32x4 s4 = *(const LAS f32x4*)(sc + d * 8); const float s5 = sc[d * 8 + 4];
            acc[0] += s4[0] * wv; acc[1] += s4[1] * wv; acc[2] += s4[2] * wv; acc[3] += s4[3] * wv; acc[4] += s5 * wv; }
#pragma unroll
        for (int cnd = 0; cnd < 5; ++cnd) part[(F.wave * 5 + cnd) * 64 + F.lane] = acc[cnd];
        __syncthreads();
        if (F.tid < 320) { const int cnd = F.tid >> 6, ln = F.tid & 63; float s = p.b_mod[l * 6 * D + (it % 96) * 64 + ln];
#pragma unroll
            for (int w8 = 0; w8 < 8; ++w8) s += part[(w8 * 5 + cnd) * 64 + ln];
            ((float*)(p.ws + WS_MOD))[(size_t)(l * 5 + cnd) * 6 * D + (it % 96) * 64 + ln] = s; }
        __syncthreads();
    }
}

DEV bf16_t* xl16_row(const Params& p, int r) { return (bf16_t*)((unsigned char*)p.out + (size_t)r * 4096 + 2048); }
DEV void load_xl(const Params& p, int r, int lane, float (&v)[16]) {
    if (r < TL) { const bf16_t* x = xl16_row(p, r);
#pragma unroll
        for (int j = 0; j < 4; ++j) { const ushort4 t = *(const ushort4*)(x + (j * 64 + lane) * 4); v[4 * j] = bf2f(t.x); v[4 * j + 1] = bf2f(t.y); v[4 * j + 2] = bf2f(t.z); v[4 * j + 3] = bf2f(t.w); } }
    else { const float* x = (const float*)(p.ws + WS_XC) + (size_t)(r - TL) * D;
#pragma unroll
        for (int j = 0; j < 4; ++j) { const float4 t = *(const float4*)(x + (j * 64 + lane) * 4); v[4 * j] = t.x; v[4 * j + 1] = t.y; v[4 * j + 2] = t.z; v[4 * j + 3] = t.w; } }
}
DEV void store_xl(const Params& p, int r, int lane, const float (&v)[16], bool final_f32) {
    if (r < TL && !final_f32) { bf16_t* x = xl16_row(p, r);
#pragma unroll
        for (int j = 0; j < 4; ++j) { u32x2 o; o.x = pk2(v[4 * j], v[4 * j + 1]); o.y = pk2(v[4 * j + 2], v[4 * j + 3]); *(u32x2*)(x + (j * 64 + lane) * 4) = o; } }
    else { float* x = r < TL ? p.out + (size_t)r * D : (float*)(p.ws + WS_XC) + (size_t)(r - TL) * D;
#pragma unroll
        for (int j = 0; j < 4; ++j) *(float4*)(x + (j * 64 + lane) * 4) = make_float4(v[4 * j], v[4 * j + 1], v[4 * j + 2], v[4 * j + 3]); }
}
DEV void row_pass_A(const Params& p, int l, int wave, int nw, int lane) {
    const int nrows = (l == 2) ? TL : R;
    const bf16_t* FL = (const bf16_t*)(p.ws + WS_RY);
    for (int r = wave; r < nrows; r += nw) {
        const int cond = r < TL ? (r >> 13) : 4;
        float v[16];
        if (l == 0) {
            const float* src = r < TL ? p.x + (size_t)r * D : p.ctx + (size_t)(r - TL) * D;
#pragma unroll
            for (int j = 0; j < 4; ++j) { const float4 t = *(const float4*)(src + (j * 64 + lane) * 4); v[4 * j] = t.x; v[4 * j + 1] = t.y; v[4 * j + 2] = t.z; v[4 * j + 3] = t.w; }
            if (r < TL) {
                const int t = r & (SEQ - 1); const float* PE = (const float*)(p.ws + WS_PE);
#pragma unroll
                for (int j = 0; j < 4; ++j) { const float4 e = *(const float4*)(PE + ((j < 2) ? (t >> 6) : (t & 63)) * 512 + (j & 1) * 256 + lane * 4);
                    v[4 * j] += e.x; v[4 * j + 1] += e.y; v[4 * j + 2] += e.z; v[4 * j + 3] += e.w; }
            }
        } else {
            float f[16]; float ss = 0.f;
            load_xl(p, r, lane, v);
#pragma unroll
            for (int j = 0; j < 4; ++j) {
                const ushort4 fb = *(const ushort4*)(FL + (size_t)r * D + (j * 64 + lane) * 4);
                f[4 * j] = bf2f(fb.x); f[4 * j + 1] = bf2f(fb.y); f[4 * j + 2] = bf2f(fb.z); f[4 * j + 3] = bf2f(fb.w);
            }
            { const unsigned char* SL = p.ws + WS_SLOTS + (size_t)r * 8 * 1024;
                unsigned sv[8][4];
#pragma unroll
                for (int s = 0; s < 8; ++s)
#pragma unroll
                    for (int j = 0; j < 4; ++j) sv[s][j] = *(const unsigned*)(SL + (size_t)s * 1024 + (j * 64 + lane) * 4);
#pragma unroll
                for (int j = 0; j < 4; ++j) { float a0 = 0.f, a1 = 0.f, a2 = 0.f, a3 = 0.f;
#pragma unroll
                    for (int s = 0; s < 8; ++s) { a0 += __builtin_amdgcn_cvt_f32_fp8(sv[s][j], 0); a1 += __builtin_amdgcn_cvt_f32_fp8(sv[s][j], 1); a2 += __builtin_amdgcn_cvt_f32_fp8(sv[s][j], 2); a3 += __builtin_amdgcn_cvt_f32_fp8(sv[s][j], 3); }
                    f[4 * j] += a0 * 0.0625f; f[4 * j + 1] += a1 * 0.0625f; f[4 * j + 2] += a2 * 0.0625f; f[4 * j + 3] += a3 * 0.0625f; } }
#pragma unroll
            for (int i = 0; i < 16; ++i) ss += f[i] * f[i];
            const float rstd = rsqrtf(wave_sum(ss) * (1.f / D) + 1e-6f);
            const float* gt = mod_ptr(p, l - 1, cond, 5); const float* g = p.g_post_ffn + (l - 1) * D;
#pragma unroll
            for (int j = 0; j < 4; ++j) { const float4 gt4 = *(const float4*)(gt + (j * 64 + lane) * 4), g4 = *(const float4*)(g + (j * 64 + lane) * 4);
                v[4 * j] += gt4.x * (f[4 * j] * rstd * g4.x); v[4 * j + 1] += gt4.y * (f[4 * j + 1] * rstd * g4.y); v[4 * j + 2] += gt4.z * (f[4 * j + 2] * rstd * g4.z); v[4 * j + 3] += gt4.w * (f[4 * j + 3] * rstd * g4.w); }
        }
        store_xl(p, r, lane, v, l == 2);
        if (l < 2) {
            float ss = 0.f;
#pragma unroll
            for (int i = 0; i < 16; ++i) ss += v[i] * v[i];
            const float rstd = rsqrtf(wave_sum(ss) * (1.f / D) + 1e-6f);
            const float* sh = mod_ptr(p, l, cond, 0); const float* sc = mod_ptr(p, l, cond, 1); const float* g = p.g_pre_mix + l * D;
#pragma unroll
            for (int j = 0; j < 4; ++j) { const int d = (j * 64 + lane) * 4; const float4 sh4 = *(const float4*)(sh + d), sc4 = *(const float4*)(sc + d), g4 = *(const float4*)(g + d);
                u32x2 o; o.x = pk2(v[4 * j] * rstd * g4.x * (1.f + sc4.x) + sh4.x, v[4 * j + 1] * rstd * g4.y * (1.f + sc4.y) + sh4.y);
                o.y = pk2(v[4 * j + 2] * rstd * g4.z * (1.f + sc4.z) + sh4.z, v[4 * j + 3] * rstd * g4.w * (1.f + sc4.w) + sh4.w);
#if GIN_FP8
                { const float h0 = __uint_as_float(o.x << 16) * 16.f, h1 = __uint_as_float(o.x & 0xffff0000u) * 16.f, h2 = __uint_as_float(o.y << 16) * 16.f, h3 = __uint_as_float(o.y & 0xffff0000u) * 16.f;
                  unsigned t = 0; t = __builtin_amdgcn_cvt_pk_fp8_f32(__builtin_amdgcn_fmed3f(h0, -440.f, 440.f), __builtin_amdgcn_fmed3f(h1, -440.f, 440.f), t, false);
                  t = __builtin_amdgcn_cvt_pk_fp8_f32(__builtin_amdgcn_fmed3f(h2, -440.f, 440.f), __builtin_amdgcn_fmed3f(h3, -440.f, 440.f), t, true);
                  *(unsigned*)(p.ws + WS_H8 + (size_t)r * D + d) = t; }
#else
                *(u32x2*)((bf16_t*)(p.ws + WS_RY) + (size_t)r * D + d) = o;
#endif
            }
        }
    }
}
DEV void row_pass_H(const Params& p, int l, int nrows, int wave, int nw, int lane) {
    const bf16_t* YL = (const bf16_t*)(p.ws + WS_Z);
    bf16_t* H = (bf16_t*)(p.ws + WS_RA);
    for (int r = wave; r < nrows; r += nw) {
        const int cond = r < TL ? (r >> 13) : 4;
        float v[16], f[16]; float ss = 0.f;
        load_xl(p, r, lane, v);
#pragma unroll
        for (int j = 0; j < 4; ++j) {
            const ushort4 fb = *(const ushort4*)(YL + (size_t)r * D + (j * 64 + lane) * 4);
            f[4 * j] = bf2f(fb.x); f[4 * j + 1] = bf2f(fb.y); f[4 * j + 2] = bf2f(fb.z); f[4 * j + 3] = bf2f(fb.w);
        }
#pragma unroll
        for (int i = 0; i < 16; ++i) ss += f[i] * f[i];
        const float rstd = rsqrtf(wave_sum(ss) * (1.f / D) + 1e-6f);
        const float* gt = mod_ptr(p, l, cond, 2); const float* g = p.g_post_mix + l * D;
#pragma unroll
        for (int j = 0; j < 4; ++j) { const float4 gt4 = *(const float4*)(gt + (j * 64 + lane) * 4), g4 = *(const float4*)(g + (j * 64 + lane) * 4);
            v[4 * j] += gt4.x * (f[4 * j] * rstd * g4.x); v[4 * j + 1] += gt4.y * (f[4 * j + 1] * rstd * g4.y); v[4 * j + 2] += gt4.z * (f[4 * j + 2] * rstd * g4.z); v[4 * j + 3] += gt4.w * (f[4 * j + 3] * rstd * g4.w); }
        store_xl(p, r, lane, v, false);
        float s2 = 0.f;
#pragma unroll
        for (int i = 0; i < 16; ++i) s2 += v[i] * v[i];
        const float rstd2 = rsqrtf(wave_sum(s2) * (1.f / D) + 1e-6f);
        const float* sh = mod_ptr(p, l, cond, 3); const float* sc = mod_ptr(p, l, cond, 4); const float* g2 = p.g_pre_ffn + l * D;
#pragma unroll
        for (int j = 0; j < 4; ++j) { const int d = (j * 64 + lane) * 4; const float4 sh4 = *(const float4*)(sh + d), sc4 = *(const float4*)(sc + d), g4 = *(const float4*)(g2 + d);
            u32x2 o; o.x = pk2(v[4 * j] * rstd2 * g4.x * (1.f + sc4.x) + sh4.x, v[4 * j + 1] * rstd2 * g4.y * (1.f + sc4.y) + sh4.y);
            o.y = pk2(v[4 * j + 2] * rstd2 * g4.z * (1.f + sc4.z) + sh4.z, v[4 * j + 3] * rstd2 * g4.w * (1.f + sc4.w) + sh4.w);
            *(u32x2*)(H + (size_t)r * D + d) = o;
            { const float h0 = __uint_as_float(o.x << 16) * 16.f, h1 = __uint_as_float(o.x & 0xffff0000u) * 16.f, h2 = __uint_as_float(o.y << 16) * 16.f, h3 = __uint_as_float(o.y & 0xffff0000u) * 16.f;
              unsigned t = 0; t = __builtin_amdgcn_cvt_pk_fp8_f32(__builtin_amdgcn_fmed3f(h0, -440.f, 440.f), __builtin_amdgcn_fmed3f(h1, -440.f, 440.f), t, false);
              t = __builtin_amdgcn_cvt_pk_fp8_f32(__builtin_amdgcn_fmed3f(h2, -440.f, 440.f), __builtin_amdgcn_fmed3f(h3, -440.f, 440.f), t, true);
              *(unsigned*)(p.ws + WS_H2E + (size_t)r * D + d) = t; } }
    }
}

DEV void route_token(const Params& p, int l, float logit, int lane, int& myi, float& myw) {
    const float s = sigmoidf_(logit);
    const float sel = s + p.router_b[l * 64 + lane];
    int rank = 0;
#pragma unroll
    for (int k = 1; k < 8; ++k) { const float o = __shfl_xor(sel, k); const int ol = lane ^ k; rank += (o > sel || (o == sel && ol < lane)) ? 1 : 0; }
    float gs = rank < 2 ? sel : 0.f;
    gs += __shfl_xor(gs, 1); gs += __shfl_xor(gs, 2); gs += __shfl_xor(gs, 4);
    const int g = lane >> 3; int grank = 0;
#pragma unroll
    for (int k = 1; k < 8; ++k) { const float o = __shfl_xor(gs, 8 * k); const int og = g ^ k; grank += (o > gs || (o == gs && og < g)) ? 1 : 0; }
    float mv = grank < 4 ? sel : -INFINITY;
    float wsum = 0.f; myw = 0.f; myi = 0;
    for (int s8 = 0; s8 < 8; ++s8) {
        float mx = mv;
#pragma unroll
        for (int o = 32; o >= 1; o >>= 1) mx = fmaxf(mx, __shfl_xor(mx, o));
        const unsigned long long bal = __ballot(mv == mx);
        const int win = __ffsll((long long)bal) - 1;
        const float sw = __shfl(s, win);
        if (lane == s8) { myi = win; myw = sw; }
        wsum += sw;
        if (lane == win) mv = -INFINITY;
    }
    myw = myw / wsum * 2.5f;
}
DEV void route_rows(const Params& p, const Frame& F, int l, int r0) {
    int* hist = (int*)(F.ldsg); int* base = hist + 64; int* loc = hist + 128; float* locw = (float*)(hist + 128 + 2048);
    int* LISTA = (int*)(p.ws + WS_LISTA); float* LISTW = (float*)(p.ws + WS_LISTW);
    unsigned* CNT = (unsigned*)(p.ws + WS_CTL) + CW_CNT + l * 64;
    constexpr int rpw = 256;
    if (F.tid < 64) hist[F.tid] = 0;
    __syncthreads();
    const int ti = F.wave * 64 + F.lane;
    if (F.wave < 4) {
        const float* LOG = (const float*)(p.ws + WS_LOG) + (size_t)(r0 + ti) * 64;
        float sv[64], sel[64];
#pragma unroll
        for (int q = 0; q < 16; ++q) { const float4 t = *(const float4*)(LOG + 4 * q); sv[4 * q] = t.x; sv[4 * q + 1] = t.y; sv[4 * q + 2] = t.z; sv[4 * q + 3] = t.w; }
#pragma unroll
        for (int e = 0; e < 64; ++e) { sv[e] = fsigmoid(sv[e]); sel[e] = sv[e] + p.router_b[l * 64 + e]; }
        float gs[8];
#pragma unroll
        for (int g = 0; g < 8; ++g) { float m1 = fmaxf(sel[8 * g], sel[8 * g + 1]), m2 = fminf(sel[8 * g], sel[8 * g + 1]);
#pragma unroll
            for (int k = 2; k < 8; ++k) { const float x = sel[8 * g + k]; m2 = fmaxf(m2, fminf(m1, x)); m1 = fmaxf(m1, x); }
            gs[g] = m1 + m2; }
#pragma unroll
        for (int g = 0; g < 8; ++g) { int rank = 0;
#pragma unroll
            for (int k = 0; k < 8; ++k) if (k != g) rank += (gs[k] > gs[g] || (gs[k] == gs[g] && k < g)) ? 1 : 0;
            if (rank >= 4) {
#pragma unroll
                for (int k = 0; k < 8; ++k) sel[8 * g + k] = -INFINITY; } }
        float wsum = 0.f; int bi8[8]; float bw8[8];
#pragma unroll
        for (int s8 = 0; s8 < 8; ++s8) { float best = sel[0], bs = sv[0]; int bi = 0;
#pragma unroll
            for (int e = 1; e < 64; ++e) { const bool gt = sel[e] > best; best = gt ? sel[e] : best; bs = gt ? sv[e] : bs; bi = gt ? e : bi; }
#pragma unroll
            for (int e = 0; e < 64; ++e) sel[e] = (e == bi) ? -INFINITY : sel[e];
            bi8[s8] = bi; bw8[s8] = bs; wsum += bs; }
        const float sc = 2.5f / wsum;
#pragma unroll
        for (int s8 = 0; s8 < 8; ++s8) { const int rk = atomicAdd(&hist[bi8[s8]], 1); loc[ti * 8 + s8] = (bi8[s8] << 16) | rk; locw[ti * 8 + s8] = bw8[s8] * sc; }
    }
    __syncthreads();
    if (F.tid < 64) base[F.tid] = (int)__hip_atomic_fetch_add(CNT + F.tid, (unsigned)hist[F.tid], __ATOMIC_RELAXED, __HIP_MEMORY_SCOPE_AGENT);
    __syncthreads();
    for (int idx = F.tid; idx < rpw * 8; idx += NWAVES * 64) { const int v = loc[idx], e = v >> 16, rk = v & 0xffff; const int within = base[e] + rk;
        if (within < CAP) { const size_t pos = (size_t)e * CAP + within; LISTA[pos] = (r0 + (idx >> 3)) * 8 + (idx & 7); LISTW[pos] = locw[idx]; } }
    __syncthreads();
}
DEV void combine_pass(const Params& p, int hf, int nrows, int wave, int nw, int lane) {
    bf16_t* FS = (bf16_t*)(p.ws + WS_RY); const bf16_t* SL = (const bf16_t*)(p.ws + WS_SLOTS);
    for (int r = wave; r < nrows; r += nw) {
        bf16_t* fp = FS + (size_t)r * D + hf * 512 + lane * 8;
        f32x4 a0, a1; pg8::unpack8(*(const u32x4*)fp, a0, a1);
        u32x4 sv[8];
#pragma unroll
        for (int s = 0; s < 8; ++s) sv[s] = *(const u32x4*)(SL + ((size_t)r * 8 + s) * 512 + lane * 8);
#pragma unroll
        for (int s = 0; s < 8; ++s) { f32x4 b0, b1; pg8::unpack8(sv[s], b0, b1); a0 += b0; a1 += b1; }
        *(u32x4*)fp = pg8::pack8(a0, a1);
    }
}
DEV size_t summ_idx(int dir, int b, int pos, int which, int ch) { return ((((size_t)dir * 4 + b) * 66 + pos) * 2 + which) * 512 + ch; }
DEV f32x4 mfma16(bf16x8 a, bf16x8 b, f32x4 c) { return __builtin_amdgcn_mfma_f32_16x16x32_bf16(a, b, c, 0, 0, 0); }

template <int PASS>
DEV void chunk_pass(const Params& p, const Frame& F, int l_in, int c, bool do_gmlp) {
    int oz = 0; asm volatile("" : "+s"(oz));
    const int l = l_in + oz;
    const int lane = F.lane, h = F.wave, fr = lane & 15, fq = lane >> 4;
    const bf16_t* Z = (const bf16_t*)(p.ws + WS_Z); bf16_t* Y = (bf16_t*)(p.ws + WS_RY); float* SUMM = (float*)(p.ws + WS_SUMM);
    const unsigned char* W = p.ws + WS_W + oz;
    int r0, t0, n, b, posf, posb;
    if (c < 256) { b = c >> 6; const int k = c & 63; r0 = b * SEQ + k * 128; t0 = k * 128; n = SEQ; posf = 2 + k; posb = 2 + (63 - k); }
    else { const int cc = c - 256; b = cc >> 1; const int k = cc & 1; r0 = TL + b * CTXL + k * 128; t0 = k * 128; n = CTXL; posf = k; posb = 1 - k; }
    {
        LAS bf16_t* xcs = (LAS bf16_t*)(F.lds + h * 16384);
        TREG_BEGIN(1);
        bf16_t* XCT = (bf16_t*)(p.ws + WS_XCT) + ((size_t)c * 8 + h) * 8192;
        if (PASS == 1) {
            u32x4 t[16];
#pragma unroll
            for (int k = 0; k < 16; ++k) t[k] = *(const u32x4*)(XCT + (k * 64 + lane) * 8);
#pragma unroll
            for (int k = 0; k < 16; ++k) *(LAS u32x4*)(xcs + (k * 64 + lane) * 8) = t[k];
        } else {
            const int cg = lane & 7, rsub = lane >> 3, ch0 = h * 64 + cg * 8;
            float w[4][8], cb[8];
#pragma unroll
            for (int k = 0; k < 4; ++k) { const float4 a = *(const float4*)(p.conv_w + (size_t)(l * 4 + k) * 512 + ch0), bb = *(const float4*)(p.conv_w + (size_t)(l * 4 + k) * 512 + ch0 + 4);
                w[k][0] = a.x; w[k][1] = a.y; w[k][2] = a.z; w[k][3] = a.w; w[k][4] = bb.x; w[k][5] = bb.y; w[k][6] = bb.z; w[k][7] = bb.w; }
            { const float4 a = *(const float4*)(p.conv_b + l * 512 + ch0), bb = *(const float4*)(p.conv_b + l * 512 + ch0 + 4);
                cb[0] = a.x; cb[1] = a.y; cb[2] = a.z; cb[3] = a.w; cb[4] = bb.x; cb[5] = bb.y; cb[6] = bb.z; cb[7] = bb.w; }
            const bf16_t* Zx = Z + (size_t)r0 * 4096 + 1024 + ch0;
#pragma unroll 1
            for (int it = 0; it < 2; ++it) {
                const int tb = (it * 8 + rsub) * 8;
                u32x4 raw[11];
#pragma unroll
                for (int k = 0; k < 11; ++k) { const int tt = t0 + tb + k - 2; const int rowc = (tt >= 0 && tt < n) ? (tb + k - 2) : tb;
                    raw[k] = *(const u32x4*)(Zx + (long)rowc * 4096); }
#pragma unroll
                for (int k = 0; k < 11; ++k) { const int tt = t0 + tb + k - 2; if (!(tt >= 0 && tt < n)) raw[k] = (u32x4){0u, 0u, 0u, 0u}; }
#pragma unroll
                for (int o = 0; o < 8; ++o) {
                    float y[8];
#pragma unroll
                    for (int j = 0; j < 8; ++j) y[j] = cb[j];
#pragma unroll
                    for (int k = 0; k < 4; ++k) { f32x4 x0, x1; pg8::unpack8(raw[o + k], x0, x1);
#pragma unroll
                        for (int j = 0; j < 4; ++j) { y[j] += w[k][j] * x0[j]; y[4 + j] += w[k][4 + j] * x1[j]; } }
                    const u32x4 pk = pg8::pack8((f32x4){y[0], y[1], y[2], y[3]}, (f32x4){y[4], y[5], y[6], y[7]});
                    *(LAS u32x4*)(xcs + (tb + o) * 64 + cg * 8) = pk; *(u32x4*)(XCT + (tb + o) * 64 + cg * 8) = pk;
                }
            }
        }
        asm volatile("s_waitcnt lgkmcnt(0)" ::: "memory");
        TREG_END(1, F);
        TREG_BEGIN(2);
        float carry0 = 0.f, carry1 = 0.f;
        if (PASS == 1) {
            const int chl = h * 64 + lane;
#pragma unroll
            for (int dir = 0; dir < 2; ++dir) {
                const int np = dir ? posb : posf; float cr = 0.f;
                for (int q0 = 0; q0 < np; q0 += 16) { float a8[16], h8[16];
#pragma unroll
                    for (int j = 0; j < 16; ++j) { const int q = (q0 + j < np) ? q0 + j : np - 1; a8[j] = SUMM[summ_idx(dir, b, q, 0, chl)]; h8[j] = SUMM[summ_idx(dir, b, q, 1, chl)]; }
#pragma unroll
                    for (int j = 0; j < 16; ++j) if (q0 + j < np) cr = a8[j] * cr + h8[j]; }
                if (dir) carry1 = cr; else carry0 = cr;
            }
        }
        TREG_END(2, F);
        TREG_BEGIN(3);
#pragma unroll 1
        for (int ct = 0; ct < 4; ++ct) {
            const int chc = h * 64 + ct * 16 + fr;
            float hsum[8][4];
            u32x4 gbr[2][2];
            if (PASS == 1) {
#pragma unroll
                for (int hv = 0; hv < 2; ++hv) { const bf16_t* gp = Z + (size_t)(r0 + hv * 64 + lane) * 4096 + 1536 + h * 64 + ct * 16; gbr[hv][0] = *(const u32x4*)gp; gbr[hv][1] = *(const u32x4*)(gp + 8); }
            }
            bf16x8 wfr[2][4]; float bias_a2[2], bias_x2[2], spc2[2];
#pragma unroll
            for (int dir = 0; dir < 2; ++dir) {
                const bf16_t* wa = (const bf16_t*)(W + WO_LRU) + (size_t)(0 * 16 + dir * 8 + h) * 4096 + (size_t)(ct * 16 + fr) * 64 + 8 * fq;
                const bf16_t* wx = (const bf16_t*)(W + WO_LRU) + (size_t)(1 * 16 + dir * 8 + h) * 4096 + (size_t)(ct * 16 + fr) * 64 + 8 * fq;
                wfr[dir][0] = *(const bf16x8*)(wa); wfr[dir][1] = *(const bf16x8*)(wa + 32); wfr[dir][2] = *(const bf16x8*)(wx); wfr[dir][3] = *(const bf16x8*)(wx + 32);
                bias_a2[dir] = -1.4426950408889634f * p.lru_ba[(l * 2 + dir) * 512 + chc]; bias_x2[dir] = -1.4426950408889634f * p.lru_bx[(l * 2 + dir) * 512 + chc];
                spc2[dir] = -8.0f * log1pf(expf(-p.lru_lam[(l * 2 + dir) * 512 + chc])) * 1.4426950408889634f;
            }
#pragma unroll
            for (int dir = 0; dir < 2; ++dir) {
                const bf16x8 ba0 = wfr[dir][0], ba1 = wfr[dir][1], bx0 = wfr[dir][2], bx1 = wfr[dir][3];
                const float bias_a = bias_a2[dir], bias_x = bias_x2[dir], spc = spc2[dir];
                float Hrun = 0.f, Arun = 1.f;
                if (PASS == 1) Hrun = __shfl(dir ? carry1 : carry0, ct * 16 + fr);
                const int mypos = dir ? 3 - fq : fq;
#pragma unroll
                for (int grp = 0; grp < 2; ++grp) {
                    float av[4][4], dv[4][4], Ap[4], Hp[4], At[4], Ht[4];
#pragma unroll
                    for (int rq = 0; rq < 4; ++rq) {
                        const int rr = grp * 4 + rq, rt = dir ? 7 - rr : rr;
                        const bf16x8 f0 = *(const LAS bf16x8*)(xcs + (rt * 16 + fr) * 64 + 8 * fq), f1 = *(const LAS bf16x8*)(xcs + (rt * 16 + fr) * 64 + 32 + 8 * fq);
                        f32x4 aa = {bias_a, bias_a, bias_a, bias_a}, ax = {bias_x, bias_x, bias_x, bias_x};
                        aa = mfma16(f0, ba0, aa); aa = mfma16(f1, ba1, aa);
                        ax = mfma16(f0, bx0, ax); ax = mfma16(f1, bx1, ax);
#pragma unroll
                        for (int i = 0; i < 4; ++i) {
                            const float xc = bf2f(xcs[(rt * 16 + 4 * fq + i) * 64 + ct * 16 + fr]);
                            const float rg = __builtin_amdgcn_rcpf(1.f + __builtin_amdgcn_exp2f(aa[i])), ig = __builtin_amdgcn_rcpf(1.f + __builtin_amdgcn_exp2f(ax[i]));
                            const float a = __builtin_amdgcn_exp2f(spc * rg);
                            av[rq][i] = a; dv[rq][i] = __builtin_amdgcn_sqrtf(fmaxf(1.f - a * a, 0.f)) * (ig * xc);
                        }
                        float Al = 1.f, Hl = 0.f;
#pragma unroll
                        for (int s = 0; s < 4; ++s) { const int i = dir ? 3 - s : s; Hl = av[rq][i] * Hl + dv[rq][i]; Al = av[rq][i] * Al; }
                        float ap = 1.f, hp = 0.f, at = 1.f, ht = 0.f;
#pragma unroll
                        for (int s = 0; s < 4; ++s) { const int g = dir ? 3 - s : s; const float Ag = __shfl(Al, fr + 16 * g), Hg = __shfl(Hl, fr + 16 * g);
                            ht = Ag * ht + Hg; at = Ag * at;
                            const bool before = s < mypos; hp = before ? Ag * hp + Hg : hp; ap = before ? Ag * ap : ap; }
                        Ap[rq] = ap; Hp[rq] = hp; At[rq] = at; Ht[rq] = ht;
                    }
#pragma unroll
                    for (int rq = 0; rq < 4; ++rq) {
                        const int rr = grp * 4 + rq, rt = dir ? 7 - rr : rr;
                        if (PASS == 1) {
                            float hc = Ap[rq] * Hrun + Hp[rq];
#pragma unroll
                            for (int s = 0; s < 4; ++s) { const int i = dir ? 3 - s : s; hc = av[rq][i] * hc + dv[rq][i]; if (dir == 0) hsum[rt][i] = hc; else hsum[rt][i] += hc; }
                        }
                        Hrun = At[rq] * Hrun + Ht[rq]; Arun = At[rq] * Arun;
                    }
                    asm volatile("" ::: "memory");
                }
                if (PASS == 0 && fq == 0) { const int pos = dir ? posb : posf; SUMM[summ_idx(dir, b, pos, 0, chc)] = Arun; SUMM[summ_idx(dir, b, pos, 1, chc)] = Hrun; }
            }
            if (PASS == 1) {
                LAS bf16_t* sp = (LAS bf16_t*)(F.lds + SPW_OFF + h * SPW_BYTES);
#pragma unroll
                for (int hv = 0; hv < 2; ++hv) {
#pragma unroll
                    for (int j = 0; j < 4; ++j)
#pragma unroll
                        for (int i = 0; i < 4; ++i) sp[(j * 16 + 4 * fq + i) * 16 + fr] = f2bf(hsum[hv * 4 + j][i]);
                    asm volatile("s_waitcnt lgkmcnt(0)" ::: "memory");
                    const u32x4 s0 = *(const LAS u32x4*)(sp + lane * 16), s1 = *(const LAS u32x4*)(sp + lane * 16 + 8);
                    asm volatile("s_waitcnt lgkmcnt(0)" ::: "memory");
                    f32x4 a0, a1, b0, b1, g0, g1, g2, g3; pg8::unpack8(s0, a0, a1); pg8::unpack8(s1, b0, b1); pg8::unpack8(gbr[hv][0], g0, g1); pg8::unpack8(gbr[hv][1], g2, g3);
                    bf16_t* yp = Y + (size_t)(r0 + hv * 64 + lane) * D + 512 + h * 64 + ct * 16;
                    *(u32x4*)yp = pg8::pack8(a0 * g0, a1 * g1); *(u32x4*)(yp + 8) = pg8::pack8(b0 * g2, b1 * g3);
                }
            }
        }
        asm volatile("s_waitcnt vmcnt(0)" ::: "memory");
        TREG_END(3, F);
    }
    if (PASS == 0 && do_gmlp) {
        typedef float f32x2 __attribute__((ext_vector_type(2)));
        LAS f32x2* stats = (LAS f32x2*)(F.lds + STATS_OFF);
        TREG_BEGIN(4);
#pragma unroll 1
        for (int i0 = 0; i0 < 16; i0 += 8) {
            f32x4 v0[8], v1[8]; float mu[8], var[8];
#pragma unroll
            for (int j = 0; j < 8; ++j) pg8::unpack8(*(const u32x4*)(Z + (size_t)(r0 + F.wave * 16 + i0 + j) * 4096 + 512 + lane * 8), v0[j], v1[j]);
#pragma unroll
            for (int j = 0; j < 8; ++j) mu[j] = (v0[j][0] + v0[j][1]) + (v0[j][2] + v0[j][3]) + (v1[j][0] + v1[j][1]) + (v1[j][2] + v1[j][3]);
#pragma unroll
            for (int o = 1; o < 64; o <<= 1) {
#pragma unroll
                for (int j = 0; j < 8; ++j) mu[j] += __shfl_xor(mu[j], o); }
#pragma unroll
            for (int j = 0; j < 8; ++j) { mu[j] *= (1.f / 512.f); v0[j] -= mu[j]; v1[j] -= mu[j];
                var[j] = (v0[j][0] * v0[j][0] + v0[j][1] * v0[j][1]) + (v0[j][2] * v0[j][2] + v0[j][3] * v0[j][3]) + (v1[j][0] * v1[j][0] + v1[j][1] * v1[j][1]) + (v1[j][2] * v1[j][2] + v1[j][3] * v1[j][3]); }
#pragma unroll
            for (int o = 1; o < 64; o <<= 1) {
#pragma unroll
                for (int j = 0; j < 8; ++j) var[j] += __shfl_xor(var[j], o); }
            float m_ = mu[0], v_ = var[0];
#pragma unroll
            for (int j = 1; j < 8; ++j) { m_ = (lane == j) ? mu[j] : m_; v_ = (lane == j) ? var[j] : v_; }
            if (lane < 8) stats[F.wave * 16 + i0 + lane] = (f32x2){m_, rsqrtf(v_ * (1.f / 512.f) + 1e-5f)};
        }
        TREG_END(4, F);
        __syncthreads();
        TREG_BEGIN(5);
        const int g = F.wave;
        const bf16_t* Wg = (const bf16_t*)(W + WO_GWS) + (size_t)g * 128 * 128;
        LAS bf16_t* vn = (LAS bf16_t*)(F.lds + g * 16384);
        LAS bf16_t* sp = (LAS bf16_t*)(F.lds + SPW_OFF + g * SPW_BYTES);
        {
            const int cg = lane & 7, rsub = lane >> 3, ch0 = g * 64 + cg * 8;
            float lg[8], lb[8];
            { const float4 a = *(const float4*)(p.ln_g + l * 512 + ch0), bb = *(const float4*)(p.ln_g + l * 512 + ch0 + 4), c4 = *(const float4*)(p.ln_b + l * 512 + ch0), d4 = *(const float4*)(p.ln_b + l * 512 + ch0 + 4);
                lg[0] = a.x; lg[1] = a.y; lg[2] = a.z; lg[3] = a.w; lg[4] = bb.x; lg[5] = bb.y; lg[6] = bb.z; lg[7] = bb.w;
                lb[0] = c4.x; lb[1] = c4.y; lb[2] = c4.z; lb[3] = c4.w; lb[4] = d4.x; lb[5] = d4.y; lb[6] = d4.z; lb[7] = d4.w; }
            const bf16_t* Zv = Z + (size_t)r0 * 4096 + 512 + ch0;
#pragma unroll 1
            for (int i8 = 0; i8 < 16; i8 += 8) {
                u32x4 raw[8];
#pragma unroll
                for (int it = 0; it < 8; ++it) raw[it] = *(const u32x4*)(Zv + (long)((i8 + it) * 8 + rsub) * 4096);
#pragma unroll
                for (int it = 0; it < 8; ++it) { const int q = (i8 + it) * 8 + rsub; const f32x2 st = stats[q]; f32x4 x0, x1; pg8::unpack8(raw[it], x0, x1);
#pragma unroll
                    for (int j = 0; j < 4; ++j) { x0[j] = (x0[j] - st.x) * st.y * lg[j] + lb[j]; x1[j] = (x1[j] - st.x) * st.y * lg[4 + j] + lb[4 + j]; }
                    *(LAS u32x4*)(vn + q * 64 + cg * 8) = pg8::pack8(x0, x1); }
            }
        }
        asm volatile("s_waitcnt lgkmcnt(0)" ::: "memory");
        bf16x8 bfr[4][4];
#pragma unroll
        for (int ct = 0; ct < 4; ++ct)
#pragma unroll
            for (int ks = 0; ks < 4; ++ks) { unsigned wd[4];
#pragma unroll
                for (int j2 = 0; j2 < 4; ++j2) { const unsigned lo = vn[(ks * 32 + 8 * fq + 2 * j2) * 64 + ct * 16 + fr], hi = vn[(ks * 32 + 8 * fq + 2 * j2 + 1) * 64 + ct * 16 + fr]; wd[j2] = lo | (hi << 16); }
                bfr[ct][ks] = __builtin_bit_cast(bf16x8, (u32x4){wd[0], wd[1], wd[2], wd[3]}); }
        const bf16_t* Zu = Z + (size_t)r0 * 4096 + g * 64; bf16_t* Yu = Y + (size_t)r0 * D + g * 64;
        const int orow = lane >> 2, och = (lane & 3) * 16;
#pragma unroll 1
        for (int rt = 0; rt < 8; ++rt) {
            bf16x8 af[4];
#pragma unroll
            for (int ks = 0; ks < 4; ++ks) af[ks] = *(const bf16x8*)(Wg + (unsigned)((rt * 16 + fr) * 128 + ks * 32 + 8 * fq));
            const float4 bsv = *(const float4*)(p.gbs + (l * 8 + g) * 128 + rt * 16 + 4 * fq);
            const u32x4 u0 = *(const u32x4*)(Zu + (long)(rt * 16 + orow) * 4096 + och), u1 = *(const u32x4*)(Zu + (long)(rt * 16 + orow) * 4096 + och + 8);
            const float bs4[4] = {bsv.x, bsv.y, bsv.z, bsv.w};
#pragma unroll
            for (int ct = 0; ct < 4; ++ct) {
                f32x4 acc = {0.f, 0.f, 0.f, 0.f};
#pragma unroll
                for (int ks = 0; ks < 4; ++ks) acc = mfma16(af[ks], bfr[ct][ks], acc);
#pragma unroll
                for (int i = 0; i < 4; ++i) sp[(4 * fq + i) * 64 + ct * 16 + fr] = f2bf(acc[i] + bs4[i]);
            }
            asm volatile("s_waitcnt lgkmcnt(0)" ::: "memory");
            const u32x4 m0 = *(const LAS u32x4*)(sp + orow * 64 + och), m1 = *(const LAS u32x4*)(sp + orow * 64 + och + 8);
            asm volatile("s_waitcnt lgkmcnt(0)" ::: "memory");
            f32x4 a0, a1, b0, b1, c0, c1, d0, d1; pg8::unpack8(m0, a0, a1); pg8::unpack8(m1, b0, b1); pg8::unpack8(u0, c0, c1); pg8::unpack8(u1, d0, d1);
            bf16_t* yp = Yu + (long)(rt * 16 + orow) * D + och;
            *(u32x4*)yp = pg8::pack8(a0 * c0, a1 * c1); *(u32x4*)(yp + 8) = pg8::pack8(b0 * d0, b1 * d1);
        }
        asm volatile("s_waitcnt vmcnt(0)" ::: "memory"); TREG_END(5, F);
    }
    __syncthreads();
}
constexpr int NPL = 10, PH_FINAL = 1 + 2 * NPL, PH_END = PH_FINAL + 1;
struct Args { Params p; int ph_lo, ph_hi; };

DEV void build_toff(const Params& p, const Frame& F, int l, LAS int* toff) {
    if (F.tid < NE) { const unsigned* CNT = (const unsigned*)(p.ws + WS_CTL) + CW_CNT + l * 64;
        int cn = (int)__hip_atomic_load(CNT + F.tid, __ATOMIC_RELAXED, __HIP_MEMORY_SCOPE_AGENT); cn = cn < CAP ? cn : CAP;
        const int tiles = (cn + 255) >> 8; int incl = tiles;
#pragma unroll
        for (int o = 1; o < 64; o <<= 1) { const int t = __shfl_up(incl, o); if (F.lane >= o) incl += t; }
        const int excl = incl - tiles;
        toff[F.tid] = excl < 1120 ? excl : 1120; toff[80 + F.tid] = cn;
        if (F.tid == NE - 1) toff[64] = incl < 1120 ? incl : 1120; }
    __syncthreads();
    if (F.tid < NE) { LAS unsigned char* te = (LAS unsigned char*)(F.lds + SPW_OFF); for (int t = toff[F.tid]; t < toff[F.tid + 1]; ++t) te[t] = (unsigned char)F.tid; }
    __syncthreads();
}

template <int ph> DEV void run_phase(const Frame& F0) {
    Frame F = F0; { unsigned z_ = 0; asm volatile("" : "+v"(z_)); F.lane = (int)__builtin_amdgcn_mbcnt_hi(~0u, __builtin_amdgcn_mbcnt_lo(~0u, z_)); F.tid = F.wave * 64 + F.lane; }
    asm volatile("" : "+s"(F.G), "+s"(F.bx));
    const Params p = load_params(F);
    unsigned char* ws = p.ws; unsigned char* W = ws + WS_W;
    LAS int* toff = (LAS int*)(F.lds + MISC_OFF + 256);
    const int gw = F.bx * NWAVES + F.wave, NGW = F.G * NWAVES;
#ifndef NOPRO
    if (ph == 0) { if (F.bx == 0 && F.tid < 128) __hip_atomic_store((unsigned*)(p.ws + WS_CTL) + CW_CNT + F.tid, 0u, __ATOMIC_RELAXED, __HIP_MEMORY_SCOPE_AGENT);
        if (F.bx >= 192) { pe_table(p, F, (F.bx - 192) * 1024 + F.tid); pe_table(p, F, (F.bx - 192) * 1024 + 512 + F.tid); }
        mod_items(p, F); __syncthreads(); convert_weights(p, F, 0, 0, gw, NGW); return; }
    if (ph == PH_FINAL) { row_pass_A(p, 2, gw, NGW, F.lane); return; }
#endif
    constexpr int l = (ph - 1) / NPL, k = (ph - 1) % NPL;
    constexpr int nr = (l == 0) ? R : TL;
#ifndef PMASK
#define PMASK 0xffff
#endif
#define PON(k_) ((PMASK >> (k_)) & 1)
    switch (k) {
    case 0: if (PON(0)) { if (l > 0) convert_weights(p, F, l, 0, gw, NGW); row_pass_A(p, l, gw, NGW, F.lane); } break;
    case 1: if (PON(1)) {
#if GIN_FP8
        pg8::DenseSched<512, WS_H8, WS_W + WO_IN> S; S.init(ws, R, 4096, F.bx); pg8::EpiZ E{ws};
        pg8::gemm_phase<pg8::EpiZ, decltype(S), true, 0x7b>(F.lds, F.tid, S, E);
#else
        pg8::DenseSched<D, WS_RY, WS_W + WO_IN> S; S.init(ws, R, 4096, F.bx); pg8::EpiZ E{ws};
        pg8::gemm_phase<pg8::EpiZ, decltype(S), true>(F.lds, F.tid, S, E);
#endif
        if (F.bx >= 64) convert_weights(p, F, l, 2, (F.bx - 64) * NWAVES + F.wave, 192 * NWAVES); } break;
    case 2: if (PON(2)) { for (int c = F.bx; c < NCHUNK; c += F.G) chunk_pass<0>(p, F, l, c, l == 0 || c < 256);
        if (F.bx >= NCHUNK - F.G) { convert_weights(p, F, l, 1, (F.bx - (NCHUNK - F.G)) * NWAVES + F.wave, (2 * F.G - NCHUNK) * NWAVES); } } break;
    case 3: if (PON(3)) for (int c = F.bx; c < (l == 0 ? NCHUNK : 256); c += F.G) chunk_pass<1>(p, F, l, c, false); break;
    case 4: if (PON(4)) { pg8::DenseSched<D, WS_RY, WS_W + WO_AB> S; S.init(ws, nr, D, F.bx); pg8::EpiAB E{ws};
        pg8::gemm_phase<pg8::EpiAB, decltype(S), true>(F.lds, F.tid, S, E); } break;
    case 5: if (PON(5)) { pg8::DenseSched<D, WS_RA, WS_W + WO_OUT> S; S.init(ws, nr, D, F.bx); pg8::EpiPlain<WS_Z> E{ws};
        pg8::gemm_phase<pg8::EpiPlain<WS_Z>, decltype(S), true>(F.lds, F.tid, S, E); } break;
    case 6: if (PON(6)) row_pass_H(p, l, nr, gw, NGW, F.lane); break;
    case 7: if (PON(7)) { pg8::DenseSched<D, WS_RA, WS_W + WO_SR> S; S.init(ws, nr, 768, F.bx); pg8::EpiSR E{ws};
        pg8::gemm_phase<pg8::EpiSR, decltype(S), true>(F.lds, F.tid, S, E);
        asm volatile("s_waitcnt vmcnt(0)" ::: "memory"); __syncthreads();
        for (int i = 0;; ++i) { pg8::UnitD u; if (!S.next(i, u)) break; if (u.pn == 0) route_rows(p, F, l, u.pm * 256); } } break;
    case 8: if (PON(8)) { build_toff(p, F, l, toff);
        { pg8::ExpSched<512, 1, 2, WS_H2E, WS_W + WO_EG, (size_t)512 * D> S; S.ws = ws; S.lds = F.lds; S.U = toff[64] * 2; S.c = F.bx; S.brow0 = 0; S.Krt = 512;
          pg8::EpiEG<0> E{ws};
          pg8::gemm_phase<pg8::EpiEG<0>, decltype(S), true, 0x7b>(F.lds, F.tid, S, E); }
        { pg8::DenseSched<256, WS_SH, WS_W + WO_SD> S; S.init(ws, nr, D, 255 - F.bx); pg8::EpiPlain<WS_RY> E{ws};
          pg8::gemm_phase<pg8::EpiPlain<WS_RY>, decltype(S), true>(F.lds, F.tid, S, E); } } break;
    case 9: if (PON(9)) { build_toff(p, F, l, toff);
#if GED_FP8
        pg8::ExpSched<128, 0, 4, WS_HM, WS_W + WO_ED, (size_t)D * 256> S; S.ws = ws; S.lds = F.lds; S.U = toff[64] * 4; S.c = F.bx; S.brow0 = 0; S.Krt = 128;
        pg8::EpiED E{ws, F.lds};
        pg8::gemm_phase<pg8::EpiED, decltype(S), true, 0x7c>(F.lds, F.tid, S, E); } break;
#else
        pg8::ExpSched<256, 0, 4, WS_HM, WS_W + WO_ED, (size_t)D * 256 * 2> S; S.ws = ws; S.lds = F.lds; S.U = toff[64] * 4; S.c = F.bx; S.brow0 = 0; S.Krt = 256;
        pg8::EpiED E{ws, F.lds};
        pg8::gemm_phase<pg8::EpiED, decltype(S), true>(F.lds, F.tid, S, E); } break;
#endif
    }
}

__global__ void __launch_bounds__(NWAVES * 64, 2) mk_fwd(Args a) {
    extern __shared__ __attribute__((aligned(16))) unsigned char lds_raw[];
    Frame F; F.lds = (LAS unsigned char*)lds_raw; F.ldsg = lds_raw; F.tid = threadIdx.x; F.lane = F.tid & 63; F.wave = __builtin_amdgcn_readfirstlane(F.tid >> 6); F.G = gridDim.x; F.bx = blockIdx.x;
    volatile LAS unsigned* MISC = (volatile LAS unsigned*)(F.lds + MISC_OFF);
    for (int u = F.tid; u < (LDS_BYTES - MISC_OFF) / 4; u += NWAVES * 64) MISC[u] = 0u;
    store_params(F, a.p);
    __syncthreads();
    XcdBarrier bar; bar.bar = (GAS unsigned*)(a.p.ws + WS_CTL) + CW_BAR; bar.x = 0; bar.st = nullptr;
    const bool multi = a.ph_hi - a.ph_lo > 1;
    if (multi) bar = xcd_barrier_post((GAS unsigned*)(a.p.ws + WS_CTL) + CW_BAR, MISC);
#ifdef DELAYMASK
#define MK_PH(k_) if (a.ph_lo <= (k_) && (k_) < a.ph_hi) { const unsigned long long t0_ = __builtin_amdgcn_s_memrealtime(); run_phase<(k_)>(F); \
        { constexpr int kind = ((k_) == 0) ? 15 : ((k_) == PH_FINAL ? 0 : ((k_) - 1) % NPL); \
          if ((DELAYMASK >> kind) & 1) { __syncthreads(); const unsigned long long t1_ = __builtin_amdgcn_s_memrealtime(); while (__builtin_amdgcn_s_memrealtime() - t1_ < t1_ - t0_) __builtin_amdgcn_s_sleep(8); } } \
        if ((k_) + 1 < a.ph_hi) xcd_barrier(bar); }
#elif defined(PROBE_REGION)
#define MK_PH(k_) if (a.ph_lo <= (k_) && (k_) < a.ph_hi) { run_phase<(k_)>(F); \
        { __syncthreads(); const unsigned long long t1_ = __builtin_amdgcn_s_memrealtime(); const unsigned long long dt_ = MISC[16]; while (__builtin_amdgcn_s_memrealtime() - t1_ < dt_) __builtin_amdgcn_s_sleep(8); __syncthreads(); if (F.tid == 0) MISC[16] = 0u; } \
        if ((k_) + 1 < a.ph_hi) xcd_barrier(bar); }
#else
#define MK_PH(k_) if (a.ph_lo <= (k_) && (k_) < a.ph_hi) { run_phase<(k_)>(F); if ((k_) + 1 < a.ph_hi) xcd_barrier(bar); }
#endif
    MK_PH(0) MK_PH(1) MK_PH(2) MK_PH(3) MK_PH(4) MK_PH(5) MK_PH(6) MK_PH(7) MK_PH(8) MK_PH(9) MK_PH(10)
    MK_PH(11) MK_PH(12) MK_PH(13) MK_PH(14) MK_PH(15) MK_PH(16) MK_PH(17) MK_PH(18) MK_PH(19) MK_PH(20) MK_PH(21)
#undef MK_PH
}
#ifndef FAST
#define FAST 0x1ff
#endif
#if FAST != 0x1ff
constexpr size_t WS_NV1 = 538 * MiB;
constexpr size_t WS_NSG = 291 * MiB, WS_NFLS = 324 * MiB;
__global__ void __launch_bounds__(256) k_mod(Params p) {
    const int e = blockIdx.x * 256 + threadIdx.x, cond = blockIdx.y, l = blockIdx.z;
    const float* cv = cond < 4 ? p.c + cond * D : p.c_ctx;
    const float* w = p.w_mod + (size_t)l * D * 6 * D;
    float acc = p.b_mod[l * 6 * D + e];
    for (int d = 0; d < D; ++d) acc += siluf_(cv[d]) * w[(size_t)d * 6 * D + e];
    ((float*)(p.ws + WS_MOD))[(size_t)(l * 5 + cond) * 6 * D + e] = acc;
}
__global__ void __launch_bounds__(256) k_rowA(Params p, int l) { row_pass_A(p, l, (blockIdx.x * 256 + threadIdx.x) >> 6, (gridDim.x * 256) >> 6, threadIdx.x & 63); }
__global__ void __launch_bounds__(256) k_rowH(Params p, int l, int nrows) { row_pass_H(p, l, nrows, (blockIdx.x * 256 + threadIdx.x) >> 6, (gridDim.x * 256) >> 6, threadIdx.x & 63); }
struct ABf16 { const bf16_t* A; int lda, coff; DEV float operator()(int m, int k) const { return bf2f(A[(size_t)m * lda + coff + k]); } };
struct BF32 { const float* B; int ldb, pad; DEV float operator()(int k, int n) const { return B[(size_t)k * ldb + n]; } };
struct BAB { const float* Ba; const float* Bb; DEV float operator()(int k, int n) const { return k < 512 ? Ba[(size_t)k * D + n] : Bb[(size_t)(k - 512) * D + n]; } };
struct NEpiZ { bf16_t* Z; DEV void operator()(int m, int n, float v, float) const {
    float o; if (n < 1024) o = gelu_tanh(v); else if (n < 1536) o = v; else if (n < 2048) o = gelu_tanh(v); else o = sigmoidf_(v);
    Z[(size_t)m * 4096 + n] = f2bf(o); } };
struct NEpiF32 { float* C; int ldc, pad; DEV void operator()(int m, int n, float v, float) const { C[(size_t)m * ldc + n] = v; } };
struct NEpiBf { bf16_t* C; int ldc, pad; DEV void operator()(int m, int n, float v, float) const { C[(size_t)m * ldc + n] = f2bf(v); } };
struct NEpiMerge { const bf16_t* Z; bf16_t* M; DEV void operator()(int m, int n, float vb, float va) const {
    const float ga = bf2f(Z[(size_t)m * 4096 + 2048 + n]), gr = bf2f(Z[(size_t)m * 4096 + 3072 + n]);
    M[(size_t)m * D + n] = f2bf(ga * va + gr * vb); } };
struct NEpiSwi { const float* SG; bf16_t* SH; DEV void operator()(int m, int n, float v, float) const { SH[(size_t)m * 256 + n] = f2bf(siluf_(SG[(size_t)m * 256 + n]) * v); } };
template <class AL, class BL, class EP, int SPLIT>
__global__ void __launch_bounds__(256) k_gemm(AL al, BL bl, EP ep, int K) {
    __shared__ __attribute__((aligned(16))) float As[16][68];
    __shared__ __attribute__((aligned(16))) float Bs[16][68];
    const int tid = threadIdx.x, tx = tid & 15, ty = tid >> 4, m0 = blockIdx.y * 64, n0 = blockIdx.x * 64;
    float acc[4][4], acc2[4][4];
#pragma unroll
    for (int i = 0; i < 4; ++i)
#pragma unroll
        for (int j = 0; j < 4; ++j) { acc[i][j] = 0.f; acc2[i][j] = 0.f; }
    for (int k0 = 0; k0 < K; k0 += 16) {
        if (SPLIT && k0 == SPLIT) {
#pragma unroll
            for (int i = 0; i < 4; ++i)
#pragma unroll
                for (int j = 0; j < 4; ++j) { acc2[i][j] = acc[i][j]; acc[i][j] = 0.f; }
        }
#pragma unroll
        for (int i = 0; i < 4; ++i) { const int e = tid + 256 * i, kk = e & 15, mm = e >> 4; As[kk][mm] = al(m0 + mm, k0 + kk); }
#pragma unroll
        for (int i = 0; i < 4; ++i) { const int e = tid + 256 * i, nn = e & 63, kk = e >> 6; Bs[kk][nn] = bl(k0 + kk, n0 + nn); }
        __syncthreads();
#pragma unroll
        for (int kk = 0; kk < 16; ++kk) {
            const float4 a = *(const float4*)&As[kk][ty * 4]; const float4 b = *(const float4*)&Bs[kk][tx * 4];
            const float av[4] = {a.x, a.y, a.z, a.w}, bv[4] = {b.x, b.y, b.z, b.w};
#pragma unroll
            for (int i = 0; i < 4; ++i)
#pragma unroll
                for (int j = 0; j < 4; ++j) acc[i][j] += av[i] * bv[j];
        }
        __syncthreads();
    }
#pragma unroll
    for (int i = 0; i < 4; ++i)
#pragma unroll
        for (int j = 0; j < 4; ++j) ep(m0 + ty * 4 + i, n0 + tx * 4 + j, acc[i][j], acc2[i][j]);
}
__global__ void __launch_bounds__(256) k_conv(Params p, int l) {
    const size_t idx = (size_t)blockIdx.x * 256 + threadIdx.x; const int r = (int)(idx >> 9), ch = (int)(idx & 511);
    const bf16_t* Z = (const bf16_t*)(p.ws + WS_Z); float* XCONV = (float*)(p.ws + WS_NV1);
    int t, n; if (r < TL) { t = r & (SEQ - 1); n = SEQ; } else { t = (r - TL) & (CTXL - 1); n = CTXL; }
    const int base = r - t;
    float y = p.conv_b[l * 512 + ch];
#pragma unroll
    for (int k = 0; k < 4; ++k) { const int tt = t + k - 2; if (tt >= 0 && tt < n) y += p.conv_w[(l * 4 + k) * 512 + ch] * bf2f(Z[(size_t)(base + tt) * 4096 + 1024 + ch]); }
    XCONV[(size_t)r * 512 + ch] = y;
}
__global__ void __launch_bounds__(64) k_scan(Params p, int l, int dir) {
    const int b = blockIdx.x >> 3, h = blockIdx.x & 7, j = threadIdx.x, ch = h * 64 + j;
    const float* XCONV = (const float*)(p.ws + WS_NV1); float* HS = (float*)(p.ws + WS_RA);
    const float* wa = p.lru_wa + (size_t)((l * 2 + dir) * 8 + h) * 4096; const float* wx = p.lru_wx + (size_t)((l * 2 + dir) * 8 + h) * 4096;
    float wac[64], wxc[64];
#pragma unroll
    for (int i = 0; i < 64; ++i) { wac[i] = wa[i * 64 + j]; wxc[i] = wx[i * 64 + j]; }
    const float ba = p.lru_ba[(l * 2 + dir) * 512 + ch], bx = p.lru_bx[(l * 2 + dir) * 512 + ch];
    const float sp = log1pf(expf(-p.lru_lam[(l * 2 + dir) * 512 + ch]));
    float hst = 0.f;
    for (int step = 0; step < CTXL + SEQ; ++step) {
        int r;
        if (dir == 0) r = step < CTXL ? TL + b * CTXL + step : b * SEQ + (step - CTXL);
        else r = step < CTXL ? TL + b * CTXL + (CTXL - 1 - step) : b * SEQ + (SEQ - 1 - (step - CTXL));
        const float* xr = XCONV + (size_t)r * 512 + h * 64;
        float pr = ba, px = bx;
#pragma unroll
        for (int i = 0; i < 16; ++i) { const float4 xv = *(const float4*)(xr + 4 * i);
            pr += xv.x * wac[4 * i] + xv.y * wac[4 * i + 1] + xv.z * wac[4 * i + 2] + xv.w * wac[4 * i + 3];
            px += xv.x * wxc[4 * i] + xv.y * wxc[4 * i + 1] + xv.z * wxc[4 * i + 2] + xv.w * wxc[4 * i + 3]; }
        const float rg = sigmoidf_(pr), ig = sigmoidf_(px);
        const float log_a = -8.0f * rg * sp;
        const float a = expf(log_a), drv = sqrtf(-expm1f(2.0f * log_a)) * (ig * xr[j]);
        hst = a * hst + drv;
        if (dir == 0) HS[(size_t)r * 512 + ch] = hst; else HS[(size_t)r * 512 + ch] += hst;
    }
}
__global__ void __launch_bounds__(256) k_yb(Params p) {
    const size_t idx = (size_t)blockIdx.x * 256 + threadIdx.x; const int r = (int)(idx >> 9), ch = (int)(idx & 511);
    const bf16_t* Z = (const bf16_t*)(p.ws + WS_Z); const float* HS = (const float*)(p.ws + WS_RA); bf16_t* Y = (bf16_t*)(p.ws + WS_RY);
    Y[(size_t)r * D + 512 + ch] = f2bf(HS[(size_t)r * 512 + ch] * bf2f(Z[(size_t)r * 4096 + 1536 + ch]));
}
__global__ void __launch_bounds__(256) k_ln(Params p, int l, int nrows) {
    const int lane = threadIdx.x & 63, wave = (blockIdx.x * 256 + threadIdx.x) >> 6, nw = (gridDim.x * 256) >> 6;
    const bf16_t* Z = (const bf16_t*)(p.ws + WS_Z); float* VN = (float*)(p.ws + WS_NV1);
    for (int r = wave; r < nrows; r += nw) {
        float v[8]; float s = 0.f;
#pragma unroll
        for (int i = 0; i < 8; ++i) { v[i] = bf2f(Z[(size_t)r * 4096 + 512 + i * 64 + lane]); s += v[i]; }
        const float mu = wave_sum(s) * (1.f / 512.f); float q = 0.f;
#pragma unroll
        for (int i = 0; i < 8; ++i) { v[i] -= mu; q += v[i] * v[i]; }
        const float rstd = rsqrtf(wave_sum(q) * (1.f / 512.f) + 1e-5f);
#pragma unroll
        for (int i = 0; i < 8; ++i) { const int cch = i * 64 + lane; VN[(size_t)r * 512 + cch] = v[i] * rstd * p.ln_g[l * 512 + cch] + p.ln_b[l * 512 + cch]; }
    }
}
__global__ void __launch_bounds__(256) k_mix(Params p, int l) {
    const size_t idx = (size_t)blockIdx.x * 256 + threadIdx.x; const int r = (int)(idx >> 9), ch = (int)(idx & 511), g = ch >> 6;
    const bf16_t* Z = (const bf16_t*)(p.ws + WS_Z); const float* VN = (const float*)(p.ws + WS_NV1); bf16_t* Y = (bf16_t*)(p.ws + WS_RY);
    const int base = r & ~127, pp = r & 127;
    const float* w = p.gws + ((size_t)(l * 8 + g) * 128 + pp) * 128;
    float acc = p.gbs[(l * 8 + g) * 128 + pp];
    for (int q = 0; q < 128; ++q) acc += w[q] * VN[(size_t)(base + q) * 512 + ch];
    Y[(size_t)r * D + ch] = f2bf(bf2f(Z[(size_t)r * 4096 + ch]) * acc);
}
__global__ void __launch_bounds__(256) k_route(Params p, int l, int nrows) {
    const int lane = threadIdx.x & 63, wave = (blockIdx.x * 256 + threadIdx.x) >> 6, nw = (gridDim.x * 256) >> 6;
    int* TOPI = (int*)(p.ws + WS_TOPI); float* TOPW = (float*)(p.ws + WS_TOPW);
    for (int r = wave; r < nrows; r += nw) { int myi; float myw; route_token(p, l, ((const float*)(p.ws + WS_LOG))[(size_t)r * 64 + lane], lane, myi, myw);
        if (lane < 8) { TOPI[(size_t)r * 8 + lane] = myi; TOPW[(size_t)r * 8 + lane] = myw; } }
}
__global__ void __launch_bounds__(256) k_routed(Params p, int l) {
    __shared__ float hs[D]; __shared__ float hm[256];
    const int r = blockIdx.x, tid = threadIdx.x;
    const bf16_t* H2 = (const bf16_t*)(p.ws + WS_RA); const int* TOPI = (const int*)(p.ws + WS_TOPI); const float* TOPW = (const float*)(p.ws + WS_TOPW);
    const float* FLs = (const float*)(p.ws + WS_NFLS); bf16_t* FL = (bf16_t*)(p.ws + WS_RY);
#pragma unroll
    for (int i = 0; i < 4; ++i) hs[tid + 256 * i] = bf2f(H2[(size_t)r * D + tid + 256 * i]);
    float acc[4] = {0.f, 0.f, 0.f, 0.f};
    __syncthreads();
    for (int s = 0; s < 8; ++s) {
        const int e = TOPI[(size_t)r * 8 + s]; const float w = TOPW[(size_t)r * 8 + s];
        const float* wg = p.e_g + ((size_t)(l * NE + e) * D) * 256; const float* wu = p.e_u + ((size_t)(l * NE + e) * D) * 256;
        float g = 0.f, u = 0.f;
        for (int k = 0; k < D; ++k) { const float hv = hs[k]; g += hv * wg[(size_t)k * 256 + tid]; u += hv * wu[(size_t)k * 256 + tid]; }
        hm[tid] = siluf_(g) * u;
        __syncthreads();
        const float* wd = p.e_d + ((size_t)(l * NE + e) * 256) * D;
        float o[4] = {0.f, 0.f, 0.f, 0.f};
        for (int j = 0; j < 256; ++j) { const float hv = hm[j];
#pragma unroll
            for (int i = 0; i < 4; ++i) o[i] += hv * wd[(size_t)j * D + tid + 256 * i]; }
#pragma unroll
        for (int i = 0; i < 4; ++i) acc[i] += w * o[i];
        __syncthreads();
    }
#pragma unroll
    for (int i = 0; i < 4; ++i) FL[(size_t)r * D + tid + 256 * i] = f2bf(FLs[(size_t)r * D + tid + 256 * i] + acc[i]);
}
template <int SPLIT, class AL, class BL, class EP>
static void ngemm(hipStream_t st, int M, int N, int K, AL al, BL bl, EP ep) { hipLaunchKernelGGL((k_gemm<AL, BL, EP, SPLIT>), dim3(N / 64, M / 64), dim3(256), 0, st, al, bl, ep, K); }
#endif

static void mk(hipStream_t st, const Params& p, int lo, int hi) { Args a{}; a.p = p; a.ph_lo = lo; a.ph_hi = hi; hipLaunchKernelGGL(mk_fwd, dim3(256), dim3(NWAVES * 64), LDS_BYTES, st, a); }

extern "C" void kernel_launch(void* const* d_in, const int* in_sizes, int n_in, void* d_out, int out_size, void* d_ws, size_t ws_size, hipStream_t stream) {
    static int ready = 0;
    if (ready == 0) {
        ready = -1;
        if (n_in != 33 || ws_size < WS_END || out_size != TL * D) return;
        int dev = 0, cus = 0;
        if (hipGetDevice(&dev) != hipSuccess || hipDeviceGetAttribute(&cus, hipDeviceAttributeMultiprocessorCount, dev) != hipSuccess || cus < 256) return;
        if (hipFuncSetAttribute((const void*)mk_fwd, hipFuncAttributeMaxDynamicSharedMemorySize, LDS_BYTES) != hipSuccess) return;
        ready = 1;
    }
    if (ready < 0) return;
    Params p{};
    const float** pp = (const float**)&p;
    for (int i = 0; i < 33; ++i) pp[i] = (const float*)d_in[i];
    p.out = (float*)d_out; p.ws = (unsigned char*)d_ws;
    (void)hipMemsetAsync((char*)d_ws + WS_CTL, 0, 1 * MiB, stream);
#if FAST == 0x1ff && !defined(MK_PER_PHASE)
    mk(stream, p, 0, PH_END);
#elif FAST == 0x1ff
    for (int ph = 0; ph < PH_END; ++ph) mk(stream, p, ph, ph + 1);
#else
    unsigned char* ws = p.ws;
    bf16_t* RA = (bf16_t*)(ws + WS_RA); bf16_t* Z = (bf16_t*)(ws + WS_Z); bf16_t* RY = (bf16_t*)(ws + WS_RY);
    float* LOG = (float*)(ws + WS_LOG); float* SG = (float*)(ws + WS_NSG); bf16_t* SH = (bf16_t*)(ws + WS_SH); float* FLs = (float*)(ws + WS_NFLS);
    mk(stream, p, 0, 1);
    if (!(FAST & 1)) hipLaunchKernelGGL(k_mod, dim3(24, 5, 2), dim3(256), 0, stream, p);
    for (int l = 0; l < 2; ++l) {
        const int nr = (l == 0) ? R : TL, b0 = 1 + l * NPL;
        if (FAST & 2) mk(stream, p, b0 + 0, b0 + 1); else { if (l > 0) mk(stream, p, 100 + l, 101 + l); hipLaunchKernelGGL(k_rowA, dim3(2048), dim3(256), 0, stream, p, l); }
        if (FAST & 4) mk(stream, p, b0 + 1, b0 + 2); else ngemm<0>(stream, R, 4096, D, ABf16{RA, D, 0}, BF32{p.w_in + (size_t)l * D * 4096, 4096, 0}, NEpiZ{Z});
        if (FAST & 8) { mk(stream, p, b0 + 2, b0 + 3); mk(stream, p, b0 + 3, b0 + 4); }
        else {
            hipLaunchKernelGGL(k_conv, dim3(R * 512 / 256), dim3(256), 0, stream, p, l);
            for (int dir = 0; dir < 2; ++dir) hipLaunchKernelGGL(k_scan, dim3(NBATCH * 8), dim3(64), 0, stream, p, l, dir);
            hipLaunchKernelGGL(k_yb, dim3(nr * 512 / 256), dim3(256), 0, stream, p);
            hipLaunchKernelGGL(k_ln, dim3(2048), dim3(256), 0, stream, p, l, nr);
            hipLaunchKernelGGL(k_mix, dim3(nr * 512 / 256), dim3(256), 0, stream, p, l);
        }
        if (FAST & 16) mk(stream, p, b0 + 4, b0 + 5); else ngemm<512>(stream, nr, D, D, ABf16{RY, D, 0}, BAB{p.w_out_a + (size_t)l * 512 * D, p.w_out_b + (size_t)l * 512 * D}, NEpiMerge{Z, RA});
        if (FAST & 32) mk(stream, p, b0 + 5, b0 + 6); else ngemm<0>(stream, nr, D, D, ABf16{RA, D, 0}, BF32{p.w_out + (size_t)l * D * D, D, 0}, NEpiBf{Z, D, 0});
        if (FAST & 64) mk(stream, p, b0 + 6, b0 + 7); else hipLaunchKernelGGL(k_rowH, dim3(2048), dim3(256), 0, stream, p, l, nr);
        if (FAST & 128) { mk(stream, p, b0 + 7, b0 + 8); mk(stream, p, b0 + 8, b0 + 9); }
        else {
            ngemm<0>(stream, nr, 64, D, ABf16{RA, D, 0}, BF32{p.router_w + (size_t)l * D * 64, 64, 0}, NEpiF32{LOG, 64, 0});
            hipLaunchKernelGGL(k_route, dim3(2048), dim3(256), 0, stream, p, l, nr);
            ngemm<0>(stream, nr, 256, D, ABf16{RA, D, 0}, BF32{p.s_g + (size_t)l * D * 256, 256, 0}, NEpiF32{SG, 256, 0});
            ngemm<0>(stream, nr, 256, D, ABf16{RA, D, 0}, BF32{p.s_u + (size_t)l * D * 256, 256, 0}, NEpiSwi{SG, SH});
        }
        if (FAST & 256) { for (int k = 9; k < NPL; ++k) mk(stream, p, b0 + k, b0 + k + 1); }
        else {
            ngemm<0>(stream, nr, D, 256, ABf16{SH, 256, 0}, BF32{p.s_d + (size_t)l * 256 * D, D, 0}, NEpiF32{FLs, D, 0});
            hipLaunchKernelGGL(k_routed, dim3(nr), dim3(256), 0, stream, p, l);
        }
    }
    if (FAST & 2) mk(stream, p, PH_FINAL, PH_END); else hipLaunchKernelGGL(k_rowA, dim3(2048), dim3(256), 0, stream, p, 2);
#endif
}
```

```cpp
#include <hip/hip_runtime.h>
#include <stdint.h>
#include <math.h>

#ifndef GIN_FP8
#define GIN_FP8 1
#endif
#ifndef GED_FP8
#define GED_FP8 1
#endif
typedef unsigned short bf16_t;
#define DEV __device__ __forceinline__
#define LAS __attribute__((address_space(3)))
#define GAS __attribute__((address_space(1)))
typedef short bf16x8 __attribute__((ext_vector_type(8)));
typedef float f32x4 __attribute__((ext_vector_type(4)));
typedef unsigned u32x4 __attribute__((ext_vector_type(4)));
typedef unsigned u32x2 __attribute__((ext_vector_type(2)));

constexpr int D = 1024, NBATCH = 4, SEQ = 8192, CTXL = 256;
constexpr int TL = NBATCH * SEQ, TC = NBATCH * CTXL, R = TL + TC;
constexpr int NE = 64, CAP = R;
constexpr int NCHUNK = R / 128;
constexpr size_t MiB = 1u << 20;
constexpr size_t WS_CTL = 0;
constexpr size_t WS_PE = 1 * MiB + 512 * 1024  ;
constexpr size_t WS_MOD = 1 * MiB, WS_H8 = 2 * MiB  , WS_LISTA = 6 * MiB  , WS_LISTW = 15 * MiB  , WS_SUMM = 24 * MiB, WS_LOG = 27 * MiB;
constexpr size_t WS_TOPI = WS_LOG, WS_TOPW = WS_LOG;
constexpr size_t WS_W = 36 * MiB;
constexpr size_t WS_XC = 84 * MiB;
constexpr size_t WS_RY = 148 * MiB;
constexpr size_t WS_Z = 214 * MiB;
constexpr size_t WS_HM = 214 * MiB;
constexpr size_t WS_SH = 354 * MiB;
constexpr size_t WS_SLOTS = 354 * MiB;
constexpr size_t WS_RA = 478 * MiB;
constexpr size_t WS_LR = 478 * MiB;
constexpr size_t WS_XCT = 478 * MiB;
constexpr size_t WS_H2E = 544 * MiB;
constexpr size_t WS_END = 618 * MiB;
constexpr size_t WO_IN = 0, WO_AB = 8 * MiB, WO_OUT = 10 * MiB, WO_SR = 12 * MiB  , WO_SD = 14 * MiB  , WO_LRU = 15 * MiB  ,
                 WO_GWS = 15 * MiB + MiB / 2  , WO_EG = 16 * MiB  , WO_ED = 80 * MiB  ;
constexpr int CW_CNT = 64;
constexpr int CW_BAR = 4096;

struct Params {
    const float *x, *c, *ctx, *c_ctx, *w_mod, *b_mod, *g_pre_mix, *g_post_mix, *g_pre_ffn, *g_post_ffn, *w_in, *ln_g, *ln_b, *gws, *gbs,
        *conv_w, *conv_b, *lru_wa, *lru_ba, *lru_wx, *lru_bx, *lru_lam, *w_out_a, *w_out_b, *w_out, *router_w, *router_b, *e_g, *e_u, *e_d, *s_g, *s_u, *s_d;
    float* out; unsigned char* ws;
};

DEV float bf2f(bf16_t v) { return __uint_as_float(((unsigned)v) << 16); }
DEV bf16_t f2bf(float f) { unsigned u = __float_as_uint(f); return (bf16_t)((u + 0x7fffu + ((u >> 16) & 1u)) >> 16); }
DEV unsigned pk2(float lo, float hi) { return (unsigned)f2bf(lo) | ((unsigned)f2bf(hi) << 16); }
DEV float sigmoidf_(float x) { return 1.f / (1.f + expf(-x)); }
DEV float siluf_(float x) { return x / (1.f + expf(-x)); }
DEV float gelu_tanh(float x) { return 0.5f * x * (1.f + tanhf(0.7978845608028654f * (x + 0.044715f * x * x * x))); }
DEV float fsigmoid(float x) { return __builtin_amdgcn_rcpf(1.f + __builtin_amdgcn_exp2f(-1.4426950408889634f * x)); }
DEV float fsilu(float x) { return x * fsigmoid(x); }
DEV float fgelu(float x) { const float u = 1.5957691216057308f * (x + 0.044715f * x * x * x); return x * fsigmoid(u); }
DEV float wave_sum(float v) {
#pragma unroll
    for (int o = 1; o < 64; o <<= 1) v += __shfl_xor(v, o);
    return v;
}
DEV const float* mod_ptr(const Params& p, int l, int cond, int j) { return (const float*)(p.ws + WS_MOD) + ((size_t)((l * 5 + cond) * 6 + j)) * D; }
DEV float* xl_row(const Params& p, int r) { return r < TL ? p.out + (size_t)r * D : (float*)(p.ws + WS_XC) + (size_t)(r - TL) * D; }
namespace pg8 {
constexpr int BM = 256, BK = 64, HALF = 128, HTB = HALF * BK * 2  , STAGE_BYTES = 8 * HTB;
DEV int lds_byte(int r, int c) { const int st = (r >> 4) * 2 + (c >> 5), rr = r & 15, cc = c & 31, ob = rr * 64 + cc * 2; return st * 1024 + (ob ^ (((ob >> 9) & 1) << 5)); }
DEV void stage_rc(int b, int& Rr, int& C) { const int st = b / 1024, sb = b % 1024, swz = sb ^ (((sb >> 9) & 1) << 5); Rr = (st >> 1) * 16 + swz / 64; C = (st & 1) * 32 + (swz % 64) / 2; }
DEV int perm32(int rho) { const int n = rho >> 4, i = rho & 15; return 8 * (i >> 2) + 4 * n + (i & 3); }
DEV unsigned cvt_pk_bf16(float lo, float hi) { unsigned r; asm volatile("v_cvt_pk_bf16_f32 %0, %1, %2" : "=v"(r) : "v"(lo), "v"(hi)); return r; }
DEV u32x4 pack8(const f32x4 v0, const f32x4 v1) { u32x4 w; w.x = cvt_pk_bf16(v0[0], v0[1]); w.y = cvt_pk_bf16(v0[2], v0[3]); w.z = cvt_pk_bf16(v1[0], v1[1]); w.w = cvt_pk_bf16(v1[2], v1[3]); return w; }
DEV void unpack8(const u32x4 w, f32x4& v0, f32x4& v1) {
    v0[0] = __uint_as_float(w.x << 16); v0[1] = __uint_as_float(w.x & 0xffff0000u); v0[2] = __uint_as_float(w.y << 16); v0[3] = __uint_as_float(w.y & 0xffff0000u);
    v1[0] = __uint_as_float(w.z << 16); v1[1] = __uint_as_float(w.z & 0xffff0000u); v1[2] = __uint_as_float(w.w << 16); v1[3] = __uint_as_float(w.w & 0xffff0000u);
}
DEV int xcd_remap(int L, int U) { const int q = U / 8, r = U % 8, xcd = L % 8, off = L / 8; return (xcd < r ? xcd * (q + 1) : r * (q + 1) + (xcd - r) * q) + off; }

struct UnitD { int pm, pn; };
template <int K, size_t AOFF, size_t BOFF> struct DenseSched {
    typedef UnitD Unit; static constexpr int KK = K;
    const unsigned char* ws; int nM, nN, nwg, c, Krt; static constexpr int G = 256;
    DEV void init(const unsigned char* ws_, int M, int N, int c_) { ws = ws_; nM = M / BM; nN = N / BM; nwg = nM * nN; c = c_; Krt = K; asm volatile("" : "+s"(Krt)); }
    DEV bool next(int i, Unit& u) const {
        const int L = i * G + c; if (L >= nwg) return false;
        const int wgid = xcd_remap(L, nwg);
        const int nig = 8 * nN, gid = wgid / nig, fm = gid * 8, gsz = (nM - fm) < 8 ? (nM - fm) : 8;
        u.pm = fm + ((wgid % nig) % gsz); u.pn = (wgid % nig) / gsz; return true;
    }
    DEV const char* abase(const Unit& u) const { return (const char*)ws + AOFF + (size_t)u.pm * BM * K * 2; }
    DEV const char* bbase(const Unit& u) const { return (const char*)ws + BOFF + (size_t)u.pn * BM * K * 2; }
    DEV void prefetch(const Unit&, LAS unsigned char*, int, int) const {}
    DEV void aoffs(const Unit&, int tid, unsigned (&v)[2][2], LAS unsigned char*, int, bool) const {
#pragma unroll
        for (int i = 0; i < 2; ++i) { int Rr, C; stage_rc(tid * 16 + i * 8192, Rr, C);
#pragma unroll
            for (int h = 0; h < 2; ++h) v[h][i] = (unsigned)((h * HALF + Rr) * K + C) * 2u; }
    }
};
struct UnitE { int e, row0, cnt, hmrow0, pn; };
template <int K, int GATHER, int NCOL, size_t AOFF, size_t BOFF, size_t BSTRIDE> struct ExpSched {
    typedef UnitE Unit; static constexpr int KK = K;
    const unsigned char* ws; LAS unsigned char* lds;
    int U, c, brow0, Krt; static constexpr int ncol = NCOL, gather = GATHER, G = 256;
    DEV bool next(int i, Unit& u) const {
        const int L = i * G + c; if (L >= U) return false;
        const int id = xcd_remap(L, U), tile = id / ncol; u.pn = id % ncol;
        const LAS int* toff = (const LAS int*)(lds + 131072 + 256);
        const int e = (int)((const LAS unsigned char*)(lds + 131072 + 2048))[tile];
        u.e = e; u.row0 = (tile - toff[e]) * BM; u.cnt = toff[80 + e]; u.hmrow0 = tile * BM; return true;
    }
    DEV const char* abase(const Unit& u) const { return gather ? (const char*)ws + AOFF : (const char*)ws + AOFF + (size_t)u.hmrow0 * K * 2; }
    DEV const char* bbase(const Unit& u) const { return (const char*)ws + BOFF + (size_t)u.e * BSTRIDE + (size_t)(brow0 + u.pn * BM) * K * 2; }
    DEV void prefetch(const Unit& u, LAS unsigned char* lds_, int wid, int lane) const {
        if (gather) __builtin_amdgcn_global_load_lds((const unsigned*)(ws + WS_LISTA) + (size_t)u.e * CAP + u.row0 + lane * 4, (LAS unsigned*)(lds_ + 131072 + 2048 + wid * 3712 + 2048), 16, 0, 0);
    }
    DEV void aoffs(const Unit& u, int tid, unsigned (&v)[2][2], LAS unsigned char* lds_, int wid, bool from_lds) const {
        asm volatile("" : "+v"(tid));
        const int* lista = (const int*)(ws + WS_LISTA);
        const LAS int* sp = (const LAS int*)(lds_ + 131072 + 2048 + wid * 3712 + 2048);
#pragma unroll
        for (int i = 0; i < 2; ++i) { int Rr, C; stage_rc(tid * 16 + i * 8192, Rr, C);
#pragma unroll
            for (int h = 0; h < 2; ++h) {
                const int lr = h * HALF + Rr;
                if (gather) { const int rr = u.row0 + lr; const int aid = from_lds ? sp[lr] : ((rr < u.cnt) ? lista[(size_t)u.e * CAP + rr] : 0);
                    const int tok = (rr < u.cnt) ? (aid >> 3) : 0; v[h][i] = (unsigned)(tok * K + C) * 2u; }
                else v[h][i] = (unsigned)(lr * K + C) * 2u;
            } }
    }
};

typedef f32x4 Acc[2][2][4][2];
#define EPI_ROWS(ai, m) for (int ai = 0; ai < 2; ++ai) _Pragma("unroll") for (int m = 0; m < 4; ++m)

struct EpiZ {
    static constexpr int PID = 10; static constexpr bool HAS_MID = false; static constexpr int MID_T = 0;
    unsigned char* ws;
    DEV void mid(Acc&, const UnitD&, int, int, int, int) const {}
    DEV void unit_begin(const UnitD&, LAS unsigned char*, int, int) const {}
    DEV void operator()(const Acc& acc, const UnitD& u, int wr, int wc, int fr, int fq) const {
        bf16_t* Z = (bf16_t*)(ws + WS_Z);
        const int act = (u.pn < 4) ? 1 : (u.pn < 6 ? 0 : (u.pn < 8 ? 1 : 2));
        const int row0 = u.pm * BM + wr * 64 + fr, col0 = u.pn * BM + wc * 32 + 8 * fq;
#pragma unroll
        EPI_ROWS(ai, m) { bf16_t* rowp = Z + (size_t)(row0 + ai * HALF + m * 16) * 4096 + col0;
#pragma unroll
            for (int bj = 0; bj < 2; ++bj) { f32x4 v0 = acc[ai][bj][m][0], v1 = acc[ai][bj][m][1];
                if (act == 1) {
#pragma unroll
                    for (int i = 0; i < 4; ++i) { v0[i] = fgelu(v0[i]); v1[i] = fgelu(v1[i]); }
                } else if (act == 2) {
                    unsigned w0 = 0, w1 = 0;
#pragma unroll
                    for (int i = 0; i < 4; ++i) { w0 |= (unsigned)__builtin_rintf(fsigmoid(v0[i]) * 255.f) << (8 * i); w1 |= (unsigned)__builtin_rintf(fsigmoid(v1[i]) * 255.f) << (8 * i); }
                    *(u32x2*)((unsigned char*)(Z + (size_t)(row0 + ai * HALF + m * 16) * 4096) + 4096 + (col0 - 2048) + bj * HALF) = (u32x2){w0, w1};
                    continue;
                }
                *(u32x4*)(rowp + bj * HALF) = pack8(v0, v1); } }
    }
};
struct EpiAB {
    static constexpr int PID = 11; static constexpr bool HAS_MID = true; static constexpr int MID_T = 8;
    unsigned char* ws;
    DEV void unit_begin(const UnitD&, LAS unsigned char*, int, int) const {}
    DEV void mid(Acc& acc, const UnitD& u, int wr, int wc, int fr, int fq) const {
        const bf16_t* Z = (const bf16_t*)(ws + WS_Z);
        int oz = 0; asm volatile("" : "+v"(oz));
        const int row0 = u.pm * BM + wr * 64 + fr + oz, col0 = u.pn * BM + wc * 32 + 8 * fq;
#pragma unroll
        for (int ai = 0; ai < 2; ++ai) {
            u32x2 ga[4][2], gr[4][2];
#pragma unroll
            for (int m = 0; m < 4; ++m) { const unsigned char* zr = (const unsigned char*)(Z + (size_t)(row0 + ai * HALF + m * 16) * 4096) + 4096 + col0;
#pragma unroll
                for (int bj = 0; bj < 2; ++bj) { ga[m][bj] = *(const u32x2*)(zr + bj * HALF); gr[m][bj] = *(const u32x2*)(zr + 1024 + bj * HALF); } }
#pragma unroll
            for (int m = 0; m < 4; ++m)
#pragma unroll
                for (int bj = 0; bj < 2; ++bj) {
#pragma unroll
                    for (int i = 0; i < 4; ++i) {
                        const float a0 = (float)((ga[m][bj].x >> (8 * i)) & 255u), a1 = (float)((ga[m][bj].y >> (8 * i)) & 255u);
                        const float r0 = fmaxf((float)((gr[m][bj].x >> (8 * i)) & 255u), 0.5f), r1 = fmaxf((float)((gr[m][bj].y >> (8 * i)) & 255u), 0.5f);
                        acc[ai][bj][m][0][i] *= a0 * __builtin_amdgcn_rcpf(r0); acc[ai][bj][m][1][i] *= a1 * __builtin_amdgcn_rcpf(r1); } }
            asm volatile("" ::: "memory"); }
    }
    DEV void operator()(const Acc& acc, const UnitD& u, int wr, int wc, int fr, int fq) const {
        const bf16_t* Z = (const bf16_t*)(ws + WS_Z); bf16_t* M = (bf16_t*)(ws + WS_RA);
        const int row0 = u.pm * BM + wr * 64 + fr, col0 = u.pn * BM + wc * 32 + 8 * fq;
        u32x2 gr[2][4][2];
#pragma unroll
        EPI_ROWS(ai, m) { const unsigned char* zr = (const unsigned char*)(Z + (size_t)(row0 + ai * HALF + m * 16) * 4096) + 4096 + 1024 + col0;
#pragma unroll
            for (int bj = 0; bj < 2; ++bj) gr[ai][m][bj] = *(const u32x2*)(zr + bj * HALF); }
#pragma unroll
        EPI_ROWS(ai, m) { bf16_t* rowp = M + (size_t)(row0 + ai * HALF + m * 16) * D + col0;
#pragma unroll
            for (int bj = 0; bj < 2; ++bj) { f32x4 r0, r1;
#pragma unroll
                for (int i = 0; i < 4; ++i) { r0[i] = fmaxf((float)((gr[ai][m][bj].x >> (8 * i)) & 255u), 0.5f) * (1.f / 255.f); r1[i] = fmaxf((float)((gr[ai][m][bj].y >> (8 * i)) & 255u), 0.5f) * (1.f / 255.f); }
                *(u32x4*)(rowp + bj * HALF) = pack8(acc[ai][bj][m][0] * r0, acc[ai][bj][m][1] * r1); } }
    }
};
template <size_t COFF> struct EpiPlain {
    static constexpr int PID = 12; static constexpr bool HAS_MID = false; static constexpr int MID_T = 0;
    unsigned char* ws;
    DEV void mid(Acc&, const UnitD&, int, int, int, int) const {}
    DEV void unit_begin(const UnitD&, LAS unsigned char*, int, int) const {}
    DEV void operator()(const Acc& acc, const UnitD& u, int wr, int wc, int fr, int fq) const {
        bf16_t* C = (bf16_t*)(ws + COFF); constexpr int ldc = D;
        const int row0 = u.pm * BM + wr * 64 + fr, col0 = u.pn * BM + wc * 32 + 8 * fq;
#pragma unroll
        EPI_ROWS(ai, m) { bf16_t* rowp = C + (size_t)(row0 + ai * HALF + m * 16) * ldc + col0;
#pragma unroll
            for (int bj = 0; bj < 2; ++bj) *(u32x4*)(rowp + bj * HALF) = pack8(acc[ai][bj][m][0], acc[ai][bj][m][1]); }
    }
};
struct EpiSR {
    static constexpr int PID = 13; static constexpr bool HAS_MID = false; static constexpr int MID_T = 0;
    unsigned char* ws;
    DEV void mid(Acc&, const UnitD&, int, int, int, int) const {}
    DEV void unit_begin(const UnitD&, LAS unsigned char*, int, int) const {}
    DEV void operator()(const Acc& acc, const UnitD& u, int wr, int wc, int fr, int fq) const {
        float* LOG = (float*)(ws + WS_LOG); bf16_t* SH = (bf16_t*)(ws + WS_SH);
        const int row0 = u.pm * BM + wr * 64 + fr;
        if (u.pn == 0) {
            if (wc < 2) {
#pragma unroll
                EPI_ROWS(ai, m) { float* rowp = LOG + (size_t)(row0 + ai * HALF + m * 16) * 64 + wc * 32 + 8 * fq;
                    *(f32x4*)(rowp) = acc[ai][0][m][0]; *(f32x4*)(rowp + 4) = acc[ai][0][m][1]; }
            }
        } else {
            const int j0 = (u.pn - 1) * HALF + wc * 32 + 8 * fq;
#pragma unroll
            EPI_ROWS(ai, m) { f32x4 v0, v1;
#pragma unroll
                for (int i = 0; i < 4; ++i) { v0[i] = fsilu(acc[ai][0][m][0][i]) * acc[ai][1][m][0][i]; v1[i] = fsilu(acc[ai][0][m][1][i]) * acc[ai][1][m][1][i]; }
#if GED_FP8
                { u32x2 o; unsigned t = 0;
#pragma unroll
                  for (int i = 0; i < 4; ++i) { v0[i] = __builtin_amdgcn_fmed3f(v0[i] * 8.f, -440.f, 440.f); v1[i] = __builtin_amdgcn_fmed3f(v1[i] * 8.f, -440.f, 440.f); }
                  t = __builtin_amdgcn_cvt_pk_fp8_f32(v0[0], v0[1], t, false); t = __builtin_amdgcn_cvt_pk_fp8_f32(v0[2], v0[3], t, true); o.x = t;
                  t = __builtin_amdgcn_cvt_pk_fp8_f32(v1[0], v1[1], t, false); t = __builtin_amdgcn_cvt_pk_fp8_f32(v1[2], v1[3], t, true); o.y = t;
                  *(u32x2*)((unsigned char*)SH + (size_t)(row0 + ai * HALF + m * 16) * 256 + j0) = o; }
#else
                *(u32x4*)(SH + (size_t)(row0 + ai * HALF + m * 16) * 256 + j0) = pack8(v0, v1);
#endif
            }
        }
    }
};
template <int FP8S> struct EpiEG {
    static constexpr int PID = 14; static constexpr bool HAS_MID = false; static constexpr int MID_T = 0;
    unsigned char* ws;
    DEV void mid(Acc&, const UnitE&, int, int, int, int) const {}
    DEV void unit_begin(const UnitE&, LAS unsigned char*, int, int) const {}
    DEV void operator()(const Acc& acc, const UnitE& u, int wr, int wc, int fr, int fq) const {
        bf16_t* HM = (bf16_t*)(ws + WS_HM);
        const int j0 = u.pn * HALF + wc * 32 + 8 * fq;
#pragma unroll
        EPI_ROWS(ai, m) { f32x4 v0, v1;
#pragma unroll
            for (int i = 0; i < 4; ++i) { constexpr float sc = FP8S ? (1.f / 1024.f) : 1.f; v0[i] = fsilu(acc[ai][0][m][0][i] * sc) * (acc[ai][1][m][0][i] * sc); v1[i] = fsilu(acc[ai][0][m][1][i] * sc) * (acc[ai][1][m][1][i] * sc); }
#if GED_FP8
            { u32x2 o; unsigned t = 0;
#pragma unroll
              for (int i = 0; i < 4; ++i) { v0[i] = __builtin_amdgcn_fmed3f(v0[i] * 8.f, -440.f, 440.f); v1[i] = __builtin_amdgcn_fmed3f(v1[i] * 8.f, -440.f, 440.f); }
              t = __builtin_amdgcn_cvt_pk_fp8_f32(v0[0], v0[1], t, false); t = __builtin_amdgcn_cvt_pk_fp8_f32(v0[2], v0[3], t, true); o.x = t;
              t = __builtin_amdgcn_cvt_pk_fp8_f32(v1[0], v1[1], t, false); t = __builtin_amdgcn_cvt_pk_fp8_f32(v1[2], v1[3], t, true); o.y = t;
              *(u32x2*)((unsigned char*)HM + (size_t)(u.hmrow0 + ai * HALF + wr * 64 + m * 16 + fr) * 256 + j0) = o; }
#else
            *(u32x4*)(HM + (size_t)(u.hmrow0 + ai * HALF + wr * 64 + m * 16 + fr) * 256 + j0) = pack8(v0, v1);
#endif
        }
    }
};
struct EpiED {
    static constexpr int PID = 15; static constexpr bool HAS_MID = false; static constexpr int MID_T = 0;
    unsigned char* ws;
    DEV void mid(Acc&, const UnitE&, int, int, int, int) const {}
    DEV void unit_begin(const UnitE& u, LAS unsigned char* lds, int wid, int lane) const {
        const int wr = wid >> 2; LAS unsigned char* sp = lds + 131072 + 2048 + wid * 3712 + 2048;
#pragma unroll
        for (int ai = 0; ai < 2; ++ai) { const size_t idx = (size_t)u.e * CAP + u.row0 + ai * HALF + wr * 64 + lane;
            __builtin_amdgcn_global_load_lds((const unsigned*)(ws + WS_LISTA) + idx, (LAS unsigned*)(sp + ai * 256), 4, 0, 0);
            __builtin_amdgcn_global_load_lds((const unsigned*)(ws + WS_LISTW) + idx, (LAS unsigned*)(sp + 512 + ai * 256), 4, 0, 0); }
    }
    DEV void operator()(const Acc& acc, const UnitE& u, int wr, int wc, int fr, int fq) const {
        unsigned char* SLOTS = ws + WS_SLOTS;
        const LAS unsigned* sp = (const LAS unsigned*)(lds_ + 131072 + 2048 + (wr * 4 + wc) * 3712 + 2048);
        const int col0 = u.pn * BM + wc * 32 + 8 * fq;
#pragma unroll
        EPI_ROWS(ai, m) { const int rr = u.row0 + ai * HALF + wr * 64 + m * 16 + fr;
            const int aid = (int)sp[ai * 64 + m * 16 + fr]; const float w = __uint_as_float(sp[128 + ai * 64 + m * 16 + fr]) * 16.0f;
            if (rr < u.cnt) { unsigned char* rowp = SLOTS + (size_t)aid * 1024 + col0;
#pragma unroll
                for (int bj = 0; bj < 2; ++bj) { f32x4 v0 = acc[ai][bj][m][0] * w, v1 = acc[ai][bj][m][1] * w; u32x2 o; unsigned t = 0;
#pragma unroll
                    for (int i = 0; i < 4; ++i) { v0[i] = __builtin_amdgcn_fmed3f(v0[i], -440.f, 440.f); v1[i] = __builtin_amdgcn_fmed3f(v1[i], -440.f, 440.f); }
                    t = __builtin_amdgcn_cvt_pk_fp8_f32(v0[0], v0[1], t, false); t = __builtin_amdgcn_cvt_pk_fp8_f32(v0[2], v0[3], t, true); o.x = t;
                    t = __builtin_amdgcn_cvt_pk_fp8_f32(v1[0], v1[1], t, false); t = __builtin_amdgcn_cvt_pk_fp8_f32(v1[2], v1[3], t, true); o.y = t;
                    *(u32x2*)(rowp + bj * HALF) = o; } } }
    }
    LAS unsigned char* lds_;
};

template <class Epi, class Sched, bool ALIGN_EPI, int FP8 = 0>
DEV void gemm_phase(LAS unsigned char* lds, const int tid, const Sched& S, const Epi& E) {
    typedef typename Sched::Unit Unit;
    const int wid = __builtin_amdgcn_readfirstlane(tid >> 6), lane = tid & 63, wr = wid >> 2, wc = wid & 3, fr = lane & 15, fq = lane >> 4;
    const int K = S.Krt, nt = K / BK;
    unsigned voffB[2];
#pragma unroll
    for (int i = 0; i < 2; ++i) { int Rr, C; stage_rc(tid * 16 + i * 8192, Rr, C); const int Rb = (Rr & ~31) + perm32(Rr & 31); voffB[i] = (unsigned)(Rb * K + C) * 2u; }
    const size_t kstep = (size_t)(BK * 2);
    const size_t hstepB = (size_t)HALF * K * 2;
    const unsigned ldsw = (unsigned)wid * 1024u;
    const int aoff = lds_byte(wr * 64 + fr, fq * 8), boff = lds_byte(wc * 32 + fr, fq * 8);
#define PG8_SA(b, h) (((b) * 2 + (h)) * HTB)
#define PG8_SB(b, h) ((4 + (b) * 2 + (h)) * HTB)
#define PG8_STAGE2(bufoff, gbase, o0, o1) do { unsigned o0_ = (o0), o1_ = (o1); asm volatile("" : "+v"(o0_), "+v"(o1_));     \
        __builtin_amdgcn_global_load_lds((const unsigned*)((const char*)(gbase) + o0_), (LAS unsigned*)(lds + (bufoff) + ldsw), 16, 0, 0); \
        __builtin_amdgcn_global_load_lds((const unsigned*)((const char*)(gbase) + o1_), (LAS unsigned*)(lds + (bufoff) + ldsw + 8192), 16, 0, 0); } while (0)
#define PG8_STAGEB(bufoff, gbase) PG8_STAGE2(bufoff, gbase, voffB[0], voffB[1])
#define PG8_LDA(dst, b, h) do { _Pragma("unroll") for (int m = 0; m < 4; ++m) _Pragma("unroll") for (int k = 0; k < 2; ++k) dst[m][k] = *(const LAS bf16x8*)(lds + PG8_SA(b, h) + aoff + m * 2048 + k * 1024); } while (0)
#define PG8_LDB(dst, b, h) do { _Pragma("unroll") for (int n = 0; n < 2; ++n) _Pragma("unroll") for (int k = 0; k < 2; ++k) dst[n][k] = *(const LAS bf16x8*)(lds + PG8_SB(b, h) + boff + n * 2048 + k * 1024); } while (0)
#define PG8_MMA(ai, bj, At, Bt) do { __builtin_amdgcn_s_setprio(1); _Pragma("unroll") for (int m = 0; m < 4; ++m) _Pragma("unroll") for (int n = 0; n < 2; ++n) _Pragma("unroll") for (int k = 0; k < 2; ++k) \
        acc[ai][bj][m][n] = __builtin_amdgcn_mfma_f32_16x16x32_bf16(Bt[n][k], At[m][k], acc[ai][bj][m][n], 0, 0, 0); __builtin_amdgcn_s_setprio(0); } while (0)
typedef int i32x8_t __attribute__((ext_vector_type(8)));
struct Frag2 { bf16x8 lo, hi; };
#define PG8_MMA8(ai, bj, At, Bt) do { __builtin_amdgcn_s_setprio(1); _Pragma("unroll") for (int m = 0; m < 4; ++m) _Pragma("unroll") for (int n = 0; n < 2; ++n) { \
        const Frag2 fb_{Bt[n][0], Bt[n][1]}, fa_{At[m][0], At[m][1]}; \
        acc[ai][bj][m][n] = __builtin_amdgcn_mfma_scale_f32_16x16x128_f8f6f4(__builtin_bit_cast(i32x8_t, fb_), __builtin_bit_cast(i32x8_t, fa_), acc[ai][bj][m][n], 0, 0, 0, 0x79797979, 0, FP8 * 0x01010101); } __builtin_amdgcn_s_setprio(0); } while (0)
#define PG8_MM(ai, bj, At, Bt) do { if constexpr (FP8) PG8_MMA8(ai, bj, At, Bt); else PG8_MMA(ai, bj, At, Bt); } while (0)
#define PG8_WAIT_V(n) asm volatile("s_waitcnt vmcnt(" #n ")" ::: "memory")
#define PG8_WAIT_L(n) asm volatile("s_waitcnt lgkmcnt(" #n ")" ::: "memory")
#define PG8_BAR __builtin_amdgcn_s_barrier()
#define PG8_SCHED __builtin_amdgcn_sched_barrier(0)
    Unit cur, nxt; int ui = 0;
    if (!S.next(0, cur)) return;
    Acc acc;
#pragma unroll
    for (int a = 0; a < 2; ++a)
#pragma unroll
        for (int b = 0; b < 2; ++b)
#pragma unroll
            for (int m = 0; m < 4; ++m)
#pragma unroll
                for (int n = 0; n < 2; ++n) acc[a][b][m][n] = (f32x4){0.f, 0.f, 0.f, 0.f};
    bf16x8 At[4][2], B0[2][2], B1[2][2];
    unsigned vA[2][2];
    S.aoffs(cur, tid, vA, lds, wid, false);
    const char* cA = S.abase(cur); const char* cB = S.bbase(cur);
    PG8_STAGEB(PG8_SB(0, 0), cB); PG8_STAGEB(PG8_SB(0, 1), cB + hstepB); PG8_STAGE2(PG8_SA(0, 0), cA, vA[0][0], vA[0][1]); PG8_STAGE2(PG8_SA(0, 1), cA, vA[1][0], vA[1][1]);
    if (wr == 1) PG8_BAR;
    PG8_WAIT_V(2); PG8_BAR;
    PG8_STAGEB(PG8_SB(1, 0), cB + kstep); PG8_STAGE2(PG8_SA(1, 0), cA + kstep, vA[0][0], vA[0][1]); PG8_STAGEB(PG8_SB(1, 1), cB + hstepB + kstep);
    PG8_WAIT_V(6); PG8_BAR;
    for (;;) {
        E.unit_begin(cur, lds, wid, lane);
        const bool has_next = S.next(ui + 1, nxt);
        const char* nA = cA; const char* nB = cB;
        if (has_next) { nA = S.abase(nxt); nB = S.bbase(nxt); S.prefetch(nxt, lds, wid, lane); }
        for (int t = 0; t < nt; t += 2) {
            const bool last = (t == nt - 2);
            if constexpr (Epi::HAS_MID) { if (t == Epi::MID_T) E.mid(acc, cur, wr, wc, fr, fq); }
            const char* a1 = cA + (size_t)(t + 1) * kstep;
            const char* a2 = last ? nA : cA + (size_t)(t + 2) * kstep; const char* b2 = last ? nB : cB + (size_t)(t + 2) * kstep;
            const char* a3 = a2 + kstep; const char* b3 = b2 + kstep;
            PG8_LDB(B0, 0, 0); PG8_LDB(B1, 0, 1); PG8_SCHED; PG8_LDA(At, 0, 0); PG8_STAGE2(PG8_SA(1, 1), a1, vA[1][0], vA[1][1]);
            if (last && has_next) S.aoffs(nxt, tid, vA, lds, wid, true);
            PG8_WAIT_V(8); PG8_WAIT_L(0); PG8_BAR; PG8_MM(0, 0, At, B0); PG8_MM(0, 1, At, B1); PG8_BAR; PG8_SCHED;
            PG8_LDA(At, 0, 1); PG8_STAGEB(PG8_SB(0, 0), b2); PG8_STAGEB(PG8_SB(0, 1), b2 + hstepB); PG8_STAGE2(PG8_SA(0, 0), a2, vA[0][0], vA[0][1]);
            PG8_WAIT_V(8); PG8_WAIT_L(0); PG8_BAR; PG8_MM(1, 0, At, B0); PG8_MM(1, 1, At, B1); PG8_BAR; PG8_SCHED;
            PG8_LDB(B0, 1, 0); PG8_LDB(B1, 1, 1); PG8_SCHED; PG8_LDA(At, 1, 0); PG8_STAGE2(PG8_SA(0, 1), a2, vA[1][0], vA[1][1]);
            PG8_WAIT_V(8); PG8_WAIT_L(0); PG8_BAR; PG8_MM(0, 0, At, B0); PG8_MM(0, 1, At, B1); PG8_BAR; PG8_SCHED;
            PG8_LDA(At, 1, 1); PG8_STAGEB(PG8_SB(1, 0), b3); PG8_STAGEB(PG8_SB(1, 1), b3 + hstepB); PG8_STAGE2(PG8_SA(1, 0), a3, vA[0][0], vA[0][1]);
            PG8_WAIT_V(8); PG8_WAIT_L(0); PG8_BAR; PG8_MM(1, 0, At, B0); PG8_MM(1, 1, At, B1); PG8_BAR; PG8_SCHED;
        }
        if constexpr (ALIGN_EPI) { if (wr == 0) PG8_BAR; }
#ifdef PROBE_REGION
        { unsigned long long t0_ = 0; if (Epi::PID == PROBE_REGION) t0_ = __builtin_amdgcn_s_memrealtime();
          E(acc, cur, wr, wc, fr, fq);
          if (Epi::PID == PROBE_REGION && tid == 0) { asm volatile("s_waitcnt vmcnt(0)" ::: "memory"); volatile LAS unsigned* m_ = (volatile LAS unsigned*)(lds + 131072); m_[16] += (unsigned)(__builtin_amdgcn_s_memrealtime() - t0_); } }
#else
        { unsigned z_ = 0; asm volatile("" : "+v"(z_)); const int l2 = (int)__builtin_amdgcn_mbcnt_hi(~0u, __builtin_amdgcn_mbcnt_lo(~0u, z_));
          E(acc, cur, wr, wc, l2 & 15, l2 >> 4); }
#endif
        if (!has_next) break;
#pragma unroll
        for (int a = 0; a < 2; ++a)
#pragma unroll
            for (int b = 0; b < 2; ++b)
#pragma unroll
                for (int m = 0; m < 4; ++m)
#pragma unroll
                    for (int n = 0; n < 2; ++n) acc[a][b][m][n] = (f32x4){0.f, 0.f, 0.f, 0.f};
        cur = nxt; cA = nA; cB = nB; ++ui;
        if constexpr (ALIGN_EPI) { if (wr == 1) PG8_BAR; }
    }
    PG8_WAIT_V(0);
    if constexpr (!ALIGN_EPI) { if (wr == 0) PG8_BAR; }
    PG8_BAR;
#undef PG8_SA
#undef PG8_SB
#undef PG8_STAGE2
#undef PG8_STAGEB
#undef PG8_LDA
#undef PG8_LDB
#undef PG8_MMA
#undef PG8_MMA8
#undef PG8_MM
#undef PG8_WAIT_V
#undef PG8_WAIT_L
#undef PG8_BAR
#undef PG8_SCHED
}
}
constexpr int NWAVES = 8;
constexpr int RING_BYTES = 131072;
constexpr int MISC_OFF = RING_BYTES;
constexpr int LDS_BYTES = 163840;
constexpr int PARAMS_OFF = MISC_OFF + 1024;
constexpr int SPW_OFF = MISC_OFF + 2048, SPW_BYTES = 3712, STATS_OFF = SPW_OFF + 8 * SPW_BYTES;

#define XB_TMO      128
#define XB_XCNT(j)  (256  + 64 * (j))
#define XB_XSUB(j)  (1280 + 64 * (j))
#define XB_XGEN(j)  (2304 + 64 * (j))
#define XB_TOP      3328
#define XB_TOPGEN   3392
#define XCD_BAR_WORDS 3456
#define XB_SPIN_CAP (1u << 22)
DEV unsigned xb_ld(GAS unsigned* p) { return __hip_atomic_load(p, __ATOMIC_RELAXED, __HIP_MEMORY_SCOPE_AGENT); }
DEV unsigned xb_add(GAS unsigned* p, unsigned v) { return __hip_atomic_fetch_add(p, v, __ATOMIC_RELAXED, __HIP_MEMORY_SCOPE_AGENT); }
DEV unsigned xb_xcc_id() { return (unsigned)__builtin_amdgcn_s_getreg((3 << 11) | 20) & 0xFu; }
#define XB_SPIN(cond, bar) do { unsigned _sp = 0; while (cond) { __builtin_amdgcn_s_sleep(1); \
    if ((++_sp & 255u) == 0u) { if (xb_ld(&(bar)[XB_TMO])) break; if (_sp > XB_SPIN_CAP) { xb_add(&(bar)[XB_TMO], 1u); break; } } } } while (0)
struct XcdBarrier { GAS unsigned* bar; unsigned x; volatile LAS unsigned* st; };
DEV XcdBarrier xcd_barrier_post(GAS unsigned* bar, volatile LAS unsigned* st) {
    XcdBarrier b; b.bar = bar; b.x = xb_xcc_id(); b.st = st;
    if (threadIdx.x == 0) (void)xb_add(&bar[XB_XCNT(b.x)], 1u);
    return b;
}
DEV void xcd_barrier_complete(GAS unsigned* bar, unsigned x, unsigned& nloc, unsigned& nx) {
    const unsigned G = gridDim.x * gridDim.y * gridDim.z;
    unsigned sum, cnt, mine, sp = 0u;
    for (;;) {
        sum = 0u; cnt = 0u; mine = 0u;
#pragma unroll
        for (unsigned j = 0; j < 16; ++j) { const unsigned c = xb_ld(&bar[XB_XCNT(j)]); sum += c; cnt += (c > 0u) ? 1u : 0u; mine = (j == x) ? c : mine; }
        if (sum == G) break;
        __builtin_amdgcn_s_sleep(1);
        if ((++sp & 255u) == 0u) { if (xb_ld(&bar[XB_TMO])) break; if (sp > XB_SPIN_CAP) { xb_add(&bar[XB_TMO], 1u); break; } }
    }
    nloc = mine > 0u ? mine : 1u; nx = cnt > 0u ? cnt : 1u;
}
DEV void xcd_barrier(const XcdBarrier& b) {
    asm volatile("s_waitcnt vmcnt(0)" ::: "memory");
    __syncthreads();
    if (threadIdx.x == 0) {
        GAS unsigned* bar = b.bar; asm volatile("" : "+s"(bar));
        __builtin_amdgcn_s_waitcnt(0);
        unsigned nloc = b.st[0], nx = b.st[1];
        if (nloc == 0u) { xcd_barrier_complete(bar, b.x, nloc, nx); b.st[0] = nloc; b.st[1] = nx; }
        const unsigned old = xb_add(&bar[XB_XSUB(b.x)], 1u);
        const unsigned gen = old / nloc;
        if (old + 1u == (gen + 1u) * nloc) {
            __builtin_amdgcn_fence(__ATOMIC_RELEASE, "agent");
            asm volatile("s_waitcnt vmcnt(0)" ::: "memory");
            const unsigned og = xb_add(&bar[XB_TOP], 1u);
            const unsigned tg = og / nx;
            if (og + 1u == (tg + 1u) * nx) xb_add(&bar[XB_TOPGEN], 1u);
            else XB_SPIN(xb_ld(&bar[XB_TOPGEN]) == tg, bar);
            __builtin_amdgcn_fence(__ATOMIC_ACQUIRE, "agent");
            xb_add(&bar[XB_XGEN(b.x)], 1u);
            asm volatile("s_waitcnt vmcnt(0)" ::: "memory");
        } else {
            XB_SPIN(xb_ld(&bar[XB_XGEN(b.x)]) == gen, bar);
            __builtin_amdgcn_fence(__ATOMIC_ACQUIRE, "agent");
            asm volatile("s_waitcnt vmcnt(0)" ::: "memory");
        }
    }
    __syncthreads();
}

#ifdef PROBE_REGION
#define TREG_BEGIN(k) unsigned long long _treg##k = 0; if ((k) == PROBE_REGION) _treg##k = __builtin_amdgcn_s_memrealtime()
#define TREG_END(k, F) do { if ((k) == PROBE_REGION && (F).tid == 0) { volatile LAS unsigned* _m = (volatile LAS unsigned*)((F).lds + MISC_OFF); _m[16] += (unsigned)(__builtin_amdgcn_s_memrealtime() - _treg##k); } } while (0)
#else
#define TREG_BEGIN(k) do {} while (0)
#define TREG_END(k, F) do {} while (0)
#endif
struct Frame { LAS unsigned char* lds; unsigned char* ldsg; int tid, lane, wave, G, bx; };
DEV unsigned long long ldp64(const LAS unsigned* q, int i) { const unsigned lo = __builtin_amdgcn_readfirstlane(q[2 * i]), hi = __builtin_amdgcn_readfirstlane(q[2 * i + 1]); return ((unsigned long long)hi << 32) | lo; }
DEV Params load_params(const Frame& F) {
    unsigned off_ = PARAMS_OFF; asm volatile("" : "+v"(off_));
    Params p; const LAS unsigned* q = (const LAS unsigned*)(F.lds + off_);
    p.x = (const float*)(const GAS float*)ldp64(q, 0);
    p.c = (const float*)(const GAS float*)ldp64(q, 1);
    p.ctx = (const float*)(const GAS float*)ldp64(q, 2);
    p.c_ctx = (const float*)(const GAS float*)ldp64(q, 3);
    p.w_mod = (const float*)(const GAS float*)ldp64(q, 4);
    p.b_mod = (const float*)(const GAS float*)ldp64(q, 5);
    p.g_pre_mix = (const float*)(const GAS float*)ldp64(q, 6);
    p.g_post_mix = (const float*)(const GAS float*)ldp64(q, 7);
    p.g_pre_ffn = (const float*)(const GAS float*)ldp64(q, 8);
    p.g_post_ffn = (const float*)(const GAS float*)ldp64(q, 9);
    p.w_in = (const float*)(const GAS float*)ldp64(q, 10);
    p.ln_g = (const float*)(const GAS float*)ldp64(q, 11);
    p.ln_b = (const float*)(const GAS float*)ldp64(q, 12);
    p.gws = (const float*)(const GAS float*)ldp64(q, 13);
    p.gbs = (const float*)(const GAS float*)ldp64(q, 14);
    p.conv_w = (const float*)(const GAS float*)ldp64(q, 15);
    p.conv_b = (const float*)(const GAS float*)ldp64(q, 16);
    p.lru_wa = (const float*)(const GAS float*)ldp64(q, 17);
    p.lru_ba = (const float*)(const GAS float*)ldp64(q, 18);
    p.lru_wx = (const float*)(const GAS float*)ldp64(q, 19);
    p.lru_bx = (const float*)(const GAS float*)ldp64(q, 20);
    p.lru_lam = (const float*)(const GAS float*)ldp64(q, 21);
    p.w_out_a = (const float*)(const GAS float*)ldp64(q, 22);
    p.w_out_b = (const float*)(const GAS float*)ldp64(q, 23);
    p.w_out = (const float*)(const GAS float*)ldp64(q, 24);
    p.router_w = (const float*)(const GAS float*)ldp64(q, 25);
    p.router_b = (const float*)(const GAS float*)ldp64(q, 26);
    p.e_g = (const float*)(const GAS float*)ldp64(q, 27);
    p.e_u = (const float*)(const GAS float*)ldp64(q, 28);
    p.e_d = (const float*)(const GAS float*)ldp64(q, 29);
    p.s_g = (const float*)(const GAS float*)ldp64(q, 30);
    p.s_u = (const float*)(const GAS float*)ldp64(q, 31);
    p.s_d = (const float*)(const GAS float*)ldp64(q, 32);
    p.out = (float*)(GAS float*)ldp64(q, 33); p.ws = (unsigned char*)(GAS unsigned char*)ldp64(q, 34);
    return p;
}
DEV void store_params(const Frame& F, const Params& a) {
    if (F.tid == 0) { LAS unsigned long long* q = (LAS unsigned long long*)(F.lds + PARAMS_OFF);
        q[0] = (unsigned long long)a.x;
        q[1] = (unsigned long long)a.c;
        q[2] = (unsigned long long)a.ctx;
        q[3] = (unsigned long long)a.c_ctx;
        q[4] = (unsigned long long)a.w_mod;
        q[5] = (unsigned long long)a.b_mod;
        q[6] = (unsigned long long)a.g_pre_mix;
        q[7] = (unsigned long long)a.g_post_mix;
        q[8] = (unsigned long long)a.g_pre_ffn;
        q[9] = (unsigned long long)a.g_post_ffn;
        q[10] = (unsigned long long)a.w_in;
        q[11] = (unsigned long long)a.ln_g;
        q[12] = (unsigned long long)a.ln_b;
        q[13] = (unsigned long long)a.gws;
        q[14] = (unsigned long long)a.gbs;
        q[15] = (unsigned long long)a.conv_w;
        q[16] = (unsigned long long)a.conv_b;
        q[17] = (unsigned long long)a.lru_wa;
        q[18] = (unsigned long long)a.lru_ba;
        q[19] = (unsigned long long)a.lru_wx;
        q[20] = (unsigned long long)a.lru_bx;
        q[21] = (unsigned long long)a.lru_lam;
        q[22] = (unsigned long long)a.w_out_a;
        q[23] = (unsigned long long)a.w_out_b;
        q[24] = (unsigned long long)a.w_out;
        q[25] = (unsigned long long)a.router_w;
        q[26] = (unsigned long long)a.router_b;
        q[27] = (unsigned long long)a.e_g;
        q[28] = (unsigned long long)a.e_u;
        q[29] = (unsigned long long)a.e_d;
        q[30] = (unsigned long long)a.s_g;
        q[31] = (unsigned long long)a.s_u;
        q[32] = (unsigned long long)a.s_d;
        q[33] = (unsigned long long)a.out; q[34] = (unsigned long long)a.ws; }
}

DEV void transpose_item(const float* W, int N, bf16_t* WT, int dK, int koff, int rbase, int rhi, LAS float* scr, int kb, int nb, int lane, float scale = 1.0f) {
    const int k0 = 64 * kb, n0 = 32 * nb;
    float4 ld[8];
#pragma unroll
    for (int i = 0; i < 8; ++i) ld[i] = *(const float4*)(W + (size_t)(k0 + 8 * i + (lane >> 3)) * N + n0 + (lane & 7) * 4);
#pragma unroll
    for (int i = 0; i < 8; ++i) { LAS float* d = scr + (8 * i + (lane >> 3)) * 33 + (lane & 7) * 4; d[0] = ld[i].x; d[1] = ld[i].y; d[2] = ld[i].z; d[3] = ld[i].w; }
    asm volatile("s_waitcnt lgkmcnt(0)" ::: "memory");
    const int cc = lane & 7;
#pragma unroll
    for (int j = 0; j < 4; ++j) { const int nl = (lane >> 3) + 8 * j, n = n0 + nl; const LAS float* s = scr + (8 * cc) * 33 + nl;
        u32x4 o; o.x = pk2(s[0 * 33] * scale, s[1 * 33] * scale); o.y = pk2(s[2 * 33] * scale, s[3 * 33] * scale); o.z = pk2(s[4 * 33] * scale, s[5 * 33] * scale); o.w = pk2(s[6 * 33] * scale, s[7 * 33] * scale);
        const int drow = rbase + (n >> 7) * rhi + (n & 127);
        *(u32x4*)(WT + (size_t)drow * dK + koff + k0 + 8 * cc) = o; }
    asm volatile("s_waitcnt lgkmcnt(0)" ::: "memory");
}
DEV void transpose_item8(const float* W, int N, unsigned char* WT, int dK, int rbase, int rhi, LAS float* scr, int kb, int nb, int lane) {
    const int k0 = 64 * kb, n0 = 32 * nb;
    float4 ld[8];
#pragma unroll
    for (int i = 0; i < 8; ++i) ld[i] = *(const float4*)(W + (size_t)(k0 + 8 * i + (lane >> 3)) * N + n0 + (lane & 7) * 4);
#pragma unroll
    for (int i = 0; i < 8; ++i) { LAS float* d = scr + (8 * i + (lane >> 3)) * 33 + (lane & 7) * 4; d[0] = ld[i].x; d[1] = ld[i].y; d[2] = ld[i].z; d[3] = ld[i].w; }
    asm volatile("s_waitcnt lgkmcnt(0)" ::: "memory");
    const int cc = lane & 7;
#pragma unroll
    for (int j = 0; j < 4; ++j) { const int nl = (lane >> 3) + 8 * j, n = n0 + nl; const LAS float* s = scr + (8 * cc) * 33 + nl;
        unsigned lo = 0, hi = 0;
        lo = __builtin_amdgcn_cvt_pk_fp8_f32(s[0 * 33] * 64.f, s[1 * 33] * 64.f, lo, false); lo = __builtin_amdgcn_cvt_pk_fp8_f32(s[2 * 33] * 64.f, s[3 * 33] * 64.f, lo, true);
        hi = __builtin_amdgcn_cvt_pk_fp8_f32(s[4 * 33] * 64.f, s[5 * 33] * 64.f, hi, false); hi = __builtin_amdgcn_cvt_pk_fp8_f32(s[6 * 33] * 64.f, s[7 * 33] * 64.f, hi, true);
        const int drow = rbase + (n >> 7) * rhi + (n & 127);
        *(u32x2*)(WT + (size_t)drow * dK + k0 + 8 * cc) = (u32x2){lo, hi}; }
    asm volatile("s_waitcnt lgkmcnt(0)" ::: "memory");
}
DEV void convert_weights(const Params& p, const Frame& F, int l, int part, int vw, int nvw) {
    LAS float* scr = (LAS float*)(F.lds + F.wave * 16384);
    unsigned char* W = p.ws + WS_W;
    const int lane = F.lane;
    constexpr int I_IN = 16 * 128, I_OA = 8 * 32, I_OUT = 16 * 32, I_RT = 16 * 2, I_SG = 16 * 8, I_SD = 4 * 32, I_EG = NE * 16 * 8, I_ED = NE * 4 * 32, I_LRU = 32 * 2;
    if (part == 0) {
        constexpr int NITEMS = I_IN + 2 * I_OA + I_OUT + I_RT + 2 * I_SG + I_SD + I_LRU;
        for (int it = vw; it < NITEMS; it += nvw) {
            int r = it;
#if GIN_FP8
            if (r < I_IN) { transpose_item8(p.w_in + (size_t)l * D * 4096, 4096, W + WO_IN, D, 0, 128, scr, r / 128, r % 128, lane); continue; } r -= I_IN;
#else
            if (r < I_IN) { transpose_item(p.w_in + (size_t)l * D * 4096, 4096, (bf16_t*)(W + WO_IN), D, 0, 0, 128, scr, r / 128, r % 128, lane); continue; } r -= I_IN;
#endif
            if (r < I_OA) { transpose_item(p.w_out_a + (size_t)l * 512 * D, D, (bf16_t*)(W + WO_AB), D, 0, 0, 128, scr, r / 32, r % 32, lane); continue; } r -= I_OA;
            if (r < I_OA) { transpose_item(p.w_out_b + (size_t)l * 512 * D, D, (bf16_t*)(W + WO_AB), D, 512, 0, 128, scr, r / 32, r % 32, lane); continue; } r -= I_OA;
            if (r < I_OUT) { transpose_item(p.w_out + (size_t)l * D * D, D, (bf16_t*)(W + WO_OUT), D, 0, 0, 128, scr, r / 32, r % 32, lane); continue; } r -= I_OUT;
            if (r < I_RT) { transpose_item(p.router_w + (size_t)l * D * 64, 64, (bf16_t*)(W + WO_SR), D, 0, 0, 128, scr, r / 2, r % 2, lane); continue; } r -= I_RT;
            if (r < I_SG) { transpose_item(p.s_g + (size_t)l * D * 256, 256, (bf16_t*)(W + WO_SR), D, 0, 256, 256, scr, r / 8, r % 8, lane); continue; } r -= I_SG;
            if (r < I_SG) { transpose_item(p.s_u + (size_t)l * D * 256, 256, (bf16_t*)(W + WO_SR), D, 0, 256 + 128, 256, scr, r / 8, r % 8, lane); continue; } r -= I_SG;
#if GED_FP8
            if (r < I_SD) { transpose_item8(p.s_d + (size_t)l * 256 * D, D, W + WO_SD, 256, 0, 128, scr, r / 32, r % 32, lane); continue; } r -= I_SD;
#else
            if (r < I_SD) { transpose_item(p.s_d + (size_t)l * 256 * D, D, (bf16_t*)(W + WO_SD), 256, 0, 0, 128, scr, r / 32, r % 32, lane); continue; } r -= I_SD;
#endif
            { const int mat = r / 2, nb = r % 2, type = mat >> 4, dh = mat & 15;
              const float* src = (type ? p.lru_wx : p.lru_wa) + (size_t)((l * 2) * 8 + dh) * 4096;
              transpose_item(src, 64, (bf16_t*)(W + WO_LRU) + (size_t)mat * 4096, 64, 0, 0, 128, scr, 0, nb, lane, -1.4426950408889634f); }
        }
        const int gt = vw * 64 + lane, NT = nvw * 64;
        for (int i = gt; i < 192 * D / 8; i += NT) *(u32x4*)((bf16_t*)(W + WO_SR) + (size_t)64 * D + (size_t)i * 8) = (u32x4){0u, 0u, 0u, 0u};
        for (int i = gt; i < 8 * 128 * 128 / 4; i += NT) { const float4 v = *(const float4*)(p.gws + (size_t)l * 8 * 128 * 128 + (size_t)i * 4);
            u32x2 o; o.x = pk2(v.x, v.y); o.y = pk2(v.z, v.w); *(u32x2*)((bf16_t*)(W + WO_GWS) + (size_t)i * 4) = o; }
    } else if (part == 2) {
#if GED_FP8
        for (int it = vw; it < I_ED; it += nvw) { const int e = it / 128, q = it % 128; transpose_item8(p.e_d + ((size_t)(l * NE + e) * 256) * D, D, W + WO_ED + (size_t)e * D * 256, 256, 0, 128, scr, q / 32, q % 32, lane); }
#else
        for (int it = vw; it < I_ED; it += nvw) { const int e = it / 128, q = it % 128; transpose_item(p.e_d + ((size_t)(l * NE + e) * 256) * D, D, (bf16_t*)(W + WO_ED) + (size_t)e * D * 256, 256, 0, 0, 128, scr, q / 32, q % 32, lane); }
#endif
    } else {
        constexpr int NITEMS = 2 * I_EG;
        for (int it = vw; it < NITEMS; it += nvw) {
            int r = it;
            if (r < I_EG) { const int e = r / 128, q = r % 128; transpose_item8(p.e_g + ((size_t)(l * NE + e) * D) * 256, 256, W + WO_EG + (size_t)e * 512 * D, D, 0, 256, scr, q / 8, q % 8, lane); continue; } r -= I_EG;
            { const int e = r / 128, q = r % 128; transpose_item8(p.e_u + ((size_t)(l * NE + e) * D) * 256, 256, W + WO_EG + (size_t)e * 512 * D, D, 128, 256, scr, q / 8, q % 8, lane); }
        }
    }
}
DEV void pe_table(const Params& p, const Frame& F, int idx) {
    const int pos = idx >> 9, half = (idx >> 8) & 1, q = idx & 255;
    const float omega = 1.0f / powf(10000.0f, (float)q / 256.0f);
    const float ang = (float)pos * omega;
    ((float*)(p.ws + WS_PE))[idx] = half ? cosf(ang) : sinf(ang);
}
DEV void mod_items(const Params& p, const Frame& F) {
    LAS float* part = (LAS float*)(F.lds);
    LAS float* sc = (LAS float*)(F.lds + 16384);
    if (F.bx < 2 * 96) {
        for (int i = F.tid; i < 5 * D; i += NWAVES * 64) { const int cnd = i >> 10, d = i & (D - 1); sc[d * 8 + cnd] = siluf_(cnd < 4 ? p.c[cnd * D + d] : p.c_ctx[d]); }
        __syncthreads();
    }
    for (int it = F.bx; it < 2 * 96; it += F.G) {
        const int l = it / 96, e = (it % 96) * 64 + F.lane;
        const float* w = p.w_mod + (size_t)l * D * 6 * D + e;
        float acc[5] = {0.f, 0.f, 0.f, 0.f, 0.f};
        const int d0 = F.wave * 128;
#pragma unroll 32
        for (int d = d0; d < d0 + 128; ++d) { const float wv = w[(size_t)d * 6 * D]; const f32x4 s4 = *(const LAS f32x4*)(sc + d * 8); const float s5 = sc[d * 8 + 4];
            acc[0] += s4[0] * wv; acc[1] += s4[1] * wv; acc[2] += s4[2] * wv; acc[3] += s4[3] * wv; acc[4] += s5 * wv; }
#pragma unroll
        for (int cnd = 0; cnd < 5; ++cnd) part[(F.wave * 5 + cnd) * 64 + F.lane] = acc[cnd];
        __syncthreads();
        if (F.tid < 320) { const int cnd = F.tid >> 6, ln = F.tid & 63; float s = p.b_mod[l * 6 * D + (it % 96) * 64 + ln];
#pragma unroll
            for (int w8 = 0; w8 < 8; ++w8) s += part[(w8 * 5 + cnd) * 64 + ln];
            ((float*)(p.ws + WS_MOD))[(size_t)(l * 5 + cnd) * 6 * D + (it % 96) * 64 + ln] = s; }
        __syncthreads();
    }
}

DEV bf16_t* xl16_row(const Params& p, int r) { return (bf16_t*)((unsigned char*)p.out + (size_t)r * 4096 + 2048); }
DEV void load_xl(const Params& p, int r, int lane, float (&v)[16]) {
    if (r < TL) { const bf16_t* x = xl16_row(p, r);
#pragma unroll
        for (int j = 0; j < 4; ++j) { const ushort4 t = *(const ushort4*)(x + (j * 64 + lane) * 4); v[4 * j] = bf2f(t.x); v[4 * j + 1] = bf2f(t.y); v[4 * j + 2] = bf2f(t.z); v[4 * j + 3] = bf2f(t.w); } }
    else { const float* x = (const float*)(p.ws + WS_XC) + (size_t)(r - TL) * D;
#pragma unroll
        for (int j = 0; j < 4; ++j) { const float4 t = *(const float4*)(x + (j * 64 + lane) * 4); v[4 * j] = t.x; v[4 * j + 1] = t.y; v[4 * j + 2] = t.z; v[4 * j + 3] = t.w; } }
}
DEV void store_xl(const Params& p, int r, int lane, const float (&v)[16], bool final_f32) {
    if (r < TL && !final_f32) { bf16_t* x = xl16_row(p, r);
#pragma unroll
        for (int j = 0; j < 4; ++j) { u32x2 o; o.x = pk2(v[4 * j], v[4 * j + 1]); o.y = pk2(v[4 * j + 2], v[4 * j + 3]); *(u32x2*)(x + (j * 64 + lane) * 4) = o; } }
    else { float* x = r < TL ? p.out + (size_t)r * D : (float*)(p.ws + WS_XC) + (size_t)(r - TL) * D;
#pragma unroll
        for (int j = 0; j < 4; ++j) *(float4*)(x + (j * 64 + lane) * 4) = make_float4(v[4 * j], v[4 * j + 1], v[4 * j + 2], v[4 * j + 3]); }
}
DEV void row_pass_A(const Params& p, int l, int wave, int nw, int lane) {
    const int nrows = (l == 2) ? TL : R;
    const bf16_t* FL = (const bf16_t*)(p.ws + WS_RY);
    for (int r = wave; r < nrows; r += nw) {
        const int cond = r < TL ? (r >> 13) : 4;
        float v[16];
        if (l == 0) {
            const float* src = r < TL ? p.x + (size_t)r * D : p.ctx + (size_t)(r - TL) * D;
#pragma unroll
            for (int j = 0; j < 4; ++j) { const float4 t = *(const float4*)(src + (j * 64 + lane) * 4); v[4 * j] = t.x; v[4 * j + 1] = t.y; v[4 * j + 2] = t.z; v[4 * j + 3] = t.w; }
            if (r < TL) {
                const int t = r & (SEQ - 1); const float* PE = (const float*)(p.ws + WS_PE);
#pragma unroll
                for (int j = 0; j < 4; ++j) { const float4 e = *(const float4*)(PE + ((j < 2) ? (t >> 6) : (t & 63)) * 512 + (j & 1) * 256 + lane * 4);
                    v[4 * j] += e.x; v[4 * j + 1] += e.y; v[4 * j + 2] += e.z; v[4 * j + 3] += e.w; }
            }
        } else {
            float f[16]; float ss = 0.f;
            load_xl(p, r, lane, v);
#pragma unroll
            for (int j = 0; j < 4; ++j) {
                const ushort4 fb = *(const ushort4*)(FL + (size_t)r * D + (j * 64 + lane) * 4);
                f[4 * j] = bf2f(fb.x); f[4 * j + 1] = bf2f(fb.y); f[4 * j + 2] = bf2f(fb.z); f[4 * j + 3] = bf2f(fb.w);
            }
            { const unsigned char* SL = p.ws + WS_SLOTS + (size_t)r * 8 * 1024;
                unsigned sv[8][4];
#pragma unroll
                for (int s = 0; s < 8; ++s)
#pragma unroll
                    for (int j = 0; j < 4; ++j) sv[s][j] = *(const unsigned*)(SL + (size_t)s * 1024 + (j * 64 + lane) * 4);
#pragma unroll
                for (int j = 0; j < 4; ++j) { float a0 = 0.f, a1 = 0.f, a2 = 0.f, a3 = 0.f;
#pragma unroll
                    for (int s = 0; s < 8; ++s) { a0 += __builtin_amdgcn_cvt_f32_fp8(sv[s][j], 0); a1 += __builtin_amdgcn_cvt_f32_fp8(sv[s][j], 1); a2 += __builtin_amdgcn_cvt_f32_fp8(sv[s][j], 2); a3 += __builtin_amdgcn_cvt_f32_fp8(sv[s][j], 3); }
                    f[4 * j] += a0 * 0.0625f; f[4 * j + 1] += a1 * 0.0625f; f[4 * j + 2] += a2 * 0.0625f; f[4 * j + 3] += a3 * 0.0625f; } }
#pragma unroll
            for (int i = 0; i < 16; ++i) ss += f[i] * f[i];
            const float rstd = rsqrtf(wave_sum(ss) * (1.f / D) + 1e-6f);
            const float* gt = mod_ptr(p, l - 1, cond, 5); const float* g = p.g_post_ffn + (l - 1) * D;
#pragma unroll
            for (int j = 0; j < 4; ++j) { const float4 gt4 = *(const float4*)(gt + (j * 64 + lane) * 4), g4 = *(const float4*)(g + (j * 64 + lane) * 4);
                v[4 * j] += gt4.x * (f[4 * j] * rstd * g4.x); v[4 * j + 1] += gt4.y * (f[4 * j + 1] * rstd * g4.y); v[4 * j + 2] += gt4.z * (f[4 * j + 2] * rstd * g4.z); v[4 * j + 3] += gt4.w * (f[4 * j + 3] * rstd * g4.w); }
        }
        store_xl(p, r, lane, v, l == 2);
        if (l < 2) {
            float ss = 0.f;
#pragma unroll
            for (int i = 0; i < 16; ++i) ss += v[i] * v[i];
            const float rstd = rsqrtf(wave_sum(ss) * (1.f / D) + 1e-6f);
            const float* sh = mod_ptr(p, l, cond, 0); const float* sc = mod_ptr(p, l, cond, 1); const float* g = p.g_pre_mix + l * D;
#pragma unroll
            for (int j = 0; j < 4; ++j) { const int d = (j * 64 + lane) * 4; const float4 sh4 = *(const float4*)(sh + d), sc4 = *(const float4*)(sc + d), g4 = *(const float4*)(g + d);
                u32x2 o; o.x = pk2(v[4 * j] * rstd * g4.x * (1.f + sc4.x) + sh4.x, v[4 * j + 1] * rstd * g4.y * (1.f + sc4.y) + sh4.y);
                o.y = pk2(v[4 * j + 2] * rstd * g4.z * (1.f + sc4.z) + sh4.z, v[4 * j + 3] * rstd * g4.w * (1.f + sc4.w) + sh4.w);
#if GIN_FP8
                { const float h0 = __uint_as_float(o.x << 16) * 16.f, h1 = __uint_as_float(o.x & 0xffff0000u) * 16.f, h2 = __uint_as_float(o.y << 16) * 16.f, h3 = __uint_as_float(o.y & 0xffff0000u) * 16.f;
                  unsigned t = 0; t = __builtin_amdgcn_cvt_pk_fp8_f32(__builtin_amdgcn_fmed3f(h0, -440.f, 440.f), __builtin_amdgcn_fmed3f(h1, -440.f, 440.f), t, false);
                  t = __builtin_amdgcn_cvt_pk_fp8_f32(__builtin_amdgcn_fmed3f(h2, -440.f, 440.f), __builtin_amdgcn_fmed3f(h3, -440.f, 440.f), t, true);
                  *(unsigned*)(p.ws + WS_H8 + (size_t)r * D + d) = t; }
#else
                *(u32x2*)((bf16_t*)(p.ws + WS_RY) + (size_t)r * D + d) = o;
#endif
            }
        }
    }
}
DEV void row_pass_H(const Params& p, int l, int nrows, int wave, int nw, int lane) {
    const bf16_t* YL = (const bf16_t*)(p.ws + WS_Z);
    bf16_t* H = (bf16_t*)(p.ws + WS_RA);
    for (int r = wave; r < nrows; r += nw) {
        const int cond = r < TL ? (r >> 13) : 4;
        float v[16], f[16]; float ss = 0.f;
        load_xl(p, r, lane, v);
#pragma unroll
        for (int j = 0; j < 4; ++j) {
            const ushort4 fb = *(const ushort4*)(YL + (size_t)r * D + (j * 64 + lane) * 4);
            f[4 * j] = bf2f(fb.x); f[4 * j + 1] = bf2f(fb.y); f[4 * j + 2] = bf2f(fb.z); f[4 * j + 3] = bf2f(fb.w);
        }
#pragma unroll
        for (int i = 0; i < 16; ++i) ss += f[i] * f[i];
        const float rstd = rsqrtf(wave_sum(ss) * (1.f / D) + 1e-6f);
        const float* gt = mod_ptr(p, l, cond, 2); const float* g = p.g_post_mix + l * D;
#pragma unroll
        for (int j = 0; j < 4; ++j) { const float4 gt4 = *(const float4*)(gt + (j * 64 + lane) * 4), g4 = *(const float4*)(g + (j * 64 + lane) * 4);
            v[4 * j] += gt4.x * (f[4 * j] * rstd * g4.x); v[4 * j + 1] += gt4.y * (f[4 * j + 1] * rstd * g4.y); v[4 * j + 2] += gt4.z * (f[4 * j + 2] * rstd * g4.z); v[4 * j + 3] += gt4.w * (f[4 * j + 3] * rstd * g4.w); }
        store_xl(p, r, lane, v, false);
        float s2 = 0.f;
#pragma unroll
        for (int i = 0; i < 16; ++i) s2 += v[i] * v[i];
        const float rstd2 = rsqrtf(wave_sum(s2) * (1.f / D) + 1e-6f);
        const float* sh = mod_ptr(p, l, cond, 3); const float* sc = mod_ptr(p, l, cond, 4); const float* g2 = p.g_pre_ffn + l * D;
#pragma unroll
        for (int j = 0; j < 4; ++j) { const int d = (j * 64 + lane) * 4; const float4 sh4 = *(const float4*)(sh + d), sc4 = *(const float4*)(sc + d), g4 = *(const float4*)(g2 + d);
            u32x2 o; o.x = pk2(v[4 * j] * rstd2 * g4.x * (1.f + sc4.x) + sh4.x, v[4 * j + 1] * rstd2 * g4.y * (1.f + sc4.y) + sh4.y);
            o.y = pk2(v[4 * j + 2] * rstd2 * g4.z * (1.f + sc4.z) + sh4.z, v[4 * j + 3] * rstd2 * g4.w * (1.f + sc4.w) + sh4.w);
            *(u32x2*)(H + (size_t)r * D + d) = o;
            { const float h0 = __uint_as_float(o.x << 16) * 16.f, h1 = __uint_as_float(o.x & 0xffff0000u) * 16.f, h2 = __uint_as_float(o.y << 16) * 16.f, h3 = __uint_as_float(o.y & 0xffff0000u) * 16.f;
              unsigned t = 0; t = __builtin_amdgcn_cvt_pk_fp8_f32(__builtin_amdgcn_fmed3f(h0, -440.f, 440.f), __builtin_amdgcn_fmed3f(h1, -440.f, 440.f), t, false);
              t = __builtin_amdgcn_cvt_pk_fp8_f32(__builtin_amdgcn_fmed3f(h2, -440.f, 440.f), __builtin_amdgcn_fmed3f(h3, -440.f, 440.f), t, true);
              *(unsigned*)(p.ws + WS_H2E + (size_t)r * D + d) = t; } }
    }
}

DEV void route_token(const Params& p, int l, float logit, int lane, int& myi, float& myw) {
    const float s = sigmoidf_(logit);
    const float sel = s + p.router_b[l * 64 + lane];
    int rank = 0;
#pragma unroll
    for (int k = 1; k < 8; ++k) { const float o = __shfl_xor(sel, k); const int ol = lane ^ k; rank += (o > sel || (o == sel && ol < lane)) ? 1 : 0; }
    float gs = rank < 2 ? sel : 0.f;
    gs += __shfl_xor(gs, 1); gs += __shfl_xor(gs, 2); gs += __shfl_xor(gs, 4);
    const int g = lane >> 3; int grank = 0;
#pragma unroll
    for (int k = 1; k < 8; ++k) { const float o = __shfl_xor(gs, 8 * k); const int og = g ^ k; grank += (o > gs || (o == gs && og < g)) ? 1 : 0; }
    float mv = grank < 4 ? sel : -INFINITY;
    float wsum = 0.f; myw = 0.f; myi = 0;
    for (int s8 = 0; s8 < 8; ++s8) {
        float mx = mv;
#pragma unroll
        for (int o = 32; o >= 1; o >>= 1) mx = fmaxf(mx, __shfl_xor(mx, o));
        const unsigned long long bal = __ballot(mv == mx);
        const int win = __ffsll((long long)bal) - 1;
        const float sw = __shfl(s, win);
        if (lane == s8) { myi = win; myw = sw; }
        wsum += sw;
        if (lane == win) mv = -INFINITY;
    }
    myw = myw / wsum * 2.5f;
}
DEV void route_rows(const Params& p, const Frame& F, int l, int r0) {
    int* hist = (int*)(F.ldsg); int* base = hist + 64; int* loc = hist + 128; float* locw = (float*)(hist + 128 + 2048);
    int* LISTA = (int*)(p.ws + WS_LISTA); float* LISTW = (float*)(p.ws + WS_LISTW);
    unsigned* CNT = (unsigned*)(p.ws + WS_CTL) + CW_CNT + l * 64;
    constexpr int rpw = 256;
    if (F.tid < 64) hist[F.tid] = 0;
    __syncthreads();
    const int ti = F.wave * 64 + F.lane;
    if (F.wave < 4) {
        const float* LOG = (const float*)(p.ws + WS_LOG) + (size_t)(r0 + ti) * 64;
        float sv[64], sel[64];
#pragma unroll
        for (int q = 0; q < 16; ++q) { const float4 t = *(const float4*)(LOG + 4 * q); sv[4 * q] = t.x; sv[4 * q + 1] = t.y; sv[4 * q + 2] = t.z; sv[4 * q + 3] = t.w; }
#pragma unroll
        for (int e = 0; e < 64; ++e) { sv[e] = fsigmoid(sv[e]); sel[e] = sv[e] + p.router_b[l * 64 + e]; }
        float gs[8];
#pragma unroll
        for (int g = 0; g < 8; ++g) { float m1 = fmaxf(sel[8 * g], sel[8 * g + 1]), m2 = fminf(sel[8 * g], sel[8 * g + 1]);
#pragma unroll
            for (int k = 2; k < 8; ++k) { const float x = sel[8 * g + k]; m2 = fmaxf(m2, fminf(m1, x)); m1 = fmaxf(m1, x); }
            gs[g] = m1 + m2; }
#pragma unroll
        for (int g = 0; g < 8; ++g) { int rank = 0;
#pragma unroll
            for (int k = 0; k < 8; ++k) if (k != g) rank += (gs[k] > gs[g] || (gs[k] == gs[g] && k < g)) ? 1 : 0;
            if (rank >= 4) {
#pragma unroll
                for (int k = 0; k < 8; ++k) sel[8 * g + k] = -INFINITY; } }
        float wsum = 0.f; int bi8[8]; float bw8[8];
#pragma unroll
        for (int s8 = 0; s8 < 8; ++s8) { float best = sel[0], bs = sv[0]; int bi = 0;
#pragma unroll
            for (int e = 1; e < 64; ++e) { const bool gt = sel[e] > best; best = gt ? sel[e] : best; bs = gt ? sv[e] : bs; bi = gt ? e : bi; }
#pragma unroll
            for (int e = 0; e < 64; ++e) sel[e] = (e == bi) ? -INFINITY : sel[e];
            bi8[s8] = bi; bw8[s8] = bs; wsum += bs; }
        const float sc = 2.5f / wsum;
#pragma unroll
        for (int s8 = 0; s8 < 8; ++s8) { const int rk = atomicAdd(&hist[bi8[s8]], 1); loc[ti * 8 + s8] = (bi8[s8] << 16) | rk; locw[ti * 8 + s8] = bw8[s8] * sc; }
    }
    __syncthreads();
    if (F.tid < 64) base[F.tid] = (int)__hip_atomic_fetch_add(CNT + F.tid, (unsigned)hist[F.tid], __ATOMIC_RELAXED, __HIP_MEMORY_SCOPE_AGENT);
    __syncthreads();
    for (int idx = F.tid; idx < rpw * 8; idx += NWAVES * 64) { const int v = loc[idx], e = v >> 16, rk = v & 0xffff; const int within = base[e] + rk;
        if (within < CAP) { const size_t pos = (size_t)e * CAP + within; LISTA[pos] = (r0 + (idx >> 3)) * 8 + (idx & 7); LISTW[pos] = locw[idx]; } }
    __syncthreads();
}
DEV void combine_pass(const Params& p, int hf, int nrows, int wave, int nw, int lane) {
    bf16_t* FS = (bf16_t*)(p.ws + WS_RY); const bf16_t* SL = (const bf16_t*)(p.ws + WS_SLOTS);
    for (int r = wave; r < nrows; r += nw) {
        bf16_t* fp = FS + (size_t)r * D + hf * 512 + lane * 8;
        f32x4 a0, a1; pg8::unpack8(*(const u32x4*)fp, a0, a1);
        u32x4 sv[8];
#pragma unroll
        for (int s = 0; s < 8; ++s) sv[s] = *(const u32x4*)(SL + ((size_t)r * 8 + s) * 512 + lane * 8);
#pragma unroll
        for (int s = 0; s < 8; ++s) { f32x4 b0, b1; pg8::unpack8(sv[s], b0, b1); a0 += b0; a1 += b1; }
        *(u32x4*)fp = pg8::pack8(a0, a1);
    }
}
DEV size_t summ_idx(int dir, int b, int pos, int which, int ch) { return ((((size_t)dir * 4 + b) * 66 + pos) * 2 + which) * 512 + ch; }
DEV f32x4 mfma16(bf16x8 a, bf16x8 b, f32x4 c) { return __builtin_amdgcn_mfma_f32_16x16x32_bf16(a, b, c, 0, 0, 0); }

template <int PASS>
DEV void chunk_pass(const Params& p, const Frame& F, int l_in, int c, bool do_gmlp) {
    int oz = 0; asm volatile("" : "+s"(oz));
    const int l = l_in + oz;
    const int lane = F.lane, h = F.wave, fr = lane & 15, fq = lane >> 4;
    const bf16_t* Z = (const bf16_t*)(p.ws + WS_Z); bf16_t* Y = (bf16_t*)(p.ws + WS_RY); float* SUMM = (float*)(p.ws + WS_SUMM);
    const unsigned char* W = p.ws + WS_W + oz;
    int r0, t0, n, b, posf, posb;
    if (c < 256) { b = c >> 6; const int k = c & 63; r0 = b * SEQ + k * 128; t0 = k * 128; n = SEQ; posf = 2 + k; posb = 2 + (63 - k); }
    else { const int cc = c - 256; b = cc >> 1; const int k = cc & 1; r0 = TL + b * CTXL + k * 128; t0 = k * 128; n = CTXL; posf = k; posb = 1 - k; }
    {
        LAS bf16_t* xcs = (LAS bf16_t*)(F.lds + h * 16384);
        TREG_BEGIN(1);
        bf16_t* XCT = (bf16_t*)(p.ws + WS_XCT) + ((size_t)c * 8 + h) * 8192;
        if (PASS == 1) {
            u32x4 t[16];
#pragma unroll
            for (int k = 0; k < 16; ++k) t[k] = *(const u32x4*)(XCT + (k * 64 + lane) * 8);
#pragma unroll
            for (int k = 0; k < 16; ++k) *(LAS u32x4*)(xcs + (k * 64 + lane) * 8) = t[k];
        } else {
            const int cg = lane & 7, rsub = lane >> 3, ch0 = h * 64 + cg * 8;
            float w[4][8], cb[8];
#pragma unroll
            for (int k = 0; k < 4; ++k) { const float4 a = *(const float4*)(p.conv_w + (size_t)(l * 4 + k) * 512 + ch0), bb = *(const float4*)(p.conv_w + (size_t)(l * 4 + k) * 512 + ch0 + 4);
                w[k][0] = a.x; w[k][1] = a.y; w[k][2] = a.z; w[k][3] = a.w; w[k][4] = bb.x; w[k][5] = bb.y; w[k][6] = bb.z; w[k][7] = bb.w; }
            { const float4 a = *(const float4*)(p.conv_b + l * 512 + ch0), bb = *(const float4*)(p.conv_b + l * 512 + ch0 + 4);
                cb[0] = a.x; cb[1] = a.y; cb[2] = a.z; cb[3] = a.w; cb[4] = bb.x; cb[5] = bb.y; cb[6] = bb.z; cb[7] = bb.w; }
            const bf16_t* Zx = Z + (size_t)r0 * 4096 + 1024 + ch0;
#pragma unroll 1
            for (int it = 0; it < 2; ++it) {
                const int tb = (it * 8 + rsub) * 8;
                u32x4 raw[11];
#pragma unroll
                for (int k = 0; k < 11; ++k) { const int tt = t0 + tb + k - 2; const int rowc = (tt >= 0 && tt < n) ? (tb + k - 2) : tb;
                    raw[k] = *(const u32x4*)(Zx + (long)rowc * 4096); }
#pragma unroll
                for (int k = 0; k < 11; ++k) { const int tt = t0 + tb + k - 2; if (!(tt >= 0 && tt < n)) raw[k] = (u32x4){0u, 0u, 0u, 0u}; }
#pragma unroll
                for (int o = 0; o < 8; ++o) {
                    float y[8];
#pragma unroll
                    for (int j = 0; j < 8; ++j) y[j] = cb[j];
#pragma unroll
                    for (int k = 0; k < 4; ++k) { f32x4 x0, x1; pg8::unpack8(raw[o + k], x0, x1);
#pragma unroll
                        for (int j = 0; j < 4; ++j) { y[j] += w[k][j] * x0[j]; y[4 + j] += w[k][4 + j] * x1[j]; } }
                    const u32x4 pk = pg8::pack8((f32x4){y[0], y[1], y[2], y[3]}, (f32x4){y[4], y[5], y[6], y[7]});
                    *(LAS u32x4*)(xcs + (tb + o) * 64 + cg * 8) = pk; *(u32x4*)(XCT + (tb + o) * 64 + cg * 8) = pk;
                }
            }
        }
        asm volatile("s_waitcnt lgkmcnt(0)" ::: "memory");
        TREG_END(1, F);
        TREG_BEGIN(2);
        float carry0 = 0.f, carry1 = 0.f;
        if (PASS == 1) {
            const int chl = h * 64 + lane;
#pragma unroll
            for (int dir = 0; dir < 2; ++dir) {
                const int np = dir ? posb : posf; float cr = 0.f;
                for (int q0 = 0; q0 < np; q0 += 16) { float a8[16], h8[16];
#pragma unroll
                    for (int j = 0; j < 16; ++j) { const int q = (q0 + j < np) ? q0 + j : np - 1; a8[j] = SUMM[summ_idx(dir, b, q, 0, chl)]; h8[j] = SUMM[summ_idx(dir, b, q, 1, chl)]; }
#pragma unroll
                    for (int j = 0; j < 16; ++j) if (q0 + j < np) cr = a8[j] * cr + h8[j]; }
                if (dir) carry1 = cr; else carry0 = cr;
            }
        }
        TREG_END(2, F);
        TREG_BEGIN(3);
#pragma unroll 1
        for (int ct = 0; ct < 4; ++ct) {
            const int chc = h * 64 + ct * 16 + fr;
            float hsum[8][4];
            u32x4 gbr[2][2];
            if (PASS == 1) {
#pragma unroll
                for (int hv = 0; hv < 2; ++hv) { const bf16_t* gp = Z + (size_t)(r0 + hv * 64 + lane) * 4096 + 1536 + h * 64 + ct * 16; gbr[hv][0] = *(const u32x4*)gp; gbr[hv][1] = *(const u32x4*)(gp + 8); }
            }
            bf16x8 wfr[2][4]; float bias_a2[2], bias_x2[2], spc2[2];
#pragma unroll
            for (int dir = 0; dir < 2; ++dir) {
                const bf16_t* wa = (const bf16_t*)(W + WO_LRU) + (size_t)(0 * 16 + dir * 8 + h) * 4096 + (size_t)(ct * 16 + fr) * 64 + 8 * fq;
                const bf16_t* wx = (const bf16_t*)(W + WO_LRU) + (size_t)(1 * 16 + dir * 8 + h) * 4096 + (size_t)(ct * 16 + fr) * 64 + 8 * fq;
                wfr[dir][0] = *(const bf16x8*)(wa); wfr[dir][1] = *(const bf16x8*)(wa + 32); wfr[dir][2] = *(const bf16x8*)(wx); wfr[dir][3] = *(const bf16x8*)(wx + 32);
                bias_a2[dir] = -1.4426950408889634f * p.lru_ba[(l * 2 + dir) * 512 + chc]; bias_x2[dir] = -1.4426950408889634f * p.lru_bx[(l * 2 + dir) * 512 + chc];
                spc2[dir] = -8.0f * log1pf(expf(-p.lru_lam[(l * 2 + dir) * 512 + chc])) * 1.4426950408889634f;
            }
#pragma unroll
            for (int dir = 0; dir < 2; ++dir) {
                const bf16x8 ba0 = wfr[dir][0], ba1 = wfr[dir][1], bx0 = wfr[dir][2], bx1 = wfr[dir][3];
                const float bias_a = bias_a2[dir], bias_x = bias_x2[dir], spc = spc2[dir];
                float Hrun = 0.f, Arun = 1.f;
                if (PASS == 1) Hrun = __shfl(dir ? carry1 : carry0, ct * 16 + fr);
                const int mypos = dir ? 3 - fq : fq;
#pragma unroll
                for (int grp = 0; grp < 2; ++grp) {
                    float av[4][4], dv[4][4], Ap[4], Hp[4], At[4], Ht[4];
#pragma unroll
                    for (int rq = 0; rq < 4; ++rq) {
                        const int rr = grp * 4 + rq, rt = dir ? 7 - rr : rr;
                        const bf16x8 f0 = *(const LAS bf16x8*)(xcs + (rt * 16 + fr) * 64 + 8 * fq), f1 = *(const LAS bf16x8*)(xcs + (rt * 16 + fr) * 64 + 32 + 8 * fq);
                        f32x4 aa = {bias_a, bias_a, bias_a, bias_a}, ax = {bias_x, bias_x, bias_x, bias_x};
                        aa = mfma16(f0, ba0, aa); aa = mfma16(f1, ba1, aa);
                        ax = mfma16(f0, bx0, ax); ax = mfma16(f1, bx1, ax);
#pragma unroll
                        for (int i = 0; i < 4; ++i) {
                            const float xc = bf2f(xcs[(rt * 16 + 4 * fq + i) * 64 + ct * 16 + fr]);
                            const float rg = __builtin_amdgcn_rcpf(1.f + __builtin_amdgcn_exp2f(aa[i])), ig = __builtin_amdgcn_rcpf(1.f + __builtin_amdgcn_exp2f(ax[i]));
                            const float a = __builtin_amdgcn_exp2f(spc * rg);
                            av[rq][i] = a; dv[rq][i] = __builtin_amdgcn_sqrtf(fmaxf(1.f - a * a, 0.f)) * (ig * xc);
                        }
                        float Al = 1.f, Hl = 0.f;
#pragma unroll
                        for (int s = 0; s < 4; ++s) { const int i = dir ? 3 - s : s; Hl = av[rq][i] * Hl + dv[rq][i]; Al = av[rq][i] * Al; }
                        float ap = 1.f, hp = 0.f, at = 1.f, ht = 0.f;
#pragma unroll
                        for (int s = 0; s < 4; ++s) { const int g = dir ? 3 - s : s; const float Ag = __shfl(Al, fr + 16 * g), Hg = __shfl(Hl, fr + 16 * g);
                            ht = Ag * ht + Hg; at = Ag * at;
                            const bool before = s < mypos; hp = before ? Ag * hp + Hg : hp; ap = before ? Ag * ap : ap; }
                        Ap[rq] = ap; Hp[rq] = hp; At[rq] = at; Ht[rq] = ht;
                    }
#pragma unroll
                    for (int rq = 0; rq < 4; ++rq) {
                        const int rr = grp * 4 + rq, rt = dir ? 7 - rr : rr;
                        if (PASS == 1) {
                            float hc = Ap[rq] * Hrun + Hp[rq];
#pragma unroll
                            for (int s = 0; s < 4; ++s) { const int i = dir ? 3 - s : s; hc = av[rq][i] * hc + dv[rq][i]; if (dir == 0) hsum[rt][i] = hc; else hsum[rt][i] += hc; }
                        }
                        Hrun = At[rq] * Hrun + Ht[rq]; Arun = At[rq] * Arun;
                    }
                    asm volatile("" ::: "memory");
                }
                if (PASS == 0 && fq == 0) { const int pos = dir ? posb : posf; SUMM[summ_idx(dir, b, pos, 0, chc)] = Arun; SUMM[summ_idx(dir, b, pos, 1, chc)] = Hrun; }
            }
            if (PASS == 1) {
                LAS bf16_t* sp = (LAS bf16_t*)(F.lds + SPW_OFF + h * SPW_BYTES);
#pragma unroll
                for (int hv = 0; hv < 2; ++hv) {
#pragma unroll
                    for (int j = 0; j < 4; ++j)
#pragma unroll
                        for (int i = 0; i < 4; ++i) sp[(j * 16 + 4 * fq + i) * 16 + fr] = f2bf(hsum[hv * 4 + j][i]);
                    asm volatile("s_waitcnt lgkmcnt(0)" ::: "memory");
                    const u32x4 s0 = *(const LAS u32x4*)(sp + lane * 16), s1 = *(const LAS u32x4*)(sp + lane * 16 + 8);
                    asm volatile("s_waitcnt lgkmcnt(0)" ::: "memory");
                    f32x4 a0, a1, b0, b1, g0, g1, g2, g3; pg8::unpack8(s0, a0, a1); pg8::unpack8(s1, b0, b1); pg8::unpack8(gbr[hv][0], g0, g1); pg8::unpack8(gbr[hv][1], g2, g3);
                    bf16_t* yp = Y + (size_t)(r0 + hv * 64 + lane) * D + 512 + h * 64 + ct * 16;
                    *(u32x4*)yp = pg8::pack8(a0 * g0, a1 * g1); *(u32x4*)(yp + 8) = pg8::pack8(b0 * g2, b1 * g3);
                }
            }
        }
        asm volatile("s_waitcnt vmcnt(0)" ::: "memory");
        TREG_END(3, F);
    }
    if (PASS == 0 && do_gmlp) {
        typedef float f32x2 __attribute__((ext_vector_type(2)));
        LAS f32x2* stats = (LAS f32x2*)(F.lds + STATS_OFF);
        TREG_BEGIN(4);
#pragma unroll 1
        for (int i0 = 0; i0 < 16; i0 += 8) {
            f32x4 v0[8], v1[8]; float mu[8], var[8];
#pragma unroll
            for (int j = 0; j < 8; ++j) pg8::unpack8(*(const u32x4*)(Z + (size_t)(r0 + F.wave * 16 + i0 + j) * 4096 + 512 + lane * 8), v0[j], v1[j]);
#pragma unroll
            for (int j = 0; j < 8; ++j) mu[j] = (v0[j][0] + v0[j][1]) + (v0[j][2] + v0[j][3]) + (v1[j][0] + v1[j][1]) + (v1[j][2] + v1[j][3]);
#pragma unroll
            for (int o = 1; o < 64; o <<= 1) {
#pragma unroll
                for (int j = 0; j < 8; ++j) mu[j] += __shfl_xor(mu[j], o); }
#pragma unroll
            for (int j = 0; j < 8; ++j) { mu[j] *= (1.f / 512.f); v0[j] -= mu[j]; v1[j] -= mu[j];
                var[j] = (v0[j][0] * v0[j][0] + v0[j][1] * v0[j][1]) + (v0[j][2] * v0[j][2] + v0[j][3] * v0[j][3]) + (v1[j][0] * v1[j][0] + v1[j][1] * v1[j][1]) + (v1[j][2] * v1[j][2] + v1[j][3] * v1[j][3]); }
#pragma unroll
            for (int o = 1; o < 64; o <<= 1) {
#pragma unroll
                for (int j = 0; j < 8; ++j) var[j] += __shfl_xor(var[j], o); }
            float m_ = mu[0], v_ = var[0];
#pragma unroll
            for (int j = 1; j < 8; ++j) { m_ = (lane == j) ? mu[j] : m_; v_ = (lane == j) ? var[j] : v_; }
            if (lane < 8) stats[F.wave * 16 + i0 + lane] = (f32x2){m_, rsqrtf(v_ * (1.f / 512.f) + 1e-5f)};
        }
        TREG_END(4, F);
        __syncthreads();
        TREG_BEGIN(5);
        const int g = F.wave;
        const bf16_t* Wg = (const bf16_t*)(W + WO_GWS) + (size_t)g * 128 * 128;
        LAS bf16_t* vn = (LAS bf16_t*)(F.lds + g * 16384);
        LAS bf16_t* sp = (LAS bf16_t*)(F.lds + SPW_OFF + g * SPW_BYTES);
        {
            const int cg = lane & 7, rsub = lane >> 3, ch0 = g * 64 + cg * 8;
            float lg[8], lb[8];
            { const float4 a = *(const float4*)(p.ln_g + l * 512 + ch0), bb = *(const float4*)(p.ln_g + l * 512 + ch0 + 4), c4 = *(const float4*)(p.ln_b + l * 512 + ch0), d4 = *(const float4*)(p.ln_b + l * 512 + ch0 + 4);
                lg[0] = a.x; lg[1] = a.y; lg[2] = a.z; lg[3] = a.w; lg[4] = bb.x; lg[5] = bb.y; lg[6] = bb.z; lg[7] = bb.w;
                lb[0] = c4.x; lb[1] = c4.y; lb[2] = c4.z; lb[3] = c4.w; lb[4] = d4.x; lb[5] = d4.y; lb[6] = d4.z; lb[7] = d4.w; }
            const bf16_t* Zv = Z + (size_t)r0 * 4096 + 512 + ch0;
#pragma unroll 1
            for (int i8 = 0; i8 < 16; i8 += 8) {
                u32x4 raw[8];
#pragma unroll
                for (int it = 0; it < 8; ++it) raw[it] = *(const u32x4*)(Zv + (long)((i8 + it) * 8 + rsub) * 4096);
#pragma unroll
                for (int it = 0; it < 8; ++it) { const int q = (i8 + it) * 8 + rsub; const f32x2 st = stats[q]; f32x4 x0, x1; pg8::unpack8(raw[it], x0, x1);
#pragma unroll
                    for (int j = 0; j < 4; ++j) { x0[j] = (x0[j] - st.x) * st.y * lg[j] + lb[j]; x1[j] = (x1[j] - st.x) * st.y * lg[4 + j] + lb[4 + j]; }
                    *(LAS u32x4*)(vn + q * 64 + cg * 8) = pg8::pack8(x0, x1); }
            }
        }
        asm volatile("s_waitcnt lgkmcnt(0)" ::: "memory");
        bf16x8 bfr[4][4];
#pragma unroll
        for (int ct = 0; ct < 4; ++ct)
#pragma unroll
            for (int ks = 0; ks < 4; ++ks) { unsigned wd[4];
#pragma unroll
                for (int j2 = 0; j2 < 4; ++j2) { const unsigned lo = vn[(ks * 32 + 8 * fq + 2 * j2) * 64 + ct * 16 + fr], hi = vn[(ks * 32 + 8 * fq + 2 * j2 + 1) * 64 + ct * 16 + fr]; wd[j2] = lo | (hi << 16); }
                bfr[ct][ks] = __builtin_bit_cast(bf16x8, (u32x4){wd[0], wd[1], wd[2], wd[3]}); }
        const bf16_t* Zu = Z + (size_t)r0 * 4096 + g * 64; bf16_t* Yu = Y + (size_t)r0 * D + g * 64;
        const int orow = lane >> 2, och = (lane & 3) * 16;
#pragma unroll 1
        for (int rt = 0; rt < 8; ++rt) {
            bf16x8 af[4];
#pragma unroll
            for (int ks = 0; ks < 4; ++ks) af[ks] = *(const bf16x8*)(Wg + (unsigned)((rt * 16 + fr) * 128 + ks * 32 + 8 * fq));
            const float4 bsv = *(const float4*)(p.gbs + (l * 8 + g) * 128 + rt * 16 + 4 * fq);
            const u32x4 u0 = *(const u32x4*)(Zu + (long)(rt * 16 + orow) * 4096 + och), u1 = *(const u32x4*)(Zu + (long)(rt * 16 + orow) * 4096 + och + 8);
            const float bs4[4] = {bsv.x, bsv.y, bsv.z, bsv.w};
#pragma unroll
            for (int ct = 0; ct < 4; ++ct) {
                f32x4 acc = {0.f, 0.f, 0.f, 0.f};
#pragma unroll
                for (int ks = 0; ks < 4; ++ks) acc = mfma16(af[ks], bfr[ct][ks], acc);
#pragma unroll
                for (int i = 0; i < 4; ++i) sp[(4 * fq + i) * 64 + ct * 16 + fr] = f2bf(acc[i] + bs4[i]);
            }
            asm volatile("s_waitcnt lgkmcnt(0)" ::: "memory");
            const u32x4 m0 = *(const LAS u32x4*)(sp + orow * 64 + och), m1 = *(const LAS u32x4*)(sp + orow * 64 + och + 8);
            asm volatile("s_waitcnt lgkmcnt(0)" ::: "memory");
            f32x4 a0, a1, b0, b1, c0, c1, d0, d1; pg8::unpack8(m0, a0, a1); pg8::unpack8(m1, b0, b1); pg8::unpack8(u0, c0, c1); pg8::unpack8(u1, d0, d1);
            bf16_t* yp = Yu + (long)(rt * 16 + orow) * D + och;
            *(u32x4*)yp = pg8::pack8(a0 * c0, a1 * c1); *(u32x4*)(yp + 8) = pg8::pack8(b0 * d0, b1 * d1);
        }
        asm volatile("s_waitcnt vmcnt(0)" ::: "memory"); TREG_END(5, F);
    }
    __syncthreads();
}
constexpr int NPL = 10, PH_FINAL = 1 + 2 * NPL, PH_END = PH_FINAL + 1;
struct Args { Params p; int ph_lo, ph_hi; };

DEV void build_toff(const Params& p, const Frame& F, int l, LAS int* toff) {
    if (F.tid < NE) { const unsigned* CNT = (const unsigned*)(p.ws + WS_CTL) + CW_CNT + l * 64;
        int cn = (int)__hip_atomic_load(CNT + F.tid, __ATOMIC_RELAXED, __HIP_MEMORY_SCOPE_AGENT); cn = cn < CAP ? cn : CAP;
        const int tiles = (cn + 255) >> 8; int incl = tiles;
#pragma unroll
        for (int o = 1; o < 64; o <<= 1) { const int t = __shfl_up(incl, o); if (F.lane >= o) incl += t; }
        const int excl = incl - tiles;
        toff[F.tid] = excl < 1120 ? excl : 1120; toff[80 + F.tid] = cn;
        if (F.tid == NE - 1) toff[64] = incl < 1120 ? incl : 1120; }
    __syncthreads();
    if (F.tid < NE) { LAS unsigned char* te = (LAS unsigned char*)(F.lds + SPW_OFF); for (int t = toff[F.tid]; t < toff[F.tid + 1]; ++t) te[t] = (unsigned char)F.tid; }
    __syncthreads();
}

template <int ph> DEV void run_phase(const Frame& F0) {
    Frame F = F0; { unsigned z_ = 0; asm volatile("" : "+v"(z_)); F.lane = (int)__builtin_amdgcn_mbcnt_hi(~0u, __builtin_amdgcn_mbcnt_lo(~0u, z_)); F.tid = F.wave * 64 + F.lane; }
    asm volatile("" : "+s"(F.G), "+s"(F.bx));
    const Params p = load_params(F);
    unsigned char* ws = p.ws; unsigned char* W = ws + WS_W;
    LAS int* toff = (LAS int*)(F.lds + MISC_OFF + 256);
    const int gw = F.bx * NWAVES + F.wave, NGW = F.G * NWAVES;
#ifndef NOPRO
    if (ph == 0) { if (F.bx == 0 && F.tid < 128) __hip_atomic_store((unsigned*)(p.ws + WS_CTL) + CW_CNT + F.tid, 0u, __ATOMIC_RELAXED, __HIP_MEMORY_SCOPE_AGENT);
        if (F.bx >= 192) { pe_table(p, F, (F.bx - 192) * 1024 + F.tid); pe_table(p, F, (F.bx - 192) * 1024 + 512 + F.tid); }
        mod_items(p, F); __syncthreads(); convert_weights(p, F, 0, 0, gw, NGW); return; }
    if (ph == PH_FINAL) { row_pass_A(p, 2, gw, NGW, F.lane); return; }
#endif
    constexpr int l = (ph - 1) / NPL, k = (ph - 1) % NPL;
    constexpr int nr = (l == 0) ? R : TL;
#ifndef PMASK
#define PMASK 0xffff
#endif
#define PON(k_) ((PMASK >> (k_)) & 1)
    switch (k) {
    case 0: if (PON(0)) { if (l > 0) convert_weights(p, F, l, 0, gw, NGW); row_pass_A(p, l, gw, NGW, F.lane); } break;
    case 1: if (PON(1)) {
#if GIN_FP8
        pg8::DenseSched<512, WS_H8, WS_W + WO_IN> S; S.init(ws, R, 4096, F.bx); pg8::EpiZ E{ws};
        pg8::gemm_phase<pg8::EpiZ, decltype(S), true, 0x7b>(F.lds, F.tid, S, E);
#else
        pg8::DenseSched<D, WS_RY, WS_W + WO_IN> S; S.init(ws, R, 4096, F.bx); pg8::EpiZ E{ws};
        pg8::gemm_phase<pg8::EpiZ, decltype(S), true>(F.lds, F.tid, S, E);
#endif
        if (F.bx >= 64) convert_weights(p, F, l, 2, (F.bx - 64) * NWAVES + F.wave, 192 * NWAVES); } break;
    case 2: if (PON(2)) { for (int c = F.bx; c < NCHUNK; c += F.G) chunk_pass<0>(p, F, l, c, l == 0 || c < 256);
        if (F.bx >= NCHUNK - F.G) { convert_weights(p, F, l, 1, (F.bx - (NCHUNK - F.G)) * NWAVES + F.wave, (2 * F.G - NCHUNK) * NWAVES); } } break;
    case 3: if (PON(3)) for (int c = F.bx; c < (l == 0 ? NCHUNK : 256); c += F.G) chunk_pass<1>(p, F, l, c, false); break;
    case 4: if (PON(4)) { pg8::DenseSched<D, WS_RY, WS_W + WO_AB> S; S.init(ws, nr, D, F.bx); pg8::EpiAB E{ws};
        pg8::gemm_phase<pg8::EpiAB, decltype(S), true>(F.lds, F.tid, S, E); } break;
    case 5: if (PON(5)) { pg8::DenseSched<D, WS_RA, WS_W + WO_OUT> S; S.init(ws, nr, D, F.bx); pg8::EpiPlain<WS_Z> E{ws};
        pg8::gemm_phase<pg8::EpiPlain<WS_Z>, decltype(S), true>(F.lds, F.tid, S, E); } break;
    case 6: if (PON(6)) row_pass_H(p, l, nr, gw, NGW, F.lane); break;
    case 7: if (PON(7)) { pg8::DenseSched<D, WS_RA, WS_W + WO_SR> S; S.init(ws, nr, 768, F.bx); pg8::EpiSR E{ws};
        pg8::gemm_phase<pg8::EpiSR, decltype(S), true>(F.lds, F.tid, S, E);
        asm volatile("s_waitcnt vmcnt(0)" ::: "memory"); __syncthreads();
        for (int i = 0;; ++i) { pg8::UnitD u; if (!S.next(i, u)) break; if (u.pn == 0) route_rows(p, F, l, u.pm * 256); } } break;
    case 8: if (PON(8)) { build_toff(p, F, l, toff);
        { pg8::ExpSched<512, 1, 2, WS_H2E, WS_W + WO_EG, (size_t)512 * D> S; S.ws = ws; S.lds = F.lds; S.U = toff[64] * 2; S.c = F.bx; S.brow0 = 0; S.Krt = 512;
          pg8::EpiEG<0> E{ws};
          pg8::gemm_phase<pg8::EpiEG<0>, decltype(S), true, 0x7b>(F.lds, F.tid, S, E); }
#if GED_FP8
        { pg8::DenseSched<128, WS_SH, WS_W + WO_SD> S; S.init(ws, nr, D, 255 - F.bx); pg8::EpiPlain<WS_RY> E{ws};
          pg8::gemm_phase<pg8::EpiPlain<WS_RY>, decltype(S), true, 0x7c>(F.lds, F.tid, S, E); } } break;
#else
        { pg8::DenseSched<256, WS_SH, WS_W + WO_SD> S; S.init(ws, nr, D, 255 - F.bx); pg8::EpiPlain<WS_RY> E{ws};
          pg8::gemm_phase<pg8::EpiPlain<WS_RY>, decltype(S), true>(F.lds, F.tid, S, E); } } break;
#endif
    case 9: if (PON(9)) { build_toff(p, F, l, toff);
#if GED_FP8
        pg8::ExpSched<128, 0, 4, WS_HM, WS_W + WO_ED, (size_t)D * 256> S; S.ws = ws; S.lds = F.lds; S.U = toff[64] * 4; S.c = F.bx; S.brow0 = 0; S.Krt = 128;
        pg8::EpiED E{ws, F.lds};
        pg8::gemm_phase<pg8::EpiED, decltype(S), true, 0x7c>(F.lds, F.tid, S, E); } break;
#else
        pg8::ExpSched<256, 0, 4, WS_HM, WS_W + WO_ED, (size_t)D * 256 * 2> S; S.ws = ws; S.lds = F.lds; S.U = toff[64] * 4; S.c = F.bx; S.brow0 = 0; S.Krt = 256;
        pg8::EpiED E{ws, F.lds};
        pg8::gemm_phase<pg8::EpiED, decltype(S), true>(F.lds, F.tid, S, E); } break;
#endif
    }
}

__global__ void __launch_bounds__(NWAVES * 64, 2) mk_fwd(Args a) {
    extern __shared__ __attribute__((aligned(16))) unsigned char lds_raw[];
    Frame F; F.lds = (LAS unsigned char*)lds_raw; F.ldsg = lds_raw; F.tid = threadIdx.x; F.lane = F.tid & 63; F.wave = __builtin_amdgcn_readfirstlane(F.tid >> 6); F.G = gridDim.x; F.bx = blockIdx.x;
    volatile LAS unsigned* MISC = (volatile LAS unsigned*)(F.lds + MISC_OFF);
    for (int u = F.tid; u < (LDS_BYTES - MISC_OFF) / 4; u += NWAVES * 64) MISC[u] = 0u;
    store_params(F, a.p);
    __syncthreads();
    XcdBarrier bar; bar.bar = (GAS unsigned*)(a.p.ws + WS_CTL) + CW_BAR; bar.x = 0; bar.st = nullptr;
    const bool multi = a.ph_hi - a.ph_lo > 1;
    if (multi) bar = xcd_barrier_post((GAS unsigned*)(a.p.ws + WS_CTL) + CW_BAR, MISC);
#ifdef DELAYMASK
#define MK_PH(k_) if (a.ph_lo <= (k_) && (k_) < a.ph_hi) { const unsigned long long t0_ = __builtin_amdgcn_s_memrealtime(); run_phase<(k_)>(F); \
        { constexpr int kind = ((k_) == 0) ? 15 : ((k_) == PH_FINAL ? 0 : ((k_) - 1) % NPL); \
          if ((DELAYMASK >> kind) & 1) { __syncthreads(); const unsigned long long t1_ = __builtin_amdgcn_s_memrealtime(); while (__builtin_amdgcn_s_memrealtime() - t1_ < t1_ - t0_) __builtin_amdgcn_s_sleep(8); } } \
        if ((k_) + 1 < a.ph_hi) xcd_barrier(bar); }
#elif defined(PROBE_REGION)
#define MK_PH(k_) if (a.ph_lo <= (k_) && (k_) < a.ph_hi) { run_phase<(k_)>(F); \
        { __syncthreads(); const unsigned long long t1_ = __builtin_amdgcn_s_memrealtime(); const unsigned long long dt_ = MISC[16]; while (__builtin_amdgcn_s_memrealtime() - t1_ < dt_) __builtin_amdgcn_s_sleep(8); __syncthreads(); if (F.tid == 0) MISC[16] = 0u; } \
        if ((k_) + 1 < a.ph_hi) xcd_barrier(bar); }
#else
#define MK_PH(k_) if (a.ph_lo <= (k_) && (k_) < a.ph_hi) { run_phase<(k_)>(F); if ((k_) + 1 < a.ph_hi) xcd_barrier(bar); }
#endif
    MK_PH(0) MK_PH(1) MK_PH(2) MK_PH(3) MK_PH(4) MK_PH(5) MK_PH(6) MK_PH(7) MK_PH(8) MK_PH(9) MK_PH(10)
    MK_PH(11) MK_PH(12) MK_PH(13) MK_PH(14) MK_PH(15) MK_PH(16) MK_PH(17) MK_PH(18) MK_PH(19) MK_PH(20) MK_PH(21)
#undef MK_PH
}
#ifndef FAST
#define FAST 0x1ff
#endif
#if FAST != 0x1ff
constexpr size_t WS_NV1 = 538 * MiB;
constexpr size_t WS_NSG = 291 * MiB, WS_NFLS = 324 * MiB;
__global__ void __launch_bounds__(256) k_mod(Params p) {
    const int e = blockIdx.x * 256 + threadIdx.x, cond = blockIdx.y, l = blockIdx.z;
    const float* cv = cond < 4 ? p.c + cond * D : p.c_ctx;
    const float* w = p.w_mod + (size_t)l * D * 6 * D;
    float acc = p.b_mod[l * 6 * D + e];
    for (int d = 0; d < D; ++d) acc += siluf_(cv[d]) * w[(size_t)d * 6 * D + e];
    ((float*)(p.ws + WS_MOD))[(size_t)(l * 5 + cond) * 6 * D + e] = acc;
}
__global__ void __launch_bounds__(256) k_rowA(Params p, int l) { row_pass_A(p, l, (blockIdx.x * 256 + threadIdx.x) >> 6, (gridDim.x * 256) >> 6, threadIdx.x & 63); }
__global__ void __launch_bounds__(256) k_rowH(Params p, int l, int nrows) { row_pass_H(p, l, nrows, (blockIdx.x * 256 + threadIdx.x) >> 6, (gridDim.x * 256) >> 6, threadIdx.x & 63); }
struct ABf16 { const bf16_t* A; int lda, coff; DEV float operator()(int m, int k) const { return bf2f(A[(size_t)m * lda + coff + k]); } };
struct BF32 { const float* B; int ldb, pad; DEV float operator()(int k, int n) const { return B[(size_t)k * ldb + n]; } };
struct BAB { const float* Ba; const float* Bb; DEV float operator()(int k, int n) const { return k < 512 ? Ba[(size_t)k * D + n] : Bb[(size_t)(k - 512) * D + n]; } };
struct NEpiZ { bf16_t* Z; DEV void operator()(int m, int n, float v, float) const {
    float o; if (n < 1024) o = gelu_tanh(v); else if (n < 1536) o = v; else if (n < 2048) o = gelu_tanh(v); else o = sigmoidf_(v);
    Z[(size_t)m * 4096 + n] = f2bf(o); } };
struct NEpiF32 { float* C; int ldc, pad; DEV void operator()(int m, int n, float v, float) const { C[(size_t)m * ldc + n] = v; } };
struct NEpiBf { bf16_t* C; int ldc, pad; DEV void operator()(int m, int n, float v, float) const { C[(size_t)m * ldc + n] = f2bf(v); } };
struct NEpiMerge { const bf16_t* Z; bf16_t* M; DEV void operator()(int m, int n, float vb, float va) const {
    const float ga = bf2f(Z[(size_t)m * 4096 + 2048 + n]), gr = bf2f(Z[(size_t)m * 4096 + 3072 + n]);
    M[(size_t)m * D + n] = f2bf(ga * va + gr * vb); } };
struct NEpiSwi { const float* SG; bf16_t* SH; DEV void operator()(int m, int n, float v, float) const { SH[(size_t)m * 256 + n] = f2bf(siluf_(SG[(size_t)m * 256 + n]) * v); } };
template <class AL, class BL, class EP, int SPLIT>
__global__ void __launch_bounds__(256) k_gemm(AL al, BL bl, EP ep, int K) {
    __shared__ __attribute__((aligned(16))) float As[16][68];
    __shared__ __attribute__((aligned(16))) float Bs[16][68];
    const int tid = threadIdx.x, tx = tid & 15, ty = tid >> 4, m0 = blockIdx.y * 64, n0 = blockIdx.x * 64;
    float acc[4][4], acc2[4][4];
#pragma unroll
    for (int i = 0; i < 4; ++i)
#pragma unroll
        for (int j = 0; j < 4; ++j) { acc[i][j] = 0.f; acc2[i][j] = 0.f; }
    for (int k0 = 0; k0 < K; k0 += 16) {
        if (SPLIT && k0 == SPLIT) {
#pragma unroll
            for (int i = 0; i < 4; ++i)
#pragma unroll
                for (int j = 0; j < 4; ++j) { acc2[i][j] = acc[i][j]; acc[i][j] = 0.f; }
        }
#pragma unroll
        for (int i = 0; i < 4; ++i) { const int e = tid + 256 * i, kk = e & 15, mm = e >> 4; As[kk][mm] = al(m0 + mm, k0 + kk); }
#pragma unroll
        for (int i = 0; i < 4; ++i) { const int e = tid + 256 * i, nn = e & 63, kk = e >> 6; Bs[kk][nn] = bl(k0 + kk, n0 + nn); }
        __syncthreads();
#pragma unroll
        for (int kk = 0; kk < 16; ++kk) {
            const float4 a = *(const float4*)&As[kk][ty * 4]; const float4 b = *(const float4*)&Bs[kk][tx * 4];
            const float av[4] = {a.x, a.y, a.z, a.w}, bv[4] = {b.x, b.y, b.z, b.w};
#pragma unroll
            for (int i = 0; i < 4; ++i)
#pragma unroll
                for (int j = 0; j < 4; ++j) acc[i][j] += av[i] * bv[j];
        }
        __syncthreads();
    }
#pragma unroll
    for (int i = 0; i < 4; ++i)
#pragma unroll
        for (int j = 0; j < 4; ++j) ep(m0 + ty * 4 + i, n0 + tx * 4 + j, acc[i][j], acc2[i][j]);
}
__global__ void __launch_bounds__(256) k_conv(Params p, int l) {
    const size_t idx = (size_t)blockIdx.x * 256 + threadIdx.x; const int r = (int)(idx >> 9), ch = (int)(idx & 511);
    const bf16_t* Z = (const bf16_t*)(p.ws + WS_Z); float* XCONV = (float*)(p.ws + WS_NV1);
    int t, n; if (r < TL) { t = r & (SEQ - 1); n = SEQ; } else { t = (r - TL) & (CTXL - 1); n = CTXL; }
    const int base = r - t;
    float y = p.conv_b[l * 512 + ch];
#pragma unroll
    for (int k = 0; k < 4; ++k) { const int tt = t + k - 2; if (tt >= 0 && tt < n) y += p.conv_w[(l * 4 + k) * 512 + ch] * bf2f(Z[(size_t)(base + tt) * 4096 + 1024 + ch]); }
    XCONV[(size_t)r * 512 + ch] = y;
}
__global__ void __launch_bounds__(64) k_scan(Params p, int l, int dir) {
    const int b = blockIdx.x >> 3, h = blockIdx.x & 7, j = threadIdx.x, ch = h * 64 + j;
    const float* XCONV = (const float*)(p.ws + WS_NV1); float* HS = (float*)(p.ws + WS_RA);
    const float* wa = p.lru_wa + (size_t)((l * 2 + dir) * 8 + h) * 4096; const float* wx = p.lru_wx + (size_t)((l * 2 + dir) * 8 + h) * 4096;
    float wac[64], wxc[64];
#pragma unroll
    for (int i = 0; i < 64; ++i) { wac[i] = wa[i * 64 + j]; wxc[i] = wx[i * 64 + j]; }
    const float ba = p.lru_ba[(l * 2 + dir) * 512 + ch], bx = p.lru_bx[(l * 2 + dir) * 512 + ch];
    const float sp = log1pf(expf(-p.lru_lam[(l * 2 + dir) * 512 + ch]));
    float hst = 0.f;
    for (int step = 0; step < CTXL + SEQ; ++step) {
        int r;
        if (dir == 0) r = step < CTXL ? TL + b * CTXL + step : b * SEQ + (step - CTXL);
        else r = step < CTXL ? TL + b * CTXL + (CTXL - 1 - step) : b * SEQ + (SEQ - 1 - (step - CTXL));
        const float* xr = XCONV + (size_t)r * 512 + h * 64;
        float pr = ba, px = bx;
#pragma unroll
        for (int i = 0; i < 16; ++i) { const float4 xv = *(const float4*)(xr + 4 * i);
            pr += xv.x * wac[4 * i] + xv.y * wac[4 * i + 1] + xv.z * wac[4 * i + 2] + xv.w * wac[4 * i + 3];
            px += xv.x * wxc[4 * i] + xv.y * wxc[4 * i + 1] + xv.z * wxc[4 * i + 2] + xv.w * wxc[4 * i + 3]; }
        const float rg = sigmoidf_(pr), ig = sigmoidf_(px);
        const float log_a = -8.0f * rg * sp;
        const float a = expf(log_a), drv = sqrtf(-expm1f(2.0f * log_a)) * (ig * xr[j]);
        hst = a * hst + drv;
        if (dir == 0) HS[(size_t)r * 512 + ch] = hst; else HS[(size_t)r * 512 + ch] += hst;
    }
}
__global__ void __launch_bounds__(256) k_yb(Params p) {
    const size_t idx = (size_t)blockIdx.x * 256 + threadIdx.x; const int r = (int)(idx >> 9), ch = (int)(idx & 511);
    const bf16_t* Z = (const bf16_t*)(p.ws + WS_Z); const float* HS = (const float*)(p.ws + WS_RA); bf16_t* Y = (bf16_t*)(p.ws + WS_RY);
    Y[(size_t)r * D + 512 + ch] = f2bf(HS[(size_t)r * 512 + ch] * bf2f(Z[(size_t)r * 4096 + 1536 + ch]));
}
__global__ void __launch_bounds__(256) k_ln(Params p, int l, int nrows) {
    const int lane = threadIdx.x & 63, wave = (blockIdx.x * 256 + threadIdx.x) >> 6, nw = (gridDim.x * 256) >> 6;
    const bf16_t* Z = (const bf16_t*)(p.ws + WS_Z); float* VN = (float*)(p.ws + WS_NV1);
    for (int r = wave; r < nrows; r += nw) {
        float v[8]; float s = 0.f;
#pragma unroll
        for (int i = 0; i < 8; ++i) { v[i] = bf2f(Z[(size_t)r * 4096 + 512 + i * 64 + lane]); s += v[i]; }
        const float mu = wave_sum(s) * (1.f / 512.f); float q = 0.f;
#pragma unroll
        for (int i = 0; i < 8; ++i) { v[i] -= mu; q += v[i] * v[i]; }
        const float rstd = rsqrtf(wave_sum(q) * (1.f / 512.f) + 1e-5f);
#pragma unroll
        for (int i = 0; i < 8; ++i) { const int cch = i * 64 + lane; VN[(size_t)r * 512 + cch] = v[i] * rstd * p.ln_g[l * 512 + cch] + p.ln_b[l * 512 + cch]; }
    }
}
__global__ void __launch_bounds__(256) k_mix(Params p, int l) {
    const size_t idx = (size_t)blockIdx.x * 256 + threadIdx.x; const int r = (int)(idx >> 9), ch = (int)(idx & 511), g = ch >> 6;
    const bf16_t* Z = (const bf16_t*)(p.ws + WS_Z); const float* VN = (const float*)(p.ws + WS_NV1); bf16_t* Y = (bf16_t*)(p.ws + WS_RY);
    const int base = r & ~127, pp = r & 127;
    const float* w = p.gws + ((size_t)(l * 8 + g) * 128 + pp) * 128;
    float acc = p.gbs[(l * 8 + g) * 128 + pp];
    for (int q = 0; q < 128; ++q) acc += w[q] * VN[(size_t)(base + q) * 512 + ch];
    Y[(size_t)r * D + ch] = f2bf(bf2f(Z[(size_t)r * 4096 + ch]) * acc);
}
__global__ void __launch_bounds__(256) k_route(Params p, int l, int nrows) {
    const int lane = threadIdx.x & 63, wave = (blockIdx.x * 256 + threadIdx.x) >> 6, nw = (gridDim.x * 256) >> 6;
    int* TOPI = (int*)(p.ws + WS_TOPI); float* TOPW = (float*)(p.ws + WS_TOPW);
    for (int r = wave; r < nrows; r += nw) { int myi; float myw; route_token(p, l, ((const float*)(p.ws + WS_LOG))[(size_t)r * 64 + lane], lane, myi, myw);
        if (lane < 8) { TOPI[(size_t)r * 8 + lane] = myi; TOPW[(size_t)r * 8 + lane] = myw; } }
}
__global__ void __launch_bounds__(256) k_routed(Params p, int l) {
    __shared__ float hs[D]; __shared__ float hm[256];
    const int r = blockIdx.x, tid = threadIdx.x;
    const bf16_t* H2 = (const bf16_t*)(p.ws + WS_RA); const int* TOPI = (const int*)(p.ws + WS_TOPI); const float* TOPW = (const float*)(p.ws + WS_TOPW);
    const float* FLs = (const float*)(p.ws + WS_NFLS); bf16_t* FL = (bf16_t*)(p.ws + WS_RY);
#pragma unroll
    for (int i = 0; i < 4; ++i) hs[tid + 256 * i] = bf2f(H2[(size_t)r * D + tid + 256 * i]);
    float acc[4] = {0.f, 0.f, 0.f, 0.f};
    __syncthreads();
    for (int s = 0; s < 8; ++s) {
        const int e = TOPI[(size_t)r * 8 + s]; const float w = TOPW[(size_t)r * 8 + s];
        const float* wg = p.e_g + ((size_t)(l * NE + e) * D) * 256; const float* wu = p.e_u + ((size_t)(l * NE + e) * D) * 256;
        float g = 0.f, u = 0.f;
        for (int k = 0; k < D; ++k) { const float hv = hs[k]; g += hv * wg[(size_t)k * 256 + tid]; u += hv * wu[(size_t)k * 256 + tid]; }
        hm[tid] = siluf_(g) * u;
        __syncthreads();
        const float* wd = p.e_d + ((size_t)(l * NE + e) * 256) * D;
        float o[4] = {0.f, 0.f, 0.f, 0.f};
        for (int j = 0; j < 256; ++j) { const float hv = hm[j];
#pragma unroll
            for (int i = 0; i < 4; ++i) o[i] += hv * wd[(size_t)j * D + tid + 256 * i]; }
#pragma unroll
        for (int i = 0; i < 4; ++i) acc[i] += w * o[i];
        __syncthreads();
    }
#pragma unroll
    for (int i = 0; i < 4; ++i) FL[(size_t)r * D + tid + 256 * i] = f2bf(FLs[(size_t)r * D + tid + 256 * i] + acc[i]);
}
template <int SPLIT, class AL, class BL, class EP>
static void ngemm(hipStream_t st, int M, int N, int K, AL al, BL bl, EP ep) { hipLaunchKernelGGL((k_gemm<AL, BL, EP, SPLIT>), dim3(N / 64, M / 64), dim3(256), 0, st, al, bl, ep, K); }
#endif

static void mk(hipStream_t st, const Params& p, int lo, int hi) { Args a{}; a.p = p; a.ph_lo = lo; a.ph_hi = hi; hipLaunchKernelGGL(mk_fwd, dim3(256), dim3(NWAVES * 64), LDS_BYTES, st, a); }

extern "C" void kernel_launch(void* const* d_in, const int* in_sizes, int n_in, void* d_out, int out_size, void* d_ws, size_t ws_size, hipStream_t stream) {
    static int ready = 0;
    if (ready == 0) {
        ready = -1;
        if (n_in != 33 || ws_size < WS_END || out_size != TL * D) return;
        int dev = 0, cus = 0;
        if (hipGetDevice(&dev) != hipSuccess || hipDeviceGetAttribute(&cus, hipDeviceAttributeMultiprocessorCount, dev) != hipSuccess || cus < 256) return;
        if (hipFuncSetAttribute((const void*)mk_fwd, hipFuncAttributeMaxDynamicSharedMemorySize, LDS_BYTES) != hipSuccess) return;
        ready = 1;
    }
    if (ready < 0) return;
    Params p{};
    const float** pp = (const float**)&p;
    for (int i = 0; i < 33; ++i) pp[i] = (const float*)d_in[i];
    p.out = (float*)d_out; p.ws = (unsigned char*)d_ws;
    (void)hipMemsetAsync((char*)d_ws + WS_CTL, 0, 1 * MiB, stream);
#if FAST == 0x1ff && !defined(MK_PER_PHASE)
    mk(stream, p, 0, PH_END);
#elif FAST == 0x1ff
    for (int ph = 0; ph < PH_END; ++ph) mk(stream, p, ph, ph + 1);
#else
    unsigned char* ws = p.ws;
    bf16_t* RA = (bf16_t*)(ws + WS_RA); bf16_t* Z = (bf16_t*)(ws + WS_Z); bf16_t* RY = (bf16_t*)(ws + WS_RY);
    float* LOG = (float*)(ws + WS_LOG); float* SG = (float*)(ws + WS_NSG); bf16_t* SH = (bf16_t*)(ws + WS_SH); float* FLs = (float*)(ws + WS_NFLS);
    mk(stream, p, 0, 1);
    if (!(FAST & 1)) hipLaunchKernelGGL(k_mod, dim3(24, 5, 2), dim3(256), 0, stream, p);
    for (int l = 0; l < 2; ++l) {
        const int nr = (l == 0) ? R : TL, b0 = 1 + l * NPL;
        if (FAST & 2) mk(stream, p, b0 + 0, b0 + 1); else { if (l > 0) mk(stream, p, 100 + l, 101 + l); hipLaunchKernelGGL(k_rowA, dim3(2048), dim3(256), 0, stream, p, l); }
        if (FAST & 4) mk(stream, p, b0 + 1, b0 + 2); else ngemm<0>(stream, R, 4096, D, ABf16{RA, D, 0}, BF32{p.w_in + (size_t)l * D * 4096, 4096, 0}, NEpiZ{Z});
        if (FAST & 8) { mk(stream, p, b0 + 2, b0 + 3); mk(stream, p, b0 + 3, b0 + 4); }
        else {
            hipLaunchKernelGGL(k_conv, dim3(R * 512 / 256), dim3(256), 0, stream, p, l);
            for (int dir = 0; dir < 2; ++dir) hipLaunchKernelGGL(k_scan, dim3(NBATCH * 8), dim3(64), 0, stream, p, l, dir);
            hipLaunchKernelGGL(k_yb, dim3(nr * 512 / 256), dim3(256), 0, stream, p);
            hipLaunchKernelGGL(k_ln, dim3(2048), dim3(256), 0, stream, p, l, nr);
            hipLaunchKernelGGL(k_mix, dim3(nr * 512 / 256), dim3(256), 0, stream, p, l);
        }
        if (FAST & 16) mk(stream, p, b0 + 4, b0 + 5); else ngemm<512>(stream, nr, D, D, ABf16{RY, D, 0}, BAB{p.w_out_a + (size_t)l * 512 * D, p.w_out_b + (size_t)l * 512 * D}, NEpiMerge{Z, RA});
        if (FAST & 32) mk(stream, p, b0 + 5, b0 + 6); else ngemm<0>(stream, nr, D, D, ABf16{RA, D, 0}, BF32{p.w_out + (size_t)l * D * D, D, 0}, NEpiBf{Z, D, 0});
        if (FAST & 64) mk(stream, p, b0 + 6, b0 + 7); else hipLaunchKernelGGL(k_rowH, dim3(2048), dim3(256), 0, stream, p, l, nr);
        if (FAST & 128) { mk(stream, p, b0 + 7, b0 + 8); mk(stream, p, b0 + 8, b0 + 9); }
        else {
            ngemm<0>(stream, nr, 64, D, ABf16{RA, D, 0}, BF32{p.router_w + (size_t)l * D * 64, 64, 0}, NEpiF32{LOG, 64, 0});
            hipLaunchKernelGGL(k_route, dim3(2048), dim3(256), 0, stream, p, l, nr);
            ngemm<0>(stream, nr, 256, D, ABf16{RA, D, 0}, BF32{p.s_g + (size_t)l * D * 256, 256, 0}, NEpiF32{SG, 256, 0});
            ngemm<0>(stream, nr, 256, D, ABf16{RA, D, 0}, BF32{p.s_u + (size_t)l * D * 256, 256, 0}, NEpiSwi{SG, SH});
        }
        if (FAST & 256) { for (int k = 9; k < NPL; ++k) mk(stream, p, b0 + k, b0 + k + 1); }
        else {
            ngemm<0>(stream, nr, D, 256, ABf16{SH, 256, 0}, BF32{p.s_d + (size_t)l * 256 * D, D, 0}, NEpiF32{FLs, D, 0});
            hipLaunchKernelGGL(k_routed, dim3(nr), dim3(256), 0, stream, p, l);
        }
    }
    if (FAST & 2) mk(stream, p, PH_FINAL, PH_END); else hipLaunchKernelGGL(k_rowA, dim3(2048), dim3(256), 0, stream, p, 2);
#endif
}
```

```cpp
#include <hip/hip_runtime.h>
#include <stdint.h>
#include <math.h>

#ifndef GIN_FP8
#define GIN_FP8 1
#endif
#ifndef GED_FP8
#define GED_FP8 1
#endif
#ifndef GSD_FP8
#define GSD_FP8 0
#endif
typedef unsigned short bf16_t;
#define DEV __device__ __forceinline__
#define LAS __attribute__((address_space(3)))
#define GAS __attribute__((address_space(1)))
typedef short bf16x8 __attribute__((ext_vector_type(8)));
typedef float f32x4 __attribute__((ext_vector_type(4)));
typedef unsigned u32x4 __attribute__((ext_vector_type(4)));
typedef unsigned u32x2 __attribute__((ext_vector_type(2)));

constexpr int D = 1024, NBATCH = 4, SEQ = 8192, CTXL = 256;
constexpr int TL = NBATCH * SEQ, TC = NBATCH * CTXL, R = TL + TC;
constexpr int NE = 64, CAP = R;
constexpr int NCHUNK = R / 128;
constexpr size_t MiB = 1u << 20;
constexpr size_t WS_CTL = 0;
constexpr size_t WS_PE = 1 * MiB + 512 * 1024  ;
constexpr size_t WS_MOD = 1 * MiB, WS_H8 = 2 * MiB  , WS_LISTA = 6 * MiB  , WS_LISTW = 15 * MiB  , WS_SUMM = 24 * MiB, WS_LOG = 27 * MiB;
constexpr size_t WS_TOPI = WS_LOG, WS_TOPW = WS_LOG;
constexpr size_t WS_W = 36 * MiB;
constexpr size_t WS_XC = 84 * MiB;
constexpr size_t WS_RY = 148 * MiB;
constexpr size_t WS_Z = 214 * MiB;
constexpr size_t WS_HM = 214 * MiB;
constexpr size_t WS_SH = 354 * MiB;
constexpr size_t WS_SLOTS = 354 * MiB;
constexpr size_t WS_RA = 478 * MiB;
constexpr size_t WS_LR = 478 * MiB;
constexpr size_t WS_XCT = 478 * MiB;
constexpr size_t WS_H2E = 544 * MiB;
constexpr size_t WS_END = 618 * MiB;
constexpr size_t WO_IN = 0, WO_AB = 8 * MiB, WO_OUT = 10 * MiB, WO_SR = 12 * MiB  , WO_SD = 14 * MiB  , WO_LRU = 15 * MiB  ,
                 WO_GWS = 15 * MiB + MiB / 2  , WO_EG = 16 * MiB  , WO_ED = 80 * MiB  ;
constexpr int CW_CNT = 64;
constexpr int CW_BAR = 4096;

struct Params {
    const float *x, *c, *ctx, *c_ctx, *w_mod, *b_mod, *g_pre_mix, *g_post_mix, *g_pre_ffn, *g_post_ffn, *w_in, *ln_g, *ln_b, *gws, *gbs,
        *conv_w, *conv_b, *lru_wa, *lru_ba, *lru_wx, *lru_bx, *lru_lam, *w_out_a, *w_out_b, *w_out, *router_w, *router_b, *e_g, *e_u, *e_d, *s_g, *s_u, *s_d;
    float* out; unsigned char* ws;
};

DEV float bf2f(bf16_t v) { return __uint_as_float(((unsigned)v) << 16); }
DEV bf16_t f2bf(float f) { unsigned u = __float_as_uint(f); return (bf16_t)((u + 0x7fffu + ((u >> 16) & 1u)) >> 16); }
DEV unsigned pk2(float lo, float hi) { return (unsigned)f2bf(lo) | ((unsigned)f2bf(hi) << 16); }
DEV float sigmoidf_(float x) { return 1.f / (1.f + expf(-x)); }
DEV float siluf_(float x) { return x / (1.f + expf(-x)); }
DEV float gelu_tanh(float x) { return 0.5f * x * (1.f + tanhf(0.7978845608028654f * (x + 0.044715f * x * x * x))); }
DEV float fsigmoid(float x) { return __builtin_amdgcn_rcpf(1.f + __builtin_amdgcn_exp2f(-1.4426950408889634f * x)); }
DEV float fsilu(float x) { return x * fsigmoid(x); }
DEV float fgelu(float x) { const float u = 1.5957691216057308f * (x + 0.044715f * x * x * x); return x * fsigmoid(u); }
DEV float wave_sum(float v) {
#pragma unroll
    for (int o = 1; o < 64; o <<= 1) v += __shfl_xor(v, o);
    return v;
}
DEV const float* mod_ptr(const Params& p, int l, int cond, int j) { return (const float*)(p.ws + WS_MOD) + ((size_t)((l * 5 + cond) * 6 + j)) * D; }
DEV float* xl_row(const Params& p, int r) { return r < TL ? p.out + (size_t)r * D : (float*)(p.ws + WS_XC) + (size_t)(r - TL) * D; }
namespace pg8 {
constexpr int BM = 256, BK = 64, HALF = 128, HTB = HALF * BK * 2  , STAGE_BYTES = 8 * HTB;
DEV int lds_byte(int r, int c) { const int st = (r >> 4) * 2 + (c >> 5), rr = r & 15, cc = c & 31, ob = rr * 64 + cc * 2; return st * 1024 + (ob ^ (((ob >> 9) & 1) << 5)); }
DEV void stage_rc(int b, int& Rr, int& C) { const int st = b / 1024, sb = b % 1024, swz = sb ^ (((sb >> 9) & 1) << 5); Rr = (st >> 1) * 16 + swz / 64; C = (st & 1) * 32 + (swz % 64) / 2; }
DEV int perm32(int rho) { const int n = rho >> 4, i = rho & 15; return 8 * (i >> 2) + 4 * n + (i & 3); }
DEV unsigned cvt_pk_bf16(float lo, float hi) { unsigned r; asm volatile("v_cvt_pk_bf16_f32 %0, %1, %2" : "=v"(r) : "v"(lo), "v"(hi)); return r; }
DEV u32x4 pack8(const f32x4 v0, const f32x4 v1) { u32x4 w; w.x = cvt_pk_bf16(v0[0], v0[1]); w.y = cvt_pk_bf16(v0[2], v0[3]); w.z = cvt_pk_bf16(v1[0], v1[1]); w.w = cvt_pk_bf16(v1[2], v1[3]); return w; }
DEV void unpack8(const u32x4 w, f32x4& v0, f32x4& v1) {
    v0[0] = __uint_as_float(w.x << 16); v0[1] = __uint_as_float(w.x & 0xffff0000u); v0[2] = __uint_as_float(w.y << 16); v0[3] = __uint_as_float(w.y & 0xffff0000u);
    v1[0] = __uint_as_float(w.z << 16); v1[1] = __uint_as_float(w.z & 0xffff0000u); v1[2] = __uint_as_float(w.w << 16); v1[3] = __uint_as_float(w.w & 0xffff0000u);
}
DEV int xcd_remap(int L, int U) { const int q = U / 8, r = U % 8, xcd = L % 8, off = L / 8; return (xcd < r ? xcd * (q + 1) : r * (q + 1) + (xcd - r) * q) + off; }

struct UnitD { int pm, pn; };
template <int K, size_t AOFF, size_t BOFF> struct DenseSched {
    typedef UnitD Unit; static constexpr int KK = K;
    const unsigned char* ws; int nM, nN, nwg, c, Krt; static constexpr int G = 256;
    DEV void init(const unsigned char* ws_, int M, int N, int c_) { ws = ws_; nM = M / BM; nN = N / BM; nwg = nM * nN; c = c_; Krt = K; asm volatile("" : "+s"(Krt)); }
    DEV bool next(int i, Unit& u) const {
        const int L = i * G + c; if (L >= nwg) return false;
        const int wgid = xcd_remap(L, nwg);
        const int nig = 8 * nN, gid = wgid / nig, fm = gid * 8, gsz = (nM - fm) < 8 ? (nM - fm) : 8;
        u.pm = fm + ((wgid % nig) % gsz); u.pn = (wgid % nig) / gsz; return true;
    }
    DEV const char* abase(const Unit& u) const { return (const char*)ws + AOFF + (size_t)u.pm * BM * K * 2; }
    DEV const char* bbase(const Unit& u) const { return (const char*)ws + BOFF + (size_t)u.pn * BM * K * 2; }
    DEV void prefetch(const Unit&, LAS unsigned char*, int, int) const {}
    DEV void aoffs(const Unit&, int tid, unsigned (&v)[2][2], LAS unsigned char*, int, bool) const {
#pragma unroll
        for (int i = 0; i < 2; ++i) { int Rr, C; stage_rc(tid * 16 + i * 8192, Rr, C);
#pragma unroll
            for (int h = 0; h < 2; ++h) v[h][i] = (unsigned)((h * HALF + Rr) * K + C) * 2u; }
    }
};
struct UnitE { int e, row0, cnt, hmrow0, pn; };
template <int K, int GATHER, int NCOL, size_t AOFF, size_t BOFF, size_t BSTRIDE> struct ExpSched {
    typedef UnitE Unit; static constexpr int KK = K;
    const unsigned char* ws; LAS unsigned char* lds;
    int U, c, brow0, Krt; static constexpr int ncol = NCOL, gather = GATHER, G = 256;
    DEV bool next(int i, Unit& u) const {
        const int L = i * G + c; if (L >= U) return false;
        const int id = xcd_remap(L, U), tile = id / ncol; u.pn = id % ncol;
        const LAS int* toff = (const LAS int*)(lds + 131072 + 256);
        const int e = (int)((const LAS unsigned char*)(lds + 131072 + 2048))[tile];
        u.e = e; u.row0 = (tile - toff[e]) * BM; u.cnt = toff[80 + e]; u.hmrow0 = tile * BM; return true;
    }
    DEV const char* abase(const Unit& u) const { return gather ? (const char*)ws + AOFF : (const char*)ws + AOFF + (size_t)u.hmrow0 * K * 2; }
    DEV const char* bbase(const Unit& u) const { return (const char*)ws + BOFF + (size_t)u.e * BSTRIDE + (size_t)(brow0 + u.pn * BM) * K * 2; }
    DEV void prefetch(const Unit& u, LAS unsigned char* lds_, int wid, int lane) const {
        if (gather) __builtin_amdgcn_global_load_lds((const unsigned*)(ws + WS_LISTA) + (size_t)u.e * CAP + u.row0 + lane * 4, (LAS unsigned*)(lds_ + 131072 + 2048 + wid * 3712 + 2048), 16, 0, 0);
    }
    DEV void aoffs(const Unit& u, int tid, unsigned (&v)[2][2], LAS unsigned char* lds_, int wid, bool from_lds) const {
        asm volatile("" : "+v"(tid));
        const int* lista = (const int*)(ws + WS_LISTA);
        const LAS int* sp = (const LAS int*)(lds_ + 131072 + 2048 + wid * 3712 + 2048);
#pragma unroll
        for (int i = 0; i < 2; ++i) { int Rr, C; stage_rc(tid * 16 + i * 8192, Rr, C);
#pragma unroll
            for (int h = 0; h < 2; ++h) {
                const int lr = h * HALF + Rr;
                if (gather) { const int rr = u.row0 + lr; const int aid = from_lds ? sp[lr] : ((rr < u.cnt) ? lista[(size_t)u.e * CAP + rr] : 0);
                    const int tok = (rr < u.cnt) ? (aid >> 3) : 0; v[h][i] = (unsigned)(tok * K + C) * 2u; }
                else v[h][i] = (unsigned)(lr * K + C) * 2u;
            } }
    }
};

typedef f32x4 Acc[2][2][4][2];
#define EPI_ROWS(ai, m) for (int ai = 0; ai < 2; ++ai) _Pragma("unroll") for (int m = 0; m < 4; ++m)

struct EpiZ {
    static constexpr int PID = 10; static constexpr bool HAS_MID = false; static constexpr int MID_T = 0;
    unsigned char* ws;
    DEV void mid(Acc&, const UnitD&, int, int, int, int) const {}
    DEV void unit_begin(const UnitD&, LAS unsigned char*, int, int) const {}
    DEV void operator()(const Acc& acc, const UnitD& u, int wr, int wc, int fr, int fq) const {
        bf16_t* Z = (bf16_t*)(ws + WS_Z);
        const int act = (u.pn < 4) ? 1 : (u.pn < 6 ? 0 : (u.pn < 8 ? 1 : 2));
        const int row0 = u.pm * BM + wr * 64 + fr, col0 = u.pn * BM + wc * 32 + 8 * fq;
#pragma unroll
        EPI_ROWS(ai, m) { bf16_t* rowp = Z + (size_t)(row0 + ai * HALF + m * 16) * 4096 + col0;
#pragma unroll
            for (int bj = 0; bj < 2; ++bj) { f32x4 v0 = acc[ai][bj][m][0], v1 = acc[ai][bj][m][1];
                if (act == 1) {
#pragma unroll
                    for (int i = 0; i < 4; ++i) { v0[i] = fgelu(v0[i]); v1[i] = fgelu(v1[i]); }
                } else if (act == 2) {
                    unsigned w0 = 0, w1 = 0;
#pragma unroll
                    for (int i = 0; i < 4; ++i) { w0 |= (unsigned)__builtin_rintf(fsigmoid(v0[i]) * 255.f) << (8 * i); w1 |= (unsigned)__builtin_rintf(fsigmoid(v1[i]) * 255.f) << (8 * i); }
                    *(u32x2*)((unsigned char*)(Z + (size_t)(row0 + ai * HALF + m * 16) * 4096) + 4096 + (col0 - 2048) + bj * HALF) = (u32x2){w0, w1};
                    continue;
                }
                *(u32x4*)(rowp + bj * HALF) = pack8(v0, v1); } }
    }
};
struct EpiAB {
    static constexpr int PID = 11; static constexpr bool HAS_MID = true; static constexpr int MID_T = 8;
    unsigned char* ws;
    DEV void unit_begin(const UnitD&, LAS unsigned char*, int, int) const {}
    DEV void mid(Acc& acc, const UnitD& u, int wr, int wc, int fr, int fq) const {
        const bf16_t* Z = (const bf16_t*)(ws + WS_Z);
        int oz = 0; asm volatile("" : "+v"(oz));
        const int row0 = u.pm * BM + wr * 64 + fr + oz, col0 = u.pn * BM + wc * 32 + 8 * fq;
#pragma unroll
        for (int ai = 0; ai < 2; ++ai) {
            u32x2 ga[4][2], gr[4][2];
#pragma unroll
            for (int m = 0; m < 4; ++m) { const unsigned char* zr = (const unsigned char*)(Z + (size_t)(row0 + ai * HALF + m * 16) * 4096) + 4096 + col0;
#pragma unroll
                for (int bj = 0; bj < 2; ++bj) { ga[m][bj] = *(const u32x2*)(zr + bj * HALF); gr[m][bj] = *(const u32x2*)(zr + 1024 + bj * HALF); } }
#pragma unroll
            for (int m = 0; m < 4; ++m)
#pragma unroll
                for (int bj = 0; bj < 2; ++bj) {
#pragma unroll
                    for (int i = 0; i < 4; ++i) {
                        const float a0 = (float)((ga[m][bj].x >> (8 * i)) & 255u), a1 = (float)((ga[m][bj].y >> (8 * i)) & 255u);
                        const float r0 = fmaxf((float)((gr[m][bj].x >> (8 * i)) & 255u), 0.5f), r1 = fmaxf((float)((gr[m][bj].y >> (8 * i)) & 255u), 0.5f);
                        acc[ai][bj][m][0][i] *= a0 * __builtin_amdgcn_rcpf(r0); acc[ai][bj][m][1][i] *= a1 * __builtin_amdgcn_rcpf(r1); } }
            asm volatile("" ::: "memory"); }
    }
    DEV void operator()(const Acc& acc, const UnitD& u, int wr, int wc, int fr, int fq) const {
        const bf16_t* Z = (const bf16_t*)(ws + WS_Z); bf16_t* M = (bf16_t*)(ws + WS_RA);
        const int row0 = u.pm * BM + wr * 64 + fr, col0 = u.pn * BM + wc * 32 + 8 * fq;
        u32x2 gr[2][4][2];
#pragma unroll
        EPI_ROWS(ai, m) { const unsigned char* zr = (const unsigned char*)(Z + (size_t)(row0 + ai * HALF + m * 16) * 4096) + 4096 + 1024 + col0;
#pragma unroll
            for (int bj = 0; bj < 2; ++bj) gr[ai][m][bj] = *(const u32x2*)(zr + bj * HALF); }
#pragma unroll
        EPI_ROWS(ai, m) { bf16_t* rowp = M + (size_t)(row0 + ai * HALF + m * 16) * D + col0;
#pragma unroll
            for (int bj = 0; bj < 2; ++bj) { f32x4 r0, r1;
#pragma unroll
                for (int i = 0; i < 4; ++i) { r0[i] = fmaxf((float)((gr[ai][m][bj].x >> (8 * i)) & 255u), 0.5f) * (1.f / 255.f); r1[i] = fmaxf((float)((gr[ai][m][bj].y >> (8 * i)) & 255u), 0.5f) * (1.f / 255.f); }
                *(u32x4*)(rowp + bj * HALF) = pack8(acc[ai][bj][m][0] * r0, acc[ai][bj][m][1] * r1); } }
    }
};
template <size_t COFF> struct EpiPlain {
    static constexpr int PID = 12; static constexpr bool HAS_MID = false; static constexpr int MID_T = 0;
    unsigned char* ws;
    DEV void mid(Acc&, const UnitD&, int, int, int, int) const {}
    DEV void unit_begin(const UnitD&, LAS unsigned char*, int, int) const {}
    DEV void operator()(const Acc& acc, const UnitD& u, int wr, int wc, int fr, int fq) const {
        bf16_t* C = (bf16_t*)(ws + COFF); constexpr int ldc = D;
        const int row0 = u.pm * BM + wr * 64 + fr, col0 = u.pn * BM + wc * 32 + 8 * fq;
#pragma unroll
        EPI_ROWS(ai, m) { bf16_t* rowp = C + (size_t)(row0 + ai * HALF + m * 16) * ldc + col0;
#pragma unroll
            for (int bj = 0; bj < 2; ++bj) *(u32x4*)(rowp + bj * HALF) = pack8(acc[ai][bj][m][0], acc[ai][bj][m][1]); }
    }
};
struct EpiSR {
    static constexpr int PID = 13; static constexpr bool HAS_MID = false; static constexpr int MID_T = 0;
    unsigned char* ws;
    DEV void mid(Acc&, const UnitD&, int, int, int, int) const {}
    DEV void unit_begin(const UnitD&, LAS unsigned char*, int, int) const {}
    DEV void operator()(const Acc& acc, const UnitD& u, int wr, int wc, int fr, int fq) const {
        float* LOG = (float*)(ws + WS_LOG); bf16_t* SH = (bf16_t*)(ws + WS_SH);
        const int row0 = u.pm * BM + wr * 64 + fr;
        if (u.pn == 0) {
            if (wc < 2) {
#pragma unroll
                EPI_ROWS(ai, m) { float* rowp = LOG + (size_t)(row0 + ai * HALF + m * 16) * 64 + wc * 32 + 8 * fq;
                    *(f32x4*)(rowp) = acc[ai][0][m][0]; *(f32x4*)(rowp + 4) = acc[ai][0][m][1]; }
            }
        } else {
            const int j0 = (u.pn - 1) * HALF + wc * 32 + 8 * fq;
#pragma unroll
            EPI_ROWS(ai, m) { f32x4 v0, v1;
#pragma unroll
                for (int i = 0; i < 4; ++i) { v0[i] = fsilu(acc[ai][0][m][0][i]) * acc[ai][1][m][0][i]; v1[i] = fsilu(acc[ai][0][m][1][i]) * acc[ai][1][m][1][i]; }
#if GSD_FP8
                { u32x2 o; unsigned t = 0;
#pragma unroll
                  for (int i = 0; i < 4; ++i) { v0[i] = __builtin_amdgcn_fmed3f(v0[i] * 8.f, -440.f, 440.f); v1[i] = __builtin_amdgcn_fmed3f(v1[i] * 8.f, -440.f, 440.f); }
                  t = __builtin_amdgcn_cvt_pk_fp8_f32(v0[0], v0[1], t, false); t = __builtin_amdgcn_cvt_pk_fp8_f32(v0[2], v0[3], t, true); o.x = t;
                  t = __builtin_amdgcn_cvt_pk_fp8_f32(v1[0], v1[1], t, false); t = __builtin_amdgcn_cvt_pk_fp8_f32(v1[2], v1[3], t, true); o.y = t;
                  *(u32x2*)((unsigned char*)SH + (size_t)(row0 + ai * HALF + m * 16) * 256 + j0) = o; }
#else
                *(u32x4*)(SH + (size_t)(row0 + ai * HALF + m * 16) * 256 + j0) = pack8(v0, v1);
#endif
            }
        }
    }
};
template <int FP8S> struct EpiEG {
    static constexpr int PID = 14; static constexpr bool HAS_MID = false; static constexpr int MID_T = 0;
    unsigned char* ws;
    DEV void mid(Acc&, const UnitE&, int, int, int, int) const {}
    DEV void unit_begin(const UnitE&, LAS unsigned char*, int, int) const {}
    DEV void operator()(const Acc& acc, const UnitE& u, int wr, int wc, int fr, int fq) const {
        bf16_t* HM = (bf16_t*)(ws + WS_HM);
        const int j0 = u.pn * HALF + wc * 32 + 8 * fq;
#pragma unroll
        EPI_ROWS(ai, m) { f32x4 v0, v1;
#pragma unroll
            for (int i = 0; i < 4; ++i) { constexpr float sc = FP8S ? (1.f / 1024.f) : 1.f; v0[i] = fsilu(acc[ai][0][m][0][i] * sc) * (acc[ai][1][m][0][i] * sc); v1[i] = fsilu(acc[ai][0][m][1][i] * sc) * (acc[ai][1][m][1][i] * sc); }
#if GED_FP8
            { u32x2 o; unsigned t = 0;
#pragma unroll
              for (int i = 0; i < 4; ++i) { v0[i] = __builtin_amdgcn_fmed3f(v0[i] * 8.f, -440.f, 440.f); v1[i] = __builtin_amdgcn_fmed3f(v1[i] * 8.f, -440.f, 440.f); }
              t = __builtin_amdgcn_cvt_pk_fp8_f32(v0[0], v0[1], t, false); t = __builtin_amdgcn_cvt_pk_fp8_f32(v0[2], v0[3], t, true); o.x = t;
              t = __builtin_amdgcn_cvt_pk_fp8_f32(v1[0], v1[1], t, false); t = __builtin_amdgcn_cvt_pk_fp8_f32(v1[2], v1[3], t, true); o.y = t;
              *(u32x2*)((unsigned char*)HM + (size_t)(u.hmrow0 + ai * HALF + wr * 64 + m * 16 + fr) * 256 + j0) = o; }
#else
            *(u32x4*)(HM + (size_t)(u.hmrow0 + ai * HALF + wr * 64 + m * 16 + fr) * 256 + j0) = pack8(v0, v1);
#endif
        }
    }
};
struct EpiED {
    static constexpr int PID = 15; static constexpr bool HAS_MID = false; static constexpr int MID_T = 0;
    unsigned char* ws;
    DEV void mid(Acc&, const UnitE&, int, int, int, int) const {}
    DEV void unit_begin(const UnitE& u, LAS unsigned char* lds, int wid, int lane) const {
        const int wr = wid >> 2; LAS unsigned char* sp = lds + 131072 + 2048 + wid * 3712 + 2048;
#pragma unroll
        for (int ai = 0; ai < 2; ++ai) { const size_t idx = (size_t)u.e * CAP + u.row0 + ai * HALF + wr * 64 + lane;
            __builtin_amdgcn_global_load_lds((const unsigned*)(ws + WS_LISTA) + idx, (LAS unsigned*)(sp + ai * 256), 4, 0, 0);
            __builtin_amdgcn_global_load_lds((const unsigned*)(ws + WS_LISTW) + idx, (LAS unsigned*)(sp + 512 + ai * 256), 4, 0, 0); }
    }
    DEV void operator()(const Acc& acc, const UnitE& u, int wr, int wc, int fr, int fq) const {
        unsigned char* SLOTS = ws + WS_SLOTS;
        const LAS unsigned* sp = (const LAS unsigned*)(lds_ + 131072 + 2048 + (wr * 4 + wc) * 3712 + 2048);
        const int col0 = u.pn * BM + wc * 32 + 8 * fq;
#pragma unroll
        EPI_ROWS(ai, m) { const int rr = u.row0 + ai * HALF + wr * 64 + m * 16 + fr;
            const int aid = (int)sp[ai * 64 + m * 16 + fr]; const float w = __uint_as_float(sp[128 + ai * 64 + m * 16 + fr]) * 16.0f;
            if (rr < u.cnt) { unsigned char* rowp = SLOTS + (size_t)aid * 1024 + col0;
#pragma unroll
                for (int bj = 0; bj < 2; ++bj) { f32x4 v0 = acc[ai][bj][m][0] * w, v1 = acc[ai][bj][m][1] * w; u32x2 o; unsigned t = 0;
#pragma unroll
                    for (int i = 0; i < 4; ++i) { v0[i] = __builtin_amdgcn_fmed3f(v0[i], -440.f, 440.f); v1[i] = __builtin_amdgcn_fmed3f(v1[i], -440.f, 440.f); }
                    t = __builtin_amdgcn_cvt_pk_fp8_f32(v0[0], v0[1], t, false); t = __builtin_amdgcn_cvt_pk_fp8_f32(v0[2], v0[3], t, true); o.x = t;
                    t = __builtin_amdgcn_cvt_pk_fp8_f32(v1[0], v1[1], t, false); t = __builtin_amdgcn_cvt_pk_fp8_f32(v1[2], v1[3], t, true); o.y = t;
                    *(u32x2*)(rowp + bj * HALF) = o; } } }
    }
    LAS unsigned char* lds_;
};

template <class Epi, class Sched, bool ALIGN_EPI, int FP8 = 0>
DEV void gemm_phase(LAS unsigned char* lds, const int tid, const Sched& S, const Epi& E) {
    typedef typename Sched::Unit Unit;
    const int wid = __builtin_amdgcn_readfirstlane(tid >> 6), lane = tid & 63, wr = wid >> 2, wc = wid & 3, fr = lane & 15, fq = lane >> 4;
    const int K = S.Krt, nt = K / BK;
    unsigned voffB[2];
#pragma unroll
    for (int i = 0; i < 2; ++i) { int Rr, C; stage_rc(tid * 16 + i * 8192, Rr, C); const int Rb = (Rr & ~31) + perm32(Rr & 31); voffB[i] = (unsigned)(Rb * K + C) * 2u; }
    const size_t kstep = (size_t)(BK * 2);
    const size_t hstepB = (size_t)HALF * K * 2;
    const unsigned ldsw = (unsigned)wid * 1024u;
    const int aoff = lds_byte(wr * 64 + fr, fq * 8), boff = lds_byte(wc * 32 + fr, fq * 8);
#define PG8_SA(b, h) (((b) * 2 + (h)) * HTB)
#define PG8_SB(b, h) ((4 + (b) * 2 + (h)) * HTB)
#define PG8_STAGE2(bufoff, gbase, o0, o1) do { unsigned o0_ = (o0), o1_ = (o1); asm volatile("" : "+v"(o0_), "+v"(o1_));     \
        __builtin_amdgcn_global_load_lds((const unsigned*)((const char*)(gbase) + o0_), (LAS unsigned*)(lds + (bufoff) + ldsw), 16, 0, 0); \
        __builtin_amdgcn_global_load_lds((const unsigned*)((const char*)(gbase) + o1_), (LAS unsigned*)(lds + (bufoff) + ldsw + 8192), 16, 0, 0); } while (0)
#define PG8_STAGEB(bufoff, gbase) PG8_STAGE2(bufoff, gbase, voffB[0], voffB[1])
#define PG8_LDA(dst, b, h) do { _Pragma("unroll") for (int m = 0; m < 4; ++m) _Pragma("unroll") for (int k = 0; k < 2; ++k) dst[m][k] = *(const LAS bf16x8*)(lds + PG8_SA(b, h) + aoff + m * 2048 + k * 1024); } while (0)
#define PG8_LDB(dst, b, h) do { _Pragma("unroll") for (int n = 0; n < 2; ++n) _Pragma("unroll") for (int k = 0; k < 2; ++k) dst[n][k] = *(const LAS bf16x8*)(lds + PG8_SB(b, h) + boff + n * 2048 + k * 1024); } while (0)
#define PG8_MMA(ai, bj, At, Bt) do { __builtin_amdgcn_s_setprio(1); _Pragma("unroll") for (int m = 0; m < 4; ++m) _Pragma("unroll") for (int n = 0; n < 2; ++n) _Pragma("unroll") for (int k = 0; k < 2; ++k) \
        acc[ai][bj][m][n] = __builtin_amdgcn_mfma_f32_16x16x32_bf16(Bt[n][k], At[m][k], acc[ai][bj][m][n], 0, 0, 0); __builtin_amdgcn_s_setprio(0); } while (0)
typedef int i32x8_t __attribute__((ext_vector_type(8)));
struct Frag2 { bf16x8 lo, hi; };
#define PG8_MMA8(ai, bj, At, Bt) do { __builtin_amdgcn_s_setprio(1); _Pragma("unroll") for (int m = 0; m < 4; ++m) _Pragma("unroll") for (int n = 0; n < 2; ++n) { \
        const Frag2 fb_{Bt[n][0], Bt[n][1]}, fa_{At[m][0], At[m][1]}; \
        acc[ai][bj][m][n] = __builtin_amdgcn_mfma_scale_f32_16x16x128_f8f6f4(__builtin_bit_cast(i32x8_t, fb_), __builtin_bit_cast(i32x8_t, fa_), acc[ai][bj][m][n], 0, 0, 0, 0x79797979, 0, FP8 * 0x01010101); } __builtin_amdgcn_s_setprio(0); } while (0)
#define PG8_MM(ai, bj, At, Bt) do { if constexpr (FP8) PG8_MMA8(ai, bj, At, Bt); else PG8_MMA(ai, bj, At, Bt); } while (0)
#define PG8_WAIT_V(n) asm volatile("s_waitcnt vmcnt(" #n ")" ::: "memory")
#define PG8_WAIT_L(n) asm volatile("s_waitcnt lgkmcnt(" #n ")" ::: "memory")
#define PG8_BAR __builtin_amdgcn_s_barrier()
#define PG8_SCHED __builtin_amdgcn_sched_barrier(0)
    Unit cur, nxt; int ui = 0;
    if (!S.next(0, cur)) return;
    Acc acc;
#pragma unroll
    for (int a = 0; a < 2; ++a)
#pragma unroll
        for (int b = 0; b < 2; ++b)
#pragma unroll
            for (int m = 0; m < 4; ++m)
#pragma unroll
                for (int n = 0; n < 2; ++n) acc[a][b][m][n] = (f32x4){0.f, 0.f, 0.f, 0.f};
    bf16x8 At[4][2], B0[2][2], B1[2][2];
    unsigned vA[2][2];
    S.aoffs(cur, tid, vA, lds, wid, false);
    const char* cA = S.abase(cur); const char* cB = S.bbase(cur);
    PG8_STAGEB(PG8_SB(0, 0), cB); PG8_STAGEB(PG8_SB(0, 1), cB + hstepB); PG8_STAGE2(PG8_SA(0, 0), cA, vA[0][0], vA[0][1]); PG8_STAGE2(PG8_SA(0, 1), cA, vA[1][0], vA[1][1]);
    if (wr == 1) PG8_BAR;
    PG8_WAIT_V(2); PG8_BAR;
    PG8_STAGEB(PG8_SB(1, 0), cB + kstep); PG8_STAGE2(PG8_SA(1, 0), cA + kstep, vA[0][0], vA[0][1]); PG8_STAGEB(PG8_SB(1, 1), cB + hstepB + kstep);
    PG8_WAIT_V(6); PG8_BAR;
    for (;;) {
        E.unit_begin(cur, lds, wid, lane);
        const bool has_next = S.next(ui + 1, nxt);
        const char* nA = cA; const char* nB = cB;
        if (has_next) { nA = S.abase(nxt); nB = S.bbase(nxt); S.prefetch(nxt, lds, wid, lane); }
        for (int t = 0; t < nt; t += 2) {
            const bool last = (t == nt - 2);
            if constexpr (Epi::HAS_MID) { if (t == Epi::MID_T) E.mid(acc, cur, wr, wc, fr, fq); }
            const char* a1 = cA + (size_t)(t + 1) * kstep;
            const char* a2 = last ? nA : cA + (size_t)(t + 2) * kstep; const char* b2 = last ? nB : cB + (size_t)(t + 2) * kstep;
            const char* a3 = a2 + kstep; const char* b3 = b2 + kstep;
            PG8_LDB(B0, 0, 0); PG8_LDB(B1, 0, 1); PG8_SCHED; PG8_LDA(At, 0, 0); PG8_STAGE2(PG8_SA(1, 1), a1, vA[1][0], vA[1][1]);
            if (last && has_next) S.aoffs(nxt, tid, vA, lds, wid, true);
            PG8_WAIT_V(8); PG8_WAIT_L(0); PG8_BAR; PG8_MM(0, 0, At, B0); PG8_MM(0, 1, At, B1); PG8_BAR; PG8_SCHED;
            PG8_LDA(At, 0, 1); PG8_STAGEB(PG8_SB(0, 0), b2); PG8_STAGEB(PG8_SB(0, 1), b2 + hstepB); PG8_STAGE2(PG8_SA(0, 0), a2, vA[0][0], vA[0][1]);
            PG8_WAIT_V(8); PG8_WAIT_L(0); PG8_BAR; PG8_MM(1, 0, At, B0); PG8_MM(1, 1, At, B1); PG8_BAR; PG8_SCHED;
            PG8_LDB(B0, 1, 0); PG8_LDB(B1, 1, 1); PG8_SCHED; PG8_LDA(At, 1, 0); PG8_STAGE2(PG8_SA(0, 1), a2, vA[1][0], vA[1][1]);
            PG8_WAIT_V(8); PG8_WAIT_L(0); PG8_BAR; PG8_MM(0, 0, At, B0); PG8_MM(0, 1, At, B1); PG8_BAR; PG8_SCHED;
            PG8_LDA(At, 1, 1); PG8_STAGEB(PG8_SB(1, 0), b3); PG8_STAGEB(PG8_SB(1, 1), b3 + hstepB); PG8_STAGE2(PG8_SA(1, 0), a3, vA[0][0], vA[0][1]);
            PG8_WAIT_V(8); PG8_WAIT_L(0); PG8_BAR; PG8_MM(1, 0, At, B0); PG8_MM(1, 1, At, B1); PG8_BAR; PG8_SCHED;
        }
        if constexpr (ALIGN_EPI) { if (wr == 0) PG8_BAR; }
#ifdef PROBE_REGION
        { unsigned long long t0_ = 0; if (Epi::PID == PROBE_REGION) t0_ = __builtin_amdgcn_s_memrealtime();
          E(acc, cur, wr, wc, fr, fq);
          if (Epi::PID == PROBE_REGION && tid == 0) { asm volatile("s_waitcnt vmcnt(0)" ::: "memory"); volatile LAS unsigned* m_ = (volatile LAS unsigned*)(lds + 131072); m_[16] += (unsigned)(__builtin_amdgcn_s_memrealtime() - t0_); } }
#else
        { unsigned z_ = 0; asm volatile("" : "+v"(z_)); const int l2 = (int)__builtin_amdgcn_mbcnt_hi(~0u, __builtin_amdgcn_mbcnt_lo(~0u, z_));
          E(acc, cur, wr, wc, l2 & 15, l2 >> 4); }
#endif
        if (!has_next) break;
#pragma unroll
        for (int a = 0; a < 2; ++a)
#pragma unroll
            for (int b = 0; b < 2; ++b)
#pragma unroll
                for (int m = 0; m < 4; ++m)
#pragma unroll
                    for (int n = 0; n < 2; ++n) acc[a][b][m][n] = (f32x4){0.f, 0.f, 0.f, 0.f};
        cur = nxt; cA = nA; cB = nB; ++ui;
        if constexpr (ALIGN_EPI) { if (wr == 1) PG8_BAR; }
    }
    PG8_WAIT_V(0);
    if constexpr (!ALIGN_EPI) { if (wr == 0) PG8_BAR; }
    PG8_BAR;
#undef PG8_SA
#undef PG8_SB
#undef PG8_STAGE2
#undef PG8_STAGEB
#undef PG8_LDA
#undef PG8_LDB
#undef PG8_MMA
#undef PG8_MMA8
#undef PG8_MM
#undef PG8_WAIT_V
#undef PG8_WAIT_L
#undef PG8_BAR
#undef PG8_SCHED
}
}
constexpr int NWAVES = 8;
constexpr int RING_BYTES = 131072;
constexpr int MISC_OFF = RING_BYTES;
constexpr int LDS_BYTES = 163840;
constexpr int PARAMS_OFF = MISC_OFF + 1024;
constexpr int SPW_OFF = MISC_OFF + 2048, SPW_BYTES = 3712, STATS_OFF = SPW_OFF + 8 * SPW_BYTES;

#define XB_TMO      128
#define XB_XCNT(j)  (256  + 64 * (j))
#define XB_XSUB(j)  (1280 + 64 * (j))
#define XB_XGEN(j)  (2304 + 64 * (j))
#define XB_TOP      3328
#define XB_TOPGEN   3392
#define XCD_BAR_WORDS 3456
#define XB_SPIN_CAP (1u << 22)
DEV unsigned xb_ld(GAS unsigned* p) { return __hip_atomic_load(p, __ATOMIC_RELAXED, __HIP_MEMORY_SCOPE_AGENT); }
DEV unsigned xb_add(GAS unsigned* p, unsigned v) { return __hip_atomic_fetch_add(p, v, __ATOMIC_RELAXED, __HIP_MEMORY_SCOPE_AGENT); }
DEV unsigned xb_xcc_id() { return (unsigned)__builtin_amdgcn_s_getreg((3 << 11) | 20) & 0xFu; }
#define XB_SPIN(cond, bar) do { unsigned _sp = 0; while (cond) { __builtin_amdgcn_s_sleep(1); \
    if ((++_sp & 255u) == 0u) { if (xb_ld(&(bar)[XB_TMO])) break; if (_sp > XB_SPIN_CAP) { xb_add(&(bar)[XB_TMO], 1u); break; } } } } while (0)
struct XcdBarrier { GAS unsigned* bar; unsigned x; volatile LAS unsigned* st; };
DEV XcdBarrier xcd_barrier_post(GAS unsigned* bar, volatile LAS unsigned* st) {
    XcdBarrier b; b.bar = bar; b.x = xb_xcc_id(); b.st = st;
    if (threadIdx.x == 0) (void)xb_add(&bar[XB_XCNT(b.x)], 1u);
    return b;
}
DEV void xcd_barrier_complete(GAS unsigned* bar, unsigned x, unsigned& nloc, unsigned& nx) {
    const unsigned G = gridDim.x * gridDim.y * gridDim.z;
    unsigned sum, cnt, mine, sp = 0u;
    for (;;) {
        sum = 0u; cnt = 0u; mine = 0u;
#pragma unroll
        for (unsigned j = 0; j < 16; ++j) { const unsigned c = xb_ld(&bar[XB_XCNT(j)]); sum += c; cnt += (c > 0u) ? 1u : 0u; mine = (j == x) ? c : mine; }
        if (sum == G) break;
        __builtin_amdgcn_s_sleep(1);
        if ((++sp & 255u) == 0u) { if (xb_ld(&bar[XB_TMO])) break; if (sp > XB_SPIN_CAP) { xb_add(&bar[XB_TMO], 1u); break; } }
    }
    nloc = mine > 0u ? mine : 1u; nx = cnt > 0u ? cnt : 1u;
}
DEV void xcd_barrier(const XcdBarrier& b) {
    asm volatile("s_waitcnt vmcnt(0)" ::: "memory");
    __syncthreads();
    if (threadIdx.x == 0) {
        GAS unsigned* bar = b.bar; asm volatile("" : "+s"(bar));
        __builtin_amdgcn_s_waitcnt(0);
        unsigned nloc = b.st[0], nx = b.st[1];
        if (nloc == 0u) { xcd_barrier_complete(bar, b.x, nloc, nx); b.st[0] = nloc; b.st[1] = nx; }
        const unsigned old = xb_add(&bar[XB_XSUB(b.x)], 1u);
        const unsigned gen = old / nloc;
        if (old + 1u == (gen + 1u) * nloc) {
            __builtin_amdgcn_fence(__ATOMIC_RELEASE, "agent");
            asm volatile("s_waitcnt vmcnt(0)" ::: "memory");
            const unsigned og = xb_add(&bar[XB_TOP], 1u);
            const unsigned tg = og / nx;
            if (og + 1u == (tg + 1u) * nx) xb_add(&bar[XB_TOPGEN], 1u);
            else XB_SPIN(xb_ld(&bar[XB_TOPGEN]) == tg, bar);
            __builtin_amdgcn_fence(__ATOMIC_ACQUIRE, "agent");
            xb_add(&bar[XB_XGEN(b.x)], 1u);
            asm volatile("s_waitcnt vmcnt(0)" ::: "memory");
        } else {
            XB_SPIN(xb_ld(&bar[XB_XGEN(b.x)]) == gen, bar);
            __builtin_amdgcn_fence(__ATOMIC_ACQUIRE, "agent");
            asm volatile("s_waitcnt vmcnt(0)" ::: "memory");
        }
    }
    __syncthreads();
}

#ifdef PROBE_REGION
#define TREG_BEGIN(k) unsigned long long _treg##k = 0; if ((k) == PROBE_REGION) _treg##k = __builtin_amdgcn_s_memrealtime()
#define TREG_END(k, F) do { if ((k) == PROBE_REGION && (F).tid == 0) { volatile LAS unsigned* _m = (volatile LAS unsigned*)((F).lds + MISC_OFF); _m[16] += (unsigned)(__builtin_amdgcn_s_memrealtime() - _treg##k); } } while (0)
#else
#define TREG_BEGIN(k) do {} while (0)
#define TREG_END(k, F) do {} while (0)
#endif
struct Frame { LAS unsigned char* lds; unsigned char* ldsg; int tid, lane, wave, G, bx; };
DEV unsigned long long ldp64(const LAS unsigned* q, int i) { const unsigned lo = __builtin_amdgcn_readfirstlane(q[2 * i]), hi = __builtin_amdgcn_readfirstlane(q[2 * i + 1]); return ((unsigned long long)hi << 32) | lo; }
DEV Params load_params(const Frame& F) {
    unsigned off_ = PARAMS_OFF; asm volatile("" : "+v"(off_));
    Params p; const LAS unsigned* q = (const LAS unsigned*)(F.lds + off_);
    p.x = (const float*)(const GAS float*)ldp64(q, 0);
    p.c = (const float*)(const GAS float*)ldp64(q, 1);
    p.ctx = (const float*)(const GAS float*)ldp64(q, 2);
    p.c_ctx = (const float*)(const GAS float*)ldp64(q, 3);
    p.w_mod = (const float*)(const GAS float*)ldp64(q, 4);
    p.b_mod = (const float*)(const GAS float*)ldp64(q, 5);
    p.g_pre_mix = (const float*)(const GAS float*)ldp64(q, 6);
    p.g_post_mix = (const float*)(const GAS float*)ldp64(q, 7);
    p.g_pre_ffn = (const float*)(const GAS float*)ldp64(q, 8);
    p.g_post_ffn = (const float*)(const GAS float*)ldp64(q, 9);
    p.w_in = (const float*)(const GAS float*)ldp64(q, 10);
    p.ln_g = (const float*)(const GAS float*)ldp64(q, 11);
    p.ln_b = (const float*)(const GAS float*)ldp64(q, 12);
    p.gws = (const float*)(const GAS float*)ldp64(q, 13);
    p.gbs = (const float*)(const GAS float*)ldp64(q, 14);
    p.conv_w = (const float*)(const GAS float*)ldp64(q, 15);
    p.conv_b = (const float*)(const GAS float*)ldp64(q, 16);
    p.lru_wa = (const float*)(const GAS float*)ldp64(q, 17);
    p.lru_ba = (const float*)(const GAS float*)ldp64(q, 18);
    p.lru_wx = (const float*)(const GAS float*)ldp64(q, 19);
    p.lru_bx = (const float*)(const GAS float*)ldp64(q, 20);
    p.lru_lam = (const float*)(const GAS float*)ldp64(q, 21);
    p.w_out_a = (const float*)(const GAS float*)ldp64(q, 22);
    p.w_out_b = (const float*)(const GAS float*)ldp64(q, 23);
    p.w_out = (const float*)(const GAS float*)ldp64(q, 24);
    p.router_w = (const float*)(const GAS float*)ldp64(q, 25);
    p.router_b = (const float*)(const GAS float*)ldp64(q, 26);
    p.e_g = (const float*)(const GAS float*)ldp64(q, 27);
    p.e_u = (const float*)(const GAS float*)ldp64(q, 28);
    p.e_d = (const float*)(const GAS float*)ldp64(q, 29);
    p.s_g = (const float*)(const GAS float*)ldp64(q, 30);
    p.s_u = (const float*)(const GAS float*)ldp64(q, 31);
    p.s_d = (const float*)(const GAS float*)ldp64(q, 32);
    p.out = (float*)(GAS float*)ldp64(q, 33); p.ws = (unsigned char*)(GAS unsigned char*)ldp64(q, 34);
    return p;
}
DEV void store_params(const Frame& F, const Params& a) {
    if (F.tid == 0) { LAS unsigned long long* q = (LAS unsigned long long*)(F.lds + PARAMS_OFF);
        q[0] = (unsigned long long)a.x;
        q[1] = (unsigned long long)a.c;
        q[2] = (unsigned long long)a.ctx;
        q[3] = (unsigned long long)a.c_ctx;
        q[4] = (unsigned long long)a.w_mod;
        q[5] = (unsigned long long)a.b_mod;
        q[6] = (unsigned long long)a.g_pre_mix;
        q[7] = (unsigned long long)a.g_post_mix;
        q[8] = (unsigned long long)a.g_pre_ffn;
        q[9] = (unsigned long long)a.g_post_ffn;
        q[10] = (unsigned long long)a.w_in;
        q[11] = (unsigned long long)a.ln_g;
        q[12] = (unsigned long long)a.ln_b;
        q[13] = (unsigned long long)a.gws;
        q[14] = (unsigned long long)a.gbs;
        q[15] = (unsigned long long)a.conv_w;
        q[16] = (unsigned long long)a.conv_b;
        q[17] = (unsigned long long)a.lru_wa;
        q[18] = (unsigned long long)a.lru_ba;
        q[19] = (unsigned long long)a.lru_wx;
        q[20] = (unsigned long long)a.lru_bx;
        q[21] = (unsigned long long)a.lru_lam;
        q[22] = (unsigned long long)a.w_out_a;
        q[23] = (unsigned long long)a.w_out_b;
        q[24] = (unsigned long long)a.w_out;
        q[25] = (unsigned long long)a.router_w;
        q[26] = (unsigned long long)a.router_b;
        q[27] = (unsigned long long)a.e_g;
        q[28] = (unsigned long long)a.e_u;
        q[29] = (unsigned long long)a.e_d;
        q[30] = (unsigned long long)a.s_g;
        q[31] = (unsigned long long)a.s_u;
        q[32] = (unsigned long long)a.s_d;
        q[33] = (unsigned long long)a.out; q[34] = (unsigned long long)a.ws; }
}

DEV void transpose_item(const float* W, int N, bf16_t* WT, int dK, int koff, int rbase, int rhi, LAS float* scr, int kb, int nb, int lane, float scale = 1.0f) {
    const int k0 = 64 * kb, n0 = 32 * nb;
    float4 ld[8];
#pragma unroll
    for (int i = 0; i < 8; ++i) ld[i] = *(const float4*)(W + (size_t)(k0 + 8 * i + (lane >> 3)) * N + n0 + (lane & 7) * 4);
#pragma unroll
    for (int i = 0; i < 8; ++i) { LAS float* d = scr + (8 * i + (lane >> 3)) * 33 + (lane & 7) * 4; d[0] = ld[i].x; d[1] = ld[i].y; d[2] = ld[i].z; d[3] = ld[i].w; }
    asm volatile("s_waitcnt lgkmcnt(0)" ::: "memory");
    const int cc = lane & 7;
#pragma unroll
    for (int j = 0; j < 4; ++j) { const int nl = (lane >> 3) + 8 * j, n = n0 + nl; const LAS float* s = scr + (8 * cc) * 33 + nl;
        u32x4 o; o.x = pk2(s[0 * 33] * scale, s[1 * 33] * scale); o.y = pk2(s[2 * 33] * scale, s[3 * 33] * scale); o.z = pk2(s[4 * 33] * scale, s[5 * 33] * scale); o.w = pk2(s[6 * 33] * scale, s[7 * 33] * scale);
        const int drow = rbase + (n >> 7) * rhi + (n & 127);
        *(u32x4*)(WT + (size_t)drow * dK + koff + k0 + 8 * cc) = o; }
    asm volatile("s_waitcnt lgkmcnt(0)" ::: "memory");
}
DEV void transpose_item8(const float* W, int N, unsigned char* WT, int dK, int rbase, int rhi, LAS float* scr, int kb, int nb, int lane) {
    const int k0 = 64 * kb, n0 = 32 * nb;
    float4 ld[8];
#pragma unroll
    for (int i = 0; i < 8; ++i) ld[i] = *(const float4*)(W + (size_t)(k0 + 8 * i + (lane >> 3)) * N + n0 + (lane & 7) * 4);
#pragma unroll
    for (int i = 0; i < 8; ++i) { LAS float* d = scr + (8 * i + (lane >> 3)) * 33 + (lane & 7) * 4; d[0] = ld[i].x; d[1] = ld[i].y; d[2] = ld[i].z; d[3] = ld[i].w; }
    asm volatile("s_waitcnt lgkmcnt(0)" ::: "memory");
    const int cc = lane & 7;
#pragma unroll
    for (int j = 0; j < 4; ++j) { const int nl = (lane >> 3) + 8 * j, n = n0 + nl; const LAS float* s = scr + (8 * cc) * 33 + nl;
        unsigned lo = 0, hi = 0;
        lo = __builtin_amdgcn_cvt_pk_fp8_f32(s[0 * 33] * 64.f, s[1 * 33] * 64.f, lo, false); lo = __builtin_amdgcn_cvt_pk_fp8_f32(s[2 * 33] * 64.f, s[3 * 33] * 64.f, lo, true);
        hi = __builtin_amdgcn_cvt_pk_fp8_f32(s[4 * 33] * 64.f, s[5 * 33] * 64.f, hi, false); hi = __builtin_amdgcn_cvt_pk_fp8_f32(s[6 * 33] * 64.f, s[7 * 33] * 64.f, hi, true);
        const int drow = rbase + (n >> 7) * rhi + (n & 127);
        *(u32x2*)(WT + (size_t)drow * dK + k0 + 8 * cc) = (u32x2){lo, hi}; }
    asm volatile("s_waitcnt lgkmcnt(0)" ::: "memory");
}
DEV void convert_weights(const Params& p, const Frame& F, int l, int part, int vw, int nvw) {
    LAS float* scr = (LAS float*)(F.lds + F.wave * 16384);
    unsigned char* W = p.ws + WS_W;
    const int lane = F.lane;
    constexpr int I_IN = 16 * 128, I_OA = 8 * 32, I_OUT = 16 * 32, I_RT = 16 * 2, I_SG = 16 * 8, I_SD = 4 * 32, I_EG = NE * 16 * 8, I_ED = NE * 4 * 32, I_LRU = 32 * 2;
    if (part == 0) {
        constexpr int NITEMS = I_IN + 2 * I_OA + I_OUT + I_RT + 2 * I_SG + I_SD + I_LRU;
        for (int it = vw; it < NITEMS; it += nvw) {
            int r = it;
#if GIN_FP8
            if (r < I_IN) { transpose_item8(p.w_in + (size_t)l * D * 4096, 4096, W + WO_IN, D, 0, 128, scr, r / 128, r % 128, lane); continue; } r -= I_IN;
#else
            if (r < I_IN) { transpose_item(p.w_in + (size_t)l * D * 4096, 4096, (bf16_t*)(W + WO_IN), D, 0, 0, 128, scr, r / 128, r % 128, lane); continue; } r -= I_IN;
#endif
            if (r < I_OA) { transpose_item(p.w_out_a + (size_t)l * 512 * D, D, (bf16_t*)(W + WO_AB), D, 0, 0, 128, scr, r / 32, r % 32, lane); continue; } r -= I_OA;
            if (r < I_OA) { transpose_item(p.w_out_b + (size_t)l * 512 * D, D, (bf16_t*)(W + WO_AB), D, 512, 0, 128, scr, r / 32, r % 32, lane); continue; } r -= I_OA;
            if (r < I_OUT) { transpose_item(p.w_out + (size_t)l * D * D, D, (bf16_t*)(W + WO_OUT), D, 0, 0, 128, scr, r / 32, r % 32, lane); continue; } r -= I_OUT;
            if (r < I_RT) { transpose_item(p.router_w + (size_t)l * D * 64, 64, (bf16_t*)(W + WO_SR), D, 0, 0, 128, scr, r / 2, r % 2, lane); continue; } r -= I_RT;
            if (r < I_SG) { transpose_item(p.s_g + (size_t)l * D * 256, 256, (bf16_t*)(W + WO_SR), D, 0, 256, 256, scr, r / 8, r % 8, lane); continue; } r -= I_SG;
            if (r < I_SG) { transpose_item(p.s_u + (size_t)l * D * 256, 256, (bf16_t*)(W + WO_SR), D, 0, 256 + 128, 256, scr, r / 8, r % 8, lane); continue; } r -= I_SG;
#if GSD_FP8
            if (r < I_SD) { transpose_item8(p.s_d + (size_t)l * 256 * D, D, W + WO_SD, 256, 0, 128, scr, r / 32, r % 32, lane); continue; } r -= I_SD;
#else
            if (r < I_SD) { transpose_item(p.s_d + (size_t)l * 256 * D, D, (bf16_t*)(W + WO_SD), 256, 0, 0, 128, scr, r / 32, r % 32, lane); continue; } r -= I_SD;
#endif
            { const int mat = r / 2, nb = r % 2, type = mat >> 4, dh = mat & 15;
              const float* src = (type ? p.lru_wx : p.lru_wa) + (size_t)((l * 2) * 8 + dh) * 4096;
              transpose_item(src, 64, (bf16_t*)(W + WO_LRU) + (size_t)mat * 4096, 64, 0, 0, 128, scr, 0, nb, lane, -1.4426950408889634f); }
        }
        const int gt = vw * 64 + lane, NT = nvw * 64;
        for (int i = gt; i < 192 * D / 8; i += NT) *(u32x4*)((bf16_t*)(W + WO_SR) + (size_t)64 * D + (size_t)i * 8) = (u32x4){0u, 0u, 0u, 0u};
        for (int i = gt; i < 8 * 128 * 128 / 4; i += NT) { const float4 v = *(const float4*)(p.gws + (size_t)l * 8 * 128 * 128 + (size_t)i * 4);
            u32x2 o; o.x = pk2(v.x, v.y); o.y = pk2(v.z, v.w); *(u32x2*)((bf16_t*)(W + WO_GWS) + (size_t)i * 4) = o; }
    } else if (part == 2) {
#if GED_FP8
        for (int it = vw; it < I_ED; it += nvw) { const int e = it / 128, q = it % 128; transpose_item8(p.e_d + ((size_t)(l * NE + e) * 256) * D, D, W + WO_ED + (size_t)e * D * 256, 256, 0, 128, scr, q / 32, q % 32, lane); }
#else
        for (int it = vw; it < I_ED; it += nvw) { const int e = it / 128, q = it % 128; transpose_item(p.e_d + ((size_t)(l * NE + e) * 256) * D, D, (bf16_t*)(W + WO_ED) + (size_t)e * D * 256, 256, 0, 0, 128, scr, q / 32, q % 32, lane); }
#endif
    } else {
        constexpr int NITEMS = 2 * I_EG;
        for (int it = vw; it < NITEMS; it += nvw) {
            int r = it;
            if (r < I_EG) { const int e = r / 128, q = r % 128; transpose_item8(p.e_g + ((size_t)(l * NE + e) * D) * 256, 256, W + WO_EG + (size_t)e * 512 * D, D, 0, 256, scr, q / 8, q % 8, lane); continue; } r -= I_EG;
            { const int e = r / 128, q = r % 128; transpose_item8(p.e_u + ((size_t)(l * NE + e) * D) * 256, 256, W + WO_EG + (size_t)e * 512 * D, D, 128, 256, scr, q / 8, q % 8, lane); }
        }
    }
}
DEV void pe_table(const Params& p, const Frame& F, int idx) {
    const int pos = idx >> 9, half = (idx >> 8) & 1, q = idx & 255;
    const float omega = 1.0f / powf(10000.0f, (float)q / 256.0f);
    const float ang = (float)pos * omega;
    ((float*)(p.ws + WS_PE))[idx] = half ? cosf(ang) : sinf(ang);
}
DEV void mod_items(const Params& p, const Frame& F) {
    LAS float* part = (LAS float*)(F.lds);
    LAS float* sc = (LAS float*)(F.lds + 16384);
    if (F.bx < 2 * 96) {
        for (int i = F.tid; i < 5 * D; i += NWAVES * 64) { const int cnd = i >> 10, d = i & (D - 1); sc[d * 8 + cnd] = siluf_(cnd < 4 ? p.c[cnd * D + d] : p.c_ctx[d]); }
        __syncthreads();
    }
    for (int it = F.bx; it < 2 * 96; it += F.G) {
        const int l = it / 96, e = (it % 96) * 64 + F.lane;
        const float* w = p.w_mod + (size_t)l * D * 6 * D + e;
        float acc[5] = {0.f, 0.f, 0.f, 0.f, 0.f};
        const int d0 = F.wave * 128;
#pragma unroll 32
        for (int d = d0; d < d0 + 128; ++d) { const float wv = w[(size_t)d * 6 * D]; const f32x4 s4 = *(const LAS f32x4*)(sc + d * 8); const float s5 = sc[d * 8 + 4];
            acc[0] += s4[0] * wv; acc[1] += s4[1] * wv; acc[2] += s4[2] * wv; acc[3] += s4[3] * wv; acc[4] += s5 * wv; }
#pragma unroll
        for (int cnd = 0; cnd < 5; ++cnd) part[(F.wave * 5 + cnd) * 64 + F.lane] = acc[cnd];
        __syncthreads();
        if (F.tid < 320) { const int cnd = F.tid >> 6, ln = F.tid & 63; float s = p.b_mod[l * 6 * D + (it % 96) * 64 + ln];
#pragma unroll
            for (int w8 = 0; w8 < 8; ++w8) s += part[(w8 * 5 + cnd) * 64 + ln];
            ((float*)(p.ws + WS_MOD))[(size_t)(l * 5 + cnd) * 6 * D + (it % 96) * 64 + ln] = s; }
        __syncthreads();
    }
}

DEV bf16_t* xl16_row(const Params& p, int r) { return (bf16_t*)((unsigned char*)p.out + (size_t)r * 4096 + 2048); }
DEV void load_xl(const Params& p, int r, int lane, float (&v)[16]) {
    if (r < TL) { const bf16_t* x = xl16_row(p, r);
#pragma unroll
        for (int j = 0; j < 4; ++j) { const ushort4 t = *(const ushort4*)(x + (j * 64 + lane) * 4); v[4 * j] = bf2f(t.x); v[4 * j + 1] = bf2f(t.y); v[4 * j + 2] = bf2f(t.z); v[4 * j + 3] = bf2f(t.w); } }
    else { const float* x = (const float*)(p.ws + WS_XC) + (size_t)(r - TL) * D;
#pragma unroll
        for (int j = 0; j < 4; ++j) { const float4 t = *(const float4*)(x + (j * 64 + lane) * 4); v[4 * j] = t.x; v[4 * j + 1] = t.y; v[4 * j + 2] = t.z; v[4 * j + 3] = t.w; } }
}
DEV void store_xl(const Params& p, int r, int lane, const float (&v)[16], bool final_f32) {
    if (r < TL && !final_f32) { bf16_t* x = xl16_row(p, r);
#pragma unroll
        for (int j = 0; j < 4; ++j) { u32x2 o; o.x = pk2(v[4 * j], v[4 * j + 1]); o.y = pk2(v[4 * j + 2], v[4 * j + 3]); *(u32x2*)(x + (j * 64 + lane) * 4) = o; } }
    else { float* x = r < TL ? p.out + (size_t)r * D : (float*)(p.ws + WS_XC) + (size_t)(r - TL) * D;
#pragma unroll
        for (int j = 0; j < 4; ++j) *(float4*)(x + (j * 64 + lane) * 4) = make_float4(v[4 * j], v[4 * j + 1], v[4 * j + 2], v[4 * j + 3]); }
}
DEV void row_pass_A(const Params& p, int l, int rlo, int rhi, int wave, int nw, int lane) {
    const bf16_t* FL = (const bf16_t*)(p.ws + WS_RY);
    for (int r = rlo + wave; r < rhi; r += nw) {
        const int cond = r < TL ? (r >> 13) : 4;
        float v[16];
        if (l == 0) {
            const float* src = r < TL ? p.x + (size_t)r * D : p.ctx + (size_t)(r - TL) * D;
#pragma unroll
            for (int j = 0; j < 4; ++j) { const float4 t = *(const float4*)(src + (j * 64 + lane) * 4); v[4 * j] = t.x; v[4 * j + 1] = t.y; v[4 * j + 2] = t.z; v[4 * j + 3] = t.w; }
            if (r < TL) {
                const int t = r & (SEQ - 1); const float* PE = (const float*)(p.ws + WS_PE);
#pragma unroll
                for (int j = 0; j < 4; ++j) { const float4 e = *(const float4*)(PE + ((j < 2) ? (t >> 6) : (t & 63)) * 512 + (j & 1) * 256 + lane * 4);
                    v[4 * j] += e.x; v[4 * j + 1] += e.y; v[4 * j + 2] += e.z; v[4 * j + 3] += e.w; }
            }
        } else {
            float f[16]; float ss = 0.f;
            load_xl(p, r, lane, v);
#pragma unroll
            for (int j = 0; j < 4; ++j) {
                const ushort4 fb = *(const ushort4*)(FL + (size_t)r * D + (j * 64 + lane) * 4);
                f[4 * j] = bf2f(fb.x); f[4 * j + 1] = bf2f(fb.y); f[4 * j + 2] = bf2f(fb.z); f[4 * j + 3] = bf2f(fb.w);
            }
            { const unsigned char* SL = p.ws + WS_SLOTS + (size_t)r * 8 * 1024;
                unsigned sv[8][4];
#pragma unroll
                for (int s = 0; s < 8; ++s)
#pragma unroll
                    for (int j = 0; j < 4; ++j) sv[s][j] = *(const unsigned*)(SL + (size_t)s * 1024 + (j * 64 + lane) * 4);
#pragma unroll
                for (int j = 0; j < 4; ++j) { float a0 = 0.f, a1 = 0.f, a2 = 0.f, a3 = 0.f;
#pragma unroll
                    for (int s = 0; s < 8; ++s) { a0 += __builtin_amdgcn_cvt_f32_fp8(sv[s][j], 0); a1 += __builtin_amdgcn_cvt_f32_fp8(sv[s][j], 1); a2 += __builtin_amdgcn_cvt_f32_fp8(sv[s][j], 2); a3 += __builtin_amdgcn_cvt_f32_fp8(sv[s][j], 3); }
                    f[4 * j] += a0 * 0.0625f; f[4 * j + 1] += a1 * 0.0625f; f[4 * j + 2] += a2 * 0.0625f; f[4 * j + 3] += a3 * 0.0625f; } }
#pragma unroll
            for (int i = 0; i < 16; ++i) ss += f[i] * f[i];
            const float rstd = rsqrtf(wave_sum(ss) * (1.f / D) + 1e-6f);
            const float* gt = mod_ptr(p, l - 1, cond, 5); const float* g = p.g_post_ffn + (l - 1) * D;
#pragma unroll
            for (int j = 0; j < 4; ++j) { const float4 gt4 = *(const float4*)(gt + (j * 64 + lane) * 4), g4 = *(const float4*)(g + (j * 64 + lane) * 4);
                v[4 * j] += gt4.x * (f[4 * j] * rstd * g4.x); v[4 * j + 1] += gt4.y * (f[4 * j + 1] * rstd * g4.y); v[4 * j + 2] += gt4.z * (f[4 * j + 2] * rstd * g4.z); v[4 * j + 3] += gt4.w * (f[4 * j + 3] * rstd * g4.w); }
        }
        store_xl(p, r, lane, v, l == 2);
        if (l < 2) {
            float ss = 0.f;
#pragma unroll
            for (int i = 0; i < 16; ++i) ss += v[i] * v[i];
            const float rstd = rsqrtf(wave_sum(ss) * (1.f / D) + 1e-6f);
            const float* sh = mod_ptr(p, l, cond, 0); const float* sc = mod_ptr(p, l, cond, 1); const float* g = p.g_pre_mix + l * D;
#pragma unroll
            for (int j = 0; j < 4; ++j) { const int d = (j * 64 + lane) * 4; const float4 sh4 = *(const float4*)(sh + d), sc4 = *(const float4*)(sc + d), g4 = *(const float4*)(g + d);
                u32x2 o; o.x = pk2(v[4 * j] * rstd * g4.x * (1.f + sc4.x) + sh4.x, v[4 * j + 1] * rstd * g4.y * (1.f + sc4.y) + sh4.y);
                o.y = pk2(v[4 * j + 2] * rstd * g4.z * (1.f + sc4.z) + sh4.z, v[4 * j + 3] * rstd * g4.w * (1.f + sc4.w) + sh4.w);
#if GIN_FP8
                { const float h0 = __uint_as_float(o.x << 16) * 16.f, h1 = __uint_as_float(o.x & 0xffff0000u) * 16.f, h2 = __uint_as_float(o.y << 16) * 16.f, h3 = __uint_as_float(o.y & 0xffff0000u) * 16.f;
                  unsigned t = 0; t = __builtin_amdgcn_cvt_pk_fp8_f32(__builtin_amdgcn_fmed3f(h0, -440.f, 440.f), __builtin_amdgcn_fmed3f(h1, -440.f, 440.f), t, false);
                  t = __builtin_amdgcn_cvt_pk_fp8_f32(__builtin_amdgcn_fmed3f(h2, -440.f, 440.f), __builtin_amdgcn_fmed3f(h3, -440.f, 440.f), t, true);
                  *(unsigned*)(p.ws + WS_H8 + (size_t)r * D + d) = t; }
#else
                *(u32x2*)((bf16_t*)(p.ws + WS_RY) + (size_t)r * D + d) = o;
#endif
            }
        }
    }
}
DEV void row_pass_H(const Params& p, int l, int rlo, int rhi, int wave, int nw, int lane) {
    const bf16_t* YL = (const bf16_t*)(p.ws + WS_Z);
    bf16_t* H = (bf16_t*)(p.ws + WS_RA);
    for (int r = rlo + wave; r < rhi; r += nw) {
        const int cond = r < TL ? (r >> 13) : 4;
        float v[16], f[16]; float ss = 0.f;
        load_xl(p, r, lane, v);
#pragma unroll
        for (int j = 0; j < 4; ++j) {
            const ushort4 fb = *(const ushort4*)(YL + (size_t)r * D + (j * 64 + lane) * 4);
            f[4 * j] = bf2f(fb.x); f[4 * j + 1] = bf2f(fb.y); f[4 * j + 2] = bf2f(fb.z); f[4 * j + 3] = bf2f(fb.w);
        }
#pragma unroll
        for (int i = 0; i < 16; ++i) ss += f[i] * f[i];
        const float rstd = rsqrtf(wave_sum(ss) * (1.f / D) + 1e-6f);
        const float* gt = mod_ptr(p, l, cond, 2); const float* g = p.g_post_mix + l * D;
#pragma unroll
        for (int j = 0; j < 4; ++j) { const float4 gt4 = *(const float4*)(gt + (j * 64 + lane) * 4), g4 = *(const float4*)(g + (j * 64 + lane) * 4);
            v[4 * j] += gt4.x * (f[4 * j] * rstd * g4.x); v[4 * j + 1] += gt4.y * (f[4 * j + 1] * rstd * g4.y); v[4 * j + 2] += gt4.z * (f[4 * j + 2] * rstd * g4.z); v[4 * j + 3] += gt4.w * (f[4 * j + 3] * rstd * g4.w); }
        store_xl(p, r, lane, v, false);
        float s2 = 0.f;
#pragma unroll
        for (int i = 0; i < 16; ++i) s2 += v[i] * v[i];
        const float rstd2 = rsqrtf(wave_sum(s2) * (1.f / D) + 1e-6f);
        const float* sh = mod_ptr(p, l, cond, 3); const float* sc = mod_ptr(p, l, cond, 4); const float* g2 = p.g_pre_ffn + l * D;
#pragma unroll
        for (int j = 0; j < 4; ++j) { const int d = (j * 64 + lane) * 4; const float4 sh4 = *(const float4*)(sh + d), sc4 = *(const float4*)(sc + d), g4 = *(const float4*)(g2 + d);
            u32x2 o; o.x = pk2(v[4 * j] * rstd2 * g4.x * (1.f + sc4.x) + sh4.x, v[4 * j + 1] * rstd2 * g4.y * (1.f + sc4.y) + sh4.y);
            o.y = pk2(v[4 * j + 2] * rstd2 * g4.z * (1.f + sc4.z) + sh4.z, v[4 * j + 3] * rstd2 * g4.w * (1.f + sc4.w) + sh4.w);
            *(u32x2*)(H + (size_t)r * D + d) = o;
            { const float h0 = __uint_as_float(o.x << 16) * 16.f, h1 = __uint_as_float(o.x & 0xffff0000u) * 16.f, h2 = __uint_as_float(o.y << 16) * 16.f, h3 = __uint_as_float(o.y & 0xffff0000u) * 16.f;
              unsigned t = 0; t = __builtin_amdgcn_cvt_pk_fp8_f32(__builtin_amdgcn_fmed3f(h0, -440.f, 440.f), __builtin_amdgcn_fmed3f(h1, -440.f, 440.f), t, false);
              t = __builtin_amdgcn_cvt_pk_fp8_f32(__builtin_amdgcn_fmed3f(h2, -440.f, 440.f), __builtin_amdgcn_fmed3f(h3, -440.f, 440.f), t, true);
              *(unsigned*)(p.ws + WS_H2E + (size_t)r * D + d) = t; } }
    }
}

DEV void cvt4(const u32x2 w, float* o) { o[0] = __uint_as_float(w.x << 16); o[1] = __uint_as_float(w.x & 0xffff0000u); o[2] = __uint_as_float(w.y << 16); o[3] = __uint_as_float(w.y & 0xffff0000u); }
DEV unsigned e4m3x4_x16(const u32x2 o) {
    const float h0 = __uint_as_float(o.x << 16) * 16.f, h1 = __uint_as_float(o.x & 0xffff0000u) * 16.f, h2 = __uint_as_float(o.y << 16) * 16.f, h3 = __uint_as_float(o.y & 0xffff0000u) * 16.f;
    unsigned t = 0; t = __builtin_amdgcn_cvt_pk_fp8_f32(__builtin_amdgcn_fmed3f(h0, -440.f, 440.f), __builtin_amdgcn_fmed3f(h1, -440.f, 440.f), t, false);
    return __builtin_amdgcn_cvt_pk_fp8_f32(__builtin_amdgcn_fmed3f(h2, -440.f, 440.f), __builtin_amdgcn_fmed3f(h3, -440.f, 440.f), t, true);
}
DEV void load_prod(const float* a, const float* b, int lane, float* o) {
#pragma unroll
    for (int j = 0; j < 4; ++j) { const float4 x = *(const float4*)(a + (j * 64 + lane) * 4), y = *(const float4*)(b + (j * 64 + lane) * 4); o[4 * j] = x.x * y.x; o[4 * j + 1] = x.y * y.y; o[4 * j + 2] = x.z * y.z; o[4 * j + 3] = x.w * y.w; }
}
DEV void load_affine(const float* g, const float* sc, const float* sh, int lane, float* am, float* bm) {
#pragma unroll
    for (int j = 0; j < 4; ++j) { const int d = (j * 64 + lane) * 4; const float4 g4 = *(const float4*)(g + d), s4 = *(const float4*)(sc + d), h4 = *(const float4*)(sh + d);
        am[4 * j] = g4.x * (1.f + s4.x); am[4 * j + 1] = g4.y * (1.f + s4.y); am[4 * j + 2] = g4.z * (1.f + s4.z); am[4 * j + 3] = g4.w * (1.f + s4.w);
        bm[4 * j] = h4.x; bm[4 * j + 1] = h4.y; bm[4 * j + 2] = h4.z; bm[4 * j + 3] = h4.w; }
}
DEV float sumsq16(const float* v) { float s = 0.f;
#pragma unroll
    for (int i = 0; i < 16; ++i) s += v[i] * v[i];
    return s; }
DEV void emit_h(const float* v, float rstd2, const float* am, const float* bm, int lane, bf16_t* dst16, unsigned char* dst8) {
#pragma unroll
    for (int j = 0; j < 4; ++j) { const int d = (j * 64 + lane) * 4;
        u32x2 o; o.x = pk2(v[4 * j] * rstd2 * am[4 * j] + bm[4 * j], v[4 * j + 1] * rstd2 * am[4 * j + 1] + bm[4 * j + 1]);
        o.y = pk2(v[4 * j + 2] * rstd2 * am[4 * j + 2] + bm[4 * j + 2], v[4 * j + 3] * rstd2 * am[4 * j + 3] + bm[4 * j + 3]);
        if (dst16) *(u32x2*)(dst16 + d) = o;
        if (dst8) *(unsigned*)(dst8 + d) = e4m3x4_x16(o); }
}
DEV void store_xl16(const Params& p, int r, int lane, const float* v) { bf16_t* x = xl16_row(p, r);
#pragma unroll
    for (int j = 0; j < 4; ++j) { u32x2 o; o.x = pk2(v[4 * j], v[4 * j + 1]); o.y = pk2(v[4 * j + 2], v[4 * j + 3]); *(u32x2*)(x + (j * 64 + lane) * 4) = o; }
}
DEV void row_lat_A0(const Params& p, int wave, int nw, int lane) {
    const float* PE = (const float*)(p.ws + WS_PE);
    float am[16], bm[16]; int condp = -1;
    float4 xr[4], pr[4];
    int r = wave; if (r >= TL) return;
#pragma unroll
    for (int j = 0; j < 4; ++j) { const int t = r & (SEQ - 1); xr[j] = *(const float4*)(p.x + (size_t)r * D + (j * 64 + lane) * 4); pr[j] = *(const float4*)(PE + ((j < 2) ? (t >> 6) : (t & 63)) * 512 + (j & 1) * 256 + lane * 4); }
    for (; r < TL; r += nw) {
        float v[16];
#pragma unroll
        for (int j = 0; j < 4; ++j) { v[4 * j] = xr[j].x + pr[j].x; v[4 * j + 1] = xr[j].y + pr[j].y; v[4 * j + 2] = xr[j].z + pr[j].z; v[4 * j + 3] = xr[j].w + pr[j].w; }
        const int rl = (r + nw < TL) ? r + nw : r, tl = rl & (SEQ - 1);
#pragma unroll
        for (int j = 0; j < 4; ++j) { xr[j] = *(const float4*)(p.x + (size_t)rl * D + (j * 64 + lane) * 4); pr[j] = *(const float4*)(PE + ((j < 2) ? (tl >> 6) : (tl & 63)) * 512 + (j & 1) * 256 + lane * 4); }
        const int cond = r >> 13;
        if (cond != condp) { condp = cond; load_affine(p.g_pre_mix, mod_ptr(p, 0, cond, 1), mod_ptr(p, 0, cond, 0), lane, am, bm); }
        store_xl16(p, r, lane, v);
        const float rstd2 = rsqrtf(wave_sum(sumsq16(v)) * (1.f / D) + 1e-6f);
#if GIN_FP8
        emit_h(v, rstd2, am, bm, lane, nullptr, p.ws + WS_H8 + (size_t)r * D);
#else
        emit_h(v, rstd2, am, bm, lane, (bf16_t*)(p.ws + WS_RY) + (size_t)r * D, nullptr);
#endif
    }
}
DEV void row_lat_A(const Params& p, int l, int wave, int nw, int lane) {
    const bf16_t* FL = (const bf16_t*)(p.ws + WS_RY);
    float gtg[16], am[16], bm[16]; int condp = -1;
    u32x2 xr[4], fr[4]; unsigned sr[8][4];
    int r = wave; if (r >= TL) return;
#define ROWA_LOAD(rr) do { const bf16_t* x_ = xl16_row(p, (rr)); const unsigned char* SL_ = p.ws + WS_SLOTS + (size_t)(rr) * 8 * 1024; \
        _Pragma("unroll") for (int j = 0; j < 4; ++j) { xr[j] = *(const u32x2*)(x_ + (j * 64 + lane) * 4); fr[j] = *(const u32x2*)(FL + (size_t)(rr) * D + (j * 64 + lane) * 4); } \
        _Pragma("unroll") for (int s_ = 0; s_ < 8; ++s_) _Pragma("unroll") for (int j = 0; j < 4; ++j) sr[s_][j] = *(const unsigned*)(SL_ + (size_t)s_ * 1024 + (j * 64 + lane) * 4); } while (0)
    ROWA_LOAD(r);
    for (; r < TL; r += nw) {
        float v[16], f[16];
#pragma unroll
        for (int j = 0; j < 4; ++j) { cvt4(xr[j], v + 4 * j); cvt4(fr[j], f + 4 * j);
            float a0 = 0.f, a1 = 0.f, a2 = 0.f, a3 = 0.f;
#pragma unroll
            for (int s8 = 0; s8 < 8; ++s8) { a0 += __builtin_amdgcn_cvt_f32_fp8(sr[s8][j], 0); a1 += __builtin_amdgcn_cvt_f32_fp8(sr[s8][j], 1); a2 += __builtin_amdgcn_cvt_f32_fp8(sr[s8][j], 2); a3 += __builtin_amdgcn_cvt_f32_fp8(sr[s8][j], 3); }
            f[4 * j] += a0 * 0.0625f; f[4 * j + 1] += a1 * 0.0625f; f[4 * j + 2] += a2 * 0.0625f; f[4 * j + 3] += a3 * 0.0625f; }
        const int rl = (r + nw < TL) ? r + nw : r;
        ROWA_LOAD(rl);
        const int cond = r >> 13;
        if (cond != condp) { condp = cond; load_prod(mod_ptr(p, l - 1, cond, 5), p.g_post_ffn + (l - 1) * D, lane, gtg);
            if (l < 2) load_affine(p.g_pre_mix + l * D, mod_ptr(p, l, cond, 1), mod_ptr(p, l, cond, 0), lane, am, bm); }
        const float rstd = rsqrtf(wave_sum(sumsq16(f)) * (1.f / D) + 1e-6f);
#pragma unroll
        for (int i = 0; i < 16; ++i) v[i] += gtg[i] * (f[i] * rstd);
        if (l == 2) { float* x = p.out + (size_t)r * D;
#pragma unroll
            for (int j = 0; j < 4; ++j) *(float4*)(x + (j * 64 + lane) * 4) = make_float4(v[4 * j], v[4 * j + 1], v[4 * j + 2], v[4 * j + 3]);
        } else {
            store_xl16(p, r, lane, v);
            const float rstd2 = rsqrtf(wave_sum(sumsq16(v)) * (1.f / D) + 1e-6f);
#if GIN_FP8
            emit_h(v, rstd2, am, bm, lane, nullptr, p.ws + WS_H8 + (size_t)r * D);
#else
            emit_h(v, rstd2, am, bm, lane, (bf16_t*)(p.ws + WS_RY) + (size_t)r * D, nullptr);
#endif
        }
    }
#undef ROWA_LOAD
}
DEV void row_lat_H(const Params& p, int l, int wave, int nw, int lane) {
    const bf16_t* YL = (const bf16_t*)(p.ws + WS_Z);
    float gtg[16], am[16], bm[16]; int condp = -1;
    u32x2 xr[4], yr[4];
    int r = wave; if (r >= TL) return;
#pragma unroll
    for (int j = 0; j < 4; ++j) { xr[j] = *(const u32x2*)(xl16_row(p, r) + (j * 64 + lane) * 4); yr[j] = *(const u32x2*)(YL + (size_t)r * D + (j * 64 + lane) * 4); }
    for (; r < TL; r += nw) {
        float v[16], f[16];
#pragma unroll
        for (int j = 0; j < 4; ++j) { cvt4(xr[j], v + 4 * j); cvt4(yr[j], f + 4 * j); }
        const int rl = (r + nw < TL) ? r + nw : r;
#pragma unroll
        for (int j = 0; j < 4; ++j) { xr[j] = *(const u32x2*)(xl16_row(p, rl) + (j * 64 + lane) * 4); yr[j] = *(const u32x2*)(YL + (size_t)rl * D + (j * 64 + lane) * 4); }
        const int cond = r >> 13;
        if (cond != condp) { condp = cond; load_prod(mod_ptr(p, l, cond, 2), p.g_post_mix + l * D, lane, gtg); load_affine(p.g_pre_ffn + l * D, mod_ptr(p, l, cond, 4), mod_ptr(p, l, cond, 3), lane, am, bm); }
        const float rstd = rsqrtf(wave_sum(sumsq16(f)) * (1.f / D) + 1e-6f);
#pragma unroll
        for (int i = 0; i < 16; ++i) v[i] += gtg[i] * (f[i] * rstd);
        store_xl16(p, r, lane, v);
        const float rstd2 = rsqrtf(wave_sum(sumsq16(v)) * (1.f / D) + 1e-6f);
        emit_h(v, rstd2, am, bm, lane, (bf16_t*)(p.ws + WS_RA) + (size_t)r * D, p.ws + WS_H2E + (size_t)r * D);
    }
}

DEV void route_token(const Params& p, int l, float logit, int lane, int& myi, float& myw) {
    const float s = sigmoidf_(logit);
    const float sel = s + p.router_b[l * 64 + lane];
    int rank = 0;
#pragma unroll
    for (int k = 1; k < 8; ++k) { const float o = __shfl_xor(sel, k); const int ol = lane ^ k; rank += (o > sel || (o == sel && ol < lane)) ? 1 : 0; }
    float gs = rank < 2 ? sel : 0.f;
    gs += __shfl_xor(gs, 1); gs += __shfl_xor(gs, 2); gs += __shfl_xor(gs, 4);
    const int g = lane >> 3; int grank = 0;
#pragma unroll
    for (int k = 1; k < 8; ++k) { const float o = __shfl_xor(gs, 8 * k); const int og = g ^ k; grank += (o > gs || (o == gs && og < g)) ? 1 : 0; }
    float mv = grank < 4 ? sel : -INFINITY;
    float wsum = 0.f; myw = 0.f; myi = 0;
    for (int s8 = 0; s8 < 8; ++s8) {
        float mx = mv;
#pragma unroll
        for (int o = 32; o >= 1; o >>= 1) mx = fmaxf(mx, __shfl_xor(mx, o));
        const unsigned long long bal = __ballot(mv == mx);
        const int win = __ffsll((long long)bal) - 1;
        const float sw = __shfl(s, win);
        if (lane == s8) { myi = win; myw = sw; }
        wsum += sw;
        if (lane == win) mv = -INFINITY;
    }
    myw = myw / wsum * 2.5f;
}
DEV void route_rows(const Params& p, const Frame& F, int l, int r0) {
    int* hist = (int*)(F.ldsg); int* base = hist + 64; int* loc = hist + 128; float* locw = (float*)(hist + 128 + 2048);
    int* LISTA = (int*)(p.ws + WS_LISTA); float* LISTW = (float*)(p.ws + WS_LISTW);
    unsigned* CNT = (unsigned*)(p.ws + WS_CTL) + CW_CNT + l * 64;
    constexpr int rpw = 256;
    if (F.tid < 64) hist[F.tid] = 0;
    __syncthreads();
    const int ti = F.wave * 64 + F.lane;
    if (F.wave < 4) {
        const float* LOG = (const float*)(p.ws + WS_LOG) + (size_t)(r0 + ti) * 64;
        float sv[64], sel[64];
#pragma unroll
        for (int q = 0; q < 16; ++q) { const float4 t = *(const float4*)(LOG + 4 * q); sv[4 * q] = t.x; sv[4 * q + 1] = t.y; sv[4 * q + 2] = t.z; sv[4 * q + 3] = t.w; }
#pragma unroll
        for (int e = 0; e < 64; ++e) { sv[e] = fsigmoid(sv[e]); sel[e] = sv[e] + p.router_b[l * 64 + e]; }
        float gs[8];
#pragma unroll
        for (int g = 0; g < 8; ++g) { float m1 = fmaxf(sel[8 * g], sel[8 * g + 1]), m2 = fminf(sel[8 * g], sel[8 * g + 1]);
#pragma unroll
            for (int k = 2; k < 8; ++k) { const float x = sel[8 * g + k]; m2 = fmaxf(m2, fminf(m1, x)); m1 = fmaxf(m1, x); }
            gs[g] = m1 + m2; }
#pragma unroll
        for (int g = 0; g < 8; ++g) { int rank = 0;
#pragma unroll
            for (int k = 0; k < 8; ++k) if (k != g) rank += (gs[k] > gs[g] || (gs[k] == gs[g] && k < g)) ? 1 : 0;
            if (rank >= 4) {
#pragma unroll
                for (int k = 0; k < 8; ++k) sel[8 * g + k] = -INFINITY; } }
        float wsum = 0.f; int bi8[8]; float bw8[8];
#pragma unroll
        for (int s8 = 0; s8 < 8; ++s8) { float best = sel[0], bs = sv[0]; int bi = 0;
#pragma unroll
            for (int e = 1; e < 64; ++e) { const bool gt = sel[e] > best; best = gt ? sel[e] : best; bs = gt ? sv[e] : bs; bi = gt ? e : bi; }
#pragma unroll
            for (int e = 0; e < 64; ++e) sel[e] = (e == bi) ? -INFINITY : sel[e];
            bi8[s8] = bi; bw8[s8] = bs; wsum += bs; }
        const float sc = 2.5f / wsum;
#pragma unroll
        for (int s8 = 0; s8 < 8; ++s8) { const int rk = atomicAdd(&hist[bi8[s8]], 1); loc[ti * 8 + s8] = (bi8[s8] << 16) | rk; locw[ti * 8 + s8] = bw8[s8] * sc; }
    }
    __syncthreads();
    if (F.tid < 64) base[F.tid] = (int)__hip_atomic_fetch_add(CNT + F.tid, (unsigned)hist[F.tid], __ATOMIC_RELAXED, __HIP_MEMORY_SCOPE_AGENT);
    __syncthreads();
    for (int idx = F.tid; idx < rpw * 8; idx += NWAVES * 64) { const int v = loc[idx], e = v >> 16, rk = v & 0xffff; const int within = base[e] + rk;
        if (within < CAP) { const size_t pos = (size_t)e * CAP + within; LISTA[pos] = (r0 + (idx >> 3)) * 8 + (idx & 7); LISTW[pos] = locw[idx]; } }
    __syncthreads();
}
DEV void combine_pass(const Params& p, int hf, int nrows, int wave, int nw, int lane) {
    bf16_t* FS = (bf16_t*)(p.ws + WS_RY); const bf16_t* SL = (const bf16_t*)(p.ws + WS_SLOTS);
    for (int r = wave; r < nrows; r += nw) {
        bf16_t* fp = FS + (size_t)r * D + hf * 512 + lane * 8;
        f32x4 a0, a1; pg8::unpack8(*(const u32x4*)fp, a0, a1);
        u32x4 sv[8];
#pragma unroll
        for (int s = 0; s < 8; ++s) sv[s] = *(const u32x4*)(SL + ((size_t)r * 8 + s) * 512 + lane * 8);
#pragma unroll
        for (int s = 0; s < 8; ++s) { f32x4 b0, b1; pg8::unpack8(sv[s], b0, b1); a0 += b0; a1 += b1; }
        *(u32x4*)fp = pg8::pack8(a0, a1);
    }
}
DEV size_t summ_idx(int dir, int b, int pos, int which, int ch) { return ((((size_t)dir * 4 + b) * 66 + pos) * 2 + which) * 512 + ch; }
DEV f32x4 mfma16(bf16x8 a, bf16x8 b, f32x4 c) { return __builtin_amdgcn_mfma_f32_16x16x32_bf16(a, b, c, 0, 0, 0); }

template <int PASS>
DEV void chunk_pass(const Params& p, const Frame& F, int l_in, int c, bool do_gmlp) {
    int oz = 0; asm volatile("" : "+s"(oz));
    const int l = l_in + oz;
    const int lane = F.lane, h = F.wave, fr = lane & 15, fq = lane >> 4;
    const bf16_t* Z = (const bf16_t*)(p.ws + WS_Z); bf16_t* Y = (bf16_t*)(p.ws + WS_RY); float* SUMM = (float*)(p.ws + WS_SUMM);
    const unsigned char* W = p.ws + WS_W + oz;
    int r0, t0, n, b, posf, posb;
    if (c < 256) { b = c >> 6; const int k = c & 63; r0 = b * SEQ + k * 128; t0 = k * 128; n = SEQ; posf = 2 + k; posb = 2 + (63 - k); }
    else { const int cc = c - 256; b = cc >> 1; const int k = cc & 1; r0 = TL + b * CTXL + k * 128; t0 = k * 128; n = CTXL; posf = k; posb = 1 - k; }
    {
        LAS bf16_t* xcs = (LAS bf16_t*)(F.lds + h * 16384);
        TREG_BEGIN(1);
        bf16_t* XCT = (bf16_t*)(p.ws + WS_XCT) + ((size_t)c * 8 + h) * 8192;
        if (PASS == 1) {
            u32x4 t[16];
#pragma unroll
            for (int k = 0; k < 16; ++k) t[k] = *(const u32x4*)(XCT + (k * 64 + lane) * 8);
#pragma unroll
            for (int k = 0; k < 16; ++k) *(LAS u32x4*)(xcs + (k * 64 + lane) * 8) = t[k];
        } else {
            const int cg = lane & 7, rsub = lane >> 3, ch0 = h * 64 + cg * 8;
            float w[4][8], cb[8];
#pragma unroll
            for (int k = 0; k < 4; ++k) { const float4 a = *(const float4*)(p.conv_w + (size_t)(l * 4 + k) * 512 + ch0), bb = *(const float4*)(p.conv_w + (size_t)(l * 4 + k) * 512 + ch0 + 4);
                w[k][0] = a.x; w[k][1] = a.y; w[k][2] = a.z; w[k][3] = a.w; w[k][4] = bb.x; w[k][5] = bb.y; w[k][6] = bb.z; w[k][7] = bb.w; }
            { const float4 a = *(const float4*)(p.conv_b + l * 512 + ch0), bb = *(const float4*)(p.conv_b + l * 512 + ch0 + 4);
                cb[0] = a.x; cb[1] = a.y; cb[2] = a.z; cb[3] = a.w; cb[4] = bb.x; cb[5] = bb.y; cb[6] = bb.z; cb[7] = bb.w; }
            const bf16_t* Zx = Z + (size_t)r0 * 4096 + 1024 + ch0;
#pragma unroll 1
            for (int it = 0; it < 2; ++it) {
                const int tb = (it * 8 + rsub) * 8;
                u32x4 raw[11];
#pragma unroll
                for (int k = 0; k < 11; ++k) { const int tt = t0 + tb + k - 2; const int rowc = (tt >= 0 && tt < n) ? (tb + k - 2) : tb;
                    raw[k] = *(const u32x4*)(Zx + (long)rowc * 4096); }
#pragma unroll
                for (int k = 0; k < 11; ++k) { const int tt = t0 + tb + k - 2; if (!(tt >= 0 && tt < n)) raw[k] = (u32x4){0u, 0u, 0u, 0u}; }
#pragma unroll
                for (int o = 0; o < 8; ++o) {
                    float y[8];
#pragma unroll
                    for (int j = 0; j < 8; ++j) y[j] = cb[j];
#pragma unroll
                    for (int k = 0; k < 4; ++k) { f32x4 x0, x1; pg8::unpack8(raw[o + k], x0, x1);
#pragma unroll
                        for (int j = 0; j < 4; ++j) { y[j] += w[k][j] * x0[j]; y[4 + j] += w[k][4 + j] * x1[j]; } }
                    const u32x4 pk = pg8::pack8((f32x4){y[0], y[1], y[2], y[3]}, (f32x4){y[4], y[5], y[6], y[7]});
                    *(LAS u32x4*)(xcs + (tb + o) * 64 + cg * 8) = pk; *(u32x4*)(XCT + (tb + o) * 64 + cg * 8) = pk;
                }
            }
        }
        asm volatile("s_waitcnt lgkmcnt(0)" ::: "memory");
        TREG_END(1, F);
        TREG_BEGIN(2);
        float carry0 = 0.f, carry1 = 0.f;
        if (PASS == 1) {
            const int chl = h * 64 + lane;
#pragma unroll
            for (int dir = 0; dir < 2; ++dir) {
                const int np = dir ? posb : posf; float cr = 0.f;
                for (int q0 = 0; q0 < np; q0 += 16) { float a8[16], h8[16];
#pragma unroll
                    for (int j = 0; j < 16; ++j) { const int q = (q0 + j < np) ? q0 + j : np - 1; a8[j] = SUMM[summ_idx(dir, b, q, 0, chl)]; h8[j] = SUMM[summ_idx(dir, b, q, 1, chl)]; }
#pragma unroll
                    for (int j = 0; j < 16; ++j) if (q0 + j < np) cr = a8[j] * cr + h8[j]; }
                if (dir) carry1 = cr; else carry0 = cr;
            }
        }
        TREG_END(2, F);
        TREG_BEGIN(3);
#pragma unroll 1
        for (int ct = 0; ct < 4; ++ct) {
            const int chc = h * 64 + ct * 16 + fr;
            float hsum[8][4];
            u32x4 gbr[2][2];
            if (PASS == 1) {
#pragma unroll
                for (int hv = 0; hv < 2; ++hv) { const bf16_t* gp = Z + (size_t)(r0 + hv * 64 + lane) * 4096 + 1536 + h * 64 + ct * 16; gbr[hv][0] = *(const u32x4*)gp; gbr[hv][1] = *(const u32x4*)(gp + 8); }
            }
            bf16x8 wfr[2][4]; float bias_a2[2], bias_x2[2], spc2[2];
#pragma unroll
            for (int dir = 0; dir < 2; ++dir) {
                const bf16_t* wa = (const bf16_t*)(W + WO_LRU) + (size_t)(0 * 16 + dir * 8 + h) * 4096 + (size_t)(ct * 16 + fr) * 64 + 8 * fq;
                const bf16_t* wx = (const bf16_t*)(W + WO_LRU) + (size_t)(1 * 16 + dir * 8 + h) * 4096 + (size_t)(ct * 16 + fr) * 64 + 8 * fq;
                wfr[dir][0] = *(const bf16x8*)(wa); wfr[dir][1] = *(const bf16x8*)(wa + 32); wfr[dir][2] = *(const bf16x8*)(wx); wfr[dir][3] = *(const bf16x8*)(wx + 32);
                bias_a2[dir] = -1.4426950408889634f * p.lru_ba[(l * 2 + dir) * 512 + chc]; bias_x2[dir] = -1.4426950408889634f * p.lru_bx[(l * 2 + dir) * 512 + chc];
                spc2[dir] = -8.0f * log1pf(expf(-p.lru_lam[(l * 2 + dir) * 512 + chc])) * 1.4426950408889634f;
            }
#pragma unroll
            for (int dir = 0; dir < 2; ++dir) {
                const bf16x8 ba0 = wfr[dir][0], ba1 = wfr[dir][1], bx0 = wfr[dir][2], bx1 = wfr[dir][3];
                const float bias_a = bias_a2[dir], bias_x = bias_x2[dir], spc = spc2[dir];
                float Hrun = 0.f, Arun = 1.f;
                if (PASS == 1) Hrun = __shfl(dir ? carry1 : carry0, ct * 16 + fr);
                const int mypos = dir ? 3 - fq : fq;
#pragma unroll
                for (int grp = 0; grp < 2; ++grp) {
                    float av[4][4], dv[4][4], Ap[4], Hp[4], At[4], Ht[4];
#pragma unroll
                    for (int rq = 0; rq < 4; ++rq) {
                        const int rr = grp * 4 + rq, rt = dir ? 7 - rr : rr;
                        const bf16x8 f0 = *(const LAS bf16x8*)(xcs + (rt * 16 + fr) * 64 + 8 * fq), f1 = *(const LAS bf16x8*)(xcs + (rt * 16 + fr) * 64 + 32 + 8 * fq);
                        f32x4 aa = {bias_a, bias_a, bias_a, bias_a}, ax = {bias_x, bias_x, bias_x, bias_x};
                        aa = mfma16(f0, ba0, aa); aa = mfma16(f1, ba1, aa);
                        ax = mfma16(f0, bx0, ax); ax = mfma16(f1, bx1, ax);
#pragma unroll
                        for (int i = 0; i < 4; ++i) {
                            const float xc = bf2f(xcs[(rt * 16 + 4 * fq + i) * 64 + ct * 16 + fr]);
                            const float rg = __builtin_amdgcn_rcpf(1.f + __builtin_amdgcn_exp2f(aa[i])), ig = __builtin_amdgcn_rcpf(1.f + __builtin_amdgcn_exp2f(ax[i]));
                            const float a = __builtin_amdgcn_exp2f(spc * rg);
                            av[rq][i] = a; dv[rq][i] = __builtin_amdgcn_sqrtf(fmaxf(1.f - a * a, 0.f)) * (ig * xc);
                        }
                        float Al = 1.f, Hl = 0.f;
#pragma unroll
                        for (int s = 0; s < 4; ++s) { const int i = dir ? 3 - s : s; Hl = av[rq][i] * Hl + dv[rq][i]; Al = av[rq][i] * Al; }
                        float ap = 1.f, hp = 0.f, at = 1.f, ht = 0.f;
#pragma unroll
                        for (int s = 0; s < 4; ++s) { const int g = dir ? 3 - s : s; const float Ag = __shfl(Al, fr + 16 * g), Hg = __shfl(Hl, fr + 16 * g);
                            ht = Ag * ht + Hg; at = Ag * at;
                            const bool before = s < mypos; hp = before ? Ag * hp + Hg : hp; ap = before ? Ag * ap : ap; }
                        Ap[rq] = ap; Hp[rq] = hp; At[rq] = at; Ht[rq] = ht;
                    }
#pragma unroll
                    for (int rq = 0; rq < 4; ++rq) {
                        const int rr = grp * 4 + rq, rt = dir ? 7 - rr : rr;
                        if (PASS == 1) {
                            float hc = Ap[rq] * Hrun + Hp[rq];
#pragma unroll
                            for (int s = 0; s < 4; ++s) { const int i = dir ? 3 - s : s; hc = av[rq][i] * hc + dv[rq][i]; if (dir == 0) hsum[rt][i] = hc; else hsum[rt][i] += hc; }
                        }
                        Hrun = At[rq] * Hrun + Ht[rq]; Arun = At[rq] * Arun;
                    }
                    asm volatile("" ::: "memory");
                }
                if (PASS == 0 && fq == 0) { const int pos = dir ? posb : posf; SUMM[summ_idx(dir, b, pos, 0, chc)] = Arun; SUMM[summ_idx(dir, b, pos, 1, chc)] = Hrun; }
            }
            if (PASS == 1) {
                LAS bf16_t* sp = (LAS bf16_t*)(F.lds + SPW_OFF + h * SPW_BYTES);
#pragma unroll
                for (int hv = 0; hv < 2; ++hv) {
#pragma unroll
                    for (int j = 0; j < 4; ++j)
#pragma unroll
                        for (int i = 0; i < 4; ++i) sp[(j * 16 + 4 * fq + i) * 16 + fr] = f2bf(hsum[hv * 4 + j][i]);
                    asm volatile("s_waitcnt lgkmcnt(0)" ::: "memory");
                    const u32x4 s0 = *(const LAS u32x4*)(sp + lane * 16), s1 = *(const LAS u32x4*)(sp + lane * 16 + 8);
                    asm volatile("s_waitcnt lgkmcnt(0)" ::: "memory");
                    f32x4 a0, a1, b0, b1, g0, g1, g2, g3; pg8::unpack8(s0, a0, a1); pg8::unpack8(s1, b0, b1); pg8::unpack8(gbr[hv][0], g0, g1); pg8::unpack8(gbr[hv][1], g2, g3);
                    bf16_t* yp = Y + (size_t)(r0 + hv * 64 + lane) * D + 512 + h * 64 + ct * 16;
                    *(u32x4*)yp = pg8::pack8(a0 * g0, a1 * g1); *(u32x4*)(yp + 8) = pg8::pack8(b0 * g2, b1 * g3);
                }
            }
        }
        asm volatile("s_waitcnt vmcnt(0)" ::: "memory");
        TREG_END(3, F);
    }
    if (PASS == 0 && do_gmlp) {
        typedef float f32x2 __attribute__((ext_vector_type(2)));
        LAS f32x2* stats = (LAS f32x2*)(F.lds + STATS_OFF);
        TREG_BEGIN(4);
#pragma unroll 1
        for (int i0 = 0; i0 < 16; i0 += 8) {
            f32x4 v0[8], v1[8]; float mu[8], var[8];
#pragma unroll
            for (int j = 0; j < 8; ++j) pg8::unpack8(*(const u32x4*)(Z + (size_t)(r0 + F.wave * 16 + i0 + j) * 4096 + 512 + lane * 8), v0[j], v1[j]);
#pragma unroll
            for (int j = 0; j < 8; ++j) mu[j] = (v0[j][0] + v0[j][1]) + (v0[j][2] + v0[j][3]) + (v1[j][0] + v1[j][1]) + (v1[j][2] + v1[j][3]);
#pragma unroll
            for (int o = 1; o < 64; o <<= 1) {
#pragma unroll
                for (int j = 0; j < 8; ++j) mu[j] += __shfl_xor(mu[j], o); }
#pragma unroll
            for (int j = 0; j < 8; ++j) { mu[j] *= (1.f / 512.f); v0[j] -= mu[j]; v1[j] -= mu[j];
                var[j] = (v0[j][0] * v0[j][0] + v0[j][1] * v0[j][1]) + (v0[j][2] * v0[j][2] + v0[j][3] * v0[j][3]) + (v1[j][0] * v1[j][0] + v1[j][1] * v1[j][1]) + (v1[j][2] * v1[j][2] + v1[j][3] * v1[j][3]); }
#pragma unroll
            for (int o = 1; o < 64; o <<= 1) {
#pragma unroll
                for (int j = 0; j < 8; ++j) var[j] += __shfl_xor(var[j], o); }
            float m_ = mu[0], v_ = var[0];
#pragma unroll
            for (int j = 1; j < 8; ++j) { m_ = (lane == j) ? mu[j] : m_; v_ = (lane == j) ? var[j] : v_; }
            if (lane < 8) stats[F.wave * 16 + i0 + lane] = (f32x2){m_, rsqrtf(v_ * (1.f / 512.f) + 1e-5f)};
        }
        TREG_END(4, F);
        __syncthreads();
        TREG_BEGIN(5);
        const int g = F.wave;
        const bf16_t* Wg = (const bf16_t*)(W + WO_GWS) + (size_t)g * 128 * 128;
        LAS bf16_t* vn = (LAS bf16_t*)(F.lds + g * 16384);
        LAS bf16_t* sp = (LAS bf16_t*)(F.lds + SPW_OFF + g * SPW_BYTES);
        {
            const int cg = lane & 7, rsub = lane >> 3, ch0 = g * 64 + cg * 8;
            float lg[8], lb[8];
            { const float4 a = *(const float4*)(p.ln_g + l * 512 + ch0), bb = *(const float4*)(p.ln_g + l * 512 + ch0 + 4), c4 = *(const float4*)(p.ln_b + l * 512 + ch0), d4 = *(const float4*)(p.ln_b + l * 512 + ch0 + 4);
                lg[0] = a.x; lg[1] = a.y; lg[2] = a.z; lg[3] = a.w; lg[4] = bb.x; lg[5] = bb.y; lg[6] = bb.z; lg[7] = bb.w;
                lb[0] = c4.x; lb[1] = c4.y; lb[2] = c4.z; lb[3] = c4.w; lb[4] = d4.x; lb[5] = d4.y; lb[6] = d4.z; lb[7] = d4.w; }
            const bf16_t* Zv = Z + (size_t)r0 * 4096 + 512 + ch0;
#pragma unroll 1
            for (int i8 = 0; i8 < 16; i8 += 8) {
                u32x4 raw[8];
#pragma unroll
                for (int it = 0; it < 8; ++it) raw[it] = *(const u32x4*)(Zv + (long)((i8 + it) * 8 + rsub) * 4096);
#pragma unroll
                for (int it = 0; it < 8; ++it) { const int q = (i8 + it) * 8 + rsub; const f32x2 st = stats[q]; f32x4 x0, x1; pg8::unpack8(raw[it], x0, x1);
#pragma unroll
                    for (int j = 0; j < 4; ++j) { x0[j] = (x0[j] - st.x) * st.y * lg[j] + lb[j]; x1[j] = (x1[j] - st.x) * st.y * lg[4 + j] + lb[4 + j]; }
                    *(LAS u32x4*)(vn + q * 64 + cg * 8) = pg8::pack8(x0, x1); }
            }
        }
        asm volatile("s_waitcnt lgkmcnt(0)" ::: "memory");
        bf16x8 bfr[4][4];
#pragma unroll
        for (int ct = 0; ct < 4; ++ct)
#pragma unroll
            for (int ks = 0; ks < 4; ++ks) { unsigned wd[4];
#pragma unroll
                for (int j2 = 0; j2 < 4; ++j2) { const unsigned lo = vn[(ks * 32 + 8 * fq + 2 * j2) * 64 + ct * 16 + fr], hi = vn[(ks * 32 + 8 * fq + 2 * j2 + 1) * 64 + ct * 16 + fr]; wd[j2] = lo | (hi << 16); }
                bfr[ct][ks] = __builtin_bit_cast(bf16x8, (u32x4){wd[0], wd[1], wd[2], wd[3]}); }
        const bf16_t* Zu = Z + (size_t)r0 * 4096 + g * 64; bf16_t* Yu = Y + (size_t)r0 * D + g * 64;
        const int orow = lane >> 2, och = (lane & 3) * 16;
#pragma unroll 1
        for (int rt = 0; rt < 8; ++rt) {
            bf16x8 af[4];
#pragma unroll
            for (int ks = 0; ks < 4; ++ks) af[ks] = *(const bf16x8*)(Wg + (unsigned)((rt * 16 + fr) * 128 + ks * 32 + 8 * fq));
            const float4 bsv = *(const float4*)(p.gbs + (l * 8 + g) * 128 + rt * 16 + 4 * fq);
            const u32x4 u0 = *(const u32x4*)(Zu + (long)(rt * 16 + orow) * 4096 + och), u1 = *(const u32x4*)(Zu + (long)(rt * 16 + orow) * 4096 + och + 8);
            const float bs4[4] = {bsv.x, bsv.y, bsv.z, bsv.w};
#pragma unroll
            for (int ct = 0; ct < 4; ++ct) {
                f32x4 acc = {0.f, 0.f, 0.f, 0.f};
#pragma unroll
                for (int ks = 0; ks < 4; ++ks) acc = mfma16(af[ks], bfr[ct][ks], acc);
#pragma unroll
                for (int i = 0; i < 4; ++i) sp[(4 * fq + i) * 64 + ct * 16 + fr] = f2bf(acc[i] + bs4[i]);
            }
            asm volatile("s_waitcnt lgkmcnt(0)" ::: "memory");
            const u32x4 m0 = *(const LAS u32x4*)(sp + orow * 64 + och), m1 = *(const LAS u32x4*)(sp + orow * 64 + och + 8);
            asm volatile("s_waitcnt lgkmcnt(0)" ::: "memory");
            f32x4 a0, a1, b0, b1, c0, c1, d0, d1; pg8::unpack8(m0, a0, a1); pg8::unpack8(m1, b0, b1); pg8::unpack8(u0, c0, c1); pg8::unpack8(u1, d0, d1);
            bf16_t* yp = Yu + (long)(rt * 16 + orow) * D + och;
            *(u32x4*)yp = pg8::pack8(a0 * c0, a1 * c1); *(u32x4*)(yp + 8) = pg8::pack8(b0 * d0, b1 * d1);
        }
        asm volatile("s_waitcnt vmcnt(0)" ::: "memory"); TREG_END(5, F);
    }
    __syncthreads();
}
constexpr int NPL = 10, PH_FINAL = 1 + 2 * NPL, PH_END = PH_FINAL + 1;
struct Args { Params p; int ph_lo, ph_hi; };

DEV void build_toff(const Params& p, const Frame& F, int l, LAS int* toff) {
    if (F.tid < NE) { const unsigned* CNT = (const unsigned*)(p.ws + WS_CTL) + CW_CNT + l * 64;
        int cn = (int)__hip_atomic_load(CNT + F.tid, __ATOMIC_RELAXED, __HIP_MEMORY_SCOPE_AGENT); cn = cn < CAP ? cn : CAP;
        const int tiles = (cn + 255) >> 8; int incl = tiles;
#pragma unroll
        for (int o = 1; o < 64; o <<= 1) { const int t = __shfl_up(incl, o); if (F.lane >= o) incl += t; }
        const int excl = incl - tiles;
        toff[F.tid] = excl < 1120 ? excl : 1120; toff[80 + F.tid] = cn;
        if (F.tid == NE - 1) toff[64] = incl < 1120 ? incl : 1120; }
    __syncthreads();
    if (F.tid < NE) { LAS unsigned char* te = (LAS unsigned char*)(F.lds + SPW_OFF); for (int t = toff[F.tid]; t < toff[F.tid + 1]; ++t) te[t] = (unsigned char)F.tid; }
    __syncthreads();
}

template <int ph> DEV void run_phase(const Frame& F0) {
    Frame F = F0; { unsigned z_ = 0; asm volatile("" : "+v"(z_)); F.lane = (int)__builtin_amdgcn_mbcnt_hi(~0u, __builtin_amdgcn_mbcnt_lo(~0u, z_)); F.tid = F.wave * 64 + F.lane; }
    asm volatile("" : "+s"(F.G), "+s"(F.bx));
    const Params p = load_params(F);
    unsigned char* ws = p.ws; unsigned char* W = ws + WS_W;
    LAS int* toff = (LAS int*)(F.lds + MISC_OFF + 256);
    const int gw = F.bx * NWAVES + F.wave, NGW = F.G * NWAVES;
#ifndef NOPRO
    if (ph == 0) { if (F.bx == 0 && F.tid < 128) __hip_atomic_store((unsigned*)(p.ws + WS_CTL) + CW_CNT + F.tid, 0u, __ATOMIC_RELAXED, __HIP_MEMORY_SCOPE_AGENT);
        if (F.bx >= 192) { pe_table(p, F, (F.bx - 192) * 1024 + F.tid); pe_table(p, F, (F.bx - 192) * 1024 + 512 + F.tid); }
        mod_items(p, F); __syncthreads(); convert_weights(p, F, 0, 0, gw, NGW); return; }
    if (ph == PH_FINAL) { row_lat_A(p, 2, gw, NGW, F.lane); return; }
#endif
    constexpr int l = (ph - 1) / NPL, k = (ph - 1) % NPL;
    constexpr int nr = (l == 0) ? R : TL;
#ifndef PMASK
#define PMASK 0xffff
#endif
#define PON(k_) ((PMASK >> (k_)) & 1)
    switch (k) {
    case 0: if (PON(0)) { if (l > 0) convert_weights(p, F, l, 0, gw, NGW);
        if (l == 0) row_lat_A0(p, gw, NGW, F.lane); else row_lat_A(p, l, gw, NGW, F.lane);
        row_pass_A(p, l, TL, R, gw, NGW, F.lane); } break;
    case 1: if (PON(1)) {
#if GIN_FP8
        pg8::DenseSched<512, WS_H8, WS_W + WO_IN> S; S.init(ws, R, 4096, F.bx); pg8::EpiZ E{ws};
        pg8::gemm_phase<pg8::EpiZ, decltype(S), true, 0x7b>(F.lds, F.tid, S, E);
#else
        pg8::DenseSched<D, WS_RY, WS_W + WO_IN> S; S.init(ws, R, 4096, F.bx); pg8::EpiZ E{ws};
        pg8::gemm_phase<pg8::EpiZ, decltype(S), true>(F.lds, F.tid, S, E);
#endif
        if (F.bx >= 64) convert_weights(p, F, l, 2, (F.bx - 64) * NWAVES + F.wave, 192 * NWAVES); } break;
    case 2: if (PON(2)) { for (int c = F.bx; c < NCHUNK; c += F.G) chunk_pass<0>(p, F, l, c, l == 0 || c < 256);
        if (F.bx >= NCHUNK - F.G) { convert_weights(p, F, l, 1, (F.bx - (NCHUNK - F.G)) * NWAVES + F.wave, (2 * F.G - NCHUNK) * NWAVES); } } break;
    case 3: if (PON(3)) for (int c = F.bx; c < (l == 0 ? NCHUNK : 256); c += F.G) chunk_pass<1>(p, F, l, c, false); break;
    case 4: if (PON(4)) { pg8::DenseSched<D, WS_RY, WS_W + WO_AB> S; S.init(ws, nr, D, F.bx); pg8::EpiAB E{ws};
        pg8::gemm_phase<pg8::EpiAB, decltype(S), true>(F.lds, F.tid, S, E); } break;
    case 5: if (PON(5)) { pg8::DenseSched<D, WS_RA, WS_W + WO_OUT> S; S.init(ws, nr, D, F.bx); pg8::EpiPlain<WS_Z> E{ws};
        pg8::gemm_phase<pg8::EpiPlain<WS_Z>, decltype(S), true>(F.lds, F.tid, S, E); } break;
    case 6: if (PON(6)) { row_lat_H(p, l, gw, NGW, F.lane); if (nr > TL) row_pass_H(p, l, TL, nr, gw, NGW, F.lane); } break;
    case 7: if (PON(7)) { pg8::DenseSched<D, WS_RA, WS_W + WO_SR> S; S.init(ws, nr, 768, F.bx); pg8::EpiSR E{ws};
        pg8::gemm_phase<pg8::EpiSR, decltype(S), true>(F.lds, F.tid, S, E);
        asm volatile("s_waitcnt vmcnt(0)" ::: "memory"); __syncthreads();
        for (int i = 0;; ++i) { pg8::UnitD u; if (!S.next(i, u)) break; if (u.pn == 0) route_rows(p, F, l, u.pm * 256); } } break;
    case 8: if (PON(8)) { build_toff(p, F, l, toff);
        { pg8::ExpSched<512, 1, 2, WS_H2E, WS_W + WO_EG, (size_t)512 * D> S; S.ws = ws; S.lds = F.lds; S.U = toff[64] * 2; S.c = F.bx; S.brow0 = 0; S.Krt = 512;
          pg8::EpiEG<0> E{ws};
          pg8::gemm_phase<pg8::EpiEG<0>, decltype(S), true, 0x7b>(F.lds, F.tid, S, E); }
#if GSD_FP8
        { pg8::DenseSched<128, WS_SH, WS_W + WO_SD> S; S.init(ws, nr, D, 255 - F.bx); pg8::EpiPlain<WS_RY> E{ws};
          pg8::gemm_phase<pg8::EpiPlain<WS_RY>, decltype(S), true, 0x7c>(F.lds, F.tid, S, E); } } break;
#else
        { pg8::DenseSched<256, WS_SH, WS_W + WO_SD> S; S.init(ws, nr, D, 255 - F.bx); pg8::EpiPlain<WS_RY> E{ws};
          pg8::gemm_phase<pg8::EpiPlain<WS_RY>, decltype(S), true>(F.lds, F.tid, S, E); } } break;
#endif
    case 9: if (PON(9)) { build_toff(p, F, l, toff);
#if GED_FP8
        pg8::ExpSched<128, 0, 4, WS_HM, WS_W + WO_ED, (size_t)D * 256> S; S.ws = ws; S.lds = F.lds; S.U = toff[64] * 4; S.c = F.bx; S.brow0 = 0; S.Krt = 128;
        pg8::EpiED E{ws, F.lds};
        pg8::gemm_phase<pg8::EpiED, decltype(S), true, 0x7c>(F.lds, F.tid, S, E); } break;
#else
        pg8::ExpSched<256, 0, 4, WS_HM, WS_W + WO_ED, (size_t)D * 256 * 2> S; S.ws = ws; S.lds = F.lds; S.U = toff[64] * 4; S.c = F.bx; S.brow0 = 0; S.Krt = 256;
        pg8::EpiED E{ws, F.lds};
        pg8::gemm_phase<pg8::EpiED, decltype(S), true>(F.lds, F.tid, S, E); } break;
#endif
    }
}

__global__ void __launch_bounds__(NWAVES * 64, 2) mk_fwd(Args a) {
    extern __shared__ __attribute__((aligned(16))) unsigned char lds_raw[];
    Frame F; F.lds = (LAS unsigned char*)lds_raw; F.ldsg = lds_raw; F.tid = threadIdx.x; F.lane = F.tid & 63; F.wave = __builtin_amdgcn_readfirstlane(F.tid >> 6); F.G = gridDim.x; F.bx = blockIdx.x;
    volatile LAS unsigned* MISC = (volatile LAS unsigned*)(F.lds + MISC_OFF);
    for (int u = F.tid; u < (LDS_BYTES - MISC_OFF) / 4; u += NWAVES * 64) MISC[u] = 0u;
    store_params(F, a.p);
    __syncthreads();
    XcdBarrier bar; bar.bar = (GAS unsigned*)(a.p.ws + WS_CTL) + CW_BAR; bar.x = 0; bar.st = nullptr;
    const bool multi = a.ph_hi - a.ph_lo > 1;
    if (multi) bar = xcd_barrier_post((GAS unsigned*)(a.p.ws + WS_CTL) + CW_BAR, MISC);
#ifdef DELAYMASK
#define MK_PH(k_) if (a.ph_lo <= (k_) && (k_) < a.ph_hi) { const unsigned long long t0_ = __builtin_amdgcn_s_memrealtime(); run_phase<(k_)>(F); \
        { constexpr int kind = ((k_) == 0) ? 15 : ((k_) == PH_FINAL ? 0 : ((k_) - 1) % NPL); \
          if ((DELAYMASK >> kind) & 1) { __syncthreads(); const unsigned long long t1_ = __builtin_amdgcn_s_memrealtime(); while (__builtin_amdgcn_s_memrealtime() - t1_ < t1_ - t0_) __builtin_amdgcn_s_sleep(8); } } \
        if ((k_) + 1 < a.ph_hi) xcd_barrier(bar); }
#elif defined(PROBE_REGION)
#define MK_PH(k_) if (a.ph_lo <= (k_) && (k_) < a.ph_hi) { run_phase<(k_)>(F); \
        { __syncthreads(); const unsigned long long t1_ = __builtin_amdgcn_s_memrealtime(); const unsigned long long dt_ = MISC[16]; while (__builtin_amdgcn_s_memrealtime() - t1_ < dt_) __builtin_amdgcn_s_sleep(8); __syncthreads(); if (F.tid == 0) MISC[16] = 0u; } \
        if ((k_) + 1 < a.ph_hi) xcd_barrier(bar); }
#else
#define MK_PH(k_) if (a.ph_lo <= (k_) && (k_) < a.ph_hi) { run_phase<(k_)>(F); if ((k_) + 1 < a.ph_hi) xcd_barrier(bar); }
#endif
    MK_PH(0) MK_PH(1) MK_PH(2) MK_PH(3) MK_PH(4) MK_PH(5) MK_PH(6) MK_PH(7) MK_PH(8) MK_PH(9) MK_PH(10)
    MK_PH(11) MK_PH(12) MK_PH(13) MK_PH(14) MK_PH(15) MK_PH(16) MK_PH(17) MK_PH(18) MK_PH(19) MK_PH(20) MK_PH(21)
#undef MK_PH
}
#ifndef FAST
#define FAST 0x1ff
#endif
#if FAST != 0x1ff
constexpr size_t WS_NV1 = 538 * MiB;
constexpr size_t WS_NSG = 291 * MiB, WS_NFLS = 324 * MiB;
__global__ void __launch_bounds__(256) k_mod(Params p) {
    const int e = blockIdx.x * 256 + threadIdx.x, cond = blockIdx.y, l = blockIdx.z;
    const float* cv = cond < 4 ? p.c + cond * D : p.c_ctx;
    const float* w = p.w_mod + (size_t)l * D * 6 * D;
    float acc = p.b_mod[l * 6 * D + e];
    for (int d = 0; d < D; ++d) acc += siluf_(cv[d]) * w[(size_t)d * 6 * D + e];
    ((float*)(p.ws + WS_MOD))[(size_t)(l * 5 + cond) * 6 * D + e] = acc;
}
__global__ void __launch_bounds__(256) k_rowA(Params p, int l) { row_pass_A(p, l, (blockIdx.x * 256 + threadIdx.x) >> 6, (gridDim.x * 256) >> 6, threadIdx.x & 63); }
__global__ void __launch_bounds__(256) k_rowH(Params p, int l, int nrows) { row_pass_H(p, l, nrows, (blockIdx.x * 256 + threadIdx.x) >> 6, (gridDim.x * 256) >> 6, threadIdx.x & 63); }
struct ABf16 { const bf16_t* A; int lda, coff; DEV float operator()(int m, int k) const { return bf2f(A[(size_t)m * lda + coff + k]); } };
struct BF32 { const float* B; int ldb, pad; DEV float operator()(int k, int n) const { return B[(size_t)k * ldb + n]; } };
struct BAB { const float* Ba; const float* Bb; DEV float operator()(int k, int n) const { return k < 512 ? Ba[(size_t)k * D + n] : Bb[(size_t)(k - 512) * D + n]; } };
struct NEpiZ { bf16_t* Z; DEV void operator()(int m, int n, float v, float) const {
    float o; if (n < 1024) o = gelu_tanh(v); else if (n < 1536) o = v; else if (n < 2048) o = gelu_tanh(v); else o = sigmoidf_(v);
    Z[(size_t)m * 4096 + n] = f2bf(o); } };
struct NEpiF32 { float* C; int ldc, pad; DEV void operator()(int m, int n, float v, float) const { C[(size_t)m * ldc + n] = v; } };
struct NEpiBf { bf16_t* C; int ldc, pad; DEV void operator()(int m, int n, float v, float) const { C[(size_t)m * ldc + n] = f2bf(v); } };
struct NEpiMerge { const bf16_t* Z; bf16_t* M; DEV void operator()(int m, int n, float vb, float va) const {
    const float ga = bf2f(Z[(size_t)m * 4096 + 2048 + n]), gr = bf2f(Z[(size_t)m * 4096 + 3072 + n]);
    M[(size_t)m * D + n] = f2bf(ga * va + gr * vb); } };
struct NEpiSwi { const float* SG; bf16_t* SH; DEV void operator()(int m, int n, float v, float) const { SH[(size_t)m * 256 + n] = f2bf(siluf_(SG[(size_t)m * 256 + n]) * v); } };
template <class AL, class BL, class EP, int SPLIT>
__global__ void __launch_bounds__(256) k_gemm(AL al, BL bl, EP ep, int K) {
    __shared__ __attribute__((aligned(16))) float As[16][68];
    __shared__ __attribute__((aligned(16))) float Bs[16][68];
    const int tid = threadIdx.x, tx = tid & 15, ty = tid >> 4, m0 = blockIdx.y * 64, n0 = blockIdx.x * 64;
    float acc[4][4], acc2[4][4];
#pragma unroll
    for (int i = 0; i < 4; ++i)
#pragma unroll
        for (int j = 0; j < 4; ++j) { acc[i][j] = 0.f; acc2[i][j] = 0.f; }
    for (int k0 = 0; k0 < K; k0 += 16) {
        if (SPLIT && k0 == SPLIT) {
#pragma unroll
            for (int i = 0; i < 4; ++i)
#pragma unroll
                for (int j = 0; j < 4; ++j) { acc2[i][j] = acc[i][j]; acc[i][j] = 0.f; }
        }
#pragma unroll
        for (int i = 0; i < 4; ++i) { const int e = tid + 256 * i, kk = e & 15, mm = e >> 4; As[kk][mm] = al(m0 + mm, k0 + kk); }
#pragma unroll
        for (int i = 0; i < 4; ++i) { const int e = tid + 256 * i, nn = e & 63, kk = e >> 6; Bs[kk][nn] = bl(k0 + kk, n0 + nn); }
        __syncthreads();
#pragma unroll
        for (int kk = 0; kk < 16; ++kk) {
            const float4 a = *(const float4*)&As[kk][ty * 4]; const float4 b = *(const float4*)&Bs[kk][tx * 4];
            const float av[4] = {a.x, a.y, a.z, a.w}, bv[4] = {b.x, b.y, b.z, b.w};
#pragma unroll
            for (int i = 0; i < 4; ++i)
#pragma unroll
                for (int j = 0; j < 4; ++j) acc[i][j] += av[i] * bv[j];
        }
        __syncthreads();
    }
#pragma unroll
    for (int i = 0; i < 4; ++i)
#pragma unroll
        for (int j = 0; j < 4; ++j) ep(m0 + ty * 4 + i, n0 + tx * 4 + j, acc[i][j], acc2[i][j]);
}
__global__ void __launch_bounds__(256) k_conv(Params p, int l) {
    const size_t idx = (size_t)blockIdx.x * 256 + threadIdx.x; const int r = (int)(idx >> 9), ch = (int)(idx & 511);
    const bf16_t* Z = (const bf16_t*)(p.ws + WS_Z); float* XCONV = (float*)(p.ws + WS_NV1);
    int t, n; if (r < TL) { t = r & (SEQ - 1); n = SEQ; } else { t = (r - TL) & (CTXL - 1); n = CTXL; }
    const int base = r - t;
    float y = p.conv_b[l * 512 + ch];
#pragma unroll
    for (int k = 0; k < 4; ++k) { const int tt = t + k - 2; if (tt >= 0 && tt < n) y += p.conv_w[(l * 4 + k) * 512 + ch] * bf2f(Z[(size_t)(base + tt) * 4096 + 1024 + ch]); }
    XCONV[(size_t)r * 512 + ch] = y;
}
__global__ void __launch_bounds__(64) k_scan(Params p, int l, int dir) {
    const int b = blockIdx.x >> 3, h = blockIdx.x & 7, j = threadIdx.x, ch = h * 64 + j;
    const float* XCONV = (const float*)(p.ws + WS_NV1); float* HS = (float*)(p.ws + WS_RA);
    const float* wa = p.lru_wa + (size_t)((l * 2 + dir) * 8 + h) * 4096; const float* wx = p.lru_wx + (size_t)((l * 2 + dir) * 8 + h) * 4096;
    float wac[64], wxc[64];
#pragma unroll
    for (int i = 0; i < 64; ++i) { wac[i] = wa[i * 64 + j]; wxc[i] = wx[i * 64 + j]; }
    const float ba = p.lru_ba[(l * 2 + dir) * 512 + ch], bx = p.lru_bx[(l * 2 + dir) * 512 + ch];
    const float sp = log1pf(expf(-p.lru_lam[(l * 2 + dir) * 512 + ch]));
    float hst = 0.f;
    for (int step = 0; step < CTXL + SEQ; ++step) {
        int r;
        if (dir == 0) r = step < CTXL ? TL + b * CTXL + step : b * SEQ + (step - CTXL);
        else r = step < CTXL ? TL + b * CTXL + (CTXL - 1 - step) : b * SEQ + (SEQ - 1 - (step - CTXL));
        const float* xr = XCONV + (size_t)r * 512 + h * 64;
        float pr = ba, px = bx;
#pragma unroll
        for (int i = 0; i < 16; ++i) { const float4 xv = *(const float4*)(xr + 4 * i);
            pr += xv.x * wac[4 * i] + xv.y * wac[4 * i + 1] + xv.z * wac[4 * i + 2] + xv.w * wac[4 * i + 3];
            px += xv.x * wxc[4 * i] + xv.y * wxc[4 * i + 1] + xv.z * wxc[4 * i + 2] + xv.w * wxc[4 * i + 3]; }
        const float rg = sigmoidf_(pr), ig = sigmoidf_(px);
        const float log_a = -8.0f * rg * sp;
        const float a = expf(log_a), drv = sqrtf(-expm1f(2.0f * log_a)) * (ig * xr[j]);
        hst = a * hst + drv;
        if (dir == 0) HS[(size_t)r * 512 + ch] = hst; else HS[(size_t)r * 512 + ch] += hst;
    }
}
__global__ void __launch_bounds__(256) k_yb(Params p) {
    const size_t idx = (size_t)blockIdx.x * 256 + threadIdx.x; const int r = (int)(idx >> 9), ch = (int)(idx & 511);
    const bf16_t* Z = (const bf16_t*)(p.ws + WS_Z); const float* HS = (const float*)(p.ws + WS_RA); bf16_t* Y = (bf16_t*)(p.ws + WS_RY);
    Y[(size_t)r * D + 512 + ch] = f2bf(HS[(size_t)r * 512 + ch] * bf2f(Z[(size_t)r * 4096 + 1536 + ch]));
}
__global__ void __launch_bounds__(256) k_ln(Params p, int l, int nrows) {
    const int lane = threadIdx.x & 63, wave = (blockIdx.x * 256 + threadIdx.x) >> 6, nw = (gridDim.x * 256) >> 6;
    const bf16_t* Z = (const bf16_t*)(p.ws + WS_Z); float* VN = (float*)(p.ws + WS_NV1);
    for (int r = wave; r < nrows; r += nw) {
        float v[8]; float s = 0.f;
#pragma unroll
        for (int i = 0; i < 8; ++i) { v[i] = bf2f(Z[(size_t)r * 4096 + 512 + i * 64 + lane]); s += v[i]; }
        const float mu = wave_sum(s) * (1.f / 512.f); float q = 0.f;
#pragma unroll
        for (int i = 0; i < 8; ++i) { v[i] -= mu; q += v[i] * v[i]; }
        const float rstd = rsqrtf(wave_sum(q) * (1.f / 512.f) + 1e-5f);
#pragma unroll
        for (int i = 0; i < 8; ++i) { const int cch = i * 64 + lane; VN[(size_t)r * 512 + cch] = v[i] * rstd * p.ln_g[l * 512 + cch] + p.ln_b[l * 512 + cch]; }
    }
}
__global__ void __launch_bounds__(256) k_mix(Params p, int l) {
    const size_t idx = (size_t)blockIdx.x * 256 + threadIdx.x; const int r = (int)(idx >> 9), ch = (int)(idx & 511), g = ch >> 6;
    const bf16_t* Z = (const bf16_t*)(p.ws + WS_Z); const float* VN = (const float*)(p.ws + WS_NV1); bf16_t* Y = (bf16_t*)(p.ws + WS_RY);
    const int base = r & ~127, pp = r & 127;
    const float* w = p.gws + ((size_t)(l * 8 + g) * 128 + pp) * 128;
    float acc = p.gbs[(l * 8 + g) * 128 + pp];
    for (int q = 0; q < 128; ++q) acc += w[q] * VN[(size_t)(base + q) * 512 + ch];
    Y[(size_t)r * D + ch] = f2bf(bf2f(Z[(size_t)r * 4096 + ch]) * acc);
}
__global__ void __launch_bounds__(256) k_route(Params p, int l, int nrows) {
    const int lane = threadIdx.x & 63, wave = (blockIdx.x * 256 + threadIdx.x) >> 6, nw = (gridDim.x * 256) >> 6;
    int* TOPI = (int*)(p.ws + WS_TOPI); float* TOPW = (float*)(p.ws + WS_TOPW);
    for (int r = wave; r < nrows; r += nw) { int myi; float myw; route_token(p, l, ((const float*)(p.ws + WS_LOG))[(size_t)r * 64 + lane], lane, myi, myw);
        if (lane < 8) { TOPI[(size_t)r * 8 + lane] = myi; TOPW[(size_t)r * 8 + lane] = myw; } }
}
__global__ void __launch_bounds__(256) k_routed(Params p, int l) {
    __shared__ float hs[D]; __shared__ float hm[256];
    const int r = blockIdx.x, tid = threadIdx.x;
    const bf16_t* H2 = (const bf16_t*)(p.ws + WS_RA); const int* TOPI = (const int*)(p.ws + WS_TOPI); const float* TOPW = (const float*)(p.ws + WS_TOPW);
    const float* FLs = (const float*)(p.ws + WS_NFLS); bf16_t* FL = (bf16_t*)(p.ws + WS_RY);
#pragma unroll
    for (int i = 0; i < 4; ++i) hs[tid + 256 * i] = bf2f(H2[(size_t)r * D + tid + 256 * i]);
    float acc[4] = {0.f, 0.f, 0.f, 0.f};
    __syncthreads();
    for (int s = 0; s < 8; ++s) {
        const int e = TOPI[(size_t)r * 8 + s]; const float w = TOPW[(size_t)r * 8 + s];
        const float* wg = p.e_g + ((size_t)(l * NE + e) * D) * 256; const float* wu = p.e_u + ((size_t)(l * NE + e) * D) * 256;
        float g = 0.f, u = 0.f;
        for (int k = 0; k < D; ++k) { const float hv = hs[k]; g += hv * wg[(size_t)k * 256 + tid]; u += hv * wu[(size_t)k * 256 + tid]; }
        hm[tid] = siluf_(g) * u;
        __syncthreads();
        const float* wd = p.e_d + ((size_t)(l * NE + e) * 256) * D;
        float o[4] = {0.f, 0.f, 0.f, 0.f};
        for (int j = 0; j < 256; ++j) { const float hv = hm[j];
#pragma unroll
            for (int i = 0; i < 4; ++i) o[i] += hv * wd[(size_t)j * D + tid + 256 * i]; }
#pragma unroll
        for (int i = 0; i < 4; ++i) acc[i] += w * o[i];
        __syncthreads();
    }
#pragma unroll
    for (int i = 0; i < 4; ++i) FL[(size_t)r * D + tid + 256 * i] = f2bf(FLs[(size_t)r * D + tid + 256 * i] + acc[i]);
}
template <int SPLIT, class AL, class BL, class EP>
static void ngemm(hipStream_t st, int M, int N, int K, AL al, BL bl, EP ep) { hipLaunchKernelGGL((k_gemm<AL, BL, EP, SPLIT>), dim3(N / 64, M / 64), dim3(256), 0, st, al, bl, ep, K); }
#endif

static void mk(hipStream_t st, const Params& p, int lo, int hi) { Args a{}; a.p = p; a.ph_lo = lo; a.ph_hi = hi; hipLaunchKernelGGL(mk_fwd, dim3(256), dim3(NWAVES * 64), LDS_BYTES, st, a); }

extern "C" void kernel_launch(void* const* d_in, const int* in_sizes, int n_in, void* d_out, int out_size, void* d_ws, size_t ws_size, hipStream_t stream) {
    static int ready = 0;
    if (ready == 0) {
        ready = -1;
        if (n_in != 33 || ws_size < WS_END || out_size != TL * D) return;
        int dev = 0, cus = 0;
        if (hipGetDevice(&dev) != hipSuccess || hipDeviceGetAttribute(&cus, hipDeviceAttributeMultiprocessorCount, dev) != hipSuccess || cus < 256) return;
        if (hipFuncSetAttribute((const void*)mk_fwd, hipFuncAttributeMaxDynamicSharedMemorySize, LDS_BYTES) != hipSuccess) return;
        ready = 1;
    }
    if (ready < 0) return;
    Params p{};
    const float** pp = (const float**)&p;
    for (int i = 0; i < 33; ++i) pp[i] = (const float*)d_in[i];
    p.out = (float*)d_out; p.ws = (unsigned char*)d_ws;
    (void)hipMemsetAsync((char*)d_ws + WS_CTL, 0, 1 * MiB, stream);
#if FAST == 0x1ff && !defined(MK_PER_PHASE)
    mk(stream, p, 0, PH_END);
#elif FAST == 0x1ff
    for (int ph = 0; ph < PH_END; ++ph) mk(stream, p, ph, ph + 1);
#else
    unsigned char* ws = p.ws;
    bf16_t* RA = (bf16_t*)(ws + WS_RA); bf16_t* Z = (bf16_t*)(ws + WS_Z); bf16_t* RY = (bf16_t*)(ws + WS_RY);
    float* LOG = (float*)(ws + WS_LOG); float* SG = (float*)(ws + WS_NSG); bf16_t* SH = (bf16_t*)(ws + WS_SH); float* FLs = (float*)(ws + WS_NFLS);
    mk(stream, p, 0, 1);
    if (!(FAST & 1)) hipLaunchKernelGGL(k_mod, dim3(24, 5, 2), dim3(256), 0, stream, p);
    for (int l = 0; l < 2; ++l) {
        const int nr = (l == 0) ? R : TL, b0 = 1 + l * NPL;
        if (FAST & 2) mk(stream, p, b0 + 0, b0 + 1); else { if (l > 0) mk(stream, p, 100 + l, 101 + l); hipLaunchKernelGGL(k_rowA, dim3(2048), dim3(256), 0, stream, p, l); }
        if (FAST & 4) mk(stream, p, b0 + 1, b0 + 2); else ngemm<0>(stream, R, 4096, D, ABf16{RA, D, 0}, BF32{p.w_in + (size_t)l * D * 4096, 4096, 0}, NEpiZ{Z});
        if (FAST & 8) { mk(stream, p, b0 + 2, b0 + 3); mk(stream, p, b0 + 3, b0 + 4); }
        else {
            hipLaunchKernelGGL(k_conv, dim3(R * 512 / 256), dim3(256), 0, stream, p, l);
            for (int dir = 0; dir < 2; ++dir) hipLaunchKernelGGL(k_scan, dim3(NBATCH * 8), dim3(64), 0, stream, p, l, dir);
            hipLaunchKernelGGL(k_yb, dim3(nr * 512 / 256), dim3(256), 0, stream, p);
            hipLaunchKernelGGL(k_ln, dim3(2048), dim3(256), 0, stream, p, l, nr);
            hipLaunchKernelGGL(k_mix, dim3(nr * 512 / 256), dim3(256), 0, stream, p, l);
        }
        if (FAST & 16) mk(stream, p, b0 + 4, b0 + 5); else ngemm<512>(stream, nr, D, D, ABf16{RY, D, 0}, BAB{p.w_out_a + (size_t)l * 512 * D, p.w_out_b + (size_t)l * 512 * D}, NEpiMerge{Z, RA});
        if (FAST & 32) mk(stream, p, b0 + 5, b0 + 6); else ngemm<0>(stream, nr, D, D, ABf16{RA, D, 0}, BF32{p.w_out + (size_t)l * D * D, D, 0}, NEpiBf{Z, D, 0});
        if (FAST & 64) mk(stream, p, b0 + 6, b0 + 7); else hipLaunchKernelGGL(k_rowH, dim3(2048), dim3(256), 0, stream, p, l, nr);
        if (FAST & 128) { mk(stream, p, b0 + 7, b0 + 8); mk(stream, p, b0 + 8, b0 + 9); }
        else {
            ngemm<0>(stream, nr, 64, D, ABf16{RA, D, 0}, BF32{p.router_w + (size_t)l * D * 64, 64, 0}, NEpiF32{LOG, 64, 0});
            hipLaunchKernelGGL(k_route, dim3(2048), dim3(256), 0, stream, p, l, nr);
            ngemm<0>(stream, nr, 256, D, ABf16{RA, D, 0}, BF32{p.s_g + (size_t)l * D * 256, 256, 0}, NEpiF32{SG, 256, 0});
            ngemm<0>(stream, nr, 256, D, ABf16{RA, D, 0}, BF32{p.s_u + (size_t)l * D * 256, 256, 0}, NEpiSwi{SG, SH});
        }
        if (FAST & 256) { for (int k = 9; k < NPL; ++k) mk(stream, p, b0 + k, b0 + k + 1); }
        else {
            ngemm<0>(stream, nr, D, 256, ABf16{SH, 256, 0}, BF32{p.s_d + (size_t)l * 256 * D, D, 0}, NEpiF32{FLs, D, 0});
            hipLaunchKernelGGL(k_routed, dim3(nr), dim3(256), 0, stream, p, l);
        }
    }
    if (FAST & 2) mk(stream, p, PH_FINAL, PH_END); else hipLaunchKernelGGL(k_rowA, dim3(2048), dim3(256), 0, stream, p, 2);
#endif
}
```

```cpp
#include <hip/hip_runtime.h>
#include <stdint.h>
#include <math.h>

#ifndef GIN_FP8
#define GIN_FP8 1
#endif
#ifndef GED_FP8
#define GED_FP8 1
#endif
#ifndef GSD_FP8
#define GSD_FP8 0
#endif
typedef unsigned short bf16_t;
#define DEV __device__ __forceinline__
#define LAS __attribute__((address_space(3)))
#define GAS __attribute__((address_space(1)))
typedef short bf16x8 __attribute__((ext_vector_type(8)));
typedef float f32x4 __attribute__((ext_vector_type(4)));
typedef unsigned u32x4 __attribute__((ext_vector_type(4)));
typedef unsigned u32x2 __attribute__((ext_vector_type(2)));

constexpr int D = 1024, NBATCH = 4, SEQ = 8192, CTXL = 256;
constexpr int TL = NBATCH * SEQ, TC = NBATCH * CTXL, R = TL + TC;
constexpr int NE = 64, CAP = R;
constexpr int NCHUNK = R / 128;
constexpr size_t MiB = 1u << 20;
constexpr size_t WS_CTL = 0;
constexpr size_t WS_PE = 1 * MiB + 512 * 1024  ;
constexpr size_t WS_MOD = 1 * MiB, WS_H8 = 2 * MiB  , WS_LISTA = 6 * MiB  , WS_LISTW = 15 * MiB  , WS_SUMM = 24 * MiB, WS_LOG = 27 * MiB;
constexpr size_t WS_TOPI = WS_LOG, WS_TOPW = WS_LOG;
constexpr size_t WS_W = 36 * MiB;
constexpr size_t WS_XC = 84 * MiB;
constexpr size_t WS_RY = 148 * MiB;
constexpr size_t WS_Z = 214 * MiB;
constexpr size_t WS_HM = 214 * MiB;
constexpr size_t WS_SH = 354 * MiB;
constexpr size_t WS_SLOTS = 354 * MiB;
constexpr size_t WS_RA = 478 * MiB;
constexpr size_t WS_LR = 478 * MiB;
constexpr size_t WS_XCT = 478 * MiB;
constexpr size_t WS_H2E = 544 * MiB;
constexpr size_t WS_END = 618 * MiB;
constexpr size_t WO_IN = 0, WO_AB = 8 * MiB, WO_OUT = 10 * MiB, WO_SR = 12 * MiB  , WO_SD = 14 * MiB  , WO_LRU = 15 * MiB  ,
                 WO_GWS = 15 * MiB + MiB / 2  , WO_EG = 16 * MiB  , WO_ED = 80 * MiB  ;
constexpr int CW_CNT = 64;
constexpr int CW_BAR = 4096;

struct Params {
    const float *x, *c, *ctx, *c_ctx, *w_mod, *b_mod, *g_pre_mix, *g_post_mix, *g_pre_ffn, *g_post_ffn, *w_in, *ln_g, *ln_b, *gws, *gbs,
        *conv_w, *conv_b, *lru_wa, *lru_ba, *lru_wx, *lru_bx, *lru_lam, *w_out_a, *w_out_b, *w_out, *router_w, *router_b, *e_g, *e_u, *e_d, *s_g, *s_u, *s_d;
    float* out; unsigned char* ws;
};

DEV float bf2f(bf16_t v) { return __uint_as_float(((unsigned)v) << 16); }
DEV bf16_t f2bf(float f) { unsigned u = __float_as_uint(f); return (bf16_t)((u + 0x7fffu + ((u >> 16) & 1u)) >> 16); }
DEV unsigned pk2(float lo, float hi) { return (unsigned)f2bf(lo) | ((unsigned)f2bf(hi) << 16); }
DEV float sigmoidf_(float x) { return 1.f / (1.f + expf(-x)); }
DEV float siluf_(float x) { return x / (1.f + expf(-x)); }
DEV float gelu_tanh(float x) { return 0.5f * x * (1.f + tanhf(0.7978845608028654f * (x + 0.044715f * x * x * x))); }
DEV float fsigmoid(float x) { return __builtin_amdgcn_rcpf(1.f + __builtin_amdgcn_exp2f(-1.4426950408889634f * x)); }
DEV float fsilu(float x) { return x * fsigmoid(x); }
DEV float fgelu(float x) { const float u = 1.5957691216057308f * (x + 0.044715f * x * x * x); return x * fsigmoid(u); }
DEV float wave_sum(float v) {
#pragma unroll
    for (int o = 1; o < 64; o <<= 1) v += __shfl_xor(v, o);
    return v;
}
DEV const float* mod_ptr(const Params& p, int l, int cond, int j) { return (const float*)(p.ws + WS_MOD) + ((size_t)((l * 5 + cond) * 6 + j)) * D; }
DEV float* xl_row(const Params& p, int r) { return r < TL ? p.out + (size_t)r * D : (float*)(p.ws + WS_XC) + (size_t)(r - TL) * D; }
namespace pg8 {
constexpr int BM = 256, BK = 64, HALF = 128, HTB = HALF * BK * 2  , STAGE_BYTES = 8 * HTB;
DEV int lds_byte(int r, int c) { const int st = (r >> 4) * 2 + (c >> 5), rr = r & 15, cc = c & 31, ob = rr * 64 + cc * 2; return st * 1024 + (ob ^ (((ob >> 9) & 1) << 5)); }
DEV void stage_rc(int b, int& Rr, int& C) { const int st = b / 1024, sb = b % 1024, swz = sb ^ (((sb >> 9) & 1) << 5); Rr = (st >> 1) * 16 + swz / 64; C = (st & 1) * 32 + (swz % 64) / 2; }
DEV int perm32(int rho) { const int n = rho >> 4, i = rho & 15; return 8 * (i >> 2) + 4 * n + (i & 3); }
DEV unsigned cvt_pk_bf16(float lo, float hi) { unsigned r; asm volatile("v_cvt_pk_bf16_f32 %0, %1, %2" : "=v"(r) : "v"(lo), "v"(hi)); return r; }
DEV u32x4 pack8(const f32x4 v0, const f32x4 v1) { u32x4 w; w.x = cvt_pk_bf16(v0[0], v0[1]); w.y = cvt_pk_bf16(v0[2], v0[3]); w.z = cvt_pk_bf16(v1[0], v1[1]); w.w = cvt_pk_bf16(v1[2], v1[3]); return w; }
DEV void unpack8(const u32x4 w, f32x4& v0, f32x4& v1) {
    v0[0] = __uint_as_float(w.x << 16); v0[1] = __uint_as_float(w.x & 0xffff0000u); v0[2] = __uint_as_float(w.y << 16); v0[3] = __uint_as_float(w.y & 0xffff0000u);
    v1[0] = __uint_as_float(w.z << 16); v1[1] = __uint_as_float(w.z & 0xffff0000u); v1[2] = __uint_as_float(w.w << 16); v1[3] = __uint_as_float(w.w & 0xffff0000u);
}
DEV int xcd_remap(int L, int U) { const int q = U / 8, r = U % 8, xcd = L % 8, off = L / 8; return (xcd < r ? xcd * (q + 1) : r * (q + 1) + (xcd - r) * q) + off; }

struct UnitD { int pm, pn; };
template <int K, size_t AOFF, size_t BOFF> struct DenseSched {
    typedef UnitD Unit; static constexpr int KK = K;
    const unsigned char* ws; int nM, nN, nwg, c, Krt; static constexpr int G = 256;
    DEV void init(const unsigned char* ws_, int M, int N, int c_) { ws = ws_; nM = M / BM; nN = N / BM; nwg = nM * nN; c = c_; Krt = K; asm volatile("" : "+s"(Krt)); }
    DEV bool next(int i, Unit& u) const {
        const int L = i * G + c; if (L >= nwg) return false;
        const int wgid = xcd_remap(L, nwg);
        const int nig = 8 * nN, gid = wgid / nig, fm = gid * 8, gsz = (nM - fm) < 8 ? (nM - fm) : 8;
        u.pm = fm + ((wgid % nig) % gsz); u.pn = (wgid % nig) / gsz; return true;
    }
    DEV const char* abase(const Unit& u) const { return (const char*)ws + AOFF + (size_t)u.pm * BM * K * 2; }
    DEV const char* bbase(const Unit& u) const { return (const char*)ws + BOFF + (size_t)u.pn * BM * K * 2; }
    DEV void prefetch(const Unit&, LAS unsigned char*, int, int) const {}
    DEV void aoffs(const Unit&, int tid, unsigned (&v)[2][2], LAS unsigned char*, int, bool) const {
#pragma unroll
        for (int i = 0; i < 2; ++i) { int Rr, C; stage_rc(tid * 16 + i * 8192, Rr, C);
#pragma unroll
            for (int h = 0; h < 2; ++h) v[h][i] = (unsigned)((h * HALF + Rr) * K + C) * 2u; }
    }
};
struct UnitE { int e, row0, cnt, hmrow0, pn; };
template <int K, int GATHER, int NCOL, size_t AOFF, size_t BOFF, size_t BSTRIDE> struct ExpSched {
    typedef UnitE Unit; static constexpr int KK = K;
    const unsigned char* ws; LAS unsigned char* lds;
    int U, c, brow0, Krt; static constexpr int ncol = NCOL, gather = GATHER, G = 256;
    DEV bool next(int i, Unit& u) const {
        const int L = i * G + c; if (L >= U) return false;
        const int id = xcd_remap(L, U), tile = id / ncol; u.pn = id % ncol;
        const LAS int* toff = (const LAS int*)(lds + 131072 + 256);
        const int e = (int)((const LAS unsigned char*)(lds + 131072 + 2048))[tile];
        u.e = e; u.row0 = (tile - toff[e]) * BM; u.cnt = toff[80 + e]; u.hmrow0 = tile * BM; return true;
    }
    DEV const char* abase(const Unit& u) const { return gather ? (const char*)ws + AOFF : (const char*)ws + AOFF + (size_t)u.hmrow0 * K * 2; }
    DEV const char* bbase(const Unit& u) const { return (const char*)ws + BOFF + (size_t)u.e * BSTRIDE + (size_t)(brow0 + u.pn * BM) * K * 2; }
    DEV void prefetch(const Unit& u, LAS unsigned char* lds_, int wid, int lane) const {
        if (gather) __builtin_amdgcn_global_load_lds((const unsigned*)(ws + WS_LISTA) + (size_t)u.e * CAP + u.row0 + lane * 4, (LAS unsigned*)(lds_ + 131072 + 2048 + wid * 3712 + 2048), 16, 0, 0);
    }
    DEV void aoffs(const Unit& u, int tid, unsigned (&v)[2][2], LAS unsigned char* lds_, int wid, bool from_lds) const {
        asm volatile("" : "+v"(tid));
        const int* lista = (const int*)(ws + WS_LISTA);
        const LAS int* sp = (const LAS int*)(lds_ + 131072 + 2048 + wid * 3712 + 2048);
#pragma unroll
        for (int i = 0; i < 2; ++i) { int Rr, C; stage_rc(tid * 16 + i * 8192, Rr, C);
#pragma unroll
            for (int h = 0; h < 2; ++h) {
                const int lr = h * HALF + Rr;
                if (gather) { const int rr = u.row0 + lr; const int aid = from_lds ? sp[lr] : ((rr < u.cnt) ? lista[(size_t)u.e * CAP + rr] : 0);
                    const int tok = (rr < u.cnt) ? (aid >> 3) : 0; v[h][i] = (unsigned)(tok * K + C) * 2u; }
                else v[h][i] = (unsigned)(lr * K + C) * 2u;
            } }
    }
};

typedef f32x4 Acc[2][2][4][2];
#define EPI_ROWS(ai, m) for (int ai = 0; ai < 2; ++ai) _Pragma("unroll") for (int m = 0; m < 4; ++m)

struct EpiZ {
    static constexpr int PID = 10; static constexpr bool HAS_MID = false; static constexpr int MID_T = 0;
    unsigned char* ws;
    DEV void mid(Acc&, const UnitD&, int, int, int, int) const {}
    DEV void unit_begin(const UnitD&, LAS unsigned char*, int, int) const {}
    DEV void operator()(const Acc& acc, const UnitD& u, int wr, int wc, int fr, int fq) const {
        bf16_t* Z = (bf16_t*)(ws + WS_Z);
        const int act = (u.pn < 4) ? 1 : (u.pn < 6 ? 0 : (u.pn < 8 ? 1 : 2));
        const int row0 = u.pm * BM + wr * 64 + fr, col0 = u.pn * BM + wc * 32 + 8 * fq;
#pragma unroll
        EPI_ROWS(ai, m) { bf16_t* rowp = Z + (size_t)(row0 + ai * HALF + m * 16) * 4096 + col0;
#pragma unroll
            for (int bj = 0; bj < 2; ++bj) { f32x4 v0 = acc[ai][bj][m][0], v1 = acc[ai][bj][m][1];
                if (act == 1) {
#pragma unroll
                    for (int i = 0; i < 4; ++i) { v0[i] = fgelu(v0[i]); v1[i] = fgelu(v1[i]); }
                } else if (act == 2) {
                    unsigned w0 = 0, w1 = 0;
#pragma unroll
                    for (int i = 0; i < 4; ++i) { w0 |= (unsigned)__builtin_rintf(fsigmoid(v0[i]) * 255.f) << (8 * i); w1 |= (unsigned)__builtin_rintf(fsigmoid(v1[i]) * 255.f) << (8 * i); }
                    *(u32x2*)((unsigned char*)(Z + (size_t)(row0 + ai * HALF + m * 16) * 4096) + 4096 + (col0 - 2048) + bj * HALF) = (u32x2){w0, w1};
                    continue;
                }
                *(u32x4*)(rowp + bj * HALF) = pack8(v0, v1); } }
    }
};
struct EpiAB {
    static constexpr int PID = 11; static constexpr bool HAS_MID = true; static constexpr int MID_T = 8;
    unsigned char* ws;
    DEV void unit_begin(const UnitD&, LAS unsigned char*, int, int) const {}
    DEV void mid(Acc& acc, const UnitD& u, int wr, int wc, int fr, int fq) const {
        const bf16_t* Z = (const bf16_t*)(ws + WS_Z);
        int oz = 0; asm volatile("" : "+v"(oz));
        const int row0 = u.pm * BM + wr * 64 + fr + oz, col0 = u.pn * BM + wc * 32 + 8 * fq;
#pragma unroll
        for (int ai = 0; ai < 2; ++ai) {
            u32x2 ga[4][2], gr[4][2];
#pragma unroll
            for (int m = 0; m < 4; ++m) { const unsigned char* zr = (const unsigned char*)(Z + (size_t)(row0 + ai * HALF + m * 16) * 4096) + 4096 + col0;
#pragma unroll
                for (int bj = 0; bj < 2; ++bj) { ga[m][bj] = *(const u32x2*)(zr + bj * HALF); gr[m][bj] = *(const u32x2*)(zr + 1024 + bj * HALF); } }
#pragma unroll
            for (int m = 0; m < 4; ++m)
#pragma unroll
                for (int bj = 0; bj < 2; ++bj) {
#pragma unroll
                    for (int i = 0; i < 4; ++i) {
                        const float a0 = (float)((ga[m][bj].x >> (8 * i)) & 255u), a1 = (float)((ga[m][bj].y >> (8 * i)) & 255u);
                        const float r0 = fmaxf((float)((gr[m][bj].x >> (8 * i)) & 255u), 0.5f), r1 = fmaxf((float)((gr[m][bj].y >> (8 * i)) & 255u), 0.5f);
                        acc[ai][bj][m][0][i] *= a0 * __builtin_amdgcn_rcpf(r0); acc[ai][bj][m][1][i] *= a1 * __builtin_amdgcn_rcpf(r1); } }
            asm volatile("" ::: "memory"); }
    }
    DEV void operator()(const Acc& acc, const UnitD& u, int wr, int wc, int fr, int fq) const {
        const bf16_t* Z = (const bf16_t*)(ws + WS_Z); bf16_t* M = (bf16_t*)(ws + WS_RA);
        const int row0 = u.pm * BM + wr * 64 + fr, col0 = u.pn * BM + wc * 32 + 8 * fq;
        u32x2 gr[2][4][2];
#pragma unroll
        EPI_ROWS(ai, m) { const unsigned char* zr = (const unsigned char*)(Z + (size_t)(row0 + ai * HALF + m * 16) * 4096) + 4096 + 1024 + col0;
#pragma unroll
            for (int bj = 0; bj < 2; ++bj) gr[ai][m][bj] = *(const u32x2*)(zr + bj * HALF); }
#pragma unroll
        EPI_ROWS(ai, m) { bf16_t* rowp = M + (size_t)(row0 + ai * HALF + m * 16) * D + col0;
#pragma unroll
            for (int bj = 0; bj < 2; ++bj) { f32x4 r0, r1;
#pragma unroll
                for (int i = 0; i < 4; ++i) { r0[i] = fmaxf((float)((gr[ai][m][bj].x >> (8 * i)) & 255u), 0.5f) * (1.f / 255.f); r1[i] = fmaxf((float)((gr[ai][m][bj].y >> (8 * i)) & 255u), 0.5f) * (1.f / 255.f); }
                *(u32x4*)(rowp + bj * HALF) = pack8(acc[ai][bj][m][0] * r0, acc[ai][bj][m][1] * r1); } }
    }
};
template <size_t COFF> struct EpiPlain {
    static constexpr int PID = 12; static constexpr bool HAS_MID = false; static constexpr int MID_T = 0;
    unsigned char* ws;
    DEV void mid(Acc&, const UnitD&, int, int, int, int) const {}
    DEV void unit_begin(const UnitD&, LAS unsigned char*, int, int) const {}
    DEV void operator()(const Acc& acc, const UnitD& u, int wr, int wc, int fr, int fq) const {
        bf16_t* C = (bf16_t*)(ws + COFF); constexpr int ldc = D;
        const int row0 = u.pm * BM + wr * 64 + fr, col0 = u.pn * BM + wc * 32 + 8 * fq;
#pragma unroll
        EPI_ROWS(ai, m) { bf16_t* rowp = C + (size_t)(row0 + ai * HALF + m * 16) * ldc + col0;
#pragma unroll
            for (int bj = 0; bj < 2; ++bj) *(u32x4*)(rowp + bj * HALF) = pack8(acc[ai][bj][m][0], acc[ai][bj][m][1]); }
    }
};
struct EpiSR {
    static constexpr int PID = 13; static constexpr bool HAS_MID = false; static constexpr int MID_T = 0;
    unsigned char* ws;
    DEV void mid(Acc&, const UnitD&, int, int, int, int) const {}
    DEV void unit_begin(const UnitD&, LAS unsigned char*, int, int) const {}
    DEV void operator()(const Acc& acc, const UnitD& u, int wr, int wc, int fr, int fq) const {
        float* LOG = (float*)(ws + WS_LOG); bf16_t* SH = (bf16_t*)(ws + WS_SH);
        const int row0 = u.pm * BM + wr * 64 + fr;
        if (u.pn == 0) {
            if (wc < 2) {
#pragma unroll
                EPI_ROWS(ai, m) { float* rowp = LOG + (size_t)(row0 + ai * HALF + m * 16) * 64 + wc * 32 + 8 * fq;
                    *(f32x4*)(rowp) = acc[ai][0][m][0]; *(f32x4*)(rowp + 4) = acc[ai][0][m][1]; }
            }
        } else {
            const int j0 = (u.pn - 1) * HALF + wc * 32 + 8 * fq;
#pragma unroll
            EPI_ROWS(ai, m) { f32x4 v0, v1;
#pragma unroll
                for (int i = 0; i < 4; ++i) { v0[i] = fsilu(acc[ai][0][m][0][i]) * acc[ai][1][m][0][i]; v1[i] = fsilu(acc[ai][0][m][1][i]) * acc[ai][1][m][1][i]; }
#if GSD_FP8
                { u32x2 o; unsigned t = 0;
#pragma unroll
                  for (int i = 0; i < 4; ++i) { v0[i] = __builtin_amdgcn_fmed3f(v0[i] * 8.f, -440.f, 440.f); v1[i] = __builtin_amdgcn_fmed3f(v1[i] * 8.f, -440.f, 440.f); }
                  t = __builtin_amdgcn_cvt_pk_fp8_f32(v0[0], v0[1], t, false); t = __builtin_amdgcn_cvt_pk_fp8_f32(v0[2], v0[3], t, true); o.x = t;
                  t = __builtin_amdgcn_cvt_pk_fp8_f32(v1[0], v1[1], t, false); t = __builtin_amdgcn_cvt_pk_fp8_f32(v1[2], v1[3], t, true); o.y = t;
                  *(u32x2*)((unsigned char*)SH + (size_t)(row0 + ai * HALF + m * 16) * 256 + j0) = o; }
#else
                *(u32x4*)(SH + (size_t)(row0 + ai * HALF + m * 16) * 256 + j0) = pack8(v0, v1);
#endif
            }
        }
    }
};
template <int FP8S> struct EpiEG {
    static constexpr int PID = 14; static constexpr bool HAS_MID = false; static constexpr int MID_T = 0;
    unsigned char* ws;
    DEV void mid(Acc&, const UnitE&, int, int, int, int) const {}
    DEV void unit_begin(const UnitE&, LAS unsigned char*, int, int) const {}
    DEV void operator()(const Acc& acc, const UnitE& u, int wr, int wc, int fr, int fq) const {
        bf16_t* HM = (bf16_t*)(ws + WS_HM);
        const int j0 = u.pn * HALF + wc * 32 + 8 * fq;
#pragma unroll
        EPI_ROWS(ai, m) { f32x4 v0, v1;
#pragma unroll
            for (int i = 0; i < 4; ++i) { constexpr float sc = FP8S ? (1.f / 1024.f) : 1.f; v0[i] = fsilu(acc[ai][0][m][0][i] * sc) * (acc[ai][1][m][0][i] * sc); v1[i] = fsilu(acc[ai][0][m][1][i] * sc) * (acc[ai][1][m][1][i] * sc); }
#if GED_FP8
            { u32x2 o; unsigned t = 0;
#pragma unroll
              for (int i = 0; i < 4; ++i) { v0[i] = __builtin_amdgcn_fmed3f(v0[i] * 8.f, -440.f, 440.f); v1[i] = __builtin_amdgcn_fmed3f(v1[i] * 8.f, -440.f, 440.f); }
              t = __builtin_amdgcn_cvt_pk_fp8_f32(v0[0], v0[1], t, false); t = __builtin_amdgcn_cvt_pk_fp8_f32(v0[2], v0[3], t, true); o.x = t;
              t = __builtin_amdgcn_cvt_pk_fp8_f32(v1[0], v1[1], t, false); t = __builtin_amdgcn_cvt_pk_fp8_f32(v1[2], v1[3], t, true); o.y = t;
              *(u32x2*)((unsigned char*)HM + (size_t)(u.hmrow0 + ai * HALF + wr * 64 + m * 16 + fr) * 256 + j0) = o; }
#else
            *(u32x4*)(HM + (size_t)(u.hmrow0 + ai * HALF + wr * 64 + m * 16 + fr) * 256 + j0) = pack8(v0, v1);
#endif
        }
    }
};
struct EpiED {
    static constexpr int PID = 15; static constexpr bool HAS_MID = false; static constexpr int MID_T = 0;
    unsigned char* ws;
    DEV void mid(Acc&, const UnitE&, int, int, int, int) const {}
    DEV void unit_begin(const UnitE& u, LAS unsigned char* lds, int wid, int lane) const {
        const int wr = wid >> 2; LAS unsigned char* sp = lds + 131072 + 2048 + wid * 3712 + 2048;
#pragma unroll
        for (int ai = 0; ai < 2; ++ai) { const size_t idx = (size_t)u.e * CAP + u.row0 + ai * HALF + wr * 64 + lane;
            __builtin_amdgcn_global_load_lds((const unsigned*)(ws + WS_LISTA) + idx, (LAS unsigned*)(sp + ai * 256), 4, 0, 0);
            __builtin_amdgcn_global_load_lds((const unsigned*)(ws + WS_LISTW) + idx, (LAS unsigned*)(sp + 512 + ai * 256), 4, 0, 0); }
    }
    DEV void operator()(const Acc& acc, const UnitE& u, int wr, int wc, int fr, int fq) const {
        unsigned char* SLOTS = ws + WS_SLOTS;
        const LAS unsigned* sp = (const LAS unsigned*)(lds_ + 131072 + 2048 + (wr * 4 + wc) * 3712 + 2048);
        const int col0 = u.pn * BM + wc * 32 + 8 * fq;
#pragma unroll
        EPI_ROWS(ai, m) { const int rr = u.row0 + ai * HALF + wr * 64 + m * 16 + fr;
            const int aid = (int)sp[ai * 64 + m * 16 + fr]; const float w = __uint_as_float(sp[128 + ai * 64 + m * 16 + fr]) * 16.0f;
            if (rr < u.cnt) { unsigned char* rowp = SLOTS + (size_t)aid * 1024 + col0;
#pragma unroll
                for (int bj = 0; bj < 2; ++bj) { f32x4 v0 = acc[ai][bj][m][0] * w, v1 = acc[ai][bj][m][1] * w; u32x2 o; unsigned t = 0;
#pragma unroll
                    for (int i = 0; i < 4; ++i) { v0[i] = __builtin_amdgcn_fmed3f(v0[i], -440.f, 440.f); v1[i] = __builtin_amdgcn_fmed3f(v1[i], -440.f, 440.f); }
                    t = __builtin_amdgcn_cvt_pk_fp8_f32(v0[0], v0[1], t, false); t = __builtin_amdgcn_cvt_pk_fp8_f32(v0[2], v0[3], t, true); o.x = t;
                    t = __builtin_amdgcn_cvt_pk_fp8_f32(v1[0], v1[1], t, false); t = __builtin_amdgcn_cvt_pk_fp8_f32(v1[2], v1[3], t, true); o.y = t;
                    *(u32x2*)(rowp + bj * HALF) = o; } } }
    }
    LAS unsigned char* lds_;
};

template <class Epi, class Sched, bool ALIGN_EPI, int FP8 = 0>
DEV void gemm_phase(LAS unsigned char* lds, const int tid, const Sched& S, const Epi& E) {
    typedef typename Sched::Unit Unit;
    const int wid = __builtin_amdgcn_readfirstlane(tid >> 6), lane = tid & 63, wr = wid >> 2, wc = wid & 3, fr = lane & 15, fq = lane >> 4;
    const int K = S.Krt, nt = K / BK;
    unsigned voffB[2];
#pragma unroll
    for (int i = 0; i < 2; ++i) { int Rr, C; stage_rc(tid * 16 + i * 8192, Rr, C); const int Rb = (Rr & ~31) + perm32(Rr & 31); voffB[i] = (unsigned)(Rb * K + C) * 2u; }
    const size_t kstep = (size_t)(BK * 2);
    const size_t hstepB = (size_t)HALF * K * 2;
    const unsigned ldsw = (unsigned)wid * 1024u;
    const int aoff = lds_byte(wr * 64 + fr, fq * 8), boff = lds_byte(wc * 32 + fr, fq * 8);
#define PG8_SA(b, h) (((b) * 2 + (h)) * HTB)
#define PG8_SB(b, h) ((4 + (b) * 2 + (h)) * HTB)
#define PG8_STAGE2(bufoff, gbase, o0, o1) do { unsigned o0_ = (o0), o1_ = (o1); asm volatile("" : "+v"(o0_), "+v"(o1_));     \
        __builtin_amdgcn_global_load_lds((const unsigned*)((const char*)(gbase) + o0_), (LAS unsigned*)(lds + (bufoff) + ldsw), 16, 0, 0); \
        __builtin_amdgcn_global_load_lds((const unsigned*)((const char*)(gbase) + o1_), (LAS unsigned*)(lds + (bufoff) + ldsw + 8192), 16, 0, 0); } while (0)
#define PG8_STAGEB(bufoff, gbase) PG8_STAGE2(bufoff, gbase, voffB[0], voffB[1])
#define PG8_LDA(dst, b, h) do { _Pragma("unroll") for (int m = 0; m < 4; ++m) _Pragma("unroll") for (int k = 0; k < 2; ++k) dst[m][k] = *(const LAS bf16x8*)(lds + PG8_SA(b, h) + aoff + m * 2048 + k * 1024); } while (0)
#define PG8_LDB(dst, b, h) do { _Pragma("unroll") for (int n = 0; n < 2; ++n) _Pragma("unroll") for (int k = 0; k < 2; ++k) dst[n][k] = *(const LAS bf16x8*)(lds + PG8_SB(b, h) + boff + n * 2048 + k * 1024); } while (0)
#define PG8_MMA(ai, bj, At, Bt) do { __builtin_amdgcn_s_setprio(1); _Pragma("unroll") for (int m = 0; m < 4; ++m) _Pragma("unroll") for (int n = 0; n < 2; ++n) _Pragma("unroll") for (int k = 0; k < 2; ++k) \
        acc[ai][bj][m][n] = __builtin_amdgcn_mfma_f32_16x16x32_bf16(Bt[n][k], At[m][k], acc[ai][bj][m][n], 0, 0, 0); __builtin_amdgcn_s_setprio(0); } while (0)
typedef int i32x8_t __attribute__((ext_vector_type(8)));
struct Frag2 { bf16x8 lo, hi; };
#define PG8_MMA8(ai, bj, At, Bt) do { __builtin_amdgcn_s_setprio(1); _Pragma("unroll") for (int m = 0; m < 4; ++m) _Pragma("unroll") for (int n = 0; n < 2; ++n) { \
        const Frag2 fb_{Bt[n][0], Bt[n][1]}, fa_{At[m][0], At[m][1]}; \
        acc[ai][bj][m][n] = __builtin_amdgcn_mfma_scale_f32_16x16x128_f8f6f4(__builtin_bit_cast(i32x8_t, fb_), __builtin_bit_cast(i32x8_t, fa_), acc[ai][bj][m][n], 0, 0, 0, 0x79797979, 0, FP8 * 0x01010101); } __builtin_amdgcn_s_setprio(0); } while (0)
#define PG8_MM(ai, bj, At, Bt) do { if constexpr (FP8) PG8_MMA8(ai, bj, At, Bt); else PG8_MMA(ai, bj, At, Bt); } while (0)
#define PG8_WAIT_V(n) asm volatile("s_waitcnt vmcnt(" #n ")" ::: "memory")
#define PG8_WAIT_L(n) asm volatile("s_waitcnt lgkmcnt(" #n ")" ::: "memory")
#define PG8_BAR __builtin_amdgcn_s_barrier()
#define PG8_SCHED __builtin_amdgcn_sched_barrier(0)
    Unit cur, nxt; int ui = 0;
    if (!S.next(0, cur)) return;
    Acc acc;
#pragma unroll
    for (int a = 0; a < 2; ++a)
#pragma unroll
        for (int b = 0; b < 2; ++b)
#pragma unroll
            for (int m = 0; m < 4; ++m)
#pragma unroll
                for (int n = 0; n < 2; ++n) acc[a][b][m][n] = (f32x4){0.f, 0.f, 0.f, 0.f};
    bf16x8 At[4][2], B0[2][2], B1[2][2];
    unsigned vA[2][2];
    S.aoffs(cur, tid, vA, lds, wid, false);
    const char* cA = S.abase(cur); const char* cB = S.bbase(cur);
    PG8_STAGEB(PG8_SB(0, 0), cB); PG8_STAGEB(PG8_SB(0, 1), cB + hstepB); PG8_STAGE2(PG8_SA(0, 0), cA, vA[0][0], vA[0][1]); PG8_STAGE2(PG8_SA(0, 1), cA, vA[1][0], vA[1][1]);
    if (wr == 1) PG8_BAR;
    PG8_WAIT_V(2); PG8_BAR;
    PG8_STAGEB(PG8_SB(1, 0), cB + kstep); PG8_STAGE2(PG8_SA(1, 0), cA + kstep, vA[0][0], vA[0][1]); PG8_STAGEB(PG8_SB(1, 1), cB + hstepB + kstep);
    PG8_WAIT_V(6); PG8_BAR;
    for (;;) {
        E.unit_begin(cur, lds, wid, lane);
        const bool has_next = S.next(ui + 1, nxt);
        const char* nA = cA; const char* nB = cB;
        if (has_next) { nA = S.abase(nxt); nB = S.bbase(nxt); S.prefetch(nxt, lds, wid, lane); }
        for (int t = 0; t < nt; t += 2) {
            const bool last = (t == nt - 2);
            if constexpr (Epi::HAS_MID) { if (t == Epi::MID_T) E.mid(acc, cur, wr, wc, fr, fq); }
            const char* a1 = cA + (size_t)(t + 1) * kstep;
            const char* a2 = last ? nA : cA + (size_t)(t + 2) * kstep; const char* b2 = last ? nB : cB + (size_t)(t + 2) * kstep;
            const char* a3 = a2 + kstep; const char* b3 = b2 + kstep;
            PG8_LDB(B0, 0, 0); PG8_LDB(B1, 0, 1); PG8_SCHED; PG8_LDA(At, 0, 0); PG8_STAGE2(PG8_SA(1, 1), a1, vA[1][0], vA[1][1]);
            if (last && has_next) S.aoffs(nxt, tid, vA, lds, wid, true);
            PG8_WAIT_V(8); PG8_WAIT_L(0); PG8_BAR; PG8_MM(0, 0, At, B0); PG8_MM(0, 1, At, B1); PG8_BAR; PG8_SCHED;
            PG8_LDA(At, 0, 1); PG8_STAGEB(PG8_SB(0, 0), b2); PG8_STAGEB(PG8_SB(0, 1), b2 + hstepB); PG8_STAGE2(PG8_SA(0, 0), a2, vA[0][0], vA[0][1]);
            PG8_WAIT_V(8); PG8_WAIT_L(0); PG8_BAR; PG8_MM(1, 0, At, B0); PG8_MM(1, 1, At, B1); PG8_BAR; PG8_SCHED;
            PG8_LDB(B0, 1, 0); PG8_LDB(B1, 1, 1); PG8_SCHED; PG8_LDA(At, 1, 0); PG8_STAGE2(PG8_SA(0, 1), a2, vA[1][0], vA[1][1]);
            PG8_WAIT_V(8); PG8_WAIT_L(0); PG8_BAR; PG8_MM(0, 0, At, B0); PG8_MM(0, 1, At, B1); PG8_BAR; PG8_SCHED;
            PG8_LDA(At, 1, 1); PG8_STAGEB(PG8_SB(1, 0), b3); PG8_STAGEB(PG8_SB(1, 1), b3 + hstepB); PG8_STAGE2(PG8_SA(1, 0), a3, vA[0][0], vA[0][1]);
            PG8_WAIT_V(8); PG8_WAIT_L(0); PG8_BAR; PG8_MM(1, 0, At, B0); PG8_MM(1, 1, At, B1); PG8_BAR; PG8_SCHED;
        }
        if constexpr (ALIGN_EPI) { if (wr == 0) PG8_BAR; }
#ifdef PROBE_REGION
        { unsigned long long t0_ = 0; if (Epi::PID == PROBE_REGION) t0_ = __builtin_amdgcn_s_memrealtime();
          E(acc, cur, wr, wc, fr, fq);
          if (Epi::PID == PROBE_REGION && tid == 0) { asm volatile("s_waitcnt vmcnt(0)" ::: "memory"); volatile LAS unsigned* m_ = (volatile LAS unsigned*)(lds + 131072); m_[16] += (unsigned)(__builtin_amdgcn_s_memrealtime() - t0_); } }
#else
        { unsigned z_ = 0; asm volatile("" : "+v"(z_)); const int l2 = (int)__builtin_amdgcn_mbcnt_hi(~0u, __builtin_amdgcn_mbcnt_lo(~0u, z_));
          E(acc, cur, wr, wc, l2 & 15, l2 >> 4); }
#endif
        if (!has_next) break;
#pragma unroll
        for (int a = 0; a < 2; ++a)
#pragma unroll
            for (int b = 0; b < 2; ++b)
#pragma unroll
                for (int m = 0; m < 4; ++m)
#pragma unroll
                    for (int n = 0; n < 2; ++n) acc[a][b][m][n] = (f32x4){0.f, 0.f, 0.f, 0.f};
        cur = nxt; cA = nA; cB = nB; ++ui;
        if constexpr (ALIGN_EPI) { if (wr == 1) PG8_BAR; }
    }
    PG8_WAIT_V(0);
    if constexpr (!ALIGN_EPI) { if (wr == 0) PG8_BAR; }
    PG8_BAR;
#undef PG8_SA
#undef PG8_SB
#undef PG8_STAGE2
#undef PG8_STAGEB
#undef PG8_LDA
#undef PG8_LDB
#undef PG8_MMA
#undef PG8_MMA8
#undef PG8_MM
#undef PG8_WAIT_V
#undef PG8_WAIT_L
#undef PG8_BAR
#undef PG8_SCHED
}
}
constexpr int NWAVES = 8;
constexpr int RING_BYTES = 131072;
constexpr int MISC_OFF = RING_BYTES;
constexpr int LDS_BYTES = 163840;
constexpr int PARAMS_OFF = MISC_OFF + 1024;
constexpr int SPW_OFF = MISC_OFF + 2048, SPW_BYTES = 3712, STATS_OFF = SPW_OFF + 8 * SPW_BYTES;

#define XB_TMO      128
#define XB_XCNT(j)  (256  + 64 * (j))
#define XB_XSUB(j)  (1280 + 64 * (j))
#define XB_XGEN(j)  (2304 + 64 * (j))
#define XB_TOP      3328
#define XB_TOPGEN   3392
#define XCD_BAR_WORDS 3456
#define XB_SPIN_CAP (1u << 22)
DEV unsigned xb_ld(GAS unsigned* p) { return __hip_atomic_load(p, __ATOMIC_RELAXED, __HIP_MEMORY_SCOPE_AGENT); }
DEV unsigned xb_add(GAS unsigned* p, unsigned v) { return __hip_atomic_fetch_add(p, v, __ATOMIC_RELAXED, __HIP_MEMORY_SCOPE_AGENT); }
DEV unsigned xb_xcc_id() { return (unsigned)__builtin_amdgcn_s_getreg((3 << 11) | 20) & 0xFu; }
#define XB_SPIN(cond, bar) do { unsigned _sp = 0; while (cond) { __builtin_amdgcn_s_sleep(1); \
    if ((++_sp & 255u) == 0u) { if (xb_ld(&(bar)[XB_TMO])) break; if (_sp > XB_SPIN_CAP) { xb_add(&(bar)[XB_TMO], 1u); break; } } } } while (0)
struct XcdBarrier { GAS unsigned* bar; unsigned x; volatile LAS unsigned* st; };
DEV XcdBarrier xcd_barrier_post(GAS unsigned* bar, volatile LAS unsigned* st) {
    XcdBarrier b; b.bar = bar; b.x = xb_xcc_id(); b.st = st;
    if (threadIdx.x == 0) (void)xb_add(&bar[XB_XCNT(b.x)], 1u);
    return b;
}
DEV void xcd_barrier_complete(GAS unsigned* bar, unsigned x, unsigned& nloc, unsigned& nx) {
    const unsigned G = gridDim.x * gridDim.y * gridDim.z;
    unsigned sum, cnt, mine, sp = 0u;
    for (;;) {
        sum = 0u; cnt = 0u; mine = 0u;
#pragma unroll
        for (unsigned j = 0; j < 16; ++j) { const unsigned c = xb_ld(&bar[XB_XCNT(j)]); sum += c; cnt += (c > 0u) ? 1u : 0u; mine = (j == x) ? c : mine; }
        if (sum == G) break;
        __builtin_amdgcn_s_sleep(1);
        if ((++sp & 255u) == 0u) { if (xb_ld(&bar[XB_TMO])) break; if (sp > XB_SPIN_CAP) { xb_add(&bar[XB_TMO], 1u); break; } }
    }
    nloc = mine > 0u ? mine : 1u; nx = cnt > 0u ? cnt : 1u;
}
DEV void xcd_barrier(const XcdBarrier& b) {
    asm volatile("s_waitcnt vmcnt(0)" ::: "memory");
    __syncthreads();
    if (threadIdx.x == 0) {
        GAS unsigned* bar = b.bar; asm volatile("" : "+s"(bar));
        __builtin_amdgcn_s_waitcnt(0);
        unsigned nloc = b.st[0], nx = b.st[1];
        if (nloc == 0u) { xcd_barrier_complete(bar, b.x, nloc, nx); b.st[0] = nloc; b.st[1] = nx; }
        const unsigned old = xb_add(&bar[XB_XSUB(b.x)], 1u);
        const unsigned gen = old / nloc;
        if (old + 1u == (gen + 1u) * nloc) {
            __builtin_amdgcn_fence(__ATOMIC_RELEASE, "agent");
            asm volatile("s_waitcnt vmcnt(0)" ::: "memory");
            const unsigned og = xb_add(&bar[XB_TOP], 1u);
            const unsigned tg = og / nx;
            if (og + 1u == (tg + 1u) * nx) xb_add(&bar[XB_TOPGEN], 1u);
            else XB_SPIN(xb_ld(&bar[XB_TOPGEN]) == tg, bar);
            __builtin_amdgcn_fence(__ATOMIC_ACQUIRE, "agent");
            xb_add(&bar[XB_XGEN(b.x)], 1u);
            asm volatile("s_waitcnt vmcnt(0)" ::: "memory");
        } else {
            XB_SPIN(xb_ld(&bar[XB_XGEN(b.x)]) == gen, bar);
            __builtin_amdgcn_fence(__ATOMIC_ACQUIRE, "agent");
            asm volatile("s_waitcnt vmcnt(0)" ::: "memory");
        }
    }
    __syncthreads();
}

#ifdef PROBE_REGION
#define TREG_BEGIN(k) unsigned long long _treg##k = 0; if ((k) == PROBE_REGION) _treg##k = __builtin_amdgcn_s_memrealtime()
#define TREG_END(k, F) do { if ((k) == PROBE_REGION && (F).tid == 0) { volatile LAS unsigned* _m = (volatile LAS unsigned*)((F).lds + MISC_OFF); _m[16] += (unsigned)(__builtin_amdgcn_s_memrealtime() - _treg##k); } } while (0)
#else
#define TREG_BEGIN(k) do {} while (0)
#define TREG_END(k, F) do {} while (0)
#endif
struct Frame { LAS unsigned char* lds; unsigned char* ldsg; int tid, lane, wave, G, bx; };
DEV unsigned long long ldp64(const LAS unsigned* q, int i) { const unsigned lo = __builtin_amdgcn_readfirstlane(q[2 * i]), hi = __builtin_amdgcn_readfirstlane(q[2 * i + 1]); return ((unsigned long long)hi << 32) | lo; }
DEV Params load_params(const Frame& F) {
    unsigned off_ = PARAMS_OFF; asm volatile("" : "+v"(off_));
    Params p; const LAS unsigned* q = (const LAS unsigned*)(F.lds + off_);
    p.x = (const float*)(const GAS float*)ldp64(q, 0);
    p.c = (const float*)(const GAS float*)ldp64(q, 1);
    p.ctx = (const float*)(const GAS float*)ldp64(q, 2);
    p.c_ctx = (const float*)(const GAS float*)ldp64(q, 3);
    p.w_mod = (const float*)(const GAS float*)ldp64(q, 4);
    p.b_mod = (const float*)(const GAS float*)ldp64(q, 5);
    p.g_pre_mix = (const float*)(const GAS float*)ldp64(q, 6);
    p.g_post_mix = (const float*)(const GAS float*)ldp64(q, 7);
    p.g_pre_ffn = (const float*)(const GAS float*)ldp64(q, 8);
    p.g_post_ffn = (const float*)(const GAS float*)ldp64(q, 9);
    p.w_in = (const float*)(const GAS float*)ldp64(q, 10);
    p.ln_g = (const float*)(const GAS float*)ldp64(q, 11);
    p.ln_b = (const float*)(const GAS float*)ldp64(q, 12);
    p.gws = (const float*)(const GAS float*)ldp64(q, 13);
    p.gbs = (const float*)(const GAS float*)ldp64(q, 14);
    p.conv_w = (const float*)(const GAS float*)ldp64(q, 15);
    p.conv_b = (const float*)(const GAS float*)ldp64(q, 16);
    p.lru_wa = (const float*)(const GAS float*)ldp64(q, 17);
    p.lru_ba = (const float*)(const GAS float*)ldp64(q, 18);
    p.lru_wx = (const float*)(const GAS float*)ldp64(q, 19);
    p.lru_bx = (const float*)(const GAS float*)ldp64(q, 20);
    p.lru_lam = (const float*)(const GAS float*)ldp64(q, 21);
    p.w_out_a = (const float*)(const GAS float*)ldp64(q, 22);
    p.w_out_b = (const float*)(const GAS float*)ldp64(q, 23);
    p.w_out = (const float*)(const GAS float*)ldp64(q, 24);
    p.router_w = (const float*)(const GAS float*)ldp64(q, 25);
    p.router_b = (const float*)(const GAS float*)ldp64(q, 26);
    p.e_g = (const float*)(const GAS float*)ldp64(q, 27);
    p.e_u = (const float*)(const GAS float*)ldp64(q, 28);
    p.e_d = (const float*)(const GAS float*)ldp64(q, 29);
    p.s_g = (const float*)(const GAS float*)ldp64(q, 30);
    p.s_u = (const float*)(const GAS float*)ldp64(q, 31);
    p.s_d = (const float*)(const GAS float*)ldp64(q, 32);
    p.out = (float*)(GAS float*)ldp64(q, 33); p.ws = (unsigned char*)(GAS unsigned char*)ldp64(q, 34);
    return p;
}
DEV void store_params(const Frame& F, const Params& a) {
    if (F.tid == 0) { LAS unsigned long long* q = (LAS unsigned long long*)(F.lds + PARAMS_OFF);
        q[0] = (unsigned long long)a.x;
        q[1] = (unsigned long long)a.c;
        q[2] = (unsigned long long)a.ctx;
        q[3] = (unsigned long long)a.c_ctx;
        q[4] = (unsigned long long)a.w_mod;
        q[5] = (unsigned long long)a.b_mod;
        q[6] = (unsigned long long)a.g_pre_mix;
        q[7] = (unsigned long long)a.g_post_mix;
        q[8] = (unsigned long long)a.g_pre_ffn;
        q[9] = (unsigned long long)a.g_post_ffn;
        q[10] = (unsigned long long)a.w_in;
        q[11] = (unsigned long long)a.ln_g;
        q[12] = (unsigned long long)a.ln_b;
        q[13] = (unsigned long long)a.gws;
        q[14] = (unsigned long long)a.gbs;
        q[15] = (unsigned long long)a.conv_w;
        q[16] = (unsigned long long)a.conv_b;
        q[17] = (unsigned long long)a.lru_wa;
        q[18] = (unsigned long long)a.lru_ba;
        q[19] = (unsigned long long)a.lru_wx;
        q[20] = (unsigned long long)a.lru_bx;
        q[21] = (unsigned long long)a.lru_lam;
        q[22] = (unsigned long long)a.w_out_a;
        q[23] = (unsigned long long)a.w_out_b;
        q[24] = (unsigned long long)a.w_out;
        q[25] = (unsigned long long)a.router_w;
        q[26] = (unsigned long long)a.router_b;
        q[27] = (unsigned long long)a.e_g;
        q[28] = (unsigned long long)a.e_u;
        q[29] = (unsigned long long)a.e_d;
        q[30] = (unsigned long long)a.s_g;
        q[31] = (unsigned long long)a.s_u;
        q[32] = (unsigned long long)a.s_d;
        q[33] = (unsigned long long)a.out; q[34] = (unsigned long long)a.ws; }
}

DEV void transpose_item(const float* W, int N, bf16_t* WT, int dK, int koff, int rbase, int rhi, LAS float* scr, int kb, int nb, int lane, float scale = 1.0f) {
    const int k0 = 64 * kb, n0 = 32 * nb;
    float4 ld[8];
#pragma unroll
    for (int i = 0; i < 8; ++i) ld[i] = *(const float4*)(W + (size_t)(k0 + 8 * i + (lane >> 3)) * N + n0 + (lane & 7) * 4);
#pragma unroll
    for (int i = 0; i < 8; ++i) { LAS float* d = scr + (8 * i + (lane >> 3)) * 33 + (lane & 7) * 4; d[0] = ld[i].x; d[1] = ld[i].y; d[2] = ld[i].z; d[3] = ld[i].w; }
    asm volatile("s_waitcnt lgkmcnt(0)" ::: "memory");
    const int cc = lane & 7;
#pragma unroll
    for (int j = 0; j < 4; ++j) { const int nl = (lane >> 3) + 8 * j, n = n0 + nl; const LAS float* s = scr + (8 * cc) * 33 + nl;
        u32x4 o; o.x = pk2(s[0 * 33] * scale, s[1 * 33] * scale); o.y = pk2(s[2 * 33] * scale, s[3 * 33] * scale); o.z = pk2(s[4 * 33] * scale, s[5 * 33] * scale); o.w = pk2(s[6 * 33] * scale, s[7 * 33] * scale);
        const int drow = rbase + (n >> 7) * rhi + (n & 127);
        *(u32x4*)(WT + (size_t)drow * dK + koff + k0 + 8 * cc) = o; }
    asm volatile("s_waitcnt lgkmcnt(0)" ::: "memory");
}
DEV void transpose_item8(const float* W, int N, unsigned char* WT, int dK, int rbase, int rhi, LAS float* scr, int kb, int nb, int lane) {
    const int k0 = 64 * kb, n0 = 32 * nb;
    float4 ld[8];
#pragma unroll
    for (int i = 0; i < 8; ++i) ld[i] = *(const float4*)(W + (size_t)(k0 + 8 * i + (lane >> 3)) * N + n0 + (lane & 7) * 4);
#pragma unroll
    for (int i = 0; i < 8; ++i) { LAS float* d = scr + (8 * i + (lane >> 3)) * 33 + (lane & 7) * 4; d[0] = ld[i].x; d[1] = ld[i].y; d[2] = ld[i].z; d[3] = ld[i].w; }
    asm volatile("s_waitcnt lgkmcnt(0)" ::: "memory");
    const int cc = lane & 7;
#pragma unroll
    for (int j = 0; j < 4; ++j) { const int nl = (lane >> 3) + 8 * j, n = n0 + nl; const LAS float* s = scr + (8 * cc) * 33 + nl;
        unsigned lo = 0, hi = 0;
        lo = __builtin_amdgcn_cvt_pk_fp8_f32(s[0 * 33] * 64.f, s[1 * 33] * 64.f, lo, false); lo = __builtin_amdgcn_cvt_pk_fp8_f32(s[2 * 33] * 64.f, s[3 * 33] * 64.f, lo, true);
        hi = __builtin_amdgcn_cvt_pk_fp8_f32(s[4 * 33] * 64.f, s[5 * 33] * 64.f, hi, false); hi = __builtin_amdgcn_cvt_pk_fp8_f32(s[6 * 33] * 64.f, s[7 * 33] * 64.f, hi, true);
        const int drow = rbase + (n >> 7) * rhi + (n & 127);
        *(u32x2*)(WT + (size_t)drow * dK + k0 + 8 * cc) = (u32x2){lo, hi}; }
    asm volatile("s_waitcnt lgkmcnt(0)" ::: "memory");
}
DEV void convert_weights(const Params& p, const Frame& F, int l, int part, int vw, int nvw) {
    LAS float* scr = (LAS float*)(F.lds + F.wave * 16384);
    unsigned char* W = p.ws + WS_W;
    const int lane = F.lane;
    constexpr int I_IN = 16 * 128, I_OA = 8 * 32, I_OUT = 16 * 32, I_RT = 16 * 2, I_SG = 16 * 8, I_SD = 4 * 32, I_EG = NE * 16 * 8, I_ED = NE * 4 * 32, I_LRU = 32 * 2;
    if (part == 0) {
        constexpr int NITEMS = I_IN + 2 * I_OA + I_OUT + I_RT + 2 * I_SG + I_SD + I_LRU;
        for (int it = vw; it < NITEMS; it += nvw) {
            int r = it;
#if GIN_FP8
            if (r < I_IN) { transpose_item8(p.w_in + (size_t)l * D * 4096, 4096, W + WO_IN, D, 0, 128, scr, r / 128, r % 128, lane); continue; } r -= I_IN;
#else
            if (r < I_IN) { transpose_item(p.w_in + (size_t)l * D * 4096, 4096, (bf16_t*)(W + WO_IN), D, 0, 0, 128, scr, r / 128, r % 128, lane); continue; } r -= I_IN;
#endif
            if (r < I_OA) { transpose_item(p.w_out_a + (size_t)l * 512 * D, D, (bf16_t*)(W + WO_AB), D, 0, 0, 128, scr, r / 32, r % 32, lane); continue; } r -= I_OA;
            if (r < I_OA) { transpose_item(p.w_out_b + (size_t)l * 512 * D, D, (bf16_t*)(W + WO_AB), D, 512, 0, 128, scr, r / 32, r % 32, lane); continue; } r -= I_OA;
            if (r < I_OUT) { transpose_item(p.w_out + (size_t)l * D * D, D, (bf16_t*)(W + WO_OUT), D, 0, 0, 128, scr, r / 32, r % 32, lane); continue; } r -= I_OUT;
            if (r < I_RT) { transpose_item(p.router_w + (size_t)l * D * 64, 64, (bf16_t*)(W + WO_SR), D, 0, 0, 128, scr, r / 2, r % 2, lane); continue; } r -= I_RT;
            if (r < I_SG) { transpose_item(p.s_g + (size_t)l * D * 256, 256, (bf16_t*)(W + WO_SR), D, 0, 256, 256, scr, r / 8, r % 8, lane); continue; } r -= I_SG;
            if (r < I_SG) { transpose_item(p.s_u + (size_t)l * D * 256, 256, (bf16_t*)(W + WO_SR), D, 0, 256 + 128, 256, scr, r / 8, r % 8, lane); continue; } r -= I_SG;
#if GSD_FP8
            if (r < I_SD) { transpose_item8(p.s_d + (size_t)l * 256 * D, D, W + WO_SD, 256, 0, 128, scr, r / 32, r % 32, lane); continue; } r -= I_SD;
#else
            if (r < I_SD) { transpose_item(p.s_d + (size_t)l * 256 * D, D, (bf16_t*)(W + WO_SD), 256, 0, 0, 128, scr, r / 32, r % 32, lane); continue; } r -= I_SD;
#endif
            { const int mat = r / 2, nb = r % 2, type = mat >> 4, dh = mat & 15;
              const float* src = (type ? p.lru_wx : p.lru_wa) + (size_t)((l * 2) * 8 + dh) * 4096;
              transpose_item(src, 64, (bf16_t*)(W + WO_LRU) + (size_t)mat * 4096, 64, 0, 0, 128, scr, 0, nb, lane, -1.4426950408889634f); }
        }
        const int gt = vw * 64 + lane, NT = nvw * 64;
        for (int i = gt; i < 192 * D / 8; i += NT) *(u32x4*)((bf16_t*)(W + WO_SR) + (size_t)64 * D + (size_t)i * 8) = (u32x4){0u, 0u, 0u, 0u};
        for (int i = gt; i < 8 * 128 * 128 / 4; i += NT) { const float4 v = *(const float4*)(p.gws + (size_t)l * 8 * 128 * 128 + (size_t)i * 4);
            u32x2 o; o.x = pk2(v.x, v.y); o.y = pk2(v.z, v.w); *(u32x2*)((bf16_t*)(W + WO_GWS) + (size_t)i * 4) = o; }
    } else if (part == 2) {
#if GED_FP8
        for (int it = vw; it < I_ED; it += nvw) { const int e = it / 128, q = it % 128; transpose_item8(p.e_d + ((size_t)(l * NE + e) * 256) * D, D, W + WO_ED + (size_t)e * D * 256, 256, 0, 128, scr, q / 32, q % 32, lane); }
#else
        for (int it = vw; it < I_ED; it += nvw) { const int e = it / 128, q = it % 128; transpose_item(p.e_d + ((size_t)(l * NE + e) * 256) * D, D, (bf16_t*)(W + WO_ED) + (size_t)e * D * 256, 256, 0, 0, 128, scr, q / 32, q % 32, lane); }
#endif
    } else {
        constexpr int NITEMS = 2 * I_EG;
        for (int it = vw; it < NITEMS; it += nvw) {
            int r = it;
            if (r < I_EG) { const int e = r / 128, q = r % 128; transpose_item8(p.e_g + ((size_t)(l * NE + e) * D) * 256, 256, W + WO_EG + (size_t)e * 512 * D, D, 0, 256, scr, q / 8, q % 8, lane); continue; } r -= I_EG;
            { const int e = r / 128, q = r % 128; transpose_item8(p.e_u + ((size_t)(l * NE + e) * D) * 256, 256, W + WO_EG + (size_t)e * 512 * D, D, 128, 256, scr, q / 8, q % 8, lane); }
        }
    }
}
DEV void pe_table(const Params& p, const Frame& F, int idx) {
    const int pos = idx >> 9, half = (idx >> 8) & 1, q = idx & 255;
    const float omega = 1.0f / powf(10000.0f, (float)q / 256.0f);
    const float ang = (float)pos * omega;
    ((float*)(p.ws + WS_PE))[idx] = half ? cosf(ang) : sinf(ang);
}
DEV void mod_items(const Params& p, const Frame& F) {
    LAS float* part = (LAS float*)(F.lds);
    LAS float* sc = (LAS float*)(F.lds + 16384);
    if (F.bx < 2 * 96) {
        for (int i = F.tid; i < 5 * D; i += NWAVES * 64) { const int cnd = i >> 10, d = i & (D - 1); sc[d * 8 + cnd] = siluf_(cnd < 4 ? p.c[cnd * D + d] : p.c_ctx[d]); }
        __syncthreads();
    }
    for (int it = F.bx; it < 2 * 96; it += F.G) {
        const int l = it / 96, e = (it % 96) * 64 + F.lane;
        const float* w = p.w_mod + (size_t)l * D * 6 * D + e;
        float acc[5] = {0.f, 0.f, 0.f, 0.f, 0.f};
        const int d0 = F.wave * 128;
#pragma unroll 32
        for (int d = d0; d < d0 + 128; ++d) { const float wv = w[(size_t)d * 6 * D]; const f32x4 s4 = *(const LAS f32x4*)(sc + d * 8); const float s5 = sc[d * 8 + 4];
            acc[0] += s4[0] * wv; acc[1] += s4[1] * wv; acc[2] += s4[2] * wv; acc[3] += s4[3] * wv; acc[4] += s5 * wv; }
#pragma unroll
        for (int cnd = 0; cnd < 5; ++cnd) part[(F.wave * 5 + cnd) * 64 + F.lane] = acc[cnd];
        __syncthreads();
        if (F.tid < 320) { const int cnd = F.tid >> 6, ln = F.tid & 63; float s = p.b_mod[l * 6 * D + (it % 96) * 64 + ln];
#pragma unroll
            for (int w8 = 0; w8 < 8; ++w8) s += part[(w8 * 5 + cnd) * 64 + ln];
            ((float*)(p.ws + WS_MOD))[(size_t)(l * 5 + cnd) * 6 * D + (it % 96) * 64 + ln] = s; }
        __syncthreads();
    }
}

DEV bf16_t* xl16_row(const Params& p, int r) { return (bf16_t*)((unsigned char*)p.out + (size_t)r * 4096 + 2048); }
DEV void load_xl(const Params& p, int r, int lane, float (&v)[16]) {
    if (r < TL) { const bf16_t* x = xl16_row(p, r);
#pragma unroll
        for (int j = 0; j < 4; ++j) { const ushort4 t = *(const ushort4*)(x + (j * 64 + lane) * 4); v[4 * j] = bf2f(t.x); v[4 * j + 1] = bf2f(t.y); v[4 * j + 2] = bf2f(t.z); v[4 * j + 3] = bf2f(t.w); } }
    else { const float* x = (const float*)(p.ws + WS_XC) + (size_t)(r - TL) * D;
#pragma unroll
        for (int j = 0; j < 4; ++j) { const float4 t = *(const float4*)(x + (j * 64 + lane) * 4); v[4 * j] = t.x; v[4 * j + 1] = t.y; v[4 * j + 2] = t.z; v[4 * j + 3] = t.w; } }
}
DEV void store_xl(const Params& p, int r, int lane, const float (&v)[16], bool final_f32) {
    if (r < TL && !final_f32) { bf16_t* x = xl16_row(p, r);
#pragma unroll
        for (int j = 0; j < 4; ++j) { u32x2 o; o.x = pk2(v[4 * j], v[4 * j + 1]); o.y = pk2(v[4 * j + 2], v[4 * j + 3]); *(u32x2*)(x + (j * 64 + lane) * 4) = o; } }
    else { float* x = r < TL ? p.out + (size_t)r * D : (float*)(p.ws + WS_XC) + (size_t)(r - TL) * D;
#pragma unroll
        for (int j = 0; j < 4; ++j) *(float4*)(x + (j * 64 + lane) * 4) = make_float4(v[4 * j], v[4 * j + 1], v[4 * j + 2], v[4 * j + 3]); }
}
DEV void row_pass_A(const Params& p, int l, int rlo, int rhi, int wave, int nw, int lane) {
    const bf16_t* FL = (const bf16_t*)(p.ws + WS_RY);
    for (int r = rlo + wave; r < rhi; r += nw) {
        const int cond = r < TL ? (r >> 13) : 4;
        float v[16];
        if (l == 0) {
            const float* src = r < TL ? p.x + (size_t)r * D : p.ctx + (size_t)(r - TL) * D;
#pragma unroll
            for (int j = 0; j < 4; ++j) { const float4 t = *(const float4*)(src + (j * 64 + lane) * 4); v[4 * j] = t.x; v[4 * j + 1] = t.y; v[4 * j + 2] = t.z; v[4 * j + 3] = t.w; }
            if (r < TL) {
                const int t = r & (SEQ - 1); const float* PE = (const float*)(p.ws + WS_PE);
#pragma unroll
                for (int j = 0; j < 4; ++j) { const float4 e = *(const float4*)(PE + ((j < 2) ? (t >> 6) : (t & 63)) * 512 + (j & 1) * 256 + lane * 4);
                    v[4 * j] += e.x; v[4 * j + 1] += e.y; v[4 * j + 2] += e.z; v[4 * j + 3] += e.w; }
            }
        } else {
            float f[16]; float ss = 0.f;
            load_xl(p, r, lane, v);
#pragma unroll
            for (int j = 0; j < 4; ++j) {
                const ushort4 fb = *(const ushort4*)(FL + (size_t)r * D + (j * 64 + lane) * 4);
                f[4 * j] = bf2f(fb.x); f[4 * j + 1] = bf2f(fb.y); f[4 * j + 2] = bf2f(fb.z); f[4 * j + 3] = bf2f(fb.w);
            }
            { const unsigned char* SL = p.ws + WS_SLOTS + (size_t)r * 8 * 1024;
                unsigned sv[8][4];
#pragma unroll
                for (int s = 0; s < 8; ++s)
#pragma unroll
                    for (int j = 0; j < 4; ++j) sv[s][j] = *(const unsigned*)(SL + (size_t)s * 1024 + (j * 64 + lane) * 4);
#pragma unroll
                for (int j = 0; j < 4; ++j) { float a0 = 0.f, a1 = 0.f, a2 = 0.f, a3 = 0.f;
#pragma unroll
                    for (int s = 0; s < 8; ++s) { a0 += __builtin_amdgcn_cvt_f32_fp8(sv[s][j], 0); a1 += __builtin_amdgcn_cvt_f32_fp8(sv[s][j], 1); a2 += __builtin_amdgcn_cvt_f32_fp8(sv[s][j], 2); a3 += __builtin_amdgcn_cvt_f32_fp8(sv[s][j], 3); }
                    f[4 * j] += a0 * 0.0625f; f[4 * j + 1] += a1 * 0.0625f; f[4 * j + 2] += a2 * 0.0625f; f[4 * j + 3] += a3 * 0.0625f; } }
#pragma unroll
            for (int i = 0; i < 16; ++i) ss += f[i] * f[i];
            const float rstd = rsqrtf(wave_sum(ss) * (1.f / D) + 1e-6f);
            const float* gt = mod_ptr(p, l - 1, cond, 5); const float* g = p.g_post_ffn + (l - 1) * D;
#pragma unroll
            for (int j = 0; j < 4; ++j) { const float4 gt4 = *(const float4*)(gt + (j * 64 + lane) * 4), g4 = *(const float4*)(g + (j * 64 + lane) * 4);
                v[4 * j] += gt4.x * (f[4 * j] * rstd * g4.x); v[4 * j + 1] += gt4.y * (f[4 * j + 1] * rstd * g4.y); v[4 * j + 2] += gt4.z * (f[4 * j + 2] * rstd * g4.z); v[4 * j + 3] += gt4.w * (f[4 * j + 3] * rstd * g4.w); }
        }
        store_xl(p, r, lane, v, l == 2);
        if (l < 2) {
            float ss = 0.f;
#pragma unroll
            for (int i = 0; i < 16; ++i) ss += v[i] * v[i];
            const float rstd = rsqrtf(wave_sum(ss) * (1.f / D) + 1e-6f);
            const float* sh = mod_ptr(p, l, cond, 0); const float* sc = mod_ptr(p, l, cond, 1); const float* g = p.g_pre_mix + l * D;
#pragma unroll
            for (int j = 0; j < 4; ++j) { const int d = (j * 64 + lane) * 4; const float4 sh4 = *(const float4*)(sh + d), sc4 = *(const float4*)(sc + d), g4 = *(const float4*)(g + d);
                u32x2 o; o.x = pk2(v[4 * j] * rstd * g4.x * (1.f + sc4.x) + sh4.x, v[4 * j + 1] * rstd * g4.y * (1.f + sc4.y) + sh4.y);
                o.y = pk2(v[4 * j + 2] * rstd * g4.z * (1.f + sc4.z) + sh4.z, v[4 * j + 3] * rstd * g4.w * (1.f + sc4.w) + sh4.w);
#if GIN_FP8
                { const float h0 = __uint_as_float(o.x << 16) * 16.f, h1 = __uint_as_float(o.x & 0xffff0000u) * 16.f, h2 = __uint_as_float(o.y << 16) * 16.f, h3 = __uint_as_float(o.y & 0xffff0000u) * 16.f;
                  unsigned t = 0; t = __builtin_amdgcn_cvt_pk_fp8_f32(__builtin_amdgcn_fmed3f(h0, -440.f, 440.f), __builtin_amdgcn_fmed3f(h1, -440.f, 440.f), t, false);
                  t = __builtin_amdgcn_cvt_pk_fp8_f32(__builtin_amdgcn_fmed3f(h2, -440.f, 440.f), __builtin_amdgcn_fmed3f(h3, -440.f, 440.f), t, true);
                  *(unsigned*)(p.ws + WS_H8 + (size_t)r * D + d) = t; }
#else
                *(u32x2*)((bf16_t*)(p.ws + WS_RY) + (size_t)r * D + d) = o;
#endif
            }
        }
    }
}
DEV void row_pass_H(const Params& p, int l, int rlo, int rhi, int wave, int nw, int lane) {
    const bf16_t* YL = (const bf16_t*)(p.ws + WS_Z);
    bf16_t* H = (bf16_t*)(p.ws + WS_RA);
    for (int r = rlo + wave; r < rhi; r += nw) {
        const int cond = r < TL ? (r >> 13) : 4;
        float v[16], f[16]; float ss = 0.f;
        load_xl(p, r, lane, v);
#pragma unroll
        for (int j = 0; j < 4; ++j) {
            const ushort4 fb = *(const ushort4*)(YL + (size_t)r * D + (j * 64 + lane) * 4);
            f[4 * j] = bf2f(fb.x); f[4 * j + 1] = bf2f(fb.y); f[4 * j + 2] = bf2f(fb.z); f[4 * j + 3] = bf2f(fb.w);
        }
#pragma unroll
        for (int i = 0; i < 16; ++i) ss += f[i] * f[i];
        const float rstd = rsqrtf(wave_sum(ss) * (1.f / D) + 1e-6f);
        const float* gt = mod_ptr(p, l, cond, 2); const float* g = p.g_post_mix + l * D;
#pragma unroll
        for (int j = 0; j < 4; ++j) { const float4 gt4 = *(const float4*)(gt + (j * 64 + lane) * 4), g4 = *(const float4*)(g + (j * 64 + lane) * 4);
            v[4 * j] += gt4.x * (f[4 * j] * rstd * g4.x); v[4 * j + 1] += gt4.y * (f[4 * j + 1] * rstd * g4.y); v[4 * j + 2] += gt4.z * (f[4 * j + 2] * rstd * g4.z); v[4 * j + 3] += gt4.w * (f[4 * j + 3] * rstd * g4.w); }
        store_xl(p, r, lane, v, false);
        float s2 = 0.f;
#pragma unroll
        for (int i = 0; i < 16; ++i) s2 += v[i] * v[i];
        const float rstd2 = rsqrtf(wave_sum(s2) * (1.f / D) + 1e-6f);
        const float* sh = mod_ptr(p, l, cond, 3); const float* sc = mod_ptr(p, l, cond, 4); const float* g2 = p.g_pre_ffn + l * D;
#pragma unroll
        for (int j = 0; j < 4; ++j) { const int d = (j * 64 + lane) * 4; const float4 sh4 = *(const float4*)(sh + d), sc4 = *(const float4*)(sc + d), g4 = *(const float4*)(g2 + d);
            u32x2 o; o.x = pk2(v[4 * j] * rstd2 * g4.x * (1.f + sc4.x) + sh4.x, v[4 * j + 1] * rstd2 * g4.y * (1.f + sc4.y) + sh4.y);
            o.y = pk2(v[4 * j + 2] * rstd2 * g4.z * (1.f + sc4.z) + sh4.z, v[4 * j + 3] * rstd2 * g4.w * (1.f + sc4.w) + sh4.w);
            *(u32x2*)(H + (size_t)r * D + d) = o;
            { const float h0 = __uint_as_float(o.x << 16) * 16.f, h1 = __uint_as_float(o.x & 0xffff0000u) * 16.f, h2 = __uint_as_float(o.y << 16) * 16.f, h3 = __uint_as_float(o.y & 0xffff0000u) * 16.f;
              unsigned t = 0; t = __builtin_amdgcn_cvt_pk_fp8_f32(__builtin_amdgcn_fmed3f(h0, -440.f, 440.f), __builtin_amdgcn_fmed3f(h1, -440.f, 440.f), t, false);
              t = __builtin_amdgcn_cvt_pk_fp8_f32(__builtin_amdgcn_fmed3f(h2, -440.f, 440.f), __builtin_amdgcn_fmed3f(h3, -440.f, 440.f), t, true);
              *(unsigned*)(p.ws + WS_H2E + (size_t)r * D + d) = t; } }
    }
}

DEV void cvt4(const u32x2 w, float* o) { o[0] = __uint_as_float(w.x << 16); o[1] = __uint_as_float(w.x & 0xffff0000u); o[2] = __uint_as_float(w.y << 16); o[3] = __uint_as_float(w.y & 0xffff0000u); }
DEV unsigned e4m3x4_x16(const u32x2 o) {
    const float h0 = __uint_as_float(o.x << 16) * 16.f, h1 = __uint_as_float(o.x & 0xffff0000u) * 16.f, h2 = __uint_as_float(o.y << 16) * 16.f, h3 = __uint_as_float(o.y & 0xffff0000u) * 16.f;
    unsigned t = 0; t = __builtin_amdgcn_cvt_pk_fp8_f32(__builtin_amdgcn_fmed3f(h0, -440.f, 440.f), __builtin_amdgcn_fmed3f(h1, -440.f, 440.f), t, false);
    return __builtin_amdgcn_cvt_pk_fp8_f32(__builtin_amdgcn_fmed3f(h2, -440.f, 440.f), __builtin_amdgcn_fmed3f(h3, -440.f, 440.f), t, true);
}
DEV void load_prod(const float* a, const float* b, int lane, float* o) {
#pragma unroll
    for (int j = 0; j < 4; ++j) { const float4 x = *(const float4*)(a + (j * 64 + lane) * 4), y = *(const float4*)(b + (j * 64 + lane) * 4); o[4 * j] = x.x * y.x; o[4 * j + 1] = x.y * y.y; o[4 * j + 2] = x.z * y.z; o[4 * j + 3] = x.w * y.w; }
}
DEV void load_affine(const float* g, const float* sc, const float* sh, int lane, float* am, float* bm) {
#pragma unroll
    for (int j = 0; j < 4; ++j) { const int d = (j * 64 + lane) * 4; const float4 g4 = *(const float4*)(g + d), s4 = *(const float4*)(sc + d), h4 = *(const float4*)(sh + d);
        am[4 * j] = g4.x * (1.f + s4.x); am[4 * j + 1] = g4.y * (1.f + s4.y); am[4 * j + 2] = g4.z * (1.f + s4.z); am[4 * j + 3] = g4.w * (1.f + s4.w);
        bm[4 * j] = h4.x; bm[4 * j + 1] = h4.y; bm[4 * j + 2] = h4.z; bm[4 * j + 3] = h4.w; }
}
DEV float sumsq16(const float* v) { float s = 0.f;
#pragma unroll
    for (int i = 0; i < 16; ++i) s += v[i] * v[i];
    return s; }
DEV void emit_h(const float* v, float rstd2, const float* am, const float* bm, int lane, bf16_t* dst16, unsigned char* dst8) {
#pragma unroll
    for (int j = 0; j < 4; ++j) { const int d = (j * 64 + lane) * 4;
        u32x2 o; o.x = pk2(v[4 * j] * rstd2 * am[4 * j] + bm[4 * j], v[4 * j + 1] * rstd2 * am[4 * j + 1] + bm[4 * j + 1]);
        o.y = pk2(v[4 * j + 2] * rstd2 * am[4 * j + 2] + bm[4 * j + 2], v[4 * j + 3] * rstd2 * am[4 * j + 3] + bm[4 * j + 3]);
        if (dst16) *(u32x2*)(dst16 + d) = o;
        if (dst8) *(unsigned*)(dst8 + d) = e4m3x4_x16(o); }
}
DEV void store_xl16(const Params& p, int r, int lane, const float* v) { bf16_t* x = xl16_row(p, r);
#pragma unroll
    for (int j = 0; j < 4; ++j) { u32x2 o; o.x = pk2(v[4 * j], v[4 * j + 1]); o.y = pk2(v[4 * j + 2], v[4 * j + 3]); *(u32x2*)(x + (j * 64 + lane) * 4) = o; }
}
DEV void row_lat_A0(const Params& p, int wave, int nw, int lane) {
    const float* PE = (const float*)(p.ws + WS_PE);
    float am[16], bm[16]; int condp = -1;
    float4 xr[2][4], pr[2][4];
    int r = wave; if (r >= TL) return;
#define ROWA0_LOAD(q, rr) do { const int t_ = (rr) & (SEQ - 1); \
        _Pragma("unroll") for (int j = 0; j < 4; ++j) { xr[q][j] = *(const float4*)(p.x + (size_t)(rr) * D + (j * 64 + lane) * 4); pr[q][j] = *(const float4*)(PE + ((j < 2) ? (t_ >> 6) : (t_ & 63)) * 512 + (j & 1) * 256 + lane * 4); } } while (0)
    ROWA0_LOAD(0, r); ROWA0_LOAD(1, r + nw);
    for (; r < TL; r += 2 * nw) {
        float v[2][16];
#pragma unroll
        for (int q = 0; q < 2; ++q)
#pragma unroll
            for (int j = 0; j < 4; ++j) { v[q][4 * j] = xr[q][j].x + pr[q][j].x; v[q][4 * j + 1] = xr[q][j].y + pr[q][j].y; v[q][4 * j + 2] = xr[q][j].z + pr[q][j].z; v[q][4 * j + 3] = xr[q][j].w + pr[q][j].w; }
        const int rl = (r + 2 * nw < TL) ? r + 2 * nw : r;
        ROWA0_LOAD(0, rl); ROWA0_LOAD(1, rl + nw);
        const int cond = r >> 13;
        if (cond != condp) { condp = cond; load_affine(p.g_pre_mix, mod_ptr(p, 0, cond, 1), mod_ptr(p, 0, cond, 0), lane, am, bm); }
#pragma unroll
        for (int q = 0; q < 2; ++q) { const int rq = r + q * nw;
            store_xl16(p, rq, lane, v[q]);
            const float rstd2 = rsqrtf(wave_sum(sumsq16(v[q])) * (1.f / D) + 1e-6f);
#if GIN_FP8
            emit_h(v[q], rstd2, am, bm, lane, nullptr, p.ws + WS_H8 + (size_t)rq * D);
#else
            emit_h(v[q], rstd2, am, bm, lane, (bf16_t*)(p.ws + WS_RY) + (size_t)rq * D, nullptr);
#endif
        }
    }
#undef ROWA0_LOAD
}
DEV void row_lat_A(const Params& p, int l, int wave, int nw, int lane) {
    const bf16_t* FL = (const bf16_t*)(p.ws + WS_RY);
    float gtg[16], am[16], bm[16]; int condp = -1;
    u32x2 xr[4], fr[4]; unsigned sr[8][4];
    int r = wave; if (r >= TL) return;
#define ROWA_LOAD(rr) do { const bf16_t* x_ = xl16_row(p, (rr)); const unsigned char* SL_ = p.ws + WS_SLOTS + (size_t)(rr) * 8 * 1024; \
        _Pragma("unroll") for (int j = 0; j < 4; ++j) { xr[j] = *(const u32x2*)(x_ + (j * 64 + lane) * 4); fr[j] = *(const u32x2*)(FL + (size_t)(rr) * D + (j * 64 + lane) * 4); } \
        _Pragma("unroll") for (int s_ = 0; s_ < 8; ++s_) _Pragma("unroll") for (int j = 0; j < 4; ++j) sr[s_][j] = *(const unsigned*)(SL_ + (size_t)s_ * 1024 + (j * 64 + lane) * 4); } while (0)
    ROWA_LOAD(r);
    for (; r < TL; r += nw) {
        float v[16], f[16];
#pragma unroll
        for (int j = 0; j < 4; ++j) { cvt4(xr[j], v + 4 * j); cvt4(fr[j], f + 4 * j);
            float a0 = 0.f, a1 = 0.f, a2 = 0.f, a3 = 0.f;
#pragma unroll
            for (int s8 = 0; s8 < 8; ++s8) { a0 += __builtin_amdgcn_cvt_f32_fp8(sr[s8][j], 0); a1 += __builtin_amdgcn_cvt_f32_fp8(sr[s8][j], 1); a2 += __builtin_amdgcn_cvt_f32_fp8(sr[s8][j], 2); a3 += __builtin_amdgcn_cvt_f32_fp8(sr[s8][j], 3); }
            f[4 * j] += a0 * 0.0625f; f[4 * j + 1] += a1 * 0.0625f; f[4 * j + 2] += a2 * 0.0625f; f[4 * j + 3] += a3 * 0.0625f; }
        const int rl = (r + nw < TL) ? r + nw : r;
        ROWA_LOAD(rl);
        const int cond = r >> 13;
        if (cond != condp) { condp = cond; load_prod(mod_ptr(p, l - 1, cond, 5), p.g_post_ffn + (l - 1) * D, lane, gtg);
            if (l < 2) load_affine(p.g_pre_mix + l * D, mod_ptr(p, l, cond, 1), mod_ptr(p, l, cond, 0), lane, am, bm); }
        const float rstd = rsqrtf(wave_sum(sumsq16(f)) * (1.f / D) + 1e-6f);
#pragma unroll
        for (int i = 0; i < 16; ++i) v[i] += gtg[i] * (f[i] * rstd);
        if (l == 2) { float* x = p.out + (size_t)r * D;
#pragma unroll
            for (int j = 0; j < 4; ++j) *(float4*)(x + (j * 64 + lane) * 4) = make_float4(v[4 * j], v[4 * j + 1], v[4 * j + 2], v[4 * j + 3]);
        } else {
            store_xl16(p, r, lane, v);
            const float rstd2 = rsqrtf(wave_sum(sumsq16(v)) * (1.f / D) + 1e-6f);
#if GIN_FP8
            emit_h(v, rstd2, am, bm, lane, nullptr, p.ws + WS_H8 + (size_t)r * D);
#else
            emit_h(v, rstd2, am, bm, lane, (bf16_t*)(p.ws + WS_RY) + (size_t)r * D, nullptr);
#endif
        }
    }
#undef ROWA_LOAD
}
DEV void row_lat_H(const Params& p, int l, int wave, int nw, int lane) {
    const bf16_t* YL = (const bf16_t*)(p.ws + WS_Z);
    float gtg[16], am[16], bm[16]; int condp = -1;
    u32x2 xr[2][4], yr[2][4];
    int r = wave; if (r >= TL) return;
#define ROWH_LOAD(q, rr) do { _Pragma("unroll") for (int j = 0; j < 4; ++j) { xr[q][j] = *(const u32x2*)(xl16_row(p, (rr)) + (j * 64 + lane) * 4); yr[q][j] = *(const u32x2*)(YL + (size_t)(rr) * D + (j * 64 + lane) * 4); } } while (0)
    ROWH_LOAD(0, r); ROWH_LOAD(1, r + nw);
    for (; r < TL; r += 2 * nw) {
        float v[2][16], f[2][16];
#pragma unroll
        for (int q = 0; q < 2; ++q)
#pragma unroll
            for (int j = 0; j < 4; ++j) { cvt4(xr[q][j], v[q] + 4 * j); cvt4(yr[q][j], f[q] + 4 * j); }
        const int rl = (r + 2 * nw < TL) ? r + 2 * nw : r;
        ROWH_LOAD(0, rl); ROWH_LOAD(1, rl + nw);
        const int cond = r >> 13;
        if (cond != condp) { condp = cond; load_prod(mod_ptr(p, l, cond, 2), p.g_post_mix + l * D, lane, gtg); load_affine(p.g_pre_ffn + l * D, mod_ptr(p, l, cond, 4), mod_ptr(p, l, cond, 3), lane, am, bm); }
#pragma unroll
        for (int q = 0; q < 2; ++q) { const int rq = r + q * nw;
            const float rstd = rsqrtf(wave_sum(sumsq16(f[q])) * (1.f / D) + 1e-6f);
#pragma unroll
            for (int i = 0; i < 16; ++i) v[q][i] += gtg[i] * (f[q][i] * rstd);
            store_xl16(p, rq, lane, v[q]);
            const float rstd2 = rsqrtf(wave_sum(sumsq16(v[q])) * (1.f / D) + 1e-6f);
            emit_h(v[q], rstd2, am, bm, lane, (bf16_t*)(p.ws + WS_RA) + (size_t)rq * D, p.ws + WS_H2E + (size_t)rq * D); }
    }
#undef ROWH_LOAD
}

DEV void route_token(const Params& p, int l, float logit, int lane, int& myi, float& myw) {
    const float s = sigmoidf_(logit);
    const float sel = s + p.router_b[l * 64 + lane];
    int rank = 0;
#pragma unroll
    for (int k = 1; k < 8; ++k) { const float o = __shfl_xor(sel, k); const int ol = lane ^ k; rank += (o > sel || (o == sel && ol < lane)) ? 1 : 0; }
    float gs = rank < 2 ? sel : 0.f;
    gs += __shfl_xor(gs, 1); gs += __shfl_xor(gs, 2); gs += __shfl_xor(gs, 4);
    const int g = lane >> 3; int grank = 0;
#pragma unroll
    for (int k = 1; k < 8; ++k) { const float o = __shfl_xor(gs, 8 * k); const int og = g ^ k; grank += (o > gs || (o == gs && og < g)) ? 1 : 0; }
    float mv = grank < 4 ? sel : -INFINITY;
    float wsum = 0.f; myw = 0.f; myi = 0;
    for (int s8 = 0; s8 < 8; ++s8) {
        float mx = mv;
#pragma unroll
        for (int o = 32; o >= 1; o >>= 1) mx = fmaxf(mx, __shfl_xor(mx, o));
        const unsigned long long bal = __ballot(mv == mx);
        const int win = __ffsll((long long)bal) - 1;
        const float sw = __shfl(s, win);
        if (lane == s8) { myi = win; myw = sw; }
        wsum += sw;
        if (lane == win) mv = -INFINITY;
    }
    myw = myw / wsum * 2.5f;
}
DEV void route_rows(const Params& p, const Frame& F, int l, int r0) {
    int* hist = (int*)(F.ldsg); int* base = hist + 64; int* loc = hist + 128; float* locw = (float*)(hist + 128 + 2048);
    int* LISTA = (int*)(p.ws + WS_LISTA); float* LISTW = (float*)(p.ws + WS_LISTW);
    unsigned* CNT = (unsigned*)(p.ws + WS_CTL) + CW_CNT + l * 64;
    constexpr int rpw = 256;
    if (F.tid < 64) hist[F.tid] = 0;
    __syncthreads();
    const int ti = F.wave * 64 + F.lane;
    if (F.wave < 4) {
        const float* LOG = (const float*)(p.ws + WS_LOG) + (size_t)(r0 + ti) * 64;
        float sv[64], sel[64];
#pragma unroll
        for (int q = 0; q < 16; ++q) { const float4 t = *(const float4*)(LOG + 4 * q); sv[4 * q] = t.x; sv[4 * q + 1] = t.y; sv[4 * q + 2] = t.z; sv[4 * q + 3] = t.w; }
#pragma unroll
        for (int e = 0; e < 64; ++e) { sv[e] = fsigmoid(sv[e]); sel[e] = sv[e] + p.router_b[l * 64 + e]; }
        float gs[8];
#pragma unroll
        for (int g = 0; g < 8; ++g) { float m1 = fmaxf(sel[8 * g], sel[8 * g + 1]), m2 = fminf(sel[8 * g], sel[8 * g + 1]);
#pragma unroll
            for (int k = 2; k < 8; ++k) { const float x = sel[8 * g + k]; m2 = fmaxf(m2, fminf(m1, x)); m1 = fmaxf(m1, x); }
            gs[g] = m1 + m2; }
#pragma unroll
        for (int g = 0; g < 8; ++g) { int rank = 0;
#pragma unroll
            for (int k = 0; k < 8; ++k) if (k != g) rank += (gs[k] > gs[g] || (gs[k] == gs[g] && k < g)) ? 1 : 0;
            if (rank >= 4) {
#pragma unroll
                for (int k = 0; k < 8; ++k) sel[8 * g + k] = -INFINITY; } }
        float wsum = 0.f; int bi8[8]; float bw8[8];
#pragma unroll
        for (int s8 = 0; s8 < 8; ++s8) { float best = sel[0], bs = sv[0]; int bi = 0;
#pragma unroll
            for (int e = 1; e < 64; ++e) { const bool gt = sel[e] > best; best = gt ? sel[e] : best; bs = gt ? sv[e] : bs; bi = gt ? e : bi; }
#pragma unroll
            for (int e = 0; e < 64; ++e) sel[e] = (e == bi) ? -INFINITY : sel[e];
            bi8[s8] = bi; bw8[s8] = bs; wsum += bs; }
        const float sc = 2.5f / wsum;
#pragma unroll
        for (int s8 = 0; s8 < 8; ++s8) { const int rk = atomicAdd(&hist[bi8[s8]], 1); loc[ti * 8 + s8] = (bi8[s8] << 16) | rk; locw[ti * 8 + s8] = bw8[s8] * sc; }
    }
    __syncthreads();
    if (F.tid < 64) base[F.tid] = (int)__hip_atomic_fetch_add(CNT + F.tid, (unsigned)hist[F.tid], __ATOMIC_RELAXED, __HIP_MEMORY_SCOPE_AGENT);
    __syncthreads();
    for (int idx = F.tid; idx < rpw * 8; idx += NWAVES * 64) { const int v = loc[idx], e = v >> 16, rk = v & 0xffff; const int within = base[e] + rk;
        if (within < CAP) { const size_t pos = (size_t)e * CAP + within; LISTA[pos] = (r0 + (idx >> 3)) * 8 + (idx & 7); LISTW[pos] = locw[idx]; } }
    __syncthreads();
}
DEV void combine_pass(const Params& p, int hf, int nrows, int wave, int nw, int lane) {
    bf16_t* FS = (bf16_t*)(p.ws + WS_RY); const bf16_t* SL = (const bf16_t*)(p.ws + WS_SLOTS);
    for (int r = wave; r < nrows; r += nw) {
        bf16_t* fp = FS + (size_t)r * D + hf * 512 + lane * 8;
        f32x4 a0, a1; pg8::unpack8(*(const u32x4*)fp, a0, a1);
        u32x4 sv[8];
#pragma unroll
        for (int s = 0; s < 8; ++s) sv[s] = *(const u32x4*)(SL + ((size_t)r * 8 + s) * 512 + lane * 8);
#pragma unroll
        for (int s = 0; s < 8; ++s) { f32x4 b0, b1; pg8::unpack8(sv[s], b0, b1); a0 += b0; a1 += b1; }
        *(u32x4*)fp = pg8::pack8(a0, a1);
    }
}
DEV size_t summ_idx(int dir, int b, int pos, int which, int ch) { return ((((size_t)dir * 4 + b) * 66 + pos) * 2 + which) * 512 + ch; }
DEV f32x4 mfma16(bf16x8 a, bf16x8 b, f32x4 c) { return __builtin_amdgcn_mfma_f32_16x16x32_bf16(a, b, c, 0, 0, 0); }

template <int PASS>
DEV void chunk_pass(const Params& p, const Frame& F, int l_in, int c, bool do_gmlp) {
    int oz = 0; asm volatile("" : "+s"(oz));
    const int l = l_in + oz;
    const int lane = F.lane, h = F.wave, fr = lane & 15, fq = lane >> 4;
    const bf16_t* Z = (const bf16_t*)(p.ws + WS_Z); bf16_t* Y = (bf16_t*)(p.ws + WS_RY); float* SUMM = (float*)(p.ws + WS_SUMM);
    const unsigned char* W = p.ws + WS_W + oz;
    int r0, t0, n, b, posf, posb;
    if (c < 256) { b = c >> 6; const int k = c & 63; r0 = b * SEQ + k * 128; t0 = k * 128; n = SEQ; posf = 2 + k; posb = 2 + (63 - k); }
    else { const int cc = c - 256; b = cc >> 1; const int k = cc & 1; r0 = TL + b * CTXL + k * 128; t0 = k * 128; n = CTXL; posf = k; posb = 1 - k; }
    {
        LAS bf16_t* xcs = (LAS bf16_t*)(F.lds + h * 16384);
        TREG_BEGIN(1);
        bf16_t* XCT = (bf16_t*)(p.ws + WS_XCT) + ((size_t)c * 8 + h) * 8192;
        if (PASS == 1) {
            u32x4 t[16];
#pragma unroll
            for (int k = 0; k < 16; ++k) t[k] = *(const u32x4*)(XCT + (k * 64 + lane) * 8);
#pragma unroll
            for (int k = 0; k < 16; ++k) *(LAS u32x4*)(xcs + (k * 64 + lane) * 8) = t[k];
        } else {
            const int cg = lane & 7, rsub = lane >> 3, ch0 = h * 64 + cg * 8;
            float w[4][8], cb[8];
#pragma unroll
            for (int k = 0; k < 4; ++k) { const float4 a = *(const float4*)(p.conv_w + (size_t)(l * 4 + k) * 512 + ch0), bb = *(const float4*)(p.conv_w + (size_t)(l * 4 + k) * 512 + ch0 + 4);
                w[k][0] = a.x; w[k][1] = a.y; w[k][2] = a.z; w[k][3] = a.w; w[k][4] = bb.x; w[k][5] = bb.y; w[k][6] = bb.z; w[k][7] = bb.w; }
            { const float4 a = *(const float4*)(p.conv_b + l * 512 + ch0), bb = *(const float4*)(p.conv_b + l * 512 + ch0 + 4);
                cb[0] = a.x; cb[1] = a.y; cb[2] = a.z; cb[3] = a.w; cb[4] = bb.x; cb[5] = bb.y; cb[6] = bb.z; cb[7] = bb.w; }
            const bf16_t* Zx = Z + (size_t)r0 * 4096 + 1024 + ch0;
#pragma unroll 1
            for (int it = 0; it < 2; ++it) {
                const int tb = (it * 8 + rsub) * 8;
                u32x4 raw[11];
#pragma unroll
                for (int k = 0; k < 11; ++k) { const int tt = t0 + tb + k - 2; const int rowc = (tt >= 0 && tt < n) ? (tb + k - 2) : tb;
                    raw[k] = *(const u32x4*)(Zx + (long)rowc * 4096); }
#pragma unroll
                for (int k = 0; k < 11; ++k) { const int tt = t0 + tb + k - 2; if (!(tt >= 0 && tt < n)) raw[k] = (u32x4){0u, 0u, 0u, 0u}; }
#pragma unroll
                for (int o = 0; o < 8; ++o) {
                    float y[8];
#pragma unroll
                    for (int j = 0; j < 8; ++j) y[j] = cb[j];
#pragma unroll
                    for (int k = 0; k < 4; ++k) { f32x4 x0, x1; pg8::unpack8(raw[o + k], x0, x1);
#pragma unroll
                        for (int j = 0; j < 4; ++j) { y[j] += w[k][j] * x0[j]; y[4 + j] += w[k][4 + j] * x1[j]; } }
                    const u32x4 pk = pg8::pack8((f32x4){y[0], y[1], y[2], y[3]}, (f32x4){y[4], y[5], y[6], y[7]});
                    *(LAS u32x4*)(xcs + (tb + o) * 64 + cg * 8) = pk; *(u32x4*)(XCT + (tb + o) * 64 + cg * 8) = pk;
                }
            }
        }
        asm volatile("s_waitcnt lgkmcnt(0)" ::: "memory");
        TREG_END(1, F);
        TREG_BEGIN(2);
        float carry0 = 0.f, carry1 = 0.f;
        if (PASS == 1) {
            const int chl = h * 64 + lane;
#pragma unroll
            for (int dir = 0; dir < 2; ++dir) {
                const int np = dir ? posb : posf; float cr = 0.f;
                for (int q0 = 0; q0 < np; q0 += 16) { float a8[16], h8[16];
#pragma unroll
                    for (int j = 0; j < 16; ++j) { const int q = (q0 + j < np) ? q0 + j : np - 1; a8[j] = SUMM[summ_idx(dir, b, q, 0, chl)]; h8[j] = SUMM[summ_idx(dir, b, q, 1, chl)]; }
#pragma unroll
                    for (int j = 0; j < 16; ++j) if (q0 + j < np) cr = a8[j] * cr + h8[j]; }
                if (dir) carry1 = cr; else carry0 = cr;
            }
        }
        TREG_END(2, F);
        TREG_BEGIN(3);
#pragma unroll 1
        for (int ct = 0; ct < 4; ++ct) {
            const int chc = h * 64 + ct * 16 + fr;
            float hsum[8][4];
            u32x4 gbr[2][2];
            if (PASS == 1) {
#pragma unroll
                for (int hv = 0; hv < 2; ++hv) { const bf16_t* gp = Z + (size_t)(r0 + hv * 64 + lane) * 4096 + 1536 + h * 64 + ct * 16; gbr[hv][0] = *(const u32x4*)gp; gbr[hv][1] = *(const u32x4*)(gp + 8); }
            }
            bf16x8 wfr[2][4]; float bias_a2[2], bias_x2[2], spc2[2];
#pragma unroll
            for (int dir = 0; dir < 2; ++dir) {
                const bf16_t* wa = (const bf16_t*)(W + WO_LRU) + (size_t)(0 * 16 + dir * 8 + h) * 4096 + (size_t)(ct * 16 + fr) * 64 + 8 * fq;
                const bf16_t* wx = (const bf16_t*)(W + WO_LRU) + (size_t)(1 * 16 + dir * 8 + h) * 4096 + (size_t)(ct * 16 + fr) * 64 + 8 * fq;
                wfr[dir][0] = *(const bf16x8*)(wa); wfr[dir][1] = *(const bf16x8*)(wa + 32); wfr[dir][2] = *(const bf16x8*)(wx); wfr[dir][3] = *(const bf16x8*)(wx + 32);
                bias_a2[dir] = -1.4426950408889634f * p.lru_ba[(l * 2 + dir) * 512 + chc]; bias_x2[dir] = -1.4426950408889634f * p.lru_bx[(l * 2 + dir) * 512 + chc];
                spc2[dir] = -8.0f * log1pf(expf(-p.lru_lam[(l * 2 + dir) * 512 + chc])) * 1.4426950408889634f;
            }
#pragma unroll
            for (int dir = 0; dir < 2; ++dir) {
                const bf16x8 ba0 = wfr[dir][0], ba1 = wfr[dir][1], bx0 = wfr[dir][2], bx1 = wfr[dir][3];
                const float bias_a = bias_a2[dir], bias_x = bias_x2[dir], spc = spc2[dir];
                float Hrun = 0.f, Arun = 1.f;
                if (PASS == 1) Hrun = __shfl(dir ? carry1 : carry0, ct * 16 + fr);
                const int mypos = dir ? 3 - fq : fq;
#pragma unroll
                for (int grp = 0; grp < 2; ++grp) {
                    float av[4][4], dv[4][4], Ap[4], Hp[4], At[4], Ht[4];
#pragma unroll
                    for (int rq = 0; rq < 4; ++rq) {
                        const int rr = grp * 4 + rq, rt = dir ? 7 - rr : rr;
                        const bf16x8 f0 = *(const LAS bf16x8*)(xcs + (rt * 16 + fr) * 64 + 8 * fq), f1 = *(const LAS bf16x8*)(xcs + (rt * 16 + fr) * 64 + 32 + 8 * fq);
                        f32x4 aa = {bias_a, bias_a, bias_a, bias_a}, ax = {bias_x, bias_x, bias_x, bias_x};
                        aa = mfma16(f0, ba0, aa); aa = mfma16(f1, ba1, aa);
                        ax = mfma16(f0, bx0, ax); ax = mfma16(f1, bx1, ax);
#pragma unroll
                        for (int i = 0; i < 4; ++i) {
                            const float xc = bf2f(xcs[(rt * 16 + 4 * fq + i) * 64 + ct * 16 + fr]);
                            const float rg = __builtin_amdgcn_rcpf(1.f + __builtin_amdgcn_exp2f(aa[i])), ig = __builtin_amdgcn_rcpf(1.f + __builtin_amdgcn_exp2f(ax[i]));
                            const float a = __builtin_amdgcn_exp2f(spc * rg);
                            av[rq][i] = a; dv[rq][i] = __builtin_amdgcn_sqrtf(fmaxf(1.f - a * a, 0.f)) * (ig * xc);
                        }
                        float Al = 1.f, Hl = 0.f;
#pragma unroll
                        for (int s = 0; s < 4; ++s) { const int i = dir ? 3 - s : s; Hl = av[rq][i] * Hl + dv[rq][i]; Al = av[rq][i] * Al; }
                        float ap = 1.f, hp = 0.f, at = 1.f, ht = 0.f;
#pragma unroll
                        for (int s = 0; s < 4; ++s) { const int g = dir ? 3 - s : s; const float Ag = __shfl(Al, fr + 16 * g), Hg = __shfl(Hl, fr + 16 * g);
                            ht = Ag * ht + Hg; at = Ag * at;
                            const bool before = s < mypos; hp = before ? Ag * hp + Hg : hp; ap = before ? Ag * ap : ap; }
                        Ap[rq] = ap; Hp[rq] = hp; At[rq] = at; Ht[rq] = ht;
                    }
#pragma unroll
                    for (int rq = 0; rq < 4; ++rq) {
                        const int rr = grp * 4 + rq, rt = dir ? 7 - rr : rr;
                        if (PASS == 1) {
                            float hc = Ap[rq] * Hrun + Hp[rq];
#pragma unroll
                            for (int s = 0; s < 4; ++s) { const int i = dir ? 3 - s : s; hc = av[rq][i] * hc + dv[rq][i]; if (dir == 0) hsum[rt][i] = hc; else hsum[rt][i] += hc; }
                        }
                        Hrun = At[rq] * Hrun + Ht[rq]; Arun = At[rq] * Arun;
                    }
                    asm volatile("" ::: "memory");
                }
                if (PASS == 0 && fq == 0) { const int pos = dir ? posb : posf; SUMM[summ_idx(dir, b, pos, 0, chc)] = Arun; SUMM[summ_idx(dir, b, pos, 1, chc)] = Hrun; }
            }
            if (PASS == 1) {
                LAS bf16_t* sp = (LAS bf16_t*)(F.lds + SPW_OFF + h * SPW_BYTES);
#pragma unroll
                for (int hv = 0; hv < 2; ++hv) {
#pragma unroll
                    for (int j = 0; j < 4; ++j)
#pragma unroll
                        for (int i = 0; i < 4; ++i) sp[(j * 16 + 4 * fq + i) * 16 + fr] = f2bf(hsum[hv * 4 + j][i]);
                    asm volatile("s_waitcnt lgkmcnt(0)" ::: "memory");
                    const u32x4 s0 = *(const LAS u32x4*)(sp + lane * 16), s1 = *(const LAS u32x4*)(sp + lane * 16 + 8);
                    asm volatile("s_waitcnt lgkmcnt(0)" ::: "memory");
                    f32x4 a0, a1, b0, b1, g0, g1, g2, g3; pg8::unpack8(s0, a0, a1); pg8::unpack8(s1, b0, b1); pg8::unpack8(gbr[hv][0], g0, g1); pg8::unpack8(gbr[hv][1], g2, g3);
                    bf16_t* yp = Y + (size_t)(r0 + hv * 64 + lane) * D + 512 + h * 64 + ct * 16;
                    *(u32x4*)yp = pg8::pack8(a0 * g0, a1 * g1); *(u32x4*)(yp + 8) = pg8::pack8(b0 * g2, b1 * g3);
                }
            }
        }
        asm volatile("s_waitcnt vmcnt(0)" ::: "memory");
        TREG_END(3, F);
    }
    if (PASS == 0 && do_gmlp) {
        typedef float f32x2 __attribute__((ext_vector_type(2)));
        LAS f32x2* stats = (LAS f32x2*)(F.lds + STATS_OFF);
        TREG_BEGIN(4);
#pragma unroll 1
        for (int i0 = 0; i0 < 16; i0 += 8) {
            f32x4 v0[8], v1[8]; float mu[8], var[8];
#pragma unroll
            for (int j = 0; j < 8; ++j) pg8::unpack8(*(const u32x4*)(Z + (size_t)(r0 + F.wave * 16 + i0 + j) * 4096 + 512 + lane * 8), v0[j], v1[j]);
#pragma unroll
            for (int j = 0; j < 8; ++j) mu[j] = (v0[j][0] + v0[j][1]) + (v0[j][2] + v0[j][3]) + (v1[j][0] + v1[j][1]) + (v1[j][2] + v1[j][3]);
#pragma unroll
            for (int o = 1; o < 64; o <<= 1) {
#pragma unroll
                for (int j = 0; j < 8; ++j) mu[j] += __shfl_xor(mu[j], o); }
#pragma unroll
            for (int j = 0; j < 8; ++j) { mu[j] *= (1.f / 512.f); v0[j] -= mu[j]; v1[j] -= mu[j];
                var[j] = (v0[j][0] * v0[j][0] + v0[j][1] * v0[j][1]) + (v0[j][2] * v0[j][2] + v0[j][3] * v0[j][3]) + (v1[j][0] * v1[j][0] + v1[j][1] * v1[j][1]) + (v1[j][2] * v1[j][2] + v1[j][3] * v1[j][3]); }
#pragma unroll
            for (int o = 1; o < 64; o <<= 1) {
#pragma unroll
                for (int j = 0; j < 8; ++j) var[j] += __shfl_xor(var[j], o); }
            float m_ = mu[0], v_ = var[0];
#pragma unroll
            for (int j = 1; j < 8; ++j) { m_ = (lane == j) ? mu[j] : m_; v_ = (lane == j) ? var[j] : v_; }
            if (lane < 8) stats[F.wave * 16 + i0 + lane] = (f32x2){m_, rsqrtf(v_ * (1.f / 512.f) + 1e-5f)};
        }
        TREG_END(4, F);
        __syncthreads();
        TREG_BEGIN(5);
        const int g = F.wave;
        const bf16_t* Wg = (const bf16_t*)(W + WO_GWS) + (size_t)g * 128 * 128;
        LAS bf16_t* vn = (LAS bf16_t*)(F.lds + g * 16384);
        LAS bf16_t* sp = (LAS bf16_t*)(F.lds + SPW_OFF + g * SPW_BYTES);
        {
            const int cg = lane & 7, rsub = lane >> 3, ch0 = g * 64 + cg * 8;
            float lg[8], lb[8];
            { const float4 a = *(const float4*)(p.ln_g + l * 512 + ch0), bb = *(const float4*)(p.ln_g + l * 512 + ch0 + 4), c4 = *(const float4*)(p.ln_b + l * 512 + ch0), d4 = *(const float4*)(p.ln_b + l * 512 + ch0 + 4);
                lg[0] = a.x; lg[1] = a.y; lg[2] = a.z; lg[3] = a.w; lg[4] = bb.x; lg[5] = bb.y; lg[6] = bb.z; lg[7] = bb.w;
                lb[0] = c4.x; lb[1] = c4.y; lb[2] = c4.z; lb[3] = c4.w; lb[4] = d4.x; lb[5] = d4.y; lb[6] = d4.z; lb[7] = d4.w; }
            const bf16_t* Zv = Z + (size_t)r0 * 4096 + 512 + ch0;
#pragma unroll 1
            for (int i8 = 0; i8 < 16; i8 += 8) {
                u32x4 raw[8];
#pragma unroll
                for (int it = 0; it < 8; ++it) raw[it] = *(const u32x4*)(Zv + (long)((i8 + it) * 8 + rsub) * 4096);
#pragma unroll
                for (int it = 0; it < 8; ++it) { const int q = (i8 + it) * 8 + rsub; const f32x2 st = stats[q]; f32x4 x0, x1; pg8::unpack8(raw[it], x0, x1);
#pragma unroll
                    for (int j = 0; j < 4; ++j) { x0[j] = (x0[j] - st.x) * st.y * lg[j] + lb[j]; x1[j] = (x1[j] - st.x) * st.y * lg[4 + j] + lb[4 + j]; }
                    *(LAS u32x4*)(vn + q * 64 + cg * 8) = pg8::pack8(x0, x1); }
            }
        }
        asm volatile("s_waitcnt lgkmcnt(0)" ::: "memory");
        bf16x8 bfr[4][4];
#pragma unroll
        for (int ct = 0; ct < 4; ++ct)
#pragma unroll
            for (int ks = 0; ks < 4; ++ks) { unsigned wd[4];
#pragma unroll
                for (int j2 = 0; j2 < 4; ++j2) { const unsigned lo = vn[(ks * 32 + 8 * fq + 2 * j2) * 64 + ct * 16 + fr], hi = vn[(ks * 32 + 8 * fq + 2 * j2 + 1) * 64 + ct * 16 + fr]; wd[j2] = lo | (hi << 16); }
                bfr[ct][ks] = __builtin_bit_cast(bf16x8, (u32x4){wd[0], wd[1], wd[2], wd[3]}); }
        const bf16_t* Zu = Z + (size_t)r0 * 4096 + g * 64; bf16_t* Yu = Y + (size_t)r0 * D + g * 64;
        const int orow = lane >> 2, och = (lane & 3) * 16;
#pragma unroll 1
        for (int rt = 0; rt < 8; ++rt) {
            bf16x8 af[4];
#pragma unroll
            for (int ks = 0; ks < 4; ++ks) af[ks] = *(const bf16x8*)(Wg + (unsigned)((rt * 16 + fr) * 128 + ks * 32 + 8 * fq));
            const float4 bsv = *(const float4*)(p.gbs + (l * 8 + g) * 128 + rt * 16 + 4 * fq);
            const u32x4 u0 = *(const u32x4*)(Zu + (long)(rt * 16 + orow) * 4096 + och), u1 = *(const u32x4*)(Zu + (long)(rt * 16 + orow) * 4096 + och + 8);
            const float bs4[4] = {bsv.x, bsv.y, bsv.z, bsv.w};
#pragma unroll
            for (int ct = 0; ct < 4; ++ct) {
                f32x4 acc = {0.f, 0.f, 0.f, 0.f};
#pragma unroll
                for (int ks = 0; ks < 4; ++ks) acc = mfma16(af[ks], bfr[ct][ks], acc);
#pragma unroll
                for (int i = 0; i < 4; ++i) sp[(4 * fq + i) * 64 + ct * 16 + fr] = f2bf(acc[i] + bs4[i]);
            }
            asm volatile("s_waitcnt lgkmcnt(0)" ::: "memory");
            const u32x4 m0 = *(const LAS u32x4*)(sp + orow * 64 + och), m1 = *(const LAS u32x4*)(sp + orow * 64 + och + 8);
            asm volatile("s_waitcnt lgkmcnt(0)" ::: "memory");
            f32x4 a0, a1, b0, b1, c0, c1, d0, d1; pg8::unpack8(m0, a0, a1); pg8::unpack8(m1, b0, b1); pg8::unpack8(u0, c0, c1); pg8::unpack8(u1, d0, d1);
            bf16_t* yp = Yu + (long)(rt * 16 + orow) * D + och;
            *(u32x4*)yp = pg8::pack8(a0 * c0, a1 * c1); *(u32x4*)(yp + 8) = pg8::pack8(b0 * d0, b1 * d1);
        }
        asm volatile("s_waitcnt vmcnt(0)" ::: "memory"); TREG_END(5, F);
    }
    __syncthreads();
}
constexpr int NPL = 10, PH_FINAL = 1 + 2 * NPL, PH_END = PH_FINAL + 1;
struct Args { Params p; int ph_lo, ph_hi; };

DEV void build_toff(const Params& p, const Frame& F, int l, LAS int* toff) {
    if (F.tid < NE) { const unsigned* CNT = (const unsigned*)(p.ws + WS_CTL) + CW_CNT + l * 64;
        int cn = (int)__hip_atomic_load(CNT + F.tid, __ATOMIC_RELAXED, __HIP_MEMORY_SCOPE_AGENT); cn = cn < CAP ? cn : CAP;
        const int tiles = (cn + 255) >> 8; int incl = tiles;
#pragma unroll
        for (int o = 1; o < 64; o <<= 1) { const int t = __shfl_up(incl, o); if (F.lane >= o) incl += t; }
        const int excl = incl - tiles;
        toff[F.tid] = excl < 1120 ? excl : 1120; toff[80 + F.tid] = cn;
        if (F.tid == NE - 1) toff[64] = incl < 1120 ? incl : 1120; }
    __syncthreads();
    if (F.tid < NE) { LAS unsigned char* te = (LAS unsigned char*)(F.lds + SPW_OFF); for (int t = toff[F.tid]; t < toff[F.tid + 1]; ++t) te[t] = (unsigned char)F.tid; }
    __syncthreads();
}

template <int ph> DEV void run_phase(const Frame& F0) {
    Frame F = F0; { unsigned z_ = 0; asm volatile("" : "+v"(z_)); F.lane = (int)__builtin_amdgcn_mbcnt_hi(~0u, __builtin_amdgcn_mbcnt_lo(~0u, z_)); F.tid = F.wave * 64 + F.lane; }
    asm volatile("" : "+s"(F.G), "+s"(F.bx));
    const Params p = load_params(F);
    unsigned char* ws = p.ws; unsigned char* W = ws + WS_W;
    LAS int* toff = (LAS int*)(F.lds + MISC_OFF + 256);
    const int gw = F.bx * NWAVES + F.wave, NGW = F.G * NWAVES;
#ifndef NOPRO
    if (ph == 0) { if (F.bx == 0 && F.tid < 128) __hip_atomic_store((unsigned*)(p.ws + WS_CTL) + CW_CNT + F.tid, 0u, __ATOMIC_RELAXED, __HIP_MEMORY_SCOPE_AGENT);
        if (F.bx >= 192) { pe_table(p, F, (F.bx - 192) * 1024 + F.tid); pe_table(p, F, (F.bx - 192) * 1024 + 512 + F.tid); }
        mod_items(p, F); __syncthreads(); convert_weights(p, F, 0, 0, gw, NGW); return; }
    if (ph == PH_FINAL) { row_lat_A(p, 2, gw, NGW, F.lane); return; }
#endif
    constexpr int l = (ph - 1) / NPL, k = (ph - 1) % NPL;
    constexpr int nr = (l == 0) ? R : TL;
#ifndef PMASK
#define PMASK 0xffff
#endif
#define PON(k_) ((PMASK >> (k_)) & 1)
    switch (k) {
    case 0: if (PON(0)) { if (l > 0) convert_weights(p, F, l, 0, gw, NGW);
        if (l == 0) row_lat_A0(p, gw, NGW, F.lane); else row_lat_A(p, l, gw, NGW, F.lane);
        row_pass_A(p, l, TL, R, gw, NGW, F.lane); } break;
    case 1: if (PON(1)) {
#if GIN_FP8
        pg8::DenseSched<512, WS_H8, WS_W + WO_IN> S; S.init(ws, R, 4096, F.bx); pg8::EpiZ E{ws};
        pg8::gemm_phase<pg8::EpiZ, decltype(S), true, 0x7b>(F.lds, F.tid, S, E);
#else
        pg8::DenseSched<D, WS_RY, WS_W + WO_IN> S; S.init(ws, R, 4096, F.bx); pg8::EpiZ E{ws};
        pg8::gemm_phase<pg8::EpiZ, decltype(S), true>(F.lds, F.tid, S, E);
#endif
        if (F.bx >= 64) convert_weights(p, F, l, 2, (F.bx - 64) * NWAVES + F.wave, 192 * NWAVES); } break;
    case 2: if (PON(2)) { for (int c = F.bx; c < NCHUNK; c += F.G) chunk_pass<0>(p, F, l, c, l == 0 || c < 256);
        if (F.bx >= NCHUNK - F.G) { convert_weights(p, F, l, 1, (F.bx - (NCHUNK - F.G)) * NWAVES + F.wave, (2 * F.G - NCHUNK) * NWAVES); } } break;
    case 3: if (PON(3)) for (int c = F.bx; c < (l == 0 ? NCHUNK : 256); c += F.G) chunk_pass<1>(p, F, l, c, false); break;
    case 4: if (PON(4)) { pg8::DenseSched<D, WS_RY, WS_W + WO_AB> S; S.init(ws, nr, D, F.bx); pg8::EpiAB E{ws};
        pg8::gemm_phase<pg8::EpiAB, decltype(S), true>(F.lds, F.tid, S, E); } break;
    case 5: if (PON(5)) { pg8::DenseSched<D, WS_RA, WS_W + WO_OUT> S; S.init(ws, nr, D, F.bx); pg8::EpiPlain<WS_Z> E{ws};
        pg8::gemm_phase<pg8::EpiPlain<WS_Z>, decltype(S), true>(F.lds, F.tid, S, E); } break;
    case 6: if (PON(6)) { row_lat_H(p, l, gw, NGW, F.lane); if (nr > TL) row_pass_H(p, l, TL, nr, gw, NGW, F.lane); } break;
    case 7: if (PON(7)) { pg8::DenseSched<D, WS_RA, WS_W + WO_SR> S; S.init(ws, nr, 768, F.bx); pg8::EpiSR E{ws};
        pg8::gemm_phase<pg8::EpiSR, decltype(S), true>(F.lds, F.tid, S, E);
        asm volatile("s_waitcnt vmcnt(0)" ::: "memory"); __syncthreads();
        for (int i = 0;; ++i) { pg8::UnitD u; if (!S.next(i, u)) break; if (u.pn == 0) route_rows(p, F, l, u.pm * 256); } } break;
    case 8: if (PON(8)) { build_toff(p, F, l, toff);
        { pg8::ExpSched<512, 1, 2, WS_H2E, WS_W + WO_EG, (size_t)512 * D> S; S.ws = ws; S.lds = F.lds; S.U = toff[64] * 2; S.c = F.bx; S.brow0 = 0; S.Krt = 512;
          pg8::EpiEG<0> E{ws};
          pg8::gemm_phase<pg8::EpiEG<0>, decltype(S), true, 0x7b>(F.lds, F.tid, S, E); }
#if GSD_FP8
        { pg8::DenseSched<128, WS_SH, WS_W + WO_SD> S; S.init(ws, nr, D, 255 - F.bx); pg8::EpiPlain<WS_RY> E{ws};
          pg8::gemm_phase<pg8::EpiPlain<WS_RY>, decltype(S), true, 0x7c>(F.lds, F.tid, S, E); } } break;
#else
        { pg8::DenseSched<256, WS_SH, WS_W + WO_SD> S; S.init(ws, nr, D, 255 - F.bx); pg8::EpiPlain<WS_RY> E{ws};
          pg8::gemm_phase<pg8::EpiPlain<WS_RY>, decltype(S), true>(F.lds, F.tid, S, E); } } break;
#endif
    case 9: if (PON(9)) { build_toff(p, F, l, toff);
#if GED_FP8
        pg8::ExpSched<128, 0, 4, WS_HM, WS_W + WO_ED, (size_t)D * 256> S; S.ws = ws; S.lds = F.lds; S.U = toff[64] * 4; S.c = F.bx; S.brow0 = 0; S.Krt = 128;
        pg8::EpiED E{ws, F.lds};
        pg8::gemm_phase<pg8::EpiED, decltype(S), true, 0x7c>(F.lds, F.tid, S, E); } break;
#else
        pg8::ExpSched<256, 0, 4, WS_HM, WS_W + WO_ED, (size_t)D * 256 * 2> S; S.ws = ws; S.lds = F.lds; S.U = toff[64] * 4; S.c = F.bx; S.brow0 = 0; S.Krt = 256;
        pg8::EpiED E{ws, F.lds};
        pg8::gemm_phase<pg8::EpiED, decltype(S), true>(F.lds, F.tid, S, E); } break;
#endif
    }
}

__global__ void __launch_bounds__(NWAVES * 64, 2) mk_fwd(Args a) {
    extern __shared__ __attribute__((aligned(16))) unsigned char lds_raw[];
    Frame F; F.lds = (LAS unsigned char*)lds_raw; F.ldsg = lds_raw; F.tid = threadIdx.x; F.lane = F.tid & 63; F.wave = __builtin_amdgcn_readfirstlane(F.tid >> 6); F.G = gridDim.x; F.bx = blockIdx.x;
    volatile LAS unsigned* MISC = (volatile LAS unsigned*)(F.lds + MISC_OFF);
    for (int u = F.tid; u < (LDS_BYTES - MISC_OFF) / 4; u += NWAVES * 64) MISC[u] = 0u;
    store_params(F, a.p);
    __syncthreads();
    XcdBarrier bar; bar.bar = (GAS unsigned*)(a.p.ws + WS_CTL) + CW_BAR; bar.x = 0; bar.st = nullptr;
    const bool multi = a.ph_hi - a.ph_lo > 1;
    if (multi) bar = xcd_barrier_post((GAS unsigned*)(a.p.ws + WS_CTL) + CW_BAR, MISC);
#ifdef DELAYMASK
#define MK_PH(k_) if (a.ph_lo <= (k_) && (k_) < a.ph_hi) { const unsigned long long t0_ = __builtin_amdgcn_s_memrealtime(); run_phase<(k_)>(F); \
        { constexpr int kind = ((k_) == 0) ? 15 : ((k_) == PH_FINAL ? 0 : ((k_) - 1) % NPL); \
          if ((DELAYMASK >> kind) & 1) { __syncthreads(); const unsigned long long t1_ = __builtin_amdgcn_s_memrealtime(); while (__builtin_amdgcn_s_memrealtime() - t1_ < t1_ - t0_) __builtin_amdgcn_s_sleep(8); } } \
        if ((k_) + 1 < a.ph_hi) xcd_barrier(bar); }
#elif defined(PROBE_REGION)
#define MK_PH(k_) if (a.ph_lo <= (k_) && (k_) < a.ph_hi) { run_phase<(k_)>(F); \
        { __syncthreads(); const unsigned long long t1_ = __builtin_amdgcn_s_memrealtime(); const unsigned long long dt_ = MISC[16]; while (__builtin_amdgcn_s_memrealtime() - t1_ < dt_) __builtin_amdgcn_s_sleep(8); __syncthreads(); if (F.tid == 0) MISC[16] = 0u; } \
        if ((k_) + 1 < a.ph_hi) xcd_barrier(bar); }
#else
#define MK_PH(k_) if (a.ph_lo <= (k_) && (k_) < a.ph_hi) { run_phase<(k_)>(F); if ((k_) + 1 < a.ph_hi) xcd_barrier(bar); }
#endif
    MK_PH(0) MK_PH(1) MK_PH(2) MK_PH(3) MK_PH(4) MK_PH(5) MK_PH(6) MK_PH(7) MK_PH(8) MK_PH(9) MK_PH(10)
    MK_PH(11) MK_PH(12) MK_PH(13) MK_PH(14) MK_PH(15) MK_PH(16) MK_PH(17) MK_PH(18) MK_PH(19) MK_PH(20) MK_PH(21)
#undef MK_PH
}
#ifndef FAST
#define FAST 0x1ff
#endif
#if FAST != 0x1ff
constexpr size_t WS_NV1 = 538 * MiB;
constexpr size_t WS_NSG = 291 * MiB, WS_NFLS = 324 * MiB;
__global__ void __launch_bounds__(256) k_mod(Params p) {
    const int e = blockIdx.x * 256 + threadIdx.x, cond = blockIdx.y, l = blockIdx.z;
    const float* cv = cond < 4 ? p.c + cond * D : p.c_ctx;
    const float* w = p.w_mod + (size_t)l * D * 6 * D;
    float acc = p.b_mod[l * 6 * D + e];
    for (int d = 0; d < D; ++d) acc += siluf_(cv[d]) * w[(size_t)d * 6 * D + e];
    ((float*)(p.ws + WS_MOD))[(size_t)(l * 5 + cond) * 6 * D + e] = acc;
}
__global__ void __launch_bounds__(256) k_rowA(Params p, int l) { row_pass_A(p, l, (blockIdx.x * 256 + threadIdx.x) >> 6, (gridDim.x * 256) >> 6, threadIdx.x & 63); }
__global__ void __launch_bounds__(256) k_rowH(Params p, int l, int nrows) { row_pass_H(p, l, nrows, (blockIdx.x * 256 + threadIdx.x) >> 6, (gridDim.x * 256) >> 6, threadIdx.x & 63); }
struct ABf16 { const bf16_t* A; int lda, coff; DEV float operator()(int m, int k) const { return bf2f(A[(size_t)m * lda + coff + k]); } };
struct BF32 { const float* B; int ldb, pad; DEV float operator()(int k, int n) const { return B[(size_t)k * ldb + n]; } };
struct BAB { const float* Ba; const float* Bb; DEV float operator()(int k, int n) const { return k < 512 ? Ba[(size_t)k * D + n] : Bb[(size_t)(k - 512) * D + n]; } };
struct NEpiZ { bf16_t* Z; DEV void operator()(int m, int n, float v, float) const {
    float o; if (n < 1024) o = gelu_tanh(v); else if (n < 1536) o = v; else if (n < 2048) o = gelu_tanh(v); else o = sigmoidf_(v);
    Z[(size_t)m * 4096 + n] = f2bf(o); } };
struct NEpiF32 { float* C; int ldc, pad; DEV void operator()(int m, int n, float v, float) const { C[(size_t)m * ldc + n] = v; } };
struct NEpiBf { bf16_t* C; int ldc, pad; DEV void operator()(int m, int n, float v, float) const { C[(size_t)m * ldc + n] = f2bf(v); } };
struct NEpiMerge { const bf16_t* Z; bf16_t* M; DEV void operator()(int m, int n, float vb, float va) const {
    const float ga = bf2f(Z[(size_t)m * 4096 + 2048 + n]), gr = bf2f(Z[(size_t)m * 4096 + 3072 + n]);
    M[(size_t)m * D + n] = f2bf(ga * va + gr * vb); } };
struct NEpiSwi { const float* SG; bf16_t* SH; DEV void operator()(int m, int n, float v, float) const { SH[(size_t)m * 256 + n] = f2bf(siluf_(SG[(size_t)m * 256 + n]) * v); } };
template <class AL, class BL, class EP, int SPLIT>
__global__ void __launch_bounds__(256) k_gemm(AL al, BL bl, EP ep, int K) {
    __shared__ __attribute__((aligned(16))) float As[16][68];
    __shared__ __attribute__((aligned(16))) float Bs[16][68];
    const int tid = threadIdx.x, tx = tid & 15, ty = tid >> 4, m0 = blockIdx.y * 64, n0 = blockIdx.x * 64;
    float acc[4][4], acc2[4][4];
#pragma unroll
    for (int i = 0; i < 4; ++i)
#pragma unroll
        for (int j = 0; j < 4; ++j) { acc[i][j] = 0.f; acc2[i][j] = 0.f; }
    for (int k0 = 0; k0 < K; k0 += 16) {
        if (SPLIT && k0 == SPLIT) {
#pragma unroll
            for (int i = 0; i < 4; ++i)
#pragma unroll
                for (int j = 0; j < 4; ++j) { acc2[i][j] = acc[i][j]; acc[i][j] = 0.f; }
        }
#pragma unroll
        for (int i = 0; i < 4; ++i) { const int e = tid + 256 * i, kk = e & 15, mm = e >> 4; As[kk][mm] = al(m0 + mm, k0 + kk); }
#pragma unroll
        for (int i = 0; i < 4; ++i) { const int e = tid + 256 * i, nn = e & 63, kk = e >> 6; Bs[kk][nn] = bl(k0 + kk, n0 + nn); }
        __syncthreads();
#pragma unroll
        for (int kk = 0; kk < 16; ++kk) {
            const float4 a = *(const float4*)&As[kk][ty * 4]; const float4 b = *(const float4*)&Bs[kk][tx * 4];
            const float av[4] = {a.x, a.y, a.z, a.w}, bv[4] = {b.x, b.y, b.z, b.w};
#pragma unroll
            for (int i = 0; i < 4; ++i)
#pragma unroll
                for (int j = 0; j < 4; ++j) acc[i][j] += av[i] * bv[j];
        }
        __syncthreads();
    }
#pragma unroll
    for (int i = 0; i < 4; ++i)
#pragma unroll
        for (int j = 0; j < 4; ++j) ep(m0 + ty * 4 + i, n0 + tx * 4 + j, acc[i][j], acc2[i][j]);
}
__global__ void __launch_bounds__(256) k_conv(Params p, int l) {
    const size_t idx = (size_t)blockIdx.x * 256 + threadIdx.x; const int r = (int)(idx >> 9), ch = (int)(idx & 511);
    const bf16_t* Z = (const bf16_t*)(p.ws + WS_Z); float* XCONV = (float*)(p.ws + WS_NV1);
    int t, n; if (r < TL) { t = r & (SEQ - 1); n = SEQ; } else { t = (r - TL) & (CTXL - 1); n = CTXL; }
    const int base = r - t;
    float y = p.conv_b[l * 512 + ch];
#pragma unroll
    for (int k = 0; k < 4; ++k) { const int tt = t + k - 2; if (tt >= 0 && tt < n) y += p.conv_w[(l * 4 + k) * 512 + ch] * bf2f(Z[(size_t)(base + tt) * 4096 + 1024 + ch]); }
    XCONV[(size_t)r * 512 + ch] = y;
}
__global__ void __launch_bounds__(64) k_scan(Params p, int l, int dir) {
    const int b = blockIdx.x >> 3, h = blockIdx.x & 7, j = threadIdx.x, ch = h * 64 + j;
    const float* XCONV = (const float*)(p.ws + WS_NV1); float* HS = (float*)(p.ws + WS_RA);
    const float* wa = p.lru_wa + (size_t)((l * 2 + dir) * 8 + h) * 4096; const float* wx = p.lru_wx + (size_t)((l * 2 + dir) * 8 + h) * 4096;
    float wac[64], wxc[64];
#pragma unroll
    for (int i = 0; i < 64; ++i) { wac[i] = wa[i * 64 + j]; wxc[i] = wx[i * 64 + j]; }
    const float ba = p.lru_ba[(l * 2 + dir) * 512 + ch], bx = p.lru_bx[(l * 2 + dir) * 512 + ch];
    const float sp = log1pf(expf(-p.lru_lam[(l * 2 + dir) * 512 + ch]));
    float hst = 0.f;
    for (int step = 0; step < CTXL + SEQ; ++step) {
        int r;
        if (dir == 0) r = step < CTXL ? TL + b * CTXL + step : b * SEQ + (step - CTXL);
        else r = step < CTXL ? TL + b * CTXL + (CTXL - 1 - step) : b * SEQ + (SEQ - 1 - (step - CTXL));
        const float* xr = XCONV + (size_t)r * 512 + h * 64;
        float pr = ba, px = bx;
#pragma unroll
        for (int i = 0; i < 16; ++i) { const float4 xv = *(const float4*)(xr + 4 * i);
            pr += xv.x * wac[4 * i] + xv.y * wac[4 * i + 1] + xv.z * wac[4 * i + 2] + xv.w * wac[4 * i + 3];
            px += xv.x * wxc[4 * i] + xv.y * wxc[4 * i + 1] + xv.z * wxc[4 * i + 2] + xv.w * wxc[4 * i + 3]; }
        const float rg = sigmoidf_(pr), ig = sigmoidf_(px);
        const float log_a = -8.0f * rg * sp;
        const float a = expf(log_a), drv = sqrtf(-expm1f(2.0f * log_a)) * (ig * xr[j]);
        hst = a * hst + drv;
        if (dir == 0) HS[(size_t)r * 512 + ch] = hst; else HS[(size_t)r * 512 + ch] += hst;
    }
}
__global__ void __launch_bounds__(256) k_yb(Params p) {
    const size_t idx = (size_t)blockIdx.x * 256 + threadIdx.x; const int r = (int)(idx >> 9), ch = (int)(idx & 511);
    const bf16_t* Z = (const bf16_t*)(p.ws + WS_Z); const float* HS = (const float*)(p.ws + WS_RA); bf16_t* Y = (bf16_t*)(p.ws + WS_RY);
    Y[(size_t)r * D + 512 + ch] = f2bf(HS[(size_t)r * 512 + ch] * bf2f(Z[(size_t)r * 4096 + 1536 + ch]));
}
__global__ void __launch_bounds__(256) k_ln(Params p, int l, int nrows) {
    const int lane = threadIdx.x & 63, wave = (blockIdx.x * 256 + threadIdx.x) >> 6, nw = (gridDim.x * 256) >> 6;
    const bf16_t* Z = (const bf16_t*)(p.ws + WS_Z); float* VN = (float*)(p.ws + WS_NV1);
    for (int r = wave; r < nrows; r += nw) {
        float v[8]; float s = 0.f;
#pragma unroll
        for (int i = 0; i < 8; ++i) { v[i] = bf2f(Z[(size_t)r * 4096 + 512 + i * 64 + lane]); s += v[i]; }
        const float mu = wave_sum(s) * (1.f / 512.f); float q = 0.f;
#pragma unroll
        for (int i = 0; i < 8; ++i) { v[i] -= mu; q += v[i] * v[i]; }
        const float rstd = rsqrtf(wave_sum(q) * (1.f / 512.f) + 1e-5f);
#pragma unroll
        for (int i = 0; i < 8; ++i) { const int cch = i * 64 + lane; VN[(size_t)r * 512 + cch] = v[i] * rstd * p.ln_g[l * 512 + cch] + p.ln_b[l * 512 + cch]; }
    }
}
__global__ void __launch_bounds__(256) k_mix(Params p, int l) {
    const size_t idx = (size_t)blockIdx.x * 256 + threadIdx.x; const int r = (int)(idx >> 9), ch = (int)(idx & 511), g = ch >> 6;
    const bf16_t* Z = (const bf16_t*)(p.ws + WS_Z); const float* VN = (const float*)(p.ws + WS_NV1); bf16_t* Y = (bf16_t*)(p.ws + WS_RY);
    const int base = r & ~127, pp = r & 127;
    const float* w = p.gws + ((size_t)(l * 8 + g) * 128 + pp) * 128;
    float acc = p.gbs[(l * 8 + g) * 128 + pp];
    for (int q = 0; q < 128; ++q) acc += w[q] * VN[(size_t)(base + q) * 512 + ch];
    Y[(size_t)r * D + ch] = f2bf(bf2f(Z[(size_t)r * 4096 + ch]) * acc);
}
__global__ void __launch_bounds__(256) k_route(Params p, int l, int nrows) {
    const int lane = threadIdx.x & 63, wave = (blockIdx.x * 256 + threadIdx.x) >> 6, nw = (gridDim.x * 256) >> 6;
    int* TOPI = (int*)(p.ws + WS_TOPI); float* TOPW = (float*)(p.ws + WS_TOPW);
    for (int r = wave; r < nrows; r += nw) { int myi; float myw; route_token(p, l, ((const float*)(p.ws + WS_LOG))[(size_t)r * 64 + lane], lane, myi, myw);
        if (lane < 8) { TOPI[(size_t)r * 8 + lane] = myi; TOPW[(size_t)r * 8 + lane] = myw; } }
}
__global__ void __launch_bounds__(256) k_routed(Params p, int l) {
    __shared__ float hs[D]; __shared__ float hm[256];
    const int r = blockIdx.x, tid = threadIdx.x;
    const bf16_t* H2 = (const bf16_t*)(p.ws + WS_RA); const int* TOPI = (const int*)(p.ws + WS_TOPI); const float* TOPW = (const float*)(p.ws + WS_TOPW);
    const float* FLs = (const float*)(p.ws + WS_NFLS); bf16_t* FL = (bf16_t*)(p.ws + WS_RY);
#pragma unroll
    for (int i = 0; i < 4; ++i) hs[tid + 256 * i] = bf2f(H2[(size_t)r * D + tid + 256 * i]);
    float acc[4] = {0.f, 0.f, 0.f, 0.f};
    __syncthreads();
    for (int s = 0; s < 8; ++s) {
        const int e = TOPI[(size_t)r * 8 + s]; const float w = TOPW[(size_t)r * 8 + s];
        const float* wg = p.e_g + ((size_t)(l * NE + e) * D) * 256; const float* wu = p.e_u + ((size_t)(l * NE + e) * D) * 256;
        float g = 0.f, u = 0.f;
        for (int k = 0; k < D; ++k) { const float hv = hs[k]; g += hv * wg[(size_t)k * 256 + tid]; u += hv * wu[(size_t)k * 256 + tid]; }
        hm[tid] = siluf_(g) * u;
        __syncthreads();
        const float* wd = p.e_d + ((size_t)(l * NE + e) * 256) * D;
        float o[4] = {0.f, 0.f, 0.f, 0.f};
        for (int j = 0; j < 256; ++j) { const float hv = hm[j];
#pragma unroll
            for (int i = 0; i < 4; ++i) o[i] += hv * wd[(size_t)j * D + tid + 256 * i]; }
#pragma unroll
        for (int i = 0; i < 4; ++i) acc[i] += w * o[i];
        __syncthreads();
    }
#pragma unroll
    for (int i = 0; i < 4; ++i) FL[(size_t)r * D + tid + 256 * i] = f2bf(FLs[(size_t)r * D + tid + 256 * i] + acc[i]);
}
template <int SPLIT, class AL, class BL, class EP>
static void ngemm(hipStream_t st, int M, int N, int K, AL al, BL bl, EP ep) { hipLaunchKernelGGL((k_gemm<AL, BL, EP, SPLIT>), dim3(N / 64, M / 64), dim3(256), 0, st, al, bl, ep, K); }
#endif

static void mk(hipStream_t st, const Params& p, int lo, int hi) { Args a{}; a.p = p; a.ph_lo = lo; a.ph_hi = hi; hipLaunchKernelGGL(mk_fwd, dim3(256), dim3(NWAVES * 64), LDS_BYTES, st, a); }

extern "C" void kernel_launch(void* const* d_in, const int* in_sizes, int n_in, void* d_out, int out_size, void* d_ws, size_t ws_size, hipStream_t stream) {
    static int ready = 0;
    if (ready == 0) {
        ready = -1;
        if (n_in != 33 || ws_size < WS_END || out_size != TL * D) return;
        int dev = 0, cus = 0;
        if (hipGetDevice(&dev) != hipSuccess || hipDeviceGetAttribute(&cus, hipDeviceAttributeMultiprocessorCount, dev) != hipSuccess || cus < 256) return;
        if (hipFuncSetAttribute((const void*)mk_fwd, hipFuncAttributeMaxDynamicSharedMemorySize, LDS_BYTES) != hipSuccess) return;
        ready = 1;
    }
    if (ready < 0) return;
    Params p{};
    const float** pp = (const float**)&p;
    for (int i = 0; i < 33; ++i) pp[i] = (const float*)d_in[i];
    p.out = (float*)d_out; p.ws = (unsigned char*)d_ws;
    (void)hipMemsetAsync((char*)d_ws + WS_CTL, 0, 1 * MiB, stream);
#if FAST == 0x1ff && !defined(MK_PER_PHASE)
    mk(stream, p, 0, PH_END);
#elif FAST == 0x1ff
    for (int ph = 0; ph < PH_END; ++ph) mk(stream, p, ph, ph + 1);
#else
    unsigned char* ws = p.ws;
    bf16_t* RA = (bf16_t*)(ws + WS_RA); bf16_t* Z = (bf16_t*)(ws + WS_Z); bf16_t* RY = (bf16_t*)(ws + WS_RY);
    float* LOG = (float*)(ws + WS_LOG); float* SG = (float*)(ws + WS_NSG); bf16_t* SH = (bf16_t*)(ws + WS_SH); float* FLs = (float*)(ws + WS_NFLS);
    mk(stream, p, 0, 1);
    if (!(FAST & 1)) hipLaunchKernelGGL(k_mod, dim3(24, 5, 2), dim3(256), 0, stream, p);
    for (int l = 0; l < 2; ++l) {
        const int nr = (l == 0) ? R : TL, b0 = 1 + l * NPL;
        if (FAST & 2) mk(stream, p, b0 + 0, b0 + 1); else { if (l > 0) mk(stream, p, 100 + l, 101 + l); hipLaunchKernelGGL(k_rowA, dim3(2048), dim3(256), 0, stream, p, l); }
        if (FAST & 4) mk(stream, p, b0 + 1, b0 + 2); else ngemm<0>(stream, R, 4096, D, ABf16{RA, D, 0}, BF32{p.w_in + (size_t)l * D * 4096, 4096, 0}, NEpiZ{Z});
        if (FAST & 8) { mk(stream, p, b0 + 2, b0 + 3); mk(stream, p, b0 + 3, b0 + 4); }
        else {
            hipLaunchKernelGGL(k_conv, dim3(R * 512 / 256), dim3(256), 0, stream, p, l);
            for (int dir = 0; dir < 2; ++dir) hipLaunchKernelGGL(k_scan, dim3(NBATCH * 8), dim3(64), 0, stream, p, l, dir);
            hipLaunchKernelGGL(k_yb, dim3(nr * 512 / 256), dim3(256), 0, stream, p);
            hipLaunchKernelGGL(k_ln, dim3(2048), dim3(256), 0, stream, p, l, nr);
            hipLaunchKernelGGL(k_mix, dim3(nr * 512 / 256), dim3(256), 0, stream, p, l);
        }
        if (FAST & 16) mk(stream, p, b0 + 4, b0 + 5); else ngemm<512>(stream, nr, D, D, ABf16{RY, D, 0}, BAB{p.w_out_a + (size_t)l * 512 * D, p.w_out_b + (size_t)l * 512 * D}, NEpiMerge{Z, RA});
        if (FAST & 32) mk(stream, p, b0 + 5, b0 + 6); else ngemm<0>(stream, nr, D, D, ABf16{RA, D, 0}, BF32{p.w_out + (size_t)l * D * D, D, 0}, NEpiBf{Z, D, 0});
        if (FAST & 64) mk(stream, p, b0 + 6, b0 + 7); else hipLaunchKernelGGL(k_rowH, dim3(2048), dim3(256), 0, stream, p, l, nr);
        if (FAST & 128) { mk(stream, p, b0 + 7, b0 + 8); mk(stream, p, b0 + 8, b0 + 9); }
        else {
            ngemm<0>(stream, nr, 64, D, ABf16{RA, D, 0}, BF32{p.router_w + (size_t)l * D * 64, 64, 0}, NEpiF32{LOG, 64, 0});
            hipLaunchKernelGGL(k_route, dim3(2048), dim3(256), 0, stream, p, l, nr);
            ngemm<0>(stream, nr, 256, D, ABf16{RA, D, 0}, BF32{p.s_g + (size_t)l * D * 256, 256, 0}, NEpiF32{SG, 256, 0});
            ngemm<0>(stream, nr, 256, D, ABf16{RA, D, 0}, BF32{p.s_u + (size_t)l * D * 256, 256, 0}, NEpiSwi{SG, SH});
        }
        if (FAST & 256) { for (int k = 9; k < NPL; ++k) mk(stream, p, b0 + k, b0 + k + 1); }
        else {
            ngemm<0>(stream, nr, D, 256, ABf16{SH, 256, 0}, BF32{p.s_d + (size_t)l * 256 * D, D, 0}, NEpiF32{FLs, D, 0});
            hipLaunchKernelGGL(k_routed, dim3(nr), dim3(256), 0, stream, p, l);
        }
    }
    if (FAST & 2) mk(stream, p, PH_FINAL, PH_END); else hipLaunchKernelGGL(k_rowA, dim3(2048), dim3(256), 0, stream, p, 2);
#endif
}
```

```cpp
#include <hip/hip_runtime.h>
#include <stdint.h>
#include <math.h>

#ifndef GIN_FP8
#define GIN_FP8 1
#endif
#ifndef GED_FP8
#define GED_FP8 1
#endif
#ifndef GSD_FP8
#define GSD_FP8 0
#endif
typedef unsigned short bf16_t;
#define DEV __device__ __forceinline__
#define LAS __attribute__((address_space(3)))
#define GAS __attribute__((address_space(1)))
typedef short bf16x8 __attribute__((ext_vector_type(8)));
typedef float f32x4 __attribute__((ext_vector_type(4)));
typedef unsigned u32x4 __attribute__((ext_vector_type(4)));
typedef unsigned u32x2 __attribute__((ext_vector_type(2)));

constexpr int D = 1024, NBATCH = 4, SEQ = 8192, CTXL = 256;
constexpr int TL = NBATCH * SEQ, TC = NBATCH * CTXL, R = TL + TC;
constexpr int NE = 64, CAP = R;
constexpr int NCHUNK = R / 128;
constexpr size_t MiB = 1u << 20;
constexpr size_t WS_CTL = 0;
constexpr size_t WS_PE = 1 * MiB + 512 * 1024  ;
constexpr size_t WS_MOD = 1 * MiB, WS_H8 = 2 * MiB  , WS_LISTA = 6 * MiB  , WS_LISTW = 15 * MiB  , WS_SUMM = 24 * MiB, WS_LOG = 27 * MiB;
constexpr size_t WS_TOPI = WS_LOG, WS_TOPW = WS_LOG;
constexpr size_t WS_W = 36 * MiB;
constexpr size_t WS_XC = 84 * MiB;
constexpr size_t WS_RY = 148 * MiB;
constexpr size_t WS_Z = 214 * MiB;
constexpr size_t WS_HM = 214 * MiB;
constexpr size_t WS_SH = 354 * MiB;
constexpr size_t WS_SLOTS = 354 * MiB;
constexpr size_t WS_RA = 478 * MiB;
constexpr size_t WS_LR = 478 * MiB;
constexpr size_t WS_XCT = 478 * MiB;
constexpr size_t WS_H2E = 544 * MiB;
constexpr size_t WS_END = 618 * MiB;
constexpr size_t WO_IN = 0, WO_AB = 8 * MiB, WO_OUT = 10 * MiB, WO_SR = 12 * MiB  , WO_SD = 14 * MiB  , WO_LRU = 15 * MiB  ,
                 WO_GWS = 15 * MiB + MiB / 2  , WO_EG = 16 * MiB  , WO_ED = 80 * MiB  ;
constexpr int CW_CNT = 64;
constexpr int CW_BAR = 4096;

struct Params {
    const float *x, *c, *ctx, *c_ctx, *w_mod, *b_mod, *g_pre_mix, *g_post_mix, *g_pre_ffn, *g_post_ffn, *w_in, *ln_g, *ln_b, *gws, *gbs,
        *conv_w, *conv_b, *lru_wa, *lru_ba, *lru_wx, *lru_bx, *lru_lam, *w_out_a, *w_out_b, *w_out, *router_w, *router_b, *e_g, *e_u, *e_d, *s_g, *s_u, *s_d;
    float* out; unsigned char* ws;
};

DEV float bf2f(bf16_t v) { return __uint_as_float(((unsigned)v) << 16); }
DEV bf16_t f2bf(float f) { unsigned u = __float_as_uint(f); return (bf16_t)((u + 0x7fffu + ((u >> 16) & 1u)) >> 16); }
DEV unsigned pk2(float lo, float hi) { return (unsigned)f2bf(lo) | ((unsigned)f2bf(hi) << 16); }
DEV float sigmoidf_(float x) { return 1.f / (1.f + expf(-x)); }
DEV float siluf_(float x) { return x / (1.f + expf(-x)); }
DEV float gelu_tanh(float x) { return 0.5f * x * (1.f + tanhf(0.7978845608028654f * (x + 0.044715f * x * x * x))); }
DEV float fsigmoid(float x) { return __builtin_amdgcn_rcpf(1.f + __builtin_amdgcn_exp2f(-1.4426950408889634f * x)); }
DEV float fsilu(float x) { return x * fsigmoid(x); }
DEV float fgelu(float x) { const float u = 1.5957691216057308f * (x + 0.044715f * x * x * x); return x * fsigmoid(u); }
DEV float wave_sum(float v) {
#pragma unroll
    for (int o = 1; o < 64; o <<= 1) v += __shfl_xor(v, o);
    return v;
}
DEV const float* mod_ptr(const Params& p, int l, int cond, int j) { return (const float*)(p.ws + WS_MOD) + ((size_t)((l * 5 + cond) * 6 + j)) * D; }
DEV float* xl_row(const Params& p, int r) { return r < TL ? p.out + (size_t)r * D : (float*)(p.ws + WS_XC) + (size_t)(r - TL) * D; }
namespace pg8 {
constexpr int BM = 256, BK = 64, HALF = 128, HTB = HALF * BK * 2  , STAGE_BYTES = 8 * HTB;
DEV int lds_byte(int r, int c) { const int st = (r >> 4) * 2 + (c >> 5), rr = r & 15, cc = c & 31, ob = rr * 64 + cc * 2; return st * 1024 + (ob ^ (((ob >> 9) & 1) << 5)); }
DEV void stage_rc(int b, int& Rr, int& C) { const int st = b / 1024, sb = b % 1024, swz = sb ^ (((sb >> 9) & 1) << 5); Rr = (st >> 1) * 16 + swz / 64; C = (st & 1) * 32 + (swz % 64) / 2; }
DEV int perm32(int rho) { const int n = rho >> 4, i = rho & 15; return 8 * (i >> 2) + 4 * n + (i & 3); }
DEV unsigned cvt_pk_bf16(float lo, float hi) { unsigned r; asm volatile("v_cvt_pk_bf16_f32 %0, %1, %2" : "=v"(r) : "v"(lo), "v"(hi)); return r; }
DEV u32x4 pack8(const f32x4 v0, const f32x4 v1) { u32x4 w; w.x = cvt_pk_bf16(v0[0], v0[1]); w.y = cvt_pk_bf16(v0[2], v0[3]); w.z = cvt_pk_bf16(v1[0], v1[1]); w.w = cvt_pk_bf16(v1[2], v1[3]); return w; }
DEV void unpack8(const u32x4 w, f32x4& v0, f32x4& v1) {
    v0[0] = __uint_as_float(w.x << 16); v0[1] = __uint_as_float(w.x & 0xffff0000u); v0[2] = __uint_as_float(w.y << 16); v0[3] = __uint_as_float(w.y & 0xffff0000u);
    v1[0] = __uint_as_float(w.z << 16); v1[1] = __uint_as_float(w.z & 0xffff0000u); v1[2] = __uint_as_float(w.w << 16); v1[3] = __uint_as_float(w.w & 0xffff0000u);
}
DEV int xcd_remap(int L, int U) { const int q = U / 8, r = U % 8, xcd = L % 8, off = L / 8; return (xcd < r ? xcd * (q + 1) : r * (q + 1) + (xcd - r) * q) + off; }

struct UnitD { int pm, pn; };
template <int K, size_t AOFF, size_t BOFF> struct DenseSched {
    typedef UnitD Unit; static constexpr int KK = K;
    const unsigned char* ws; int nM, nN, nwg, c, Krt; static constexpr int G = 256;
    DEV void init(const unsigned char* ws_, int M, int N, int c_) { ws = ws_; nM = M / BM; nN = N / BM; nwg = nM * nN; c = c_; Krt = K; asm volatile("" : "+s"(Krt)); }
    DEV bool next(int i, Unit& u) const {
        const int L = i * G + c; if (L >= nwg) return false;
        const int wgid = xcd_remap(L, nwg);
        const int nig = 8 * nN, gid = wgid / nig, fm = gid * 8, gsz = (nM - fm) < 8 ? (nM - fm) : 8;
        u.pm = fm + ((wgid % nig) % gsz); u.pn = (wgid % nig) / gsz; return true;
    }
    DEV const char* abase(const Unit& u) const { return (const char*)ws + AOFF + (size_t)u.pm * BM * K * 2; }
    DEV const char* bbase(const Unit& u) const { return (const char*)ws + BOFF + (size_t)u.pn * BM * K * 2; }
    DEV void prefetch(const Unit&, LAS unsigned char*, int, int) const {}
    DEV void aoffs(const Unit&, int tid, unsigned (&v)[2][2], LAS unsigned char*, int, bool) const {
#pragma unroll
        for (int i = 0; i < 2; ++i) { int Rr, C; stage_rc(tid * 16 + i * 8192, Rr, C);
#pragma unroll
            for (int h = 0; h < 2; ++h) v[h][i] = (unsigned)((h * HALF + Rr) * K + C) * 2u; }
    }
};
struct UnitE { int e, row0, cnt, hmrow0, pn; };
template <int K, int GATHER, int NCOL, size_t AOFF, size_t BOFF, size_t BSTRIDE> struct ExpSched {
    typedef UnitE Unit; static constexpr int KK = K;
    const unsigned char* ws; LAS unsigned char* lds;
    int U, c, brow0, Krt; static constexpr int ncol = NCOL, gather = GATHER, G = 256;
    DEV bool next(int i, Unit& u) const {
        const int L = i * G + c; if (L >= U) return false;
        const int id = xcd_remap(L, U), tile = id / ncol; u.pn = id % ncol;
        const LAS int* toff = (const LAS int*)(lds + 131072 + 256);
        const int e = (int)((const LAS unsigned char*)(lds + 131072 + 2048))[tile];
        u.e = e; u.row0 = (tile - toff[e]) * BM; u.cnt = toff[80 + e]; u.hmrow0 = tile * BM; return true;
    }
    DEV const char* abase(const Unit& u) const { return gather ? (const char*)ws + AOFF : (const char*)ws + AOFF + (size_t)u.hmrow0 * K * 2; }
    DEV const char* bbase(const Unit& u) const { return (const char*)ws + BOFF + (size_t)u.e * BSTRIDE + (size_t)(brow0 + u.pn * BM) * K * 2; }
    DEV void prefetch(const Unit& u, LAS unsigned char* lds_, int wid, int lane) const {
        if (gather) __builtin_amdgcn_global_load_lds((const unsigned*)(ws + WS_LISTA) + (size_t)u.e * CAP + u.row0 + lane * 4, (LAS unsigned*)(lds_ + 131072 + 2048 + wid * 3712 + 2048), 16, 0, 0);
    }
    DEV void aoffs(const Unit& u, int tid, unsigned (&v)[2][2], LAS unsigned char* lds_, int wid, bool from_lds) const {
        asm volatile("" : "+v"(tid));
        const int* lista = (const int*)(ws + WS_LISTA);
        const LAS int* sp = (const LAS int*)(lds_ + 131072 + 2048 + wid * 3712 + 2048);
#pragma unroll
        for (int i = 0; i < 2; ++i) { int Rr, C; stage_rc(tid * 16 + i * 8192, Rr, C);
#pragma unroll
            for (int h = 0; h < 2; ++h) {
                const int lr = h * HALF + Rr;
                if (gather) { const int rr = u.row0 + lr; const int aid = from_lds ? sp[lr] : ((rr < u.cnt) ? lista[(size_t)u.e * CAP + rr] : 0);
                    const int tok = (rr < u.cnt) ? (aid >> 3) : 0; v[h][i] = (unsigned)(tok * K + C) * 2u; }
                else v[h][i] = (unsigned)(lr * K + C) * 2u;
            } }
    }
};

typedef f32x4 Acc[2][2][4][2];
#define EPI_ROWS(ai, m) for (int ai = 0; ai < 2; ++ai) _Pragma("unroll") for (int m = 0; m < 4; ++m)

struct EpiZ {
    static constexpr int PID = 10; static constexpr bool HAS_MID = false; static constexpr int MID_T = 0;
    unsigned char* ws;
    DEV void mid(Acc&, const UnitD&, int, int, int, int) const {}
    DEV void unit_begin(const UnitD&, LAS unsigned char*, int, int) const {}
    DEV void operator()(const Acc& acc, const UnitD& u, int wr, int wc, int fr, int fq) const {
        bf16_t* Z = (bf16_t*)(ws + WS_Z);
        const int act = (u.pn < 4) ? 1 : (u.pn < 6 ? 0 : (u.pn < 8 ? 1 : 2));
        const int row0 = u.pm * BM + wr * 64 + fr, col0 = u.pn * BM + wc * 32 + 8 * fq;
#pragma unroll
        EPI_ROWS(ai, m) { bf16_t* rowp = Z + (size_t)(row0 + ai * HALF + m * 16) * 4096 + col0;
#pragma unroll
            for (int bj = 0; bj < 2; ++bj) { f32x4 v0 = acc[ai][bj][m][0], v1 = acc[ai][bj][m][1];
                if (act == 1) {
#pragma unroll
                    for (int i = 0; i < 4; ++i) { v0[i] = fgelu(v0[i]); v1[i] = fgelu(v1[i]); }
                } else if (act == 2) {
                    unsigned w0 = 0, w1 = 0;
#pragma unroll
                    for (int i = 0; i < 4; ++i) { w0 |= (unsigned)__builtin_rintf(fsigmoid(v0[i]) * 255.f) << (8 * i); w1 |= (unsigned)__builtin_rintf(fsigmoid(v1[i]) * 255.f) << (8 * i); }
                    *(u32x2*)((unsigned char*)(Z + (size_t)(row0 + ai * HALF + m * 16) * 4096) + 4096 + (col0 - 2048) + bj * HALF) = (u32x2){w0, w1};
                    continue;
                }
                *(u32x4*)(rowp + bj * HALF) = pack8(v0, v1); } }
    }
};
struct EpiAB {
    static constexpr int PID = 11; static constexpr bool HAS_MID = true; static constexpr int MID_T = 8;
    unsigned char* ws;
    DEV void unit_begin(const UnitD&, LAS unsigned char*, int, int) const {}
    DEV void mid(Acc& acc, const UnitD& u, int wr, int wc, int fr, int fq) const {
        const bf16_t* Z = (const bf16_t*)(ws + WS_Z);
        int oz = 0; asm volatile("" : "+v"(oz));
        const int row0 = u.pm * BM + wr * 64 + fr + oz, col0 = u.pn * BM + wc * 32 + 8 * fq;
#pragma unroll
        for (int ai = 0; ai < 2; ++ai) {
            u32x2 ga[4][2], gr[4][2];
#pragma unroll
            for (int m = 0; m < 4; ++m) { const unsigned char* zr = (const unsigned char*)(Z + (size_t)(row0 + ai * HALF + m * 16) * 4096) + 4096 + col0;
#pragma unroll
                for (int bj = 0; bj < 2; ++bj) { ga[m][bj] = *(const u32x2*)(zr + bj * HALF); gr[m][bj] = *(const u32x2*)(zr + 1024 + bj * HALF); } }
#pragma unroll
            for (int m = 0; m < 4; ++m)
#pragma unroll
                for (int bj = 0; bj < 2; ++bj) {
#pragma unroll
                    for (int i = 0; i < 4; ++i) {
                        const float a0 = (float)((ga[m][bj].x >> (8 * i)) & 255u), a1 = (float)((ga[m][bj].y >> (8 * i)) & 255u);
                        const float r0 = fmaxf((float)((gr[m][bj].x >> (8 * i)) & 255u), 0.5f), r1 = fmaxf((float)((gr[m][bj].y >> (8 * i)) & 255u), 0.5f);
                        acc[ai][bj][m][0][i] *= a0 * __builtin_amdgcn_rcpf(r0); acc[ai][bj][m][1][i] *= a1 * __builtin_amdgcn_rcpf(r1); } }
            asm volatile("" ::: "memory"); }
    }
    DEV void operator()(const Acc& acc, const UnitD& u, int wr, int wc, int fr, int fq) const {
        const bf16_t* Z = (const bf16_t*)(ws + WS_Z); bf16_t* M = (bf16_t*)(ws + WS_RA);
        const int row0 = u.pm * BM + wr * 64 + fr, col0 = u.pn * BM + wc * 32 + 8 * fq;
        u32x2 gr[2][4][2];
#pragma unroll
        EPI_ROWS(ai, m) { const unsigned char* zr = (const unsigned char*)(Z + (size_t)(row0 + ai * HALF + m * 16) * 4096) + 4096 + 1024 + col0;
#pragma unroll
            for (int bj = 0; bj < 2; ++bj) gr[ai][m][bj] = *(const u32x2*)(zr + bj * HALF); }
#pragma unroll
        EPI_ROWS(ai, m) { bf16_t* rowp = M + (size_t)(row0 + ai * HALF + m * 16) * D + col0;
#pragma unroll
            for (int bj = 0; bj < 2; ++bj) { f32x4 r0, r1;
#pragma unroll
                for (int i = 0; i < 4; ++i) { r0[i] = fmaxf((float)((gr[ai][m][bj].x >> (8 * i)) & 255u), 0.5f) * (1.f / 255.f); r1[i] = fmaxf((float)((gr[ai][m][bj].y >> (8 * i)) & 255u), 0.5f) * (1.f / 255.f); }
                *(u32x4*)(rowp + bj * HALF) = pack8(acc[ai][bj][m][0] * r0, acc[ai][bj][m][1] * r1); } }
    }
};
template <size_t COFF> struct EpiPlain {
    static constexpr int PID = 12; static constexpr bool HAS_MID = false; static constexpr int MID_T = 0;
    unsigned char* ws;
    DEV void mid(Acc&, const UnitD&, int, int, int, int) const {}
    DEV void unit_begin(const UnitD&, LAS unsigned char*, int, int) const {}
    DEV void operator()(const Acc& acc, const UnitD& u, int wr, int wc, int fr, int fq) const {
        bf16_t* C = (bf16_t*)(ws + COFF); constexpr int ldc = D;
        const int row0 = u.pm * BM + wr * 64 + fr, col0 = u.pn * BM + wc * 32 + 8 * fq;
#pragma unroll
        EPI_ROWS(ai, m) { bf16_t* rowp = C + (size_t)(row0 + ai * HALF + m * 16) * ldc + col0;
#pragma unroll
            for (int bj = 0; bj < 2; ++bj) *(u32x4*)(rowp + bj * HALF) = pack8(acc[ai][bj][m][0], acc[ai][bj][m][1]); }
    }
};
struct EpiSR {
    static constexpr int PID = 13; static constexpr bool HAS_MID = false; static constexpr int MID_T = 0;
    unsigned char* ws;
    DEV void mid(Acc&, const UnitD&, int, int, int, int) const {}
    DEV void unit_begin(const UnitD&, LAS unsigned char*, int, int) const {}
    DEV void operator()(const Acc& acc, const UnitD& u, int wr, int wc, int fr, int fq) const {
        float* LOG = (float*)(ws + WS_LOG); bf16_t* SH = (bf16_t*)(ws + WS_SH);
        const int row0 = u.pm * BM + wr * 64 + fr;
        if (u.pn == 0) {
            if (wc < 2) {
#pragma unroll
                EPI_ROWS(ai, m) { float* rowp = LOG + (size_t)(row0 + ai * HALF + m * 16) * 64 + wc * 32 + 8 * fq;
                    *(f32x4*)(rowp) = acc[ai][0][m][0]; *(f32x4*)(rowp + 4) = acc[ai][0][m][1]; }
            }
        } else {
            const int j0 = (u.pn - 1) * HALF + wc * 32 + 8 * fq;
#pragma unroll
            EPI_ROWS(ai, m) { f32x4 v0, v1;
#pragma unroll
                for (int i = 0; i < 4; ++i) { v0[i] = fsilu(acc[ai][0][m][0][i]) * acc[ai][1][m][0][i]; v1[i] = fsilu(acc[ai][0][m][1][i]) * acc[ai][1][m][1][i]; }
#if GSD_FP8
                { u32x2 o; unsigned t = 0;
#pragma unroll
                  for (int i = 0; i < 4; ++i) { v0[i] = __builtin_amdgcn_fmed3f(v0[i] * 8.f, -440.f, 440.f); v1[i] = __builtin_amdgcn_fmed3f(v1[i] * 8.f, -440.f, 440.f); }
                  t = __builtin_amdgcn_cvt_pk_fp8_f32(v0[0], v0[1], t, false); t = __builtin_amdgcn_cvt_pk_fp8_f32(v0[2], v0[3], t, true); o.x = t;
                  t = __builtin_amdgcn_cvt_pk_fp8_f32(v1[0], v1[1], t, false); t = __builtin_amdgcn_cvt_pk_fp8_f32(v1[2], v1[3], t, true); o.y = t;
                  *(u32x2*)((unsigned char*)SH + (size_t)(row0 + ai * HALF + m * 16) * 256 + j0) = o; }
#else
                *(u32x4*)(SH + (size_t)(row0 + ai * HALF + m * 16) * 256 + j0) = pack8(v0, v1);
#endif
            }
        }
    }
};
template <int FP8S> struct EpiEG {
    static constexpr int PID = 14; static constexpr bool HAS_MID = false; static constexpr int MID_T = 0;
    unsigned char* ws;
    DEV void mid(Acc&, const UnitE&, int, int, int, int) const {}
    DEV void unit_begin(const UnitE&, LAS unsigned char*, int, int) const {}
    DEV void operator()(const Acc& acc, const UnitE& u, int wr, int wc, int fr, int fq) const {
        bf16_t* HM = (bf16_t*)(ws + WS_HM);
        const int j0 = u.pn * HALF + wc * 32 + 8 * fq;
#pragma unroll
        EPI_ROWS(ai, m) { f32x4 v0, v1;
#pragma unroll
            for (int i = 0; i < 4; ++i) { constexpr float sc = FP8S ? (1.f / 1024.f) : 1.f; v0[i] = fsilu(acc[ai][0][m][0][i] * sc) * (acc[ai][1][m][0][i] * sc); v1[i] = fsilu(acc[ai][0][m][1][i] * sc) * (acc[ai][1][m][1][i] * sc); }
#if GED_FP8
            { u32x2 o; unsigned t = 0;
#pragma unroll
              for (int i = 0; i < 4; ++i) { v0[i] = __builtin_amdgcn_fmed3f(v0[i] * 8.f, -440.f, 440.f); v1[i] = __builtin_amdgcn_fmed3f(v1[i] * 8.f, -440.f, 440.f); }
              t = __builtin_amdgcn_cvt_pk_fp8_f32(v0[0], v0[1], t, false); t = __builtin_amdgcn_cvt_pk_fp8_f32(v0[2], v0[3], t, true); o.x = t;
              t = __builtin_amdgcn_cvt_pk_fp8_f32(v1[0], v1[1], t, false); t = __builtin_amdgcn_cvt_pk_fp8_f32(v1[2], v1[3], t, true); o.y = t;
              *(u32x2*)((unsigned char*)HM + (size_t)(u.hmrow0 + ai * HALF + wr * 64 + m * 16 + fr) * 256 + j0) = o; }
#else
            *(u32x4*)(HM + (size_t)(u.hmrow0 + ai * HALF + wr * 64 + m * 16 + fr) * 256 + j0) = pack8(v0, v1);
#endif
        }
    }
};
struct EpiED {
    static constexpr int PID = 15; static constexpr bool HAS_MID = false; static constexpr int MID_T = 0;
    unsigned char* ws;
    DEV void mid(Acc&, const UnitE&, int, int, int, int) const {}
    DEV void unit_begin(const UnitE& u, LAS unsigned char* lds, int wid, int lane) const {
        const int wr = wid >> 2; LAS unsigned char* sp = lds + 131072 + 2048 + wid * 3712 + 2048;
#pragma unroll
        for (int ai = 0; ai < 2; ++ai) { const size_t idx = (size_t)u.e * CAP + u.row0 + ai * HALF + wr * 64 + lane;
            __builtin_amdgcn_global_load_lds((const unsigned*)(ws + WS_LISTA) + idx, (LAS unsigned*)(sp + ai * 256), 4, 0, 0);
            __builtin_amdgcn_global_load_lds((const unsigned*)(ws + WS_LISTW) + idx, (LAS unsigned*)(sp + 512 + ai * 256), 4, 0, 0); }
    }
    DEV void operator()(const Acc& acc, const UnitE& u, int wr, int wc, int fr, int fq) const {
        unsigned char* SLOTS = ws + WS_SLOTS;
        const LAS unsigned* sp = (const LAS unsigned*)(lds_ + 131072 + 2048 + (wr * 4 + wc) * 3712 + 2048);
        const int col0 = u.pn * BM + wc * 32 + 8 * fq;
#pragma unroll
        EPI_ROWS(ai, m) { const int rr = u.row0 + ai * HALF + wr * 64 + m * 16 + fr;
            const int aid = (int)sp[ai * 64 + m * 16 + fr]; const float w = __uint_as_float(sp[128 + ai * 64 + m * 16 + fr]) * 16.0f;
            if (rr < u.cnt) { unsigned char* rowp = SLOTS + (size_t)aid * 1024 + col0;
#pragma unroll
                for (int bj = 0; bj < 2; ++bj) { f32x4 v0 = acc[ai][bj][m][0] * w, v1 = acc[ai][bj][m][1] * w; u32x2 o; unsigned t = 0;
#pragma unroll
                    for (int i = 0; i < 4; ++i) { v0[i] = __builtin_amdgcn_fmed3f(v0[i], -440.f, 440.f); v1[i] = __builtin_amdgcn_fmed3f(v1[i], -440.f, 440.f); }
                    t = __builtin_amdgcn_cvt_pk_fp8_f32(v0[0], v0[1], t, false); t = __builtin_amdgcn_cvt_pk_fp8_f32(v0[2], v0[3], t, true); o.x = t;
                    t = __builtin_amdgcn_cvt_pk_fp8_f32(v1[0], v1[1], t, false); t = __builtin_amdgcn_cvt_pk_fp8_f32(v1[2], v1[3], t, true); o.y = t;
                    *(u32x2*)(rowp + bj * HALF) = o; } } }
    }
    LAS unsigned char* lds_;
};

template <class Epi, class Sched, bool ALIGN_EPI, int FP8 = 0>
DEV void gemm_phase(LAS unsigned char* lds, const int tid, const Sched& S, const Epi& E) {
    typedef typename Sched::Unit Unit;
    const int wid = __builtin_amdgcn_readfirstlane(tid >> 6), lane = tid & 63, wr = wid >> 2, wc = wid & 3, fr = lane & 15, fq = lane >> 4;
    const int K = S.Krt, nt = K / BK;
    unsigned voffB[2];
#pragma unroll
    for (int i = 0; i < 2; ++i) { int Rr, C; stage_rc(tid * 16 + i * 8192, Rr, C); const int Rb = (Rr & ~31) + perm32(Rr & 31); voffB[i] = (unsigned)(Rb * K + C) * 2u; }
    const size_t kstep = (size_t)(BK * 2);
    const size_t hstepB = (size_t)HALF * K * 2;
    const unsigned ldsw = (unsigned)wid * 1024u;
    const int aoff = lds_byte(wr * 64 + fr, fq * 8), boff = lds_byte(wc * 32 + fr, fq * 8);
#define PG8_SA(b, h) (((b) * 2 + (h)) * HTB)
#define PG8_SB(b, h) ((4 + (b) * 2 + (h)) * HTB)
#define PG8_STAGE2(bufoff, gbase, o0, o1) do { unsigned o0_ = (o0), o1_ = (o1); asm volatile("" : "+v"(o0_), "+v"(o1_));     \
        __builtin_amdgcn_global_load_lds((const unsigned*)((const char*)(gbase) + o0_), (LAS unsigned*)(lds + (bufoff) + ldsw), 16, 0, 0); \
        __builtin_amdgcn_global_load_lds((const unsigned*)((const char*)(gbase) + o1_), (LAS unsigned*)(lds + (bufoff) + ldsw + 8192), 16, 0, 0); } while (0)
#define PG8_STAGEB(bufoff, gbase) PG8_STAGE2(bufoff, gbase, voffB[0], voffB[1])
#define PG8_LDA(dst, b, h) do { _Pragma("unroll") for (int m = 0; m < 4; ++m) _Pragma("unroll") for (int k = 0; k < 2; ++k) dst[m][k] = *(const LAS bf16x8*)(lds + PG8_SA(b, h) + aoff + m * 2048 + k * 1024); } while (0)
#define PG8_LDB(dst, b, h) do { _Pragma("unroll") for (int n = 0; n < 2; ++n) _Pragma("unroll") for (int k = 0; k < 2; ++k) dst[n][k] = *(const LAS bf16x8*)(lds + PG8_SB(b, h) + boff + n * 2048 + k * 1024); } while (0)
#define PG8_MMA(ai, bj, At, Bt) do { __builtin_amdgcn_s_setprio(1); _Pragma("unroll") for (int m = 0; m < 4; ++m) _Pragma("unroll") for (int n = 0; n < 2; ++n) _Pragma("unroll") for (int k = 0; k < 2; ++k) \
        acc[ai][bj][m][n] = __builtin_amdgcn_mfma_f32_16x16x32_bf16(Bt[n][k], At[m][k], acc[ai][bj][m][n], 0, 0, 0); __builtin_amdgcn_s_setprio(0); } while (0)
typedef int i32x8_t __attribute__((ext_vector_type(8)));
struct Frag2 { bf16x8 lo, hi; };
#define PG8_MMA8(ai, bj, At, Bt) do { __builtin_amdgcn_s_setprio(1); _Pragma("unroll") for (int m = 0; m < 4; ++m) _Pragma("unroll") for (int n = 0; n < 2; ++n) { \
        const Frag2 fb_{Bt[n][0], Bt[n][1]}, fa_{At[m][0], At[m][1]}; \
        acc[ai][bj][m][n] = __builtin_amdgcn_mfma_scale_f32_16x16x128_f8f6f4(__builtin_bit_cast(i32x8_t, fb_), __builtin_bit_cast(i32x8_t, fa_), acc[ai][bj][m][n], 0, 0, 0, 0x79797979, 0, FP8 * 0x01010101); } __builtin_amdgcn_s_setprio(0); } while (0)
#define PG8_MM(ai, bj, At, Bt) do { if constexpr (FP8) PG8_MMA8(ai, bj, At, Bt); else PG8_MMA(ai, bj, At, Bt); } while (0)
#define PG8_WAIT_V(n) asm volatile("s_waitcnt vmcnt(" #n ")" ::: "memory")
#define PG8_WAIT_L(n) asm volatile("s_waitcnt lgkmcnt(" #n ")" ::: "memory")
#define PG8_BAR __builtin_amdgcn_s_barrier()
#define PG8_SCHED __builtin_amdgcn_sched_barrier(0)
    Unit cur, nxt; int ui = 0;
    if (!S.next(0, cur)) return;
    Acc acc;
#pragma unroll
    for (int a = 0; a < 2; ++a)
#pragma unroll
        for (int b = 0; b < 2; ++b)
#pragma unroll
            for (int m = 0; m < 4; ++m)
#pragma unroll
                for (int n = 0; n < 2; ++n) acc[a][b][m][n] = (f32x4){0.f, 0.f, 0.f, 0.f};
    bf16x8 At[4][2], B0[2][2], B1[2][2];
    unsigned vA[2][2];
    S.aoffs(cur, tid, vA, lds, wid, false);
    const char* cA = S.abase(cur); const char* cB = S.bbase(cur);
    PG8_STAGEB(PG8_SB(0, 0), cB); PG8_STAGEB(PG8_SB(0, 1), cB + hstepB); PG8_STAGE2(PG8_SA(0, 0), cA, vA[0][0], vA[0][1]); PG8_STAGE2(PG8_SA(0, 1), cA, vA[1][0], vA[1][1]);
    if (wr == 1) PG8_BAR;
    PG8_WAIT_V(2); PG8_BAR;
    PG8_STAGEB(PG8_SB(1, 0), cB + kstep); PG8_STAGE2(PG8_SA(1, 0), cA + kstep, vA[0][0], vA[0][1]); PG8_STAGEB(PG8_SB(1, 1), cB + hstepB + kstep);
    PG8_WAIT_V(6); PG8_BAR;
    for (;;) {
        E.unit_begin(cur, lds, wid, lane);
        const bool has_next = S.next(ui + 1, nxt);
        const char* nA = cA; const char* nB = cB;
        if (has_next) { nA = S.abase(nxt); nB = S.bbase(nxt); S.prefetch(nxt, lds, wid, lane); }
        for (int t = 0; t < nt; t += 2) {
            const bool last = (t == nt - 2);
            if constexpr (Epi::HAS_MID) { if (t == Epi::MID_T) E.mid(acc, cur, wr, wc, fr, fq); }
            const char* a1 = cA + (size_t)(t + 1) * kstep;
            const char* a2 = last ? nA : cA + (size_t)(t + 2) * kstep; const char* b2 = last ? nB : cB + (size_t)(t + 2) * kstep;
            const char* a3 = a2 + kstep; const char* b3 = b2 + kstep;
            PG8_LDB(B0, 0, 0); PG8_LDB(B1, 0, 1); PG8_SCHED; PG8_LDA(At, 0, 0); PG8_STAGE2(PG8_SA(1, 1), a1, vA[1][0], vA[1][1]);
            if (last && has_next) S.aoffs(nxt, tid, vA, lds, wid, true);
            PG8_WAIT_V(8); PG8_WAIT_L(0); PG8_BAR; PG8_MM(0, 0, At, B0); PG8_MM(0, 1, At, B1); PG8_BAR; PG8_SCHED;
            PG8_LDA(At, 0, 1); PG8_STAGEB(PG8_SB(0, 0), b2); PG8_STAGEB(PG8_SB(0, 1), b2 + hstepB); PG8_STAGE2(PG8_SA(0, 0), a2, vA[0][0], vA[0][1]);
            PG8_WAIT_V(8); PG8_WAIT_L(0); PG8_BAR; PG8_MM(1, 0, At, B0); PG8_MM(1, 1, At, B1); PG8_BAR; PG8_SCHED;
            PG8_LDB(B0, 1, 0); PG8_LDB(B1, 1, 1); PG8_SCHED; PG8_LDA(At, 1, 0); PG8_STAGE2(PG8_SA(0, 1), a2, vA[1][0], vA[1][1]);
            PG8_WAIT_V(8); PG8_WAIT_L(0); PG8_BAR; PG8_MM(0, 0, At, B0); PG8_MM(0, 1, At, B1); PG8_BAR; PG8_SCHED;
            PG8_LDA(At, 1, 1); PG8_STAGEB(PG8_SB(1, 0), b3); PG8_STAGEB(PG8_SB(1, 1), b3 + hstepB); PG8_STAGE2(PG8_SA(1, 0), a3, vA[0][0], vA[0][1]);
            PG8_WAIT_V(8); PG8_WAIT_L(0); PG8_BAR; PG8_MM(1, 0, At, B0); PG8_MM(1, 1, At, B1); PG8_BAR; PG8_SCHED;
        }
        if constexpr (ALIGN_EPI) { if (wr == 0) PG8_BAR; }
#ifdef PROBE_REGION
        { unsigned long long t0_ = 0; if (Epi::PID == PROBE_REGION) t0_ = __builtin_amdgcn_s_memrealtime();
          E(acc, cur, wr, wc, fr, fq);
          if (Epi::PID == PROBE_REGION && tid == 0) { asm volatile("s_waitcnt vmcnt(0)" ::: "memory"); volatile LAS unsigned* m_ = (volatile LAS unsigned*)(lds + 131072); m_[16] += (unsigned)(__builtin_amdgcn_s_memrealtime() - t0_); } }
#else
        { unsigned z_ = 0; asm volatile("" : "+v"(z_)); const int l2 = (int)__builtin_amdgcn_mbcnt_hi(~0u, __builtin_amdgcn_mbcnt_lo(~0u, z_));
          E(acc, cur, wr, wc, l2 & 15, l2 >> 4); }
#endif
        if (!has_next) break;
#pragma unroll
        for (int a = 0; a < 2; ++a)
#pragma unroll
            for (int b = 0; b < 2; ++b)
#pragma unroll
                for (int m = 0; m < 4; ++m)
#pragma unroll
                    for (int n = 0; n < 2; ++n) acc[a][b][m][n] = (f32x4){0.f, 0.f, 0.f, 0.f};
        cur = nxt; cA = nA; cB = nB; ++ui;
        if constexpr (ALIGN_EPI) { if (wr == 1) PG8_BAR; }
    }
    PG8_WAIT_V(0);
    if constexpr (!ALIGN_EPI) { if (wr == 0) PG8_BAR; }
    PG8_BAR;
#undef PG8_SA
#undef PG8_SB
#undef PG8_STAGE2
#undef PG8_STAGEB
#undef PG8_LDA
#undef PG8_LDB
#undef PG8_MMA
#undef PG8_MMA8
#undef PG8_MM
#undef PG8_WAIT_V
#undef PG8_WAIT_L
#undef PG8_BAR
#undef PG8_SCHED
}
}
constexpr int NWAVES = 8;
constexpr int RING_BYTES = 131072;
constexpr int MISC_OFF = RING_BYTES;
constexpr int LDS_BYTES = 163840;
constexpr int PARAMS_OFF = MISC_OFF + 1024;
constexpr int SPW_OFF = MISC_OFF + 2048, SPW_BYTES = 3712, STATS_OFF = SPW_OFF + 8 * SPW_BYTES;

#define XB_TMO      128
#define XB_XCNT(j)  (256  + 64 * (j))
#define XB_XSUB(j)  (1280 + 64 * (j))
#define XB_XGEN(j)  (2304 + 64 * (j))
#define XB_TOP      3328
#define XB_TOPGEN   3392
#define XCD_BAR_WORDS 3456
#define XB_SPIN_CAP (1u << 22)
DEV unsigned xb_ld(GAS unsigned* p) { return __hip_atomic_load(p, __ATOMIC_RELAXED, __HIP_MEMORY_SCOPE_AGENT); }
DEV unsigned xb_add(GAS unsigned* p, unsigned v) { return __hip_atomic_fetch_add(p, v, __ATOMIC_RELAXED, __HIP_MEMORY_SCOPE_AGENT); }
DEV unsigned xb_xcc_id() { return (unsigned)__builtin_amdgcn_s_getreg((3 << 11) | 20) & 0xFu; }
#define XB_SPIN(cond, bar) do { unsigned _sp = 0; while (cond) { __builtin_amdgcn_s_sleep(1); \
    if ((++_sp & 255u) == 0u) { if (xb_ld(&(bar)[XB_TMO])) break; if (_sp > XB_SPIN_CAP) { xb_add(&(bar)[XB_TMO], 1u); break; } } } } while (0)
struct XcdBarrier { GAS unsigned* bar; unsigned x; volatile LAS unsigned* st; };
DEV XcdBarrier xcd_barrier_post(GAS unsigned* bar, volatile LAS unsigned* st) {
    XcdBarrier b; b.bar = bar; b.x = xb_xcc_id(); b.st = st;
    if (threadIdx.x == 0) (void)xb_add(&bar[XB_XCNT(b.x)], 1u);
    return b;
}
DEV void xcd_barrier_complete(GAS unsigned* bar, unsigned x, unsigned& nloc, unsigned& nx) {
    const unsigned G = gridDim.x * gridDim.y * gridDim.z;
    unsigned sum, cnt, mine, sp = 0u;
    for (;;) {
        sum = 0u; cnt = 0u; mine = 0u;
#pragma unroll
        for (unsigned j = 0; j < 16; ++j) { const unsigned c = xb_ld(&bar[XB_XCNT(j)]); sum += c; cnt += (c > 0u) ? 1u : 0u; mine = (j == x) ? c : mine; }
        if (sum == G) break;
        __builtin_amdgcn_s_sleep(1);
        if ((++sp & 255u) == 0u) { if (xb_ld(&bar[XB_TMO])) break; if (sp > XB_SPIN_CAP) { xb_add(&bar[XB_TMO], 1u); break; } }
    }
    nloc = mine > 0u ? mine : 1u; nx = cnt > 0u ? cnt : 1u;
}
DEV void xcd_barrier(const XcdBarrier& b) {
    asm volatile("s_waitcnt vmcnt(0)" ::: "memory");
    __syncthreads();
    if (threadIdx.x == 0) {
        GAS unsigned* bar = b.bar; asm volatile("" : "+s"(bar));
        __builtin_amdgcn_s_waitcnt(0);
        unsigned nloc = b.st[0], nx = b.st[1];
        if (nloc == 0u) { xcd_barrier_complete(bar, b.x, nloc, nx); b.st[0] = nloc; b.st[1] = nx; }
        const unsigned old = xb_add(&bar[XB_XSUB(b.x)], 1u);
        const unsigned gen = old / nloc;
        if (old + 1u == (gen + 1u) * nloc) {
            __builtin_amdgcn_fence(__ATOMIC_RELEASE, "agent");
            asm volatile("s_waitcnt vmcnt(0)" ::: "memory");
            const unsigned og = xb_add(&bar[XB_TOP], 1u);
            const unsigned tg = og / nx;
            if (og + 1u == (tg + 1u) * nx) xb_add(&bar[XB_TOPGEN], 1u);
            else XB_SPIN(xb_ld(&bar[XB_TOPGEN]) == tg, bar);
            __builtin_amdgcn_fence(__ATOMIC_ACQUIRE, "agent");
            xb_add(&bar[XB_XGEN(b.x)], 1u);
            asm volatile("s_waitcnt vmcnt(0)" ::: "memory");
        } else {
            XB_SPIN(xb_ld(&bar[XB_XGEN(b.x)]) == gen, bar);
            __builtin_amdgcn_fence(__ATOMIC_ACQUIRE, "agent");
            asm volatile("s_waitcnt vmcnt(0)" ::: "memory");
        }
    }
    __syncthreads();
}

#ifdef PROBE_REGION
#define TREG_BEGIN(k) unsigned long long _treg##k = 0; if ((k) == PROBE_REGION) _treg##k = __builtin_amdgcn_s_memrealtime()
#define TREG_END(k, F) do { if ((k) == PROBE_REGION && (F).tid == 0) { volatile LAS unsigned* _m = (volatile LAS unsigned*)((F).lds + MISC_OFF); _m[16] += (unsigned)(__builtin_amdgcn_s_memrealtime() - _treg##k); } } while (0)
#else
#define TREG_BEGIN(k) do {} while (0)
#define TREG_END(k, F) do {} while (0)
#endif
struct Frame { LAS unsigned char* lds; unsigned char* ldsg; int tid, lane, wave, G, bx; };
DEV unsigned long long ldp64(const LAS unsigned* q, int i) { const unsigned lo = __builtin_amdgcn_readfirstlane(q[2 * i]), hi = __builtin_amdgcn_readfirstlane(q[2 * i + 1]); return ((unsigned long long)hi << 32) | lo; }
DEV Params load_params(const Frame& F) {
    unsigned off_ = PARAMS_OFF; asm volatile("" : "+v"(off_));
    Params p; const LAS unsigned* q = (const LAS unsigned*)(F.lds + off_);
    p.x = (const float*)(const GAS float*)ldp64(q, 0);
    p.c = (const float*)(const GAS float*)ldp64(q, 1);
    p.ctx = (const float*)(const GAS float*)ldp64(q, 2);
    p.c_ctx = (const float*)(const GAS float*)ldp64(q, 3);
    p.w_mod = (const float*)(const GAS float*)ldp64(q, 4);
    p.b_mod = (const float*)(const GAS float*)ldp64(q, 5);
    p.g_pre_mix = (const float*)(const GAS float*)ldp64(q, 6);
    p.g_post_mix = (const float*)(const GAS float*)ldp64(q, 7);
    p.g_pre_ffn = (const float*)(const GAS float*)ldp64(q, 8);
    p.g_post_ffn = (const float*)(const GAS float*)ldp64(q, 9);
    p.w_in = (const float*)(const GAS float*)ldp64(q, 10);
    p.ln_g = (const float*)(const GAS float*)ldp64(q, 11);
    p.ln_b = (const float*)(const GAS float*)ldp64(q, 12);
    p.gws = (const float*)(const GAS float*)ldp64(q, 13);
    p.gbs = (const float*)(const GAS float*)ldp64(q, 14);
    p.conv_w = (const float*)(const GAS float*)ldp64(q, 15);
    p.conv_b = (const float*)(const GAS float*)ldp64(q, 16);
    p.lru_wa = (const float*)(const GAS float*)ldp64(q, 17);
    p.lru_ba = (const float*)(const GAS float*)ldp64(q, 18);
    p.lru_wx = (const float*)(const GAS float*)ldp64(q, 19);
    p.lru_bx = (const float*)(const GAS float*)ldp64(q, 20);
    p.lru_lam = (const float*)(const GAS float*)ldp64(q, 21);
    p.w_out_a = (const float*)(const GAS float*)ldp64(q, 22);
    p.w_out_b = (const float*)(const GAS float*)ldp64(q, 23);
    p.w_out = (const float*)(const GAS float*)ldp64(q, 24);
    p.router_w = (const float*)(const GAS float*)ldp64(q, 25);
    p.router_b = (const float*)(const GAS float*)ldp64(q, 26);
    p.e_g = (const float*)(const GAS float*)ldp64(q, 27);
    p.e_u = (const float*)(const GAS float*)ldp64(q, 28);
    p.e_d = (const float*)(const GAS float*)ldp64(q, 29);
    p.s_g = (const float*)(const GAS float*)ldp64(q, 30);
    p.s_u = (const float*)(const GAS float*)ldp64(q, 31);
    p.s_d = (const float*)(const GAS float*)ldp64(q, 32);
    p.out = (float*)(GAS float*)ldp64(q, 33); p.ws = (unsigned char*)(GAS unsigned char*)ldp64(q, 34);
    return p;
}
DEV void store_params(const Frame& F, const Params& a) {
    if (F.tid == 0) { LAS unsigned long long* q = (LAS unsigned long long*)(F.lds + PARAMS_OFF);
        q[0] = (unsigned long long)a.x;
        q[1] = (unsigned long long)a.c;
        q[2] = (unsigned long long)a.ctx;
        q[3] = (unsigned long long)a.c_ctx;
        q[4] = (unsigned long long)a.w_mod;
        q[5] = (unsigned long long)a.b_mod;
        q[6] = (unsigned long long)a.g_pre_mix;
        q[7] = (unsigned long long)a.g_post_mix;
        q[8] = (unsigned long long)a.g_pre_ffn;
        q[9] = (unsigned long long)a.g_post_ffn;
        q[10] = (unsigned long long)a.w_in;
        q[11] = (unsigned long long)a.ln_g;
        q[12] = (unsigned long long)a.ln_b;
        q[13] = (unsigned long long)a.gws;
        q[14] = (unsigned long long)a.gbs;
        q[15] = (unsigned long long)a.conv_w;
        q[16] = (unsigned long long)a.conv_b;
        q[17] = (unsigned long long)a.lru_wa;
        q[18] = (unsigned long long)a.lru_ba;
        q[19] = (unsigned long long)a.lru_wx;
        q[20] = (unsigned long long)a.lru_bx;
        q[21] = (unsigned long long)a.lru_lam;
        q[22] = (unsigned long long)a.w_out_a;
        q[23] = (unsigned long long)a.w_out_b;
        q[24] = (unsigned long long)a.w_out;
        q[25] = (unsigned long long)a.router_w;
        q[26] = (unsigned long long)a.router_b;
        q[27] = (unsigned long long)a.e_g;
        q[28] = (unsigned long long)a.e_u;
        q[29] = (unsigned long long)a.e_d;
        q[30] = (unsigned long long)a.s_g;
        q[31] = (unsigned long long)a.s_u;
        q[32] = (unsigned long long)a.s_d;
        q[33] = (unsigned long long)a.out; q[34] = (unsigned long long)a.ws; }
}

DEV void transpose_item(const float* W, int N, bf16_t* WT, int dK, int koff, int rbase, int rhi, LAS float* scr, int kb, int nb, int lane, float scale = 1.0f) {
    const int k0 = 64 * kb, n0 = 32 * nb;
    float4 ld[8];
#pragma unroll
    for (int i = 0; i < 8; ++i) ld[i] = *(const float4*)(W + (size_t)(k0 + 8 * i + (lane >> 3)) * N + n0 + (lane & 7) * 4);
#pragma unroll
    for (int i = 0; i < 8; ++i) { LAS float* d = scr + (8 * i + (lane >> 3)) * 33 + (lane & 7) * 4; d[0] = ld[i].x; d[1] = ld[i].y; d[2] = ld[i].z; d[3] = ld[i].w; }
    asm volatile("s_waitcnt lgkmcnt(0)" ::: "memory");
    const int cc = lane & 7;
#pragma unroll
    for (int j = 0; j < 4; ++j) { const int nl = (lane >> 3) + 8 * j, n = n0 + nl; const LAS float* s = scr + (8 * cc) * 33 + nl;
        u32x4 o; o.x = pk2(s[0 * 33] * scale, s[1 * 33] * scale); o.y = pk2(s[2 * 33] * scale, s[3 * 33] * scale); o.z = pk2(s[4 * 33] * scale, s[5 * 33] * scale); o.w = pk2(s[6 * 33] * scale, s[7 * 33] * scale);
        const int drow = rbase + (n >> 7) * rhi + (n & 127);
        *(u32x4*)(WT + (size_t)drow * dK + koff + k0 + 8 * cc) = o; }
    asm volatile("s_waitcnt lgkmcnt(0)" ::: "memory");
}
DEV void transpose_item8(const float* W, int N, unsigned char* WT, int dK, int rbase, int rhi, LAS float* scr, int kb, int nb, int lane) {
    const int k0 = 64 * kb, n0 = 32 * nb;
    float4 ld[8];
#pragma unroll
    for (int i = 0; i < 8; ++i) ld[i] = *(const float4*)(W + (size_t)(k0 + 8 * i + (lane >> 3)) * N + n0 + (lane & 7) * 4);
#pragma unroll
    for (int i = 0; i < 8; ++i) { LAS float* d = scr + (8 * i + (lane >> 3)) * 33 + (lane & 7) * 4; d[0] = ld[i].x; d[1] = ld[i].y; d[2] = ld[i].z; d[3] = ld[i].w; }
    asm volatile("s_waitcnt lgkmcnt(0)" ::: "memory");
    const int cc = lane & 7;
#pragma unroll
    for (int j = 0; j < 4; ++j) { const int nl = (lane >> 3) + 8 * j, n = n0 + nl; const LAS float* s = scr + (8 * cc) * 33 + nl;
        unsigned lo = 0, hi = 0;
        lo = __builtin_amdgcn_cvt_pk_fp8_f32(s[0 * 33] * 64.f, s[1 * 33] * 64.f, lo, false); lo = __builtin_amdgcn_cvt_pk_fp8_f32(s[2 * 33] * 64.f, s[3 * 33] * 64.f, lo, true);
        hi = __builtin_amdgcn_cvt_pk_fp8_f32(s[4 * 33] * 64.f, s[5 * 33] * 64.f, hi, false); hi = __builtin_amdgcn_cvt_pk_fp8_f32(s[6 * 33] * 64.f, s[7 * 33] * 64.f, hi, true);
        const int drow = rbase + (n >> 7) * rhi + (n & 127);
        *(u32x2*)(WT + (size_t)drow * dK + k0 + 8 * cc) = (u32x2){lo, hi}; }
    asm volatile("s_waitcnt lgkmcnt(0)" ::: "memory");
}
DEV void convert_weights(const Params& p, const Frame& F, int l, int part, int vw, int nvw) {
    LAS float* scr = (LAS float*)(F.lds + F.wave * 16384);
    unsigned char* W = p.ws + WS_W;
    const int lane = F.lane;
    constexpr int I_IN = 16 * 128, I_OA = 8 * 32, I_OUT = 16 * 32, I_RT = 16 * 2, I_SG = 16 * 8, I_SD = 4 * 32, I_EG = NE * 16 * 8, I_ED = NE * 4 * 32, I_LRU = 32 * 2;
    if (part == 0) {
        constexpr int NITEMS = I_IN + 2 * I_OA + I_OUT + I_RT + 2 * I_SG + I_SD + I_LRU;
        for (int it = vw; it < NITEMS; it += nvw) {
            int r = it;
#if GIN_FP8
            if (r < I_IN) { transpose_item8(p.w_in + (size_t)l * D * 4096, 4096, W + WO_IN, D, 0, 128, scr, r / 128, r % 128, lane); continue; } r -= I_IN;
#else
            if (r < I_IN) { transpose_item(p.w_in + (size_t)l * D * 4096, 4096, (bf16_t*)(W + WO_IN), D, 0, 0, 128, scr, r / 128, r % 128, lane); continue; } r -= I_IN;
#endif
            if (r < I_OA) { transpose_item(p.w_out_a + (size_t)l * 512 * D, D, (bf16_t*)(W + WO_AB), D, 0, 0, 128, scr, r / 32, r % 32, lane); continue; } r -= I_OA;
            if (r < I_OA) { transpose_item(p.w_out_b + (size_t)l * 512 * D, D, (bf16_t*)(W + WO_AB), D, 512, 0, 128, scr, r / 32, r % 32, lane); continue; } r -= I_OA;
            if (r < I_OUT) { transpose_item(p.w_out + (size_t)l * D * D, D, (bf16_t*)(W + WO_OUT), D, 0, 0, 128, scr, r / 32, r % 32, lane); continue; } r -= I_OUT;
            if (r < I_RT) { transpose_item(p.router_w + (size_t)l * D * 64, 64, (bf16_t*)(W + WO_SR), D, 0, 0, 128, scr, r / 2, r % 2, lane); continue; } r -= I_RT;
            if (r < I_SG) { transpose_item(p.s_g + (size_t)l * D * 256, 256, (bf16_t*)(W + WO_SR), D, 0, 256, 256, scr, r / 8, r % 8, lane); continue; } r -= I_SG;
            if (r < I_SG) { transpose_item(p.s_u + (size_t)l * D * 256, 256, (bf16_t*)(W + WO_SR), D, 0, 256 + 128, 256, scr, r / 8, r % 8, lane); continue; } r -= I_SG;
#if GSD_FP8
            if (r < I_SD) { transpose_item8(p.s_d + (size_t)l * 256 * D, D, W + WO_SD, 256, 0, 128, scr, r / 32, r % 32, lane); continue; } r -= I_SD;
#else
            if (r < I_SD) { transpose_item(p.s_d + (size_t)l * 256 * D, D, (bf16_t*)(W + WO_SD), 256, 0, 0, 128, scr, r / 32, r % 32, lane); continue; } r -= I_SD;
#endif
            { const int mat = r / 2, nb = r % 2, type = mat >> 4, dh = mat & 15;
              const float* src = (type ? p.lru_wx : p.lru_wa) + (size_t)((l * 2) * 8 + dh) * 4096;
              transpose_item(src, 64, (bf16_t*)(W + WO_LRU) + (size_t)mat * 4096, 64, 0, 0, 128, scr, 0, nb, lane, -1.4426950408889634f); }
        }
        const int gt = vw * 64 + lane, NT = nvw * 64;
        for (int i = gt; i < 192 * D / 8; i += NT) *(u32x4*)((bf16_t*)(W + WO_SR) + (size_t)64 * D + (size_t)i * 8) = (u32x4){0u, 0u, 0u, 0u};
        for (int i = gt; i < 8 * 128 * 128 / 4; i += NT) { const float4 v = *(const float4*)(p.gws + (size_t)l * 8 * 128 * 128 + (size_t)i * 4);
            u32x2 o; o.x = pk2(v.x, v.y); o.y = pk2(v.z, v.w); *(u32x2*)((bf16_t*)(W + WO_GWS) + (size_t)i * 4) = o; }
    } else if (part == 2) {
#if GED_FP8
        for (int it = vw; it < I_ED; it += nvw) { const int e = it / 128, q = it % 128; transpose_item8(p.e_d + ((size_t)(l * NE + e) * 256) * D, D, W + WO_ED + (size_t)e * D * 256, 256, 0, 128, scr, q / 32, q % 32, lane); }
#else
        for (int it = vw; it < I_ED; it += nvw) { const int e = it / 128, q = it % 128; transpose_item(p.e_d + ((size_t)(l * NE + e) * 256) * D, D, (bf16_t*)(W + WO_ED) + (size_t)e * D * 256, 256, 0, 0, 128, scr, q / 32, q % 32, lane); }
#endif
    } else {
        constexpr int NITEMS = 2 * I_EG;
        for (int it = vw; it < NITEMS; it += nvw) {
            int r = it;
            if (r < I_EG) { const int e = r / 128, q = r % 128; transpose_item8(p.e_g + ((size_t)(l * NE + e) * D) * 256, 256, W + WO_EG + (size_t)e * 512 * D, D, 0, 256, scr, q / 8, q % 8, lane); continue; } r -= I_EG;
            { const int e = r / 128, q = r % 128; transpose_item8(p.e_u + ((size_t)(l * NE + e) * D) * 256, 256, W + WO_EG + (size_t)e * 512 * D, D, 128, 256, scr, q / 8, q % 8, lane); }
        }
    }
}
DEV void pe_table(const Params& p, const Frame& F, int idx) {
    const int pos = idx >> 9, half = (idx >> 8) & 1, q = idx & 255;
    const float omega = 1.0f / powf(10000.0f, (float)q / 256.0f);
    const float ang = (float)pos * omega;
    ((float*)(p.ws + WS_PE))[idx] = half ? cosf(ang) : sinf(ang);
}
DEV void mod_items(const Params& p, const Frame& F) {
    LAS float* part = (LAS float*)(F.lds);
    LAS float* sc = (LAS float*)(F.lds + 16384);
    if (F.bx < 2 * 96) {
        for (int i = F.tid; i < 5 * D; i += NWAVES * 64) { const int cnd = i >> 10, d = i & (D - 1); sc[d * 8 + cnd] = siluf_(cnd < 4 ? p.c[cnd * D + d] : p.c_ctx[d]); }
        __syncthreads();
    }
    for (int it = F.bx; it < 2 * 96; it += F.G) {
        const int l = it / 96, e = (it % 96) * 64 + F.lane;
        const float* w = p.w_mod + (size_t)l * D * 6 * D + e;
        float acc[5] = {0.f, 0.f, 0.f, 0.f, 0.f};
        const int d0 = F.wave * 128;
#pragma unroll 32
        for (int d = d0; d < d0 + 128; ++d) { const float wv = w[(size_t)d * 6 * D]; const f32x4 s4 = *(const LAS f32x4*)(sc + d * 8); const float s5 = sc[d * 8 + 4];
            acc[0] += s4[0] * wv; acc[1] += s4[1] * wv; acc[2] += s4[2] * wv; acc[3] += s4[3] * wv; acc[4] += s5 * wv; }
#pragma unroll
        for (int cnd = 0; cnd < 5; ++cnd) part[(F.wave * 5 + cnd) * 64 + F.lane] = acc[cnd];
        __syncthreads();
        if (F.tid < 320) { const int cnd = F.tid >> 6, ln = F.tid & 63; float s = p.b_mod[l * 6 * D + (it % 96) * 64 + ln];
#pragma unroll
            for (int w8 = 0; w8 < 8; ++w8) s += part[(w8 * 5 + cnd) * 64 + ln];
            ((float*)(p.ws + WS_MOD))[(size_t)(l * 5 + cnd) * 6 * D + (it % 96) * 64 + ln] = s; }
        __syncthreads();
    }
}

DEV bf16_t* xl16_row(const Params& p, int r) { return (bf16_t*)((unsigned char*)p.out + (size_t)r * 4096 + 2048); }
DEV void load_xl(const Params& p, int r, int lane, float (&v)[16]) {
    if (r < TL) { const bf16_t* x = xl16_row(p, r);
#pragma unroll
        for (int j = 0; j < 4; ++j) { const ushort4 t = *(const ushort4*)(x + (j * 64 + lane) * 4); v[4 * j] = bf2f(t.x); v[4 * j + 1] = bf2f(t.y); v[4 * j + 2] = bf2f(t.z); v[4 * j + 3] = bf2f(t.w); } }
    else { const float* x = (const float*)(p.ws + WS_XC) + (size_t)(r - TL) * D;
#pragma unroll
        for (int j = 0; j < 4; ++j) { const float4 t = *(const float4*)(x + (j * 64 + lane) * 4); v[4 * j] = t.x; v[4 * j + 1] = t.y; v[4 * j + 2] = t.z; v[4 * j + 3] = t.w; } }
}
DEV void store_xl(const Params& p, int r, int lane, const float (&v)[16], bool final_f32) {
    if (r < TL && !final_f32) { bf16_t* x = xl16_row(p, r);
#pragma unroll
        for (int j = 0; j < 4; ++j) { u32x2 o; o.x = pk2(v[4 * j], v[4 * j + 1]); o.y = pk2(v[4 * j + 2], v[4 * j + 3]); *(u32x2*)(x + (j * 64 + lane) * 4) = o; } }
    else { float* x = r < TL ? p.out + (size_t)r * D : (float*)(p.ws + WS_XC) + (size_t)(r - TL) * D;
#pragma unroll
        for (int j = 0; j < 4; ++j) *(float4*)(x + (j * 64 + lane) * 4) = make_float4(v[4 * j], v[4 * j + 1], v[4 * j + 2], v[4 * j + 3]); }
}
DEV void row_pass_A(const Params& p, int l, int rlo, int rhi, int wave, int nw, int lane) {
    const bf16_t* FL = (const bf16_t*)(p.ws + WS_RY);
    for (int r = rlo + wave; r < rhi; r += nw) {
        const int cond = r < TL ? (r >> 13) : 4;
        float v[16];
        if (l == 0) {
            const float* src = r < TL ? p.x + (size_t)r * D : p.ctx + (size_t)(r - TL) * D;
#pragma unroll
            for (int j = 0; j < 4; ++j) { const float4 t = *(const float4*)(src + (j * 64 + lane) * 4); v[4 * j] = t.x; v[4 * j + 1] = t.y; v[4 * j + 2] = t.z; v[4 * j + 3] = t.w; }
            if (r < TL) {
                const int t = r & (SEQ - 1); const float* PE = (const float*)(p.ws + WS_PE);
#pragma unroll
                for (int j = 0; j < 4; ++j) { const float4 e = *(const float4*)(PE + ((j < 2) ? (t >> 6) : (t & 63)) * 512 + (j & 1) * 256 + lane * 4);
                    v[4 * j] += e.x; v[4 * j + 1] += e.y; v[4 * j + 2] += e.z; v[4 * j + 3] += e.w; }
            }
        } else {
            float f[16]; float ss = 0.f;
            load_xl(p, r, lane, v);
#pragma unroll
            for (int j = 0; j < 4; ++j) {
                const ushort4 fb = *(const ushort4*)(FL + (size_t)r * D + (j * 64 + lane) * 4);
                f[4 * j] = bf2f(fb.x); f[4 * j + 1] = bf2f(fb.y); f[4 * j + 2] = bf2f(fb.z); f[4 * j + 3] = bf2f(fb.w);
            }
            { const unsigned char* SL = p.ws + WS_SLOTS + (size_t)r * 8 * 1024;
                unsigned sv[8][4];
#pragma unroll
                for (int s = 0; s < 8; ++s)
#pragma unroll
                    for (int j = 0; j < 4; ++j) sv[s][j] = *(const unsigned*)(SL + (size_t)s * 1024 + (j * 64 + lane) * 4);
#pragma unroll
                for (int j = 0; j < 4; ++j) { float a0 = 0.f, a1 = 0.f, a2 = 0.f, a3 = 0.f;
#pragma unroll
                    for (int s = 0; s < 8; ++s) { a0 += __builtin_amdgcn_cvt_f32_fp8(sv[s][j], 0); a1 += __builtin_amdgcn_cvt_f32_fp8(sv[s][j], 1); a2 += __builtin_amdgcn_cvt_f32_fp8(sv[s][j], 2); a3 += __builtin_amdgcn_cvt_f32_fp8(sv[s][j], 3); }
                    f[4 * j] += a0 * 0.0625f; f[4 * j + 1] += a1 * 0.0625f; f[4 * j + 2] += a2 * 0.0625f; f[4 * j + 3] += a3 * 0.0625f; } }
#pragma unroll
            for (int i = 0; i < 16; ++i) ss += f[i] * f[i];
            const float rstd = rsqrtf(wave_sum(ss) * (1.f / D) + 1e-6f);
            const float* gt = mod_ptr(p, l - 1, cond, 5); const float* g = p.g_post_ffn + (l - 1) * D;
#pragma unroll
            for (int j = 0; j < 4; ++j) { const float4 gt4 = *(const float4*)(gt + (j * 64 + lane) * 4), g4 = *(const float4*)(g + (j * 64 + lane) * 4);
                v[4 * j] += gt4.x * (f[4 * j] * rstd * g4.x); v[4 * j + 1] += gt4.y * (f[4 * j + 1] * rstd * g4.y); v[4 * j + 2] += gt4.z * (f[4 * j + 2] * rstd * g4.z); v[4 * j + 3] += gt4.w * (f[4 * j + 3] * rstd * g4.w); }
        }
        store_xl(p, r, lane, v, l == 2);
        if (l < 2) {
            float ss = 0.f;
#pragma unroll
            for (int i = 0; i < 16; ++i) ss += v[i] * v[i];
            const float rstd = rsqrtf(wave_sum(ss) * (1.f / D) + 1e-6f);
            const float* sh = mod_ptr(p, l, cond, 0); const float* sc = mod_ptr(p, l, cond, 1); const float* g = p.g_pre_mix + l * D;
#pragma unroll
            for (int j = 0; j < 4; ++j) { const int d = (j * 64 + lane) * 4; const float4 sh4 = *(const float4*)(sh + d), sc4 = *(const float4*)(sc + d), g4 = *(const float4*)(g + d);
                u32x2 o; o.x = pk2(v[4 * j] * rstd * g4.x * (1.f + sc4.x) + sh4.x, v[4 * j + 1] * rstd * g4.y * (1.f + sc4.y) + sh4.y);
                o.y = pk2(v[4 * j + 2] * rstd * g4.z * (1.f + sc4.z) + sh4.z, v[4 * j + 3] * rstd * g4.w * (1.f + sc4.w) + sh4.w);
#if GIN_FP8
                { const float h0 = __uint_as_float(o.x << 16) * 16.f, h1 = __uint_as_float(o.x & 0xffff0000u) * 16.f, h2 = __uint_as_float(o.y << 16) * 16.f, h3 = __uint_as_float(o.y & 0xffff0000u) * 16.f;
                  unsigned t = 0; t = __builtin_amdgcn_cvt_pk_fp8_f32(__builtin_amdgcn_fmed3f(h0, -440.f, 440.f), __builtin_amdgcn_fmed3f(h1, -440.f, 440.f), t, false);
                  t = __builtin_amdgcn_cvt_pk_fp8_f32(__builtin_amdgcn_fmed3f(h2, -440.f, 440.f), __builtin_amdgcn_fmed3f(h3, -440.f, 440.f), t, true);
                  *(unsigned*)(p.ws + WS_H8 + (size_t)r * D + d) = t; }
#else
                *(u32x2*)((bf16_t*)(p.ws + WS_RY) + (size_t)r * D + d) = o;
#endif
            }
        }
    }
}
DEV void row_pass_H(const Params& p, int l, int rlo, int rhi, int wave, int nw, int lane) {
    const bf16_t* YL = (const bf16_t*)(p.ws + WS_Z);
    bf16_t* H = (bf16_t*)(p.ws + WS_RA);
    for (int r = rlo + wave; r < rhi; r += nw) {
        const int cond = r < TL ? (r >> 13) : 4;
        float v[16], f[16]; float ss = 0.f;
        load_xl(p, r, lane, v);
#pragma unroll
        for (int j = 0; j < 4; ++j) {
            const ushort4 fb = *(const ushort4*)(YL + (size_t)r * D + (j * 64 + lane) * 4);
            f[4 * j] = bf2f(fb.x); f[4 * j + 1] = bf2f(fb.y); f[4 * j + 2] = bf2f(fb.z); f[4 * j + 3] = bf2f(fb.w);
        }
#pragma unroll
        for (int i = 0; i < 16; ++i) ss += f[i] * f[i];
        const float rstd = rsqrtf(wave_sum(ss) * (1.f / D) + 1e-6f);
        const float* gt = mod_ptr(p, l, cond, 2); const float* g = p.g_post_mix + l * D;
#pragma unroll
        for (int j = 0; j < 4; ++j) { const float4 gt4 = *(const float4*)(gt + (j * 64 + lane) * 4), g4 = *(const float4*)(g + (j * 64 + lane) * 4);
            v[4 * j] += gt4.x * (f[4 * j] * rstd * g4.x); v[4 * j + 1] += gt4.y * (f[4 * j + 1] * rstd * g4.y); v[4 * j + 2] += gt4.z * (f[4 * j + 2] * rstd * g4.z); v[4 * j + 3] += gt4.w * (f[4 * j + 3] * rstd * g4.w); }
        store_xl(p, r, lane, v, false);
        float s2 = 0.f;
#pragma unroll
        for (int i = 0; i < 16; ++i) s2 += v[i] * v[i];
        const float rstd2 = rsqrtf(wave_sum(s2) * (1.f / D) + 1e-6f);
        const float* sh = mod_ptr(p, l, cond, 3); const float* sc = mod_ptr(p, l, cond, 4); const float* g2 = p.g_pre_ffn + l * D;
#pragma unroll
        for (int j = 0; j < 4; ++j) { const int d = (j * 64 + lane) * 4; const float4 sh4 = *(const float4*)(sh + d), sc4 = *(const float4*)(sc + d), g4 = *(const float4*)(g2 + d);
            u32x2 o; o.x = pk2(v[4 * j] * rstd2 * g4.x * (1.f + sc4.x) + sh4.x, v[4 * j + 1] * rstd2 * g4.y * (1.f + sc4.y) + sh4.y);
            o.y = pk2(v[4 * j + 2] * rstd2 * g4.z * (1.f + sc4.z) + sh4.z, v[4 * j + 3] * rstd2 * g4.w * (1.f + sc4.w) + sh4.w);
            *(u32x2*)(H + (size_t)r * D + d) = o;
            { const float h0 = __uint_as_float(o.x << 16) * 16.f, h1 = __uint_as_float(o.x & 0xffff0000u) * 16.f, h2 = __uint_as_float(o.y << 16) * 16.f, h3 = __uint_as_float(o.y & 0xffff0000u) * 16.f;
              unsigned t = 0; t = __builtin_amdgcn_cvt_pk_fp8_f32(__builtin_amdgcn_fmed3f(h0, -440.f, 440.f), __builtin_amdgcn_fmed3f(h1, -440.f, 440.f), t, false);
              t = __builtin_amdgcn_cvt_pk_fp8_f32(__builtin_amdgcn_fmed3f(h2, -440.f, 440.f), __builtin_amdgcn_fmed3f(h3, -440.f, 440.f), t, true);
              *(unsigned*)(p.ws + WS_H2E + (size_t)r * D + d) = t; } }
    }
}

DEV void cvt4(const u32x2 w, float* o) { o[0] = __uint_as_float(w.x << 16); o[1] = __uint_as_float(w.x & 0xffff0000u); o[2] = __uint_as_float(w.y << 16); o[3] = __uint_as_float(w.y & 0xffff0000u); }
DEV unsigned e4m3x4_x16(const u32x2 o) {
    const float h0 = __uint_as_float(o.x << 16) * 16.f, h1 = __uint_as_float(o.x & 0xffff0000u) * 16.f, h2 = __uint_as_float(o.y << 16) * 16.f, h3 = __uint_as_float(o.y & 0xffff0000u) * 16.f;
    unsigned t = 0; t = __builtin_amdgcn_cvt_pk_fp8_f32(__builtin_amdgcn_fmed3f(h0, -440.f, 440.f), __builtin_amdgcn_fmed3f(h1, -440.f, 440.f), t, false);
    return __builtin_amdgcn_cvt_pk_fp8_f32(__builtin_amdgcn_fmed3f(h2, -440.f, 440.f), __builtin_amdgcn_fmed3f(h3, -440.f, 440.f), t, true);
}
DEV void load_prod(const float* a, const float* b, int lane, float* o) {
#pragma unroll
    for (int j = 0; j < 4; ++j) { const float4 x = *(const float4*)(a + (j * 64 + lane) * 4), y = *(const float4*)(b + (j * 64 + lane) * 4); o[4 * j] = x.x * y.x; o[4 * j + 1] = x.y * y.y; o[4 * j + 2] = x.z * y.z; o[4 * j + 3] = x.w * y.w; }
}
DEV void load_affine(const float* g, const float* sc, const float* sh, int lane, float* am, float* bm) {
#pragma unroll
    for (int j = 0; j < 4; ++j) { const int d = (j * 64 + lane) * 4; const float4 g4 = *(const float4*)(g + d), s4 = *(const float4*)(sc + d), h4 = *(const float4*)(sh + d);
        am[4 * j] = g4.x * (1.f + s4.x); am[4 * j + 1] = g4.y * (1.f + s4.y); am[4 * j + 2] = g4.z * (1.f + s4.z); am[4 * j + 3] = g4.w * (1.f + s4.w);
        bm[4 * j] = h4.x; bm[4 * j + 1] = h4.y; bm[4 * j + 2] = h4.z; bm[4 * j + 3] = h4.w; }
}
DEV float sumsq16(const float* v) { float s = 0.f;
#pragma unroll
    for (int i = 0; i < 16; ++i) s += v[i] * v[i];
    return s; }
DEV void emit_h(const float* v, float rstd2, const float* am, const float* bm, int lane, bf16_t* dst16, unsigned char* dst8) {
#pragma unroll
    for (int j = 0; j < 4; ++j) { const int d = (j * 64 + lane) * 4;
        u32x2 o; o.x = pk2(v[4 * j] * rstd2 * am[4 * j] + bm[4 * j], v[4 * j + 1] * rstd2 * am[4 * j + 1] + bm[4 * j + 1]);
        o.y = pk2(v[4 * j + 2] * rstd2 * am[4 * j + 2] + bm[4 * j + 2], v[4 * j + 3] * rstd2 * am[4 * j + 3] + bm[4 * j + 3]);
        if (dst16) *(u32x2*)(dst16 + d) = o;
        if (dst8) *(unsigned*)(dst8 + d) = e4m3x4_x16(o); }
}
DEV void store_xl16(const Params& p, int r, int lane, const float* v) { bf16_t* x = xl16_row(p, r);
#pragma unroll
    for (int j = 0; j < 4; ++j) { u32x2 o; o.x = pk2(v[4 * j], v[4 * j + 1]); o.y = pk2(v[4 * j + 2], v[4 * j + 3]); *(u32x2*)(x + (j * 64 + lane) * 4) = o; }
}
DEV void row_lat_A0(const Params& p, int wave, int nw, int lane) {
    const float* PE = (const float*)(p.ws + WS_PE);
    float am[16], bm[16]; int condp = -1;
    float4 xr[2][4], pr[2][4];
    int r = wave; if (r >= TL) return;
#define ROWA0_LOAD(q, rr) do { const int t_ = (rr) & (SEQ - 1); \
        _Pragma("unroll") for (int j = 0; j < 4; ++j) { xr[q][j] = *(const float4*)(p.x + (size_t)(rr) * D + (j * 64 + lane) * 4); pr[q][j] = *(const float4*)(PE + ((j < 2) ? (t_ >> 6) : (t_ & 63)) * 512 + (j & 1) * 256 + lane * 4); } } while (0)
    ROWA0_LOAD(0, r); ROWA0_LOAD(1, r + nw);
    for (; r < TL; r += 2 * nw) {
        float v[2][16];
#pragma unroll
        for (int q = 0; q < 2; ++q)
#pragma unroll
            for (int j = 0; j < 4; ++j) { v[q][4 * j] = xr[q][j].x + pr[q][j].x; v[q][4 * j + 1] = xr[q][j].y + pr[q][j].y; v[q][4 * j + 2] = xr[q][j].z + pr[q][j].z; v[q][4 * j + 3] = xr[q][j].w + pr[q][j].w; }
        const int rl = (r + 2 * nw < TL) ? r + 2 * nw : r;
        ROWA0_LOAD(0, rl); ROWA0_LOAD(1, rl + nw);
        const int cond = r >> 13;
        if (cond != condp) { condp = cond; load_affine(p.g_pre_mix, mod_ptr(p, 0, cond, 1), mod_ptr(p, 0, cond, 0), lane, am, bm); }
#pragma unroll
        for (int q = 0; q < 2; ++q) { const int rq = r + q * nw;
            store_xl16(p, rq, lane, v[q]);
            const float rstd2 = rsqrtf(wave_sum(sumsq16(v[q])) * (1.f / D) + 1e-6f);
#if GIN_FP8
            emit_h(v[q], rstd2, am, bm, lane, nullptr, p.ws + WS_H8 + (size_t)rq * D);
#else
            emit_h(v[q], rstd2, am, bm, lane, (bf16_t*)(p.ws + WS_RY) + (size_t)rq * D, nullptr);
#endif
        }
    }
#undef ROWA0_LOAD
}
DEV void row_lat_A(const Params& p, int l, int wave, int nw, int lane) {
    const bf16_t* FL = (const bf16_t*)(p.ws + WS_RY);
    float gtg[16], am[16], bm[16]; int condp = -1;
    u32x2 xr[4], fr[4]; unsigned sr[8][4];
    int r = wave; if (r >= TL) return;
#define ROWA_LOAD(rr) do { const bf16_t* x_ = xl16_row(p, (rr)); const unsigned char* SL_ = p.ws + WS_SLOTS + (size_t)(rr) * 8 * 1024; \
        _Pragma("unroll") for (int j = 0; j < 4; ++j) { xr[j] = *(const u32x2*)(x_ + (j * 64 + lane) * 4); fr[j] = *(const u32x2*)(FL + (size_t)(rr) * D + (j * 64 + lane) * 4); } \
        _Pragma("unroll") for (int s_ = 0; s_ < 8; ++s_) _Pragma("unroll") for (int j = 0; j < 4; ++j) sr[s_][j] = *(const unsigned*)(SL_ + (size_t)s_ * 1024 + (j * 64 + lane) * 4); } while (0)
    ROWA_LOAD(r);
    for (; r < TL; r += nw) {
        float v[16], f[16];
#pragma unroll
        for (int j = 0; j < 4; ++j) { cvt4(xr[j], v + 4 * j); cvt4(fr[j], f + 4 * j);
            float a0 = 0.f, a1 = 0.f, a2 = 0.f, a3 = 0.f;
#pragma unroll
            for (int s8 = 0; s8 < 8; ++s8) { a0 += __builtin_amdgcn_cvt_f32_fp8(sr[s8][j], 0); a1 += __builtin_amdgcn_cvt_f32_fp8(sr[s8][j], 1); a2 += __builtin_amdgcn_cvt_f32_fp8(sr[s8][j], 2); a3 += __builtin_amdgcn_cvt_f32_fp8(sr[s8][j], 3); }
            f[4 * j] += a0 * 0.0625f; f[4 * j + 1] += a1 * 0.0625f; f[4 * j + 2] += a2 * 0.0625f; f[4 * j + 3] += a3 * 0.0625f; }
        const int rl = (r + nw < TL) ? r + nw : r;
        ROWA_LOAD(rl);
        const int cond = r >> 13;
        if (cond != condp) { condp = cond; load_prod(mod_ptr(p, l - 1, cond, 5), p.g_post_ffn + (l - 1) * D, lane, gtg);
            if (l < 2) load_affine(p.g_pre_mix + l * D, mod_ptr(p, l, cond, 1), mod_ptr(p, l, cond, 0), lane, am, bm); }
        const float rstd = rsqrtf(wave_sum(sumsq16(f)) * (1.f / D) + 1e-6f);
#pragma unroll
        for (int i = 0; i < 16; ++i) v[i] += gtg[i] * (f[i] * rstd);
        if (l == 2) { float* x = p.out + (size_t)r * D;
#pragma unroll
            for (int j = 0; j < 4; ++j) *(float4*)(x + (j * 64 + lane) * 4) = make_float4(v[4 * j], v[4 * j + 1], v[4 * j + 2], v[4 * j + 3]);
        } else {
            store_xl16(p, r, lane, v);
            const float rstd2 = rsqrtf(wave_sum(sumsq16(v)) * (1.f / D) + 1e-6f);
#if GIN_FP8
            emit_h(v, rstd2, am, bm, lane, nullptr, p.ws + WS_H8 + (size_t)r * D);
#else
            emit_h(v, rstd2, am, bm, lane, (bf16_t*)(p.ws + WS_RY) + (size_t)r * D, nullptr);
#endif
        }
    }
#undef ROWA_LOAD
}
DEV void row_lat_H(const Params& p, int l, int wave, int nw, int lane) {
    const bf16_t* YL = (const bf16_t*)(p.ws + WS_Z);
    float gtg[16], am[16], bm[16]; int condp = -1;
    u32x2 xr[2][4], yr[2][4];
    int r = wave; if (r >= TL) return;
#define ROWH_LOAD(q, rr) do { _Pragma("unroll") for (int j = 0; j < 4; ++j) { xr[q][j] = *(const u32x2*)(xl16_row(p, (rr)) + (j * 64 + lane) * 4); yr[q][j] = *(const u32x2*)(YL + (size_t)(rr) * D + (j * 64 + lane) * 4); } } while (0)
    ROWH_LOAD(0, r); ROWH_LOAD(1, r + nw);
    for (; r < TL; r += 2 * nw) {
        float v[2][16], f[2][16];
#pragma unroll
        for (int q = 0; q < 2; ++q)
#pragma unroll
            for (int j = 0; j < 4; ++j) { cvt4(xr[q][j], v[q] + 4 * j); cvt4(yr[q][j], f[q] + 4 * j); }
        const int rl = (r + 2 * nw < TL) ? r + 2 * nw : r;
        ROWH_LOAD(0, rl); ROWH_LOAD(1, rl + nw);
        const int cond = r >> 13;
        if (cond != condp) { condp = cond; load_prod(mod_ptr(p, l, cond, 2), p.g_post_mix + l * D, lane, gtg); load_affine(p.g_pre_ffn + l * D, mod_ptr(p, l, cond, 4), mod_ptr(p, l, cond, 3), lane, am, bm); }
#pragma unroll
        for (int q = 0; q < 2; ++q) { const int rq = r + q * nw;
            const float rstd = rsqrtf(wave_sum(sumsq16(f[q])) * (1.f / D) + 1e-6f);
#pragma unroll
            for (int i = 0; i < 16; ++i) v[q][i] += gtg[i] * (f[q][i] * rstd);
            store_xl16(p, rq, lane, v[q]);
            const float rstd2 = rsqrtf(wave_sum(sumsq16(v[q])) * (1.f / D) + 1e-6f);
            emit_h(v[q], rstd2, am, bm, lane, (bf16_t*)(p.ws + WS_RA) + (size_t)rq * D, p.ws + WS_H2E + (size_t)rq * D); }
    }
#undef ROWH_LOAD
}

DEV void route_token(const Params& p, int l, float logit, int lane, int& myi, float& myw) {
    const float s = sigmoidf_(logit);
    const float sel = s + p.router_b[l * 64 + lane];
    int rank = 0;
#pragma unroll
    for (int k = 1; k < 8; ++k) { const float o = __shfl_xor(sel, k); const int ol = lane ^ k; rank += (o > sel || (o == sel && ol < lane)) ? 1 : 0; }
    float gs = rank < 2 ? sel : 0.f;
    gs += __shfl_xor(gs, 1); gs += __shfl_xor(gs, 2); gs += __shfl_xor(gs, 4);
    const int g = lane >> 3; int grank = 0;
#pragma unroll
    for (int k = 1; k < 8; ++k) { const float o = __shfl_xor(gs, 8 * k); const int og = g ^ k; grank += (o > gs || (o == gs && og < g)) ? 1 : 0; }
    float mv = grank < 4 ? sel : -INFINITY;
    float wsum = 0.f; myw = 0.f; myi = 0;
    for (int s8 = 0; s8 < 8; ++s8) {
        float mx = mv;
#pragma unroll
        for (int o = 32; o >= 1; o >>= 1) mx = fmaxf(mx, __shfl_xor(mx, o));
        const unsigned long long bal = __ballot(mv == mx);
        const int win = __ffsll((long long)bal) - 1;
        const float sw = __shfl(s, win);
        if (lane == s8) { myi = win; myw = sw; }
        wsum += sw;
        if (lane == win) mv = -INFINITY;
    }
    myw = myw / wsum * 2.5f;
}
DEV void route_rows(const Params& p, const Frame& F, int l, int r0) {
    int* hist = (int*)(F.ldsg); int* base = hist + 64; int* loc = hist + 128; float* locw = (float*)(hist + 128 + 2048);
    int* LISTA = (int*)(p.ws + WS_LISTA); float* LISTW = (float*)(p.ws + WS_LISTW);
    unsigned* CNT = (unsigned*)(p.ws + WS_CTL) + CW_CNT + l * 64;
    constexpr int rpw = 256;
    if (F.tid < 64) hist[F.tid] = 0;
    __syncthreads();
    const int ti = F.wave * 64 + F.lane;
    if (F.wave < 4) {
        const float* LOG = (const float*)(p.ws + WS_LOG) + (size_t)(r0 + ti) * 64;
        float sv[64], sel[64];
#pragma unroll
        for (int q = 0; q < 16; ++q) { const float4 t = *(const float4*)(LOG + 4 * q); sv[4 * q] = t.x; sv[4 * q + 1] = t.y; sv[4 * q + 2] = t.z; sv[4 * q + 3] = t.w; }
#pragma unroll
        for (int e = 0; e < 64; ++e) { sv[e] = fsigmoid(sv[e]); sel[e] = sv[e] + p.router_b[l * 64 + e]; }
        float gs[8];
#pragma unroll
        for (int g = 0; g < 8; ++g) { float m1 = fmaxf(sel[8 * g], sel[8 * g + 1]), m2 = fminf(sel[8 * g], sel[8 * g + 1]);
#pragma unroll
            for (int k = 2; k < 8; ++k) { const float x = sel[8 * g + k]; m2 = fmaxf(m2, fminf(m1, x)); m1 = fmaxf(m1, x); }
            gs[g] = m1 + m2; }
#pragma unroll
        for (int g = 0; g < 8; ++g) { int rank = 0;
#pragma unroll
            for (int k = 0; k < 8; ++k) if (k != g) rank += (gs[k] > gs[g] || (gs[k] == gs[g] && k < g)) ? 1 : 0;
            if (rank >= 4) {
#pragma unroll
                for (int k = 0; k < 8; ++k) sel[8 * g + k] = -INFINITY; } }
        float wsum = 0.f; int bi8[8]; float bw8[8];
#pragma unroll
        for (int s8 = 0; s8 < 8; ++s8) { float best = sel[0], bs = sv[0]; int bi = 0;
#pragma unroll
            for (int e = 1; e < 64; ++e) { const bool gt = sel[e] > best; best = gt ? sel[e] : best; bs = gt ? sv[e] : bs; bi = gt ? e : bi; }
#pragma unroll
            for (int e = 0; e < 64; ++e) sel[e] = (e == bi) ? -INFINITY : sel[e];
            bi8[s8] = bi; bw8[s8] = bs; wsum += bs; }
        const float sc = 2.5f / wsum;
#pragma unroll
        for (int s8 = 0; s8 < 8; ++s8) { const int rk = atomicAdd(&hist[bi8[s8]], 1); loc[ti * 8 + s8] = (bi8[s8] << 16) | rk; locw[ti * 8 + s8] = bw8[s8] * sc; }
    }
    __syncthreads();
    if (F.tid < 64) base[F.tid] = (int)__hip_atomic_fetch_add(CNT + F.tid, (unsigned)hist[F.tid], __ATOMIC_RELAXED, __HIP_MEMORY_SCOPE_AGENT);
    __syncthreads();
    for (int idx = F.tid; idx < rpw * 8; idx += NWAVES * 64) { const int v = loc[idx], e = v >> 16, rk = v & 0xffff; const int within = base[e] + rk;
        if (within < CAP) { const size_t pos = (size_t)e * CAP + within; LISTA[pos] = (r0 + (idx >> 3)) * 8 + (idx & 7); LISTW[pos] = locw[idx]; } }
    __syncthreads();
}
DEV void combine_pass(const Params& p, int hf, int nrows, int wave, int nw, int lane) {
    bf16_t* FS = (bf16_t*)(p.ws + WS_RY); const bf16_t* SL = (const bf16_t*)(p.ws + WS_SLOTS);
    for (int r = wave; r < nrows; r += nw) {
        bf16_t* fp = FS + (size_t)r * D + hf * 512 + lane * 8;
        f32x4 a0, a1; pg8::unpack8(*(const u32x4*)fp, a0, a1);
        u32x4 sv[8];
#pragma unroll
        for (int s = 0; s < 8; ++s) sv[s] = *(const u32x4*)(SL + ((size_t)r * 8 + s) * 512 + lane * 8);
#pragma unroll
        for (int s = 0; s < 8; ++s) { f32x4 b0, b1; pg8::unpack8(sv[s], b0, b1); a0 += b0; a1 += b1; }
        *(u32x4*)fp = pg8::pack8(a0, a1);
    }
}
DEV size_t summ_idx(int dir, int b, int pos, int which, int ch) { return ((((size_t)dir * 4 + b) * 66 + pos) * 2 + which) * 512 + ch; }
DEV f32x4 mfma16(bf16x8 a, bf16x8 b, f32x4 c) { return __builtin_amdgcn_mfma_f32_16x16x32_bf16(a, b, c, 0, 0, 0); }

template <int PASS>
DEV void chunk_pass(const Params& p, const Frame& F, int l_in, int c, bool do_gmlp) {
    int oz = 0; asm volatile("" : "+s"(oz));
    const int l = l_in + oz;
    const int lane = F.lane, h = F.wave, fr = lane & 15, fq = lane >> 4;
    const bf16_t* Z = (const bf16_t*)(p.ws + WS_Z); bf16_t* Y = (bf16_t*)(p.ws + WS_RY); float* SUMM = (float*)(p.ws + WS_SUMM);
    const unsigned char* W = p.ws + WS_W + oz;
    int r0, t0, n, b, posf, posb;
    if (c < 256) { b = c >> 6; const int k = c & 63; r0 = b * SEQ + k * 128; t0 = k * 128; n = SEQ; posf = 2 + k; posb = 2 + (63 - k); }
    else { const int cc = c - 256; b = cc >> 1; const int k = cc & 1; r0 = TL + b * CTXL + k * 128; t0 = k * 128; n = CTXL; posf = k; posb = 1 - k; }
    {
        LAS bf16_t* xcs = (LAS bf16_t*)(F.lds + h * 16384);
        TREG_BEGIN(1);
        bf16_t* XCT = (bf16_t*)(p.ws + WS_XCT) + ((size_t)c * 8 + h) * 8192;
        if (PASS == 1) {
            u32x4 t[16];
#pragma unroll
            for (int k = 0; k < 16; ++k) t[k] = *(const u32x4*)(XCT + (k * 64 + lane) * 8);
#pragma unroll
            for (int k = 0; k < 16; ++k) *(LAS u32x4*)(xcs + (k * 64 + lane) * 8) = t[k];
        } else {
            const int cg = lane & 7, rsub = lane >> 3, ch0 = h * 64 + cg * 8;
            float w[4][8], cb[8];
#pragma unroll
            for (int k = 0; k < 4; ++k) { const float4 a = *(const float4*)(p.conv_w + (size_t)(l * 4 + k) * 512 + ch0), bb = *(const float4*)(p.conv_w + (size_t)(l * 4 + k) * 512 + ch0 + 4);
                w[k][0] = a.x; w[k][1] = a.y; w[k][2] = a.z; w[k][3] = a.w; w[k][4] = bb.x; w[k][5] = bb.y; w[k][6] = bb.z; w[k][7] = bb.w; }
            { const float4 a = *(const float4*)(p.conv_b + l * 512 + ch0), bb = *(const float4*)(p.conv_b + l * 512 + ch0 + 4);
                cb[0] = a.x; cb[1] = a.y; cb[2] = a.z; cb[3] = a.w; cb[4] = bb.x; cb[5] = bb.y; cb[6] = bb.z; cb[7] = bb.w; }
            const bf16_t* Zx = Z + (size_t)r0 * 4096 + 1024 + ch0;
#pragma unroll 1
            for (int it = 0; it < 2; ++it) {
                const int tb = (it * 8 + rsub) * 8;
                u32x4 raw[11];
#pragma unroll
                for (int k = 0; k < 11; ++k) { const int tt = t0 + tb + k - 2; const int rowc = (tt >= 0 && tt < n) ? (tb + k - 2) : tb;
                    raw[k] = *(const u32x4*)(Zx + (long)rowc * 4096); }
#pragma unroll
                for (int k = 0; k < 11; ++k) { const int tt = t0 + tb + k - 2; if (!(tt >= 0 && tt < n)) raw[k] = (u32x4){0u, 0u, 0u, 0u}; }
#pragma unroll
                for (int o = 0; o < 8; ++o) {
                    float y[8];
#pragma unroll
                    for (int j = 0; j < 8; ++j) y[j] = cb[j];
#pragma unroll
                    for (int k = 0; k < 4; ++k) { f32x4 x0, x1; pg8::unpack8(raw[o + k], x0, x1);
#pragma unroll
                        for (int j = 0; j < 4; ++j) { y[j] += w[k][j] * x0[j]; y[4 + j] += w[k][4 + j] * x1[j]; } }
                    const u32x4 pk = pg8::pack8((f32x4){y[0], y[1], y[2], y[3]}, (f32x4){y[4], y[5], y[6], y[7]});
                    *(LAS u32x4*)(xcs + (tb + o) * 64 + cg * 8) = pk; *(u32x4*)(XCT + (tb + o) * 64 + cg * 8) = pk;
                }
            }
        }
        asm volatile("s_waitcnt lgkmcnt(0)" ::: "memory");
        TREG_END(1, F);
        TREG_BEGIN(2);
        float carry0 = 0.f, carry1 = 0.f;
        if (PASS == 1) {
            const int chl = h * 64 + lane;
#pragma unroll
            for (int dir = 0; dir < 2; ++dir) {
                const int np = dir ? posb : posf; float cr = 0.f;
                for (int q0 = 0; q0 < np; q0 += 16) { float a8[16], h8[16];
#pragma unroll
                    for (int j = 0; j < 16; ++j) { const int q = (q0 + j < np) ? q0 + j : np - 1; a8[j] = SUMM[summ_idx(dir, b, q, 0, chl)]; h8[j] = SUMM[summ_idx(dir, b, q, 1, chl)]; }
#pragma unroll
                    for (int j = 0; j < 16; ++j) if (q0 + j < np) cr = a8[j] * cr + h8[j]; }
                if (dir) carry1 = cr; else carry0 = cr;
            }
        }
        TREG_END(2, F);
        TREG_BEGIN(3);
#pragma unroll 1
        for (int ct = 0; ct < 4; ++ct) {
            const int chc = h * 64 + ct * 16 + fr;
            float hsum[8][4];
            u32x4 gbr[2][2];
            if (PASS == 1) {
#pragma unroll
                for (int hv = 0; hv < 2; ++hv) { const bf16_t* gp = Z + (size_t)(r0 + hv * 64 + lane) * 4096 + 1536 + h * 64 + ct * 16; gbr[hv][0] = *(const u32x4*)gp; gbr[hv][1] = *(const u32x4*)(gp + 8); }
            }
            bf16x8 wfr[2][4]; float bias_a2[2], bias_x2[2], spc2[2];
#pragma unroll
            for (int dir = 0; dir < 2; ++dir) {
                const bf16_t* wa = (const bf16_t*)(W + WO_LRU) + (size_t)(0 * 16 + dir * 8 + h) * 4096 + (size_t)(ct * 16 + fr) * 64 + 8 * fq;
                const bf16_t* wx = (const bf16_t*)(W + WO_LRU) + (size_t)(1 * 16 + dir * 8 + h) * 4096 + (size_t)(ct * 16 + fr) * 64 + 8 * fq;
                wfr[dir][0] = *(const bf16x8*)(wa); wfr[dir][1] = *(const bf16x8*)(wa + 32); wfr[dir][2] = *(const bf16x8*)(wx); wfr[dir][3] = *(const bf16x8*)(wx + 32);
                bias_a2[dir] = -1.4426950408889634f * p.lru_ba[(l * 2 + dir) * 512 + chc]; bias_x2[dir] = -1.4426950408889634f * p.lru_bx[(l * 2 + dir) * 512 + chc];
                spc2[dir] = -8.0f * log1pf(expf(-p.lru_lam[(l * 2 + dir) * 512 + chc])) * 1.4426950408889634f;
            }
#pragma unroll
            for (int dir = 0; dir < 2; ++dir) {
                const bf16x8 ba0 = wfr[dir][0], ba1 = wfr[dir][1], bx0 = wfr[dir][2], bx1 = wfr[dir][3];
                const float bias_a = bias_a2[dir], bias_x = bias_x2[dir], spc = spc2[dir];
                float Hrun = 0.f, Arun = 1.f;
                if (PASS == 1) Hrun = __shfl(dir ? carry1 : carry0, ct * 16 + fr);
                const int mypos = dir ? 3 - fq : fq;
#pragma unroll
                for (int grp = 0; grp < 2; ++grp) {
                    float av[4][4], dv[4][4], Ap[4], Hp[4], At[4], Ht[4];
#pragma unroll
                    for (int rq = 0; rq < 4; ++rq) {
                        const int rr = grp * 4 + rq, rt = dir ? 7 - rr : rr;
                        const bf16x8 f0 = *(const LAS bf16x8*)(xcs + (rt * 16 + fr) * 64 + 8 * fq), f1 = *(const LAS bf16x8*)(xcs + (rt * 16 + fr) * 64 + 32 + 8 * fq);
                        f32x4 aa = {bias_a, bias_a, bias_a, bias_a}, ax = {bias_x, bias_x, bias_x, bias_x};
                        aa = mfma16(f0, ba0, aa); aa = mfma16(f1, ba1, aa);
                        ax = mfma16(f0, bx0, ax); ax = mfma16(f1, bx1, ax);
#pragma unroll
                        for (int i = 0; i < 4; ++i) {
                            const float xc = bf2f(xcs[(rt * 16 + 4 * fq + i) * 64 + ct * 16 + fr]);
                            const float rg = __builtin_amdgcn_rcpf(1.f + __builtin_amdgcn_exp2f(aa[i])), ig = __builtin_amdgcn_rcpf(1.f + __builtin_amdgcn_exp2f(ax[i]));
                            const float a = __builtin_amdgcn_exp2f(spc * rg);
                            av[rq][i] = a; dv[rq][i] = __builtin_amdgcn_sqrtf(fmaxf(1.f - a * a, 0.f)) * (ig * xc);
                        }
                        float Al = 1.f, Hl = 0.f;
#pragma unroll
                        for (int s = 0; s < 4; ++s) { const int i = dir ? 3 - s : s; Hl = av[rq][i] * Hl + dv[rq][i]; Al = av[rq][i] * Al; }
                        float ap = 1.f, hp = 0.f, at = 1.f, ht = 0.f;
#pragma unroll
                        for (int s = 0; s < 4; ++s) { const int g = dir ? 3 - s : s; const float Ag = __shfl(Al, fr + 16 * g), Hg = __shfl(Hl, fr + 16 * g);
                            ht = Ag * ht + Hg; at = Ag * at;
                            const bool before = s < mypos; hp = before ? Ag * hp + Hg : hp; ap = before ? Ag * ap : ap; }
                        Ap[rq] = ap; Hp[rq] = hp; At[rq] = at; Ht[rq] = ht;
                    }
#pragma unroll
                    for (int rq = 0; rq < 4; ++rq) {
                        const int rr = grp * 4 + rq, rt = dir ? 7 - rr : rr;
                        if (PASS == 1) {
                            float hc = Ap[rq] * Hrun + Hp[rq];
#pragma unroll
                            for (int s = 0; s < 4; ++s) { const int i = dir ? 3 - s : s; hc = av[rq][i] * hc + dv[rq][i]; if (dir == 0) hsum[rt][i] = hc; else hsum[rt][i] += hc; }
                        }
                        Hrun = At[rq] * Hrun + Ht[rq]; Arun = At[rq] * Arun;
                    }
                    asm volatile("" ::: "memory");
                }
                if (PASS == 0 && fq == 0) { const int pos = dir ? posb : posf; SUMM[summ_idx(dir, b, pos, 0, chc)] = Arun; SUMM[summ_idx(dir, b, pos, 1, chc)] = Hrun; }
            }
            if (PASS == 1) {
                LAS bf16_t* sp = (LAS bf16_t*)(F.lds + SPW_OFF + h * SPW_BYTES);
#pragma unroll
                for (int hv = 0; hv < 2; ++hv) {
#pragma unroll
                    for (int j = 0; j < 4; ++j)
#pragma unroll
                        for (int i = 0; i < 4; ++i) sp[(j * 16 + 4 * fq + i) * 16 + fr] = f2bf(hsum[hv * 4 + j][i]);
                    asm volatile("s_waitcnt lgkmcnt(0)" ::: "memory");
                    const u32x4 s0 = *(const LAS u32x4*)(sp + lane * 16), s1 = *(const LAS u32x4*)(sp + lane * 16 + 8);
                    asm volatile("s_waitcnt lgkmcnt(0)" ::: "memory");
                    f32x4 a0, a1, b0, b1, g0, g1, g2, g3; pg8::unpack8(s0, a0, a1); pg8::unpack8(s1, b0, b1); pg8::unpack8(gbr[hv][0], g0, g1); pg8::unpack8(gbr[hv][1], g2, g3);
                    bf16_t* yp = Y + (size_t)(r0 + hv * 64 + lane) * D + 512 + h * 64 + ct * 16;
                    *(u32x4*)yp = pg8::pack8(a0 * g0, a1 * g1); *(u32x4*)(yp + 8) = pg8::pack8(b0 * g2, b1 * g3);
                }
            }
        }
        asm volatile("s_waitcnt vmcnt(0)" ::: "memory");
        TREG_END(3, F);
    }
    if (PASS == 0 && do_gmlp) {
        typedef float f32x2 __attribute__((ext_vector_type(2)));
        LAS f32x2* stats = (LAS f32x2*)(F.lds + STATS_OFF);
        TREG_BEGIN(4);
#pragma unroll 1
        for (int i0 = 0; i0 < 16; i0 += 8) {
            f32x4 v0[8], v1[8]; float mu[8], var[8];
#pragma unroll
            for (int j = 0; j < 8; ++j) pg8::unpack8(*(const u32x4*)(Z + (size_t)(r0 + F.wave * 16 + i0 + j) * 4096 + 512 + lane * 8), v0[j], v1[j]);
#pragma unroll
            for (int j = 0; j < 8; ++j) mu[j] = (v0[j][0] + v0[j][1]) + (v0[j][2] + v0[j][3]) + (v1[j][0] + v1[j][1]) + (v1[j][2] + v1[j][3]);
#pragma unroll
            for (int o = 1; o < 64; o <<= 1) {
#pragma unroll
                for (int j = 0; j < 8; ++j) mu[j] += __shfl_xor(mu[j], o); }
#pragma unroll
            for (int j = 0; j < 8; ++j) { mu[j] *= (1.f / 512.f); v0[j] -= mu[j]; v1[j] -= mu[j];
                var[j] = (v0[j][0] * v0[j][0] + v0[j][1] * v0[j][1]) + (v0[j][2] * v0[j][2] + v0[j][3] * v0[j][3]) + (v1[j][0] * v1[j][0] + v1[j][1] * v1[j][1]) + (v1[j][2] * v1[j][2] + v1[j][3] * v1[j][3]); }
#pragma unroll
            for (int o = 1; o < 64; o <<= 1) {
#pragma unroll
                for (int j = 0; j < 8; ++j) var[j] += __shfl_xor(var[j], o); }
            float m_ = mu[0], v_ = var[0];
#pragma unroll
            for (int j = 1; j < 8; ++j) { m_ = (lane == j) ? mu[j] : m_; v_ = (lane == j) ? var[j] : v_; }
            if (lane < 8) stats[F.wave * 16 + i0 + lane] = (f32x2){m_, rsqrtf(v_ * (1.f / 512.f) + 1e-5f)};
        }
        TREG_END(4, F);
        __syncthreads();
        TREG_BEGIN(5);
        const int g = F.wave;
        const bf16_t* Wg = (const bf16_t*)(W + WO_GWS) + (size_t)g * 128 * 128;
        LAS bf16_t* vn = (LAS bf16_t*)(F.lds + g * 16384);
        LAS bf16_t* sp = (LAS bf16_t*)(F.lds + SPW_OFF + g * SPW_BYTES);
        {
            const int cg = lane & 7, rsub = lane >> 3, ch0 = g * 64 + cg * 8;
            float lg[8], lb[8];
            { const float4 a = *(const float4*)(p.ln_g + l * 512 + ch0), bb = *(const float4*)(p.ln_g + l * 512 + ch0 + 4), c4 = *(const float4*)(p.ln_b + l * 512 + ch0), d4 = *(const float4*)(p.ln_b + l * 512 + ch0 + 4);
                lg[0] = a.x; lg[1] = a.y; lg[2] = a.z; lg[3] = a.w; lg[4] = bb.x; lg[5] = bb.y; lg[6] = bb.z; lg[7] = bb.w;
                lb[0] = c4.x; lb[1] = c4.y; lb[2] = c4.z; lb[3] = c4.w; lb[4] = d4.x; lb[5] = d4.y; lb[6] = d4.z; lb[7] = d4.w; }
            const bf16_t* Zv = Z + (size_t)r0 * 4096 + 512 + ch0;
#pragma unroll 1
            for (int i8 = 0; i8 < 16; i8 += 8) {
                u32x4 raw[8];
#pragma unroll
                for (int it = 0; it < 8; ++it) raw[it] = *(const u32x4*)(Zv + (long)((i8 + it) * 8 + rsub) * 4096);
#pragma unroll
                for (int it = 0; it < 8; ++it) { const int q = (i8 + it) * 8 + rsub; const f32x2 st = stats[q]; f32x4 x0, x1; pg8::unpack8(raw[it], x0, x1);
#pragma unroll
                    for (int j = 0; j < 4; ++j) { x0[j] = (x0[j] - st.x) * st.y * lg[j] + lb[j]; x1[j] = (x1[j] - st.x) * st.y * lg[4 + j] + lb[4 + j]; }
                    *(LAS u32x4*)(vn + q * 64 + cg * 8) = pg8::pack8(x0, x1); }
            }
        }
        asm volatile("s_waitcnt lgkmcnt(0)" ::: "memory");
        bf16x8 bfr[4][4];
#pragma unroll
        for (int ct = 0; ct < 4; ++ct)
#pragma unroll
            for (int ks = 0; ks < 4; ++ks) { unsigned wd[4];
#pragma unroll
                for (int j2 = 0; j2 < 4; ++j2) { const unsigned lo = vn[(ks * 32 + 8 * fq + 2 * j2) * 64 + ct * 16 + fr], hi = vn[(ks * 32 + 8 * fq + 2 * j2 + 1) * 64 + ct * 16 + fr]; wd[j2] = lo | (hi << 16); }
                bfr[ct][ks] = __builtin_bit_cast(bf16x8, (u32x4){wd[0], wd[1], wd[2], wd[3]}); }
        const bf16_t* Zu = Z + (size_t)r0 * 4096 + g * 64; bf16_t* Yu = Y + (size_t)r0 * D + g * 64;
        const int orow = lane >> 2, och = (lane & 3) * 16;
#pragma unroll 1
        for (int rt = 0; rt < 8; ++rt) {
            bf16x8 af[4];
#pragma unroll
            for (int ks = 0; ks < 4; ++ks) af[ks] = *(const bf16x8*)(Wg + (unsigned)((rt * 16 + fr) * 128 + ks * 32 + 8 * fq));
            const float4 bsv = *(const float4*)(p.gbs + (l * 8 + g) * 128 + rt * 16 + 4 * fq);
            const u32x4 u0 = *(const u32x4*)(Zu + (long)(rt * 16 + orow) * 4096 + och), u1 = *(const u32x4*)(Zu + (long)(rt * 16 + orow) * 4096 + och + 8);
            const float bs4[4] = {bsv.x, bsv.y, bsv.z, bsv.w};
#pragma unroll
            for (int ct = 0; ct < 4; ++ct) {
                f32x4 acc = {0.f, 0.f, 0.f, 0.f};
#pragma unroll
                for (int ks = 0; ks < 4; ++ks) acc = mfma16(af[ks], bfr[ct][ks], acc);
#pragma unroll
                for (int i = 0; i < 4; ++i) sp[(4 * fq + i) * 64 + ct * 16 + fr] = f2bf(acc[i] + bs4[i]);
            }
            asm volatile("s_waitcnt lgkmcnt(0)" ::: "memory");
            const u32x4 m0 = *(const LAS u32x4*)(sp + orow * 64 + och), m1 = *(const LAS u32x4*)(sp + orow * 64 + och + 8);
            asm volatile("s_waitcnt lgkmcnt(0)" ::: "memory");
            f32x4 a0, a1, b0, b1, c0, c1, d0, d1; pg8::unpack8(m0, a0, a1); pg8::unpack8(m1, b0, b1); pg8::unpack8(u0, c0, c1); pg8::unpack8(u1, d0, d1);
            bf16_t* yp = Yu + (long)(rt * 16 + orow) * D + och;
            *(u32x4*)yp = pg8::pack8(a0 * c0, a1 * c1); *(u32x4*)(yp + 8) = pg8::pack8(b0 * d0, b1 * d1);
        }
        asm volatile("s_waitcnt vmcnt(0)" ::: "memory"); TREG_END(5, F);
    }
    __syncthreads();
}
constexpr int NPL = 10, PH_FINAL = 1 + 2 * NPL, PH_END = PH_FINAL + 1;
struct Args { Params p; int ph_lo, ph_hi; };

DEV void build_toff(const Params& p, const Frame& F, int l, LAS int* toff) {
    if (F.tid < NE) { const unsigned* CNT = (const unsigned*)(p.ws + WS_CTL) + CW_CNT + l * 64;
        int cn = (int)__hip_atomic_load(CNT + F.tid, __ATOMIC_RELAXED, __HIP_MEMORY_SCOPE_AGENT); cn = cn < CAP ? cn : CAP;
        const int tiles = (cn + 255) >> 8; int incl = tiles;
#pragma unroll
        for (int o = 1; o < 64; o <<= 1) { const int t = __shfl_up(incl, o); if (F.lane >= o) incl += t; }
        const int excl = incl - tiles;
        toff[F.tid] = excl < 1120 ? excl : 1120; toff[80 + F.tid] = cn;
        if (F.tid == NE - 1) toff[64] = incl < 1120 ? incl : 1120; }
    __syncthreads();
    if (F.tid < NE) { LAS unsigned char* te = (LAS unsigned char*)(F.lds + SPW_OFF); for (int t = toff[F.tid]; t < toff[F.tid + 1]; ++t) te[t] = (unsigned char)F.tid; }
    __syncthreads();
}

template <int ph> DEV void run_phase(const Frame& F0) {
    Frame F = F0; { unsigned z_ = 0; asm volatile("" : "+v"(z_)); F.lane = (int)__builtin_amdgcn_mbcnt_hi(~0u, __builtin_amdgcn_mbcnt_lo(~0u, z_)); F.tid = F.wave * 64 + F.lane; }
    asm volatile("" : "+s"(F.G), "+s"(F.bx));
    const Params p = load_params(F);
    unsigned char* ws = p.ws; unsigned char* W = ws + WS_W;
    LAS int* toff = (LAS int*)(F.lds + MISC_OFF + 256);
    const int gw = F.bx * NWAVES + F.wave, NGW = F.G * NWAVES;
#ifndef NOPRO
    if (ph == 0) { if (F.bx == 0 && F.tid < 128) __hip_atomic_store((unsigned*)(p.ws + WS_CTL) + CW_CNT + F.tid, 0u, __ATOMIC_RELAXED, __HIP_MEMORY_SCOPE_AGENT);
        if (F.bx >= 192) { pe_table(p, F, (F.bx - 192) * 1024 + F.tid); pe_table(p, F, (F.bx - 192) * 1024 + 512 + F.tid); }
        mod_items(p, F); __syncthreads(); convert_weights(p, F, 0, 0, gw, NGW); return; }
    if (ph == PH_FINAL) { row_lat_A(p, 2, gw, NGW, F.lane); return; }
#endif
    constexpr int l = (ph - 1) / NPL, k = (ph - 1) % NPL;
    constexpr int nr = (l == 0) ? R : TL;
#ifndef PMASK
#define PMASK 0xffff
#endif
#define PON(k_) ((PMASK >> (k_)) & 1)
    switch (k) {
    case 0: if (PON(0)) { if (l > 0) convert_weights(p, F, l, 0, gw, NGW);
        if (l == 0) row_lat_A0(p, gw, NGW, F.lane); else row_lat_A(p, l, gw, NGW, F.lane);
        row_pass_A(p, l, TL, R, gw, NGW, F.lane); } break;
    case 1: if (PON(1)) {
#if GIN_FP8
        pg8::DenseSched<512, WS_H8, WS_W + WO_IN> S; S.init(ws, R, 4096, F.bx); pg8::EpiZ E{ws};
        pg8::gemm_phase<pg8::EpiZ, decltype(S), true, 0x7b>(F.lds, F.tid, S, E);
#else
        pg8::DenseSched<D, WS_RY, WS_W + WO_IN> S; S.init(ws, R, 4096, F.bx); pg8::EpiZ E{ws};
        pg8::gemm_phase<pg8::EpiZ, decltype(S), true>(F.lds, F.tid, S, E);
#endif
        } break;
    case 2: if (PON(2)) { for (int c = F.bx; c < NCHUNK; c += F.G) chunk_pass<0>(p, F, l, c, l == 0 || c < 256);
        if (F.bx >= NCHUNK - F.G) { convert_weights(p, F, l, 1, (F.bx - (NCHUNK - F.G)) * NWAVES + F.wave, (2 * F.G - NCHUNK) * NWAVES);
            convert_weights(p, F, l, 2, (F.bx - (NCHUNK - F.G)) * NWAVES + F.wave, (2 * F.G - NCHUNK) * NWAVES); } } break;
    case 3: if (PON(3)) for (int c = F.bx; c < (l == 0 ? NCHUNK : 256); c += F.G) chunk_pass<1>(p, F, l, c, false); break;
    case 4: if (PON(4)) { pg8::DenseSched<D, WS_RY, WS_W + WO_AB> S; S.init(ws, nr, D, F.bx); pg8::EpiAB E{ws};
        pg8::gemm_phase<pg8::EpiAB, decltype(S), true>(F.lds, F.tid, S, E); } break;
    case 5: if (PON(5)) { pg8::DenseSched<D, WS_RA, WS_W + WO_OUT> S; S.init(ws, nr, D, F.bx); pg8::EpiPlain<WS_Z> E{ws};
        pg8::gemm_phase<pg8::EpiPlain<WS_Z>, decltype(S), true>(F.lds, F.tid, S, E); } break;
    case 6: if (PON(6)) { row_lat_H(p, l, gw, NGW, F.lane); if (nr > TL) row_pass_H(p, l, TL, nr, gw, NGW, F.lane); } break;
    case 7: if (PON(7)) { pg8::DenseSched<D, WS_RA, WS_W + WO_SR> S; S.init(ws, nr, 768, F.bx); pg8::EpiSR E{ws};
        pg8::gemm_phase<pg8::EpiSR, decltype(S), true>(F.lds, F.tid, S, E);
        asm volatile("s_waitcnt vmcnt(0)" ::: "memory"); __syncthreads();
        for (int i = 0;; ++i) { pg8::UnitD u; if (!S.next(i, u)) break; if (u.pn == 0) route_rows(p, F, l, u.pm * 256); } } break;
    case 8: if (PON(8)) { build_toff(p, F, l, toff);
        { pg8::ExpSched<512, 1, 2, WS_H2E, WS_W + WO_EG, (size_t)512 * D> S; S.ws = ws; S.lds = F.lds; S.U = toff[64] * 2; S.c = F.bx; S.brow0 = 0; S.Krt = 512;
          pg8::EpiEG<0> E{ws};
          pg8::gemm_phase<pg8::EpiEG<0>, decltype(S), true, 0x7b>(F.lds, F.tid, S, E); }
#if GSD_FP8
        { pg8::DenseSched<128, WS_SH, WS_W + WO_SD> S; S.init(ws, nr, D, 255 - F.bx); pg8::EpiPlain<WS_RY> E{ws};
          pg8::gemm_phase<pg8::EpiPlain<WS_RY>, decltype(S), true, 0x7c>(F.lds, F.tid, S, E); } } break;
#else
        { pg8::DenseSched<256, WS_SH, WS_W + WO_SD> S; S.init(ws, nr, D, 255 - F.bx); pg8::EpiPlain<WS_RY> E{ws};
          pg8::gemm_phase<pg8::EpiPlain<WS_RY>, decltype(S), true>(F.lds, F.tid, S, E); } } break;
#endif
    case 9: if (PON(9)) { build_toff(p, F, l, toff);
#if GED_FP8
        pg8::ExpSched<128, 0, 4, WS_HM, WS_W + WO_ED, (size_t)D * 256> S; S.ws = ws; S.lds = F.lds; S.U = toff[64] * 4; S.c = F.bx; S.brow0 = 0; S.Krt = 128;
        pg8::EpiED E{ws, F.lds};
        pg8::gemm_phase<pg8::EpiED, decltype(S), true, 0x7c>(F.lds, F.tid, S, E); } break;
#else
        pg8::ExpSched<256, 0, 4, WS_HM, WS_W + WO_ED, (size_t)D * 256 * 2> S; S.ws = ws; S.lds = F.lds; S.U = toff[64] * 4; S.c = F.bx; S.brow0 = 0; S.Krt = 256;
        pg8::EpiED E{ws, F.lds};
        pg8::gemm_phase<pg8::EpiED, decltype(S), true>(F.lds, F.tid, S, E); } break;
#endif
    }
}

__global__ void __launch_bounds__(NWAVES * 64, 2) mk_fwd(Args a) {
    extern __shared__ __attribute__((aligned(16))) unsigned char lds_raw[];
    Frame F; F.lds = (LAS unsigned char*)lds_raw; F.ldsg = lds_raw; F.tid = threadIdx.x; F.lane = F.tid & 63; F.wave = __builtin_amdgcn_readfirstlane(F.tid >> 6); F.G = gridDim.x; F.bx = blockIdx.x;
    volatile LAS unsigned* MISC = (volatile LAS unsigned*)(F.lds + MISC_OFF);
    for (int u = F.tid; u < (LDS_BYTES - MISC_OFF) / 4; u += NWAVES * 64) MISC[u] = 0u;
    store_params(F, a.p);
    __syncthreads();
    XcdBarrier bar; bar.bar = (GAS unsigned*)(a.p.ws + WS_CTL) + CW_BAR; bar.x = 0; bar.st = nullptr;
    const bool multi = a.ph_hi - a.ph_lo > 1;
    if (multi) bar = xcd_barrier_post((GAS unsigned*)(a.p.ws + WS_CTL) + CW_BAR, MISC);
#ifdef DELAYMASK
#define MK_PH(k_) if (a.ph_lo <= (k_) && (k_) < a.ph_hi) { const unsigned long long t0_ = __builtin_amdgcn_s_memrealtime(); run_phase<(k_)>(F); \
        { constexpr int kind = ((k_) == 0) ? 15 : ((k_) == PH_FINAL ? 0 : ((k_) - 1) % NPL); \
          if ((DELAYMASK >> kind) & 1) { __syncthreads(); const unsigned long long t1_ = __builtin_amdgcn_s_memrealtime(); while (__builtin_amdgcn_s_memrealtime() - t1_ < t1_ - t0_) __builtin_amdgcn_s_sleep(8); } } \
        if ((k_) + 1 < a.ph_hi) xcd_barrier(bar); }
#elif defined(PROBE_REGION)
#define MK_PH(k_) if (a.ph_lo <= (k_) && (k_) < a.ph_hi) { run_phase<(k_)>(F); \
        { __syncthreads(); const unsigned long long t1_ = __builtin_amdgcn_s_memrealtime(); const unsigned long long dt_ = MISC[16]; while (__builtin_amdgcn_s_memrealtime() - t1_ < dt_) __builtin_amdgcn_s_sleep(8); __syncthreads(); if (F.tid == 0) MISC[16] = 0u; } \
        if ((k_) + 1 < a.ph_hi) xcd_barrier(bar); }
#else
#define MK_PH(k_) if (a.ph_lo <= (k_) && (k_) < a.ph_hi) { run_phase<(k_)>(F); if ((k_) + 1 < a.ph_hi) xcd_barrier(bar); }
#endif
    MK_PH(0) MK_PH(1) MK_PH(2) MK_PH(3) MK_PH(4) MK_PH(5) MK_PH(6) MK_PH(7) MK_PH(8) MK_PH(9) MK_PH(10)
    MK_PH(11) MK_PH(12) MK_PH(13) MK_PH(14) MK_PH(15) MK_PH(16) MK_PH(17) MK_PH(18) MK_PH(19) MK_PH(20) MK_PH(21)
#undef MK_PH
}
#ifndef FAST
#define FAST 0x1ff
#endif
#if FAST != 0x1ff
constexpr size_t WS_NV1 = 538 * MiB;
constexpr size_t WS_NSG = 291 * MiB, WS_NFLS = 324 * MiB;
__global__ void __launch_bounds__(256) k_mod(Params p) {
    const int e = blockIdx.x * 256 + threadIdx.x, cond = blockIdx.y, l = blockIdx.z;
    const float* cv = cond < 4 ? p.c + cond * D : p.c_ctx;
    const float* w = p.w_mod + (size_t)l * D * 6 * D;
    float acc = p.b_mod[l * 6 * D + e];
    for (int d = 0; d < D; ++d) acc += siluf_(cv[d]) * w[(size_t)d * 6 * D + e];
    ((float*)(p.ws + WS_MOD))[(size_t)(l * 5 + cond) * 6 * D + e] = acc;
}
__global__ void __launch_bounds__(256) k_rowA(Params p, int l) { row_pass_A(p, l, (blockIdx.x * 256 + threadIdx.x) >> 6, (gridDim.x * 256) >> 6, threadIdx.x & 63); }
__global__ void __launch_bounds__(256) k_rowH(Params p, int l, int nrows) { row_pass_H(p, l, nrows, (blockIdx.x * 256 + threadIdx.x) >> 6, (gridDim.x * 256) >> 6, threadIdx.x & 63); }
struct ABf16 { const bf16_t* A; int lda, coff; DEV float operator()(int m, int k) const { return bf2f(A[(size_t)m * lda + coff + k]); } };
struct BF32 { const float* B; int ldb, pad; DEV float operator()(int k, int n) const { return B[(size_t)k * ldb + n]; } };
struct BAB { const float* Ba; const float* Bb; DEV float operator()(int k, int n) const { return k < 512 ? Ba[(size_t)k * D + n] : Bb[(size_t)(k - 512) * D + n]; } };
struct NEpiZ { bf16_t* Z; DEV void operator()(int m, int n, float v, float) const {
    float o; if (n < 1024) o = gelu_tanh(v); else if (n < 1536) o = v; else if (n < 2048) o = gelu_tanh(v); else o = sigmoidf_(v);
    Z[(size_t)m * 4096 + n] = f2bf(o); } };
struct NEpiF32 { float* C; int ldc, pad; DEV void operator()(int m, int n, float v, float) const { C[(size_t)m * ldc + n] = v; } };
struct NEpiBf { bf16_t* C; int ldc, pad; DEV void operator()(int m, int n, float v, float) const { C[(size_t)m * ldc + n] = f2bf(v); } };
struct NEpiMerge { const bf16_t* Z; bf16_t* M; DEV void operator()(int m, int n, float vb, float va) const {
    const float ga = bf2f(Z[(size_t)m * 4096 + 2048 + n]), gr = bf2f(Z[(size_t)m * 4096 + 3072 + n]);
    M[(size_t)m * D + n] = f2bf(ga * va + gr * vb); } };
struct NEpiSwi { const float* SG; bf16_t* SH; DEV void operator()(int m, int n, float v, float) const { SH[(size_t)m * 256 + n] = f2bf(siluf_(SG[(size_t)m * 256 + n]) * v); } };
template <class AL, class BL, class EP, int SPLIT>
__global__ void __launch_bounds__(256) k_gemm(AL al, BL bl, EP ep, int K) {
    __shared__ __attribute__((aligned(16))) float As[16][68];
    __shared__ __attribute__((aligned(16))) float Bs[16][68];
    const int tid = threadIdx.x, tx = tid & 15, ty = tid >> 4, m0 = blockIdx.y * 64, n0 = blockIdx.x * 64;
    float acc[4][4], acc2[4][4];
#pragma unroll
    for (int i = 0; i < 4; ++i)
#pragma unroll
        for (int j = 0; j < 4; ++j) { acc[i][j] = 0.f; acc2[i][j] = 0.f; }
    for (int k0 = 0; k0 < K; k0 += 16) {
        if (SPLIT && k0 == SPLIT) {
#pragma unroll
            for (int i = 0; i < 4; ++i)
#pragma unroll
                for (int j = 0; j < 4; ++j) { acc2[i][j] = acc[i][j]; acc[i][j] = 0.f; }
        }
#pragma unroll
        for (int i = 0; i < 4; ++i) { const int e = tid + 256 * i, kk = e & 15, mm = e >> 4; As[kk][mm] = al(m0 + mm, k0 + kk); }
#pragma unroll
        for (int i = 0; i < 4; ++i) { const int e = tid + 256 * i, nn = e & 63, kk = e >> 6; Bs[kk][nn] = bl(k0 + kk, n0 + nn); }
        __syncthreads();
#pragma unroll
        for (int kk = 0; kk < 16; ++kk) {
            const float4 a = *(const float4*)&As[kk][ty * 4]; const float4 b = *(const float4*)&Bs[kk][tx * 4];
            const float av[4] = {a.x, a.y, a.z, a.w}, bv[4] = {b.x, b.y, b.z, b.w};
#pragma unroll
            for (int i = 0; i < 4; ++i)
#pragma unroll
                for (int j = 0; j < 4; ++j) acc[i][j] += av[i] * bv[j];
        }
        __syncthreads();
    }
#pragma unroll
    for (int i = 0; i < 4; ++i)
#pragma unroll
        for (int j = 0; j < 4; ++j) ep(m0 + ty * 4 + i, n0 + tx * 4 + j, acc[i][j], acc2[i][j]);
}
__global__ void __launch_bounds__(256) k_conv(Params p, int l) {
    const size_t idx = (size_t)blockIdx.x * 256 + threadIdx.x; const int r = (int)(idx >> 9), ch = (int)(idx & 511);
    const bf16_t* Z = (const bf16_t*)(p.ws + WS_Z); float* XCONV = (float*)(p.ws + WS_NV1);
    int t, n; if (r < TL) { t = r & (SEQ - 1); n = SEQ; } else { t = (r - TL) & (CTXL - 1); n = CTXL; }
    const int base = r - t;
    float y = p.conv_b[l * 512 + ch];
#pragma unroll
    for (int k = 0; k < 4; ++k) { const int tt = t + k - 2; if (tt >= 0 && tt < n) y += p.conv_w[(l * 4 + k) * 512 + ch] * bf2f(Z[(size_t)(base + tt) * 4096 + 1024 + ch]); }
    XCONV[(size_t)r * 512 + ch] = y;
}
__global__ void __launch_bounds__(64) k_scan(Params p, int l, int dir) {
    const int b = blockIdx.x >> 3, h = blockIdx.x & 7, j = threadIdx.x, ch = h * 64 + j;
    const float* XCONV = (const float*)(p.ws + WS_NV1); float* HS = (float*)(p.ws + WS_RA);
    const float* wa = p.lru_wa + (size_t)((l * 2 + dir) * 8 + h) * 4096; const float* wx = p.lru_wx + (size_t)((l * 2 + dir) * 8 + h) * 4096;
    float wac[64], wxc[64];
#pragma unroll
    for (int i = 0; i < 64; ++i) { wac[i] = wa[i * 64 + j]; wxc[i] = wx[i * 64 + j]; }
    const float ba = p.lru_ba[(l * 2 + dir) * 512 + ch], bx = p.lru_bx[(l * 2 + dir) * 512 + ch];
    const float sp = log1pf(expf(-p.lru_lam[(l * 2 + dir) * 512 + ch]));
    float hst = 0.f;
    for (int step = 0; step < CTXL + SEQ; ++step) {
        int r;
        if (dir == 0) r = step < CTXL ? TL + b * CTXL + step : b * SEQ + (step - CTXL);
        else r = step < CTXL ? TL + b * CTXL + (CTXL - 1 - step) : b * SEQ + (SEQ - 1 - (step - CTXL));
        const float* xr = XCONV + (size_t)r * 512 + h * 64;
        float pr = ba, px = bx;
#pragma unroll
        for (int i = 0; i < 16; ++i) { const float4 xv = *(const float4*)(xr + 4 * i);
            pr += xv.x * wac[4 * i] + xv.y * wac[4 * i + 1] + xv.z * wac[4 * i + 2] + xv.w * wac[4 * i + 3];
            px += xv.x * wxc[4 * i] + xv.y * wxc[4 * i + 1] + xv.z * wxc[4 * i + 2] + xv.w * wxc[4 * i + 3]; }
        const float rg = sigmoidf_(pr), ig = sigmoidf_(px);
        const float log_a = -8.0f * rg * sp;
        const float a = expf(log_a), drv = sqrtf(-expm1f(2.0f * log_a)) * (ig * xr[j]);
        hst = a * hst + drv;
        if (dir == 0) HS[(size_t)r * 512 + ch] = hst; else HS[(size_t)r * 512 + ch] += hst;
    }
}
__global__ void __launch_bounds__(256) k_yb(Params p) {
    const size_t idx = (size_t)blockIdx.x * 256 + threadIdx.x; const int r = (int)(idx >> 9), ch = (int)(idx & 511);
    const bf16_t* Z = (const bf16_t*)(p.ws + WS_Z); const float* HS = (const float*)(p.ws + WS_RA); bf16_t* Y = (bf16_t*)(p.ws + WS_RY);
    Y[(size_t)r * D + 512 + ch] = f2bf(HS[(size_t)r * 512 + ch] * bf2f(Z[(size_t)r * 4096 + 1536 + ch]));
}
__global__ void __launch_bounds__(256) k_ln(Params p, int l, int nrows) {
    const int lane = threadIdx.x & 63, wave = (blockIdx.x * 256 + threadIdx.x) >> 6, nw = (gridDim.x * 256) >> 6;
    const bf16_t* Z = (const bf16_t*)(p.ws + WS_Z); float* VN = (float*)(p.ws + WS_NV1);
    for (int r = wave; r < nrows; r += nw) {
        float v[8]; float s = 0.f;
#pragma unroll
        for (int i = 0; i < 8; ++i) { v[i] = bf2f(Z[(size_t)r * 4096 + 512 + i * 64 + lane]); s += v[i]; }
        const float mu = wave_sum(s) * (1.f / 512.f); float q = 0.f;
#pragma unroll
        for (int i = 0; i < 8; ++i) { v[i] -= mu; q += v[i] * v[i]; }
        const float rstd = rsqrtf(wave_sum(q) * (1.f / 512.f) + 1e-5f);
#pragma unroll
        for (int i = 0; i < 8; ++i) { const int cch = i * 64 + lane; VN[(size_t)r * 512 + cch] = v[i] * rstd * p.ln_g[l * 512 + cch] + p.ln_b[l * 512 + cch]; }
    }
}
__global__ void __launch_bounds__(256) k_mix(Params p, int l) {
    const size_t idx = (size_t)blockIdx.x * 256 + threadIdx.x; const int r = (int)(idx >> 9), ch = (int)(idx & 511), g = ch >> 6;
    const bf16_t* Z = (const bf16_t*)(p.ws + WS_Z); const float* VN = (const float*)(p.ws + WS_NV1); bf16_t* Y = (bf16_t*)(p.ws + WS_RY);
    const int base = r & ~127, pp = r & 127;
    const float* w = p.gws + ((size_t)(l * 8 + g) * 128 + pp) * 128;
    float acc = p.gbs[(l * 8 + g) * 128 + pp];
    for (int q = 0; q < 128; ++q) acc += w[q] * VN[(size_t)(base + q) * 512 + ch];
    Y[(size_t)r * D + ch] = f2bf(bf2f(Z[(size_t)r * 4096 + ch]) * acc);
}
__global__ void __launch_bounds__(256) k_route(Params p, int l, int nrows) {
    const int lane = threadIdx.x & 63, wave = (blockIdx.x * 256 + threadIdx.x) >> 6, nw = (gridDim.x * 256) >> 6;
    int* TOPI = (int*)(p.ws + WS_TOPI); float* TOPW = (float*)(p.ws + WS_TOPW);
    for (int r = wave; r < nrows; r += nw) { int myi; float myw; route_token(p, l, ((const float*)(p.ws + WS_LOG))[(size_t)r * 64 + lane], lane, myi, myw);
        if (lane < 8) { TOPI[(size_t)r * 8 + lane] = myi; TOPW[(size_t)r * 8 + lane] = myw; } }
}
__global__ void __launch_bounds__(256) k_routed(Params p, int l) {
    __shared__ float hs[D]; __shared__ float hm[256];
    const int r = blockIdx.x, tid = threadIdx.x;
    const bf16_t* H2 = (const bf16_t*)(p.ws + WS_RA); const int* TOPI = (const int*)(p.ws + WS_TOPI); const float* TOPW = (const float*)(p.ws + WS_TOPW);
    const float* FLs = (const float*)(p.ws + WS_NFLS); bf16_t* FL = (bf16_t*)(p.ws + WS_RY);
#pragma unroll
    for (int i = 0; i < 4; ++i) hs[tid + 256 * i] = bf2f(H2[(size_t)r * D + tid + 256 * i]);
    float acc[4] = {0.f, 0.f, 0.f, 0.f};
    __syncthreads();
    for (int s = 0; s < 8; ++s) {
        const int e = TOPI[(size_t)r * 8 + s]; const float w = TOPW[(size_t)r * 8 + s];
        const float* wg = p.e_g + ((size_t)(l * NE + e) * D) * 256; const float* wu = p.e_u + ((size_t)(l * NE + e) * D) * 256;
        float g = 0.f, u = 0.f;
        for (int k = 0; k < D; ++k) { const float hv = hs[k]; g += hv * wg[(size_t)k * 256 + tid]; u += hv * wu[(size_t)k * 256 + tid]; }
        hm[tid] = siluf_(g) * u;
        __syncthreads();
        const float* wd = p.e_d + ((size_t)(l * NE + e) * 256) * D;
        float o[4] = {0.f, 0.f, 0.f, 0.f};
        for (int j = 0; j < 256; ++j) { const float hv = hm[j];
#pragma unroll
            for (int i = 0; i < 4; ++i) o[i] += hv * wd[(size_t)j * D + tid + 256 * i]; }
#pragma unroll
        for (int i = 0; i < 4; ++i) acc[i] += w * o[i];
        __syncthreads();
    }
#pragma unroll
    for (int i = 0; i < 4; ++i) FL[(size_t)r * D + tid + 256 * i] = f2bf(FLs[(size_t)r * D + tid + 256 * i] + acc[i]);
}
template <int SPLIT, class AL, class BL, class EP>
static void ngemm(hipStream_t st, int M, int N, int K, AL al, BL bl, EP ep) { hipLaunchKernelGGL((k_gemm<AL, BL, EP, SPLIT>), dim3(N / 64, M / 64), dim3(256), 0, st, al, bl, ep, K); }
#endif

static void mk(hipStream_t st, const Params& p, int lo, int hi) { Args a{}; a.p = p; a.ph_lo = lo; a.ph_hi = hi; hipLaunchKernelGGL(mk_fwd, dim3(256), dim3(NWAVES * 64), LDS_BYTES, st, a); }

extern "C" void kernel_launch(void* const* d_in, const int* in_sizes, int n_in, void* d_out, int out_size, void* d_ws, size_t ws_size, hipStream_t stream) {
    static int ready = 0;
    if (ready == 0) {
        ready = -1;
        if (n_in != 33 || ws_size < WS_END || out_size != TL * D) return;
        int dev = 0, cus = 0;
        if (hipGetDevice(&dev) != hipSuccess || hipDeviceGetAttribute(&cus, hipDeviceAttributeMultiprocessorCount, dev) != hipSuccess || cus < 256) return;
        if (hipFuncSetAttribute((const void*)mk_fwd, hipFuncAttributeMaxDynamicSharedMemorySize, LDS_BYTES) != hipSuccess) return;
        ready = 1;
    }
    if (ready < 0) return;
    Params p{};
    const float** pp = (const float**)&p;
    for (int i = 0; i < 33; ++i) pp[i] = (const float*)d_in[i];
    p.out = (float*)d_out; p.ws = (unsigned char*)d_ws;
    (void)hipMemsetAsync((char*)d_ws + WS_CTL, 0, 1 * MiB, stream);
#if FAST == 0x1ff && !defined(MK_PER_PHASE)
    mk(stream, p, 0, PH_END);
#elif FAST == 0x1ff
    for (int ph = 0; ph < PH_END; ++ph) mk(stream, p, ph, ph + 1);
#else
    unsigned char* ws = p.ws;
    bf16_t* RA = (bf16_t*)(ws + WS_RA); bf16_t* Z = (bf16_t*)(ws + WS_Z); bf16_t* RY = (bf16_t*)(ws + WS_RY);
    float* LOG = (float*)(ws + WS_LOG); float* SG = (float*)(ws + WS_NSG); bf16_t* SH = (bf16_t*)(ws + WS_SH); float* FLs = (float*)(ws + WS_NFLS);
    mk(stream, p, 0, 1);
    if (!(FAST & 1)) hipLaunchKernelGGL(k_mod, dim3(24, 5, 2), dim3(256), 0, stream, p);
    for (int l = 0; l < 2; ++l) {
        const int nr = (l == 0) ? R : TL, b0 = 1 + l * NPL;
        if (FAST & 2) mk(stream, p, b0 + 0, b0 + 1); else { if (l > 0) mk(stream, p, 100 + l, 101 + l); hipLaunchKernelGGL(k_rowA, dim3(2048), dim3(256), 0, stream, p, l); }
        if (FAST & 4) mk(stream, p, b0 + 1, b0 + 2); else ngemm<0>(stream, R, 4096, D, ABf16{RA, D, 0}, BF32{p.w_in + (size_t)l * D * 4096, 4096, 0}, NEpiZ{Z});
        if (FAST & 8) { mk(stream, p, b0 + 2, b0 + 3); mk(stream, p, b0 + 3, b0 + 4); }
        else {
            hipLaunchKernelGGL(k_conv, dim3(R * 512 / 256), dim3(256), 0, stream, p, l);
            for (int dir = 0; dir < 2; ++dir) hipLaunchKernelGGL(k_scan, dim3(NBATCH * 8), dim3(64), 0, stream, p, l, dir);
            hipLaunchKernelGGL(k_yb, dim3(nr * 512 / 256), dim3(256), 0, stream, p);
            hipLaunchKernelGGL(k_ln, dim3(2048), dim3(256), 0, stream, p, l, nr);
            hipLaunchKernelGGL(k_mix, dim3(nr * 512 / 256), dim3(256), 0, stream, p, l);
        }
        if (FAST & 16) mk(stream, p, b0 + 4, b0 + 5); else ngemm<512>(stream, nr, D, D, ABf16{RY, D, 0}, BAB{p.w_out_a + (size_t)l * 512 * D, p.w_out_b + (size_t)l * 512 * D}, NEpiMerge{Z, RA});
        if (FAST & 32) mk(stream, p, b0 + 5, b0 + 6); else ngemm<0>(stream, nr, D, D, ABf16{RA, D, 0}, BF32{p.w_out + (size_t)l * D * D, D, 0}, NEpiBf{Z, D, 0});
        if (FAST & 64) mk(stream, p, b0 + 6, b0 + 7); else hipLaunchKernelGGL(k_rowH, dim3(2048), dim3(256), 0, stream, p, l, nr);
        if (FAST & 128) { mk(stream, p, b0 + 7, b0 + 8); mk(stream, p, b0 + 8, b0 + 9); }
        else {
            ngemm<0>(stream, nr, 64, D, ABf16{RA, D, 0}, BF32{p.router_w + (size_t)l * D * 64, 64, 0}, NEpiF32{LOG, 64, 0});
            hipLaunchKernelGGL(k_route, dim3(2048), dim3(256), 0, stream, p, l, nr);
            ngemm<0>(stream, nr, 256, D, ABf16{RA, D, 0}, BF32{p.s_g + (size_t)l * D * 256, 256, 0}, NEpiF32{SG, 256, 0});
            ngemm<0>(stream, nr, 256, D, ABf16{RA, D, 0}, BF32{p.s_u + (size_t)l * D * 256, 256, 0}, NEpiSwi{SG, SH});
        }
        if (FAST & 256) { for (int k = 9; k < NPL; ++k) mk(stream, p, b0 + k, b0 + k + 1); }
        else {
            ngemm<0>(stream, nr, D, 256, ABf16{SH, 256, 0}, BF32{p.s_d + (size_t)l * 256 * D, D, 0}, NEpiF32{FLs, D, 0});
            hipLaunchKernelGGL(k_routed, dim3(nr), dim3(256), 0, stream, p, l);
        }
    }
    if (FAST & 2) mk(stream, p, PH_FINAL, PH_END); else hipLaunchKernelGGL(k_rowA, dim3(2048), dim3(256), 0, stream, p, 2);
#endif
}
```

```cpp
#include <hip/hip_runtime.h>
#include <stdint.h>
#include <math.h>

#ifndef GIN_FP8
#define GIN_FP8 1
#endif
#ifndef GED_FP8
#define GED_FP8 1
#endif
#ifndef GSD_FP8
#define GSD_FP8 0
#endif
typedef unsigned short bf16_t;
#define DEV __device__ __forceinline__
#define LAS __attribute__((address_space(3)))
#define GAS __attribute__((address_space(1)))
typedef short bf16x8 __attribute__((ext_vector_type(8)));
typedef float f32x4 __attribute__((ext_vector_type(4)));
typedef unsigned u32x4 __attribute__((ext_vector_type(4)));
typedef unsigned u32x2 __attribute__((ext_vector_type(2)));

constexpr int D = 1024, NBATCH = 4, SEQ = 8192, CTXL = 256;
constexpr int TL = NBATCH * SEQ, TC = NBATCH * CTXL, R = TL + TC;
constexpr int NE = 64, CAP = R;
constexpr int NCHUNK = R / 128;
constexpr size_t MiB = 1u << 20;
constexpr size_t WS_CTL = 0;
constexpr size_t WS_PE = 1 * MiB + 512 * 1024  ;
constexpr size_t WS_MOD = 1 * MiB, WS_H8 = 2 * MiB  , WS_LISTA = 6 * MiB  , WS_LISTW = 15 * MiB  , WS_SUMM = 24 * MiB, WS_LOG = 27 * MiB;
constexpr size_t WS_TOPI = WS_LOG, WS_TOPW = WS_LOG;
constexpr size_t WS_W = 36 * MiB;
constexpr size_t WS_XC = 40 * MiB;
static_assert(GIN_FP8 && GED_FP8, "the workspace map below assumes the e4m3 copies of W_in and of the routed experts' weights");
constexpr size_t WS_RY = 148 * MiB;
constexpr size_t WS_Z = 214 * MiB;
constexpr size_t WS_HM = 214 * MiB;
constexpr size_t WS_SH = 354 * MiB;
constexpr size_t WS_SLOTS = 354 * MiB;
constexpr size_t WS_RA = 478 * MiB;
constexpr size_t WS_LR = 478 * MiB;
constexpr size_t WS_XCT = 478 * MiB;
constexpr size_t WS_H2E = 544 * MiB;
constexpr size_t WS_END = 618 * MiB;
constexpr size_t WO_IN = 0, WO_AB = 8 * MiB, WO_OUT = 10 * MiB, WO_SR = 12 * MiB  , WO_SD = 14 * MiB  , WO_LRU = 15 * MiB  ,
                 WO_GWS = 15 * MiB + MiB / 2  , WO_EG = 16 * MiB  , WO_ED = 80 * MiB  ;
constexpr size_t WL_EG = 32 * MiB, WL_ED = 16 * MiB;
constexpr int CW_CNT = 64;
constexpr int CW_BAR = 4096;

struct Params {
    const float *x, *c, *ctx, *c_ctx, *w_mod, *b_mod, *g_pre_mix, *g_post_mix, *g_pre_ffn, *g_post_ffn, *w_in, *ln_g, *ln_b, *gws, *gbs,
        *conv_w, *conv_b, *lru_wa, *lru_ba, *lru_wx, *lru_bx, *lru_lam, *w_out_a, *w_out_b, *w_out, *router_w, *router_b, *e_g, *e_u, *e_d, *s_g, *s_u, *s_d;
    float* out; unsigned char* ws;
};

DEV float bf2f(bf16_t v) { return __uint_as_float(((unsigned)v) << 16); }
DEV bf16_t f2bf(float f) { unsigned u = __float_as_uint(f); return (bf16_t)((u + 0x7fffu + ((u >> 16) & 1u)) >> 16); }
DEV unsigned pk2(float lo, float hi) { return (unsigned)f2bf(lo) | ((unsigned)f2bf(hi) << 16); }
DEV float sigmoidf_(float x) { return 1.f / (1.f + expf(-x)); }
DEV float siluf_(float x) { return x / (1.f + expf(-x)); }
DEV float gelu_tanh(float x) { return 0.5f * x * (1.f + tanhf(0.7978845608028654f * (x + 0.044715f * x * x * x))); }
DEV float fsigmoid(float x) { return __builtin_amdgcn_rcpf(1.f + __builtin_amdgcn_exp2f(-1.4426950408889634f * x)); }
DEV float fsilu(float x) { return x * fsigmoid(x); }
DEV float fgelu(float x) { const float u = 1.5957691216057308f * (x + 0.044715f * x * x * x); return x * fsigmoid(u); }
DEV float wave_sum(float v) {
#pragma unroll
    for (int o = 1; o < 64; o <<= 1) v += __shfl_xor(v, o);
    return v;
}
DEV const float* mod_ptr(const Params& p, int l, int cond, int j) { return (const float*)(p.ws + WS_MOD) + ((size_t)((l * 5 + cond) * 6 + j)) * D; }
DEV float* xl_row(const Params& p, int r) { return r < TL ? p.out + (size_t)r * D : (float*)(p.ws + WS_XC) + (size_t)(r - TL) * D; }
namespace pg8 {
constexpr int BM = 256, BK = 64, HALF = 128, HTB = HALF * BK * 2  , STAGE_BYTES = 8 * HTB;
DEV int lds_byte(int r, int c) { const int st = (r >> 4) * 2 + (c >> 5), rr = r & 15, cc = c & 31, ob = rr * 64 + cc * 2; return st * 1024 + (ob ^ (((ob >> 9) & 1) << 5)); }
DEV void stage_rc(int b, int& Rr, int& C) { const int st = b / 1024, sb = b % 1024, swz = sb ^ (((sb >> 9) & 1) << 5); Rr = (st >> 1) * 16 + swz / 64; C = (st & 1) * 32 + (swz % 64) / 2; }
DEV int perm32(int rho) { const int n = rho >> 4, i = rho & 15; return 8 * (i >> 2) + 4 * n + (i & 3); }
DEV unsigned cvt_pk_bf16(float lo, float hi) { unsigned r; asm volatile("v_cvt_pk_bf16_f32 %0, %1, %2" : "=v"(r) : "v"(lo), "v"(hi)); return r; }
DEV u32x4 pack8(const f32x4 v0, const f32x4 v1) { u32x4 w; w.x = cvt_pk_bf16(v0[0], v0[1]); w.y = cvt_pk_bf16(v0[2], v0[3]); w.z = cvt_pk_bf16(v1[0], v1[1]); w.w = cvt_pk_bf16(v1[2], v1[3]); return w; }
DEV void unpack8(const u32x4 w, f32x4& v0, f32x4& v1) {
    v0[0] = __uint_as_float(w.x << 16); v0[1] = __uint_as_float(w.x & 0xffff0000u); v0[2] = __uint_as_float(w.y << 16); v0[3] = __uint_as_float(w.y & 0xffff0000u);
    v1[0] = __uint_as_float(w.z << 16); v1[1] = __uint_as_float(w.z & 0xffff0000u); v1[2] = __uint_as_float(w.w << 16); v1[3] = __uint_as_float(w.w & 0xffff0000u);
}
DEV int xcd_remap(int L, int U) { const int q = U / 8, r = U % 8, xcd = L % 8, off = L / 8; return (xcd < r ? xcd * (q + 1) : r * (q + 1) + (xcd - r) * q) + off; }

struct UnitD { int pm, pn; };
template <int K, size_t AOFF, size_t BOFF> struct DenseSched {
    typedef UnitD Unit; static constexpr int KK = K;
    const unsigned char* ws; int nM, nN, nwg, c, Krt; static constexpr int G = 256;
    DEV void init(const unsigned char* ws_, int M, int N, int c_) { ws = ws_; nM = M / BM; nN = N / BM; nwg = nM * nN; c = c_; Krt = K; asm volatile("" : "+s"(Krt)); }
    DEV bool next(int i, Unit& u) const {
        const int L = i * G + c; if (L >= nwg) return false;
        const int wgid = xcd_remap(L, nwg);
        const int nig = 8 * nN, gid = wgid / nig, fm = gid * 8, gsz = (nM - fm) < 8 ? (nM - fm) : 8;
        u.pm = fm + ((wgid % nig) % gsz); u.pn = (wgid % nig) / gsz; return true;
    }
    DEV const char* abase(const Unit& u) const { return (const char*)ws + AOFF + (size_t)u.pm * BM * K * 2; }
    DEV const char* bbase(const Unit& u) const { return (const char*)ws + BOFF + (size_t)u.pn * BM * K * 2; }
    DEV void prefetch(const Unit&, LAS unsigned char*, int, int) const {}
    DEV void aoffs(const Unit&, int tid, unsigned (&v)[2][2], LAS unsigned char*, int, bool) const {
#pragma unroll
        for (int i = 0; i < 2; ++i) { int Rr, C; stage_rc(tid * 16 + i * 8192, Rr, C);
#pragma unroll
            for (int h = 0; h < 2; ++h) v[h][i] = (unsigned)((h * HALF + Rr) * K + C) * 2u; }
    }
};
struct UnitE { int e, row0, cnt, hmrow0, pn; };
template <int K, int GATHER, int NCOL, size_t AOFF, size_t BOFF, size_t BSTRIDE> struct ExpSched {
    typedef UnitE Unit; static constexpr int KK = K;
    const unsigned char* ws; LAS unsigned char* lds;
    int U, c, brow0, Krt; static constexpr int ncol = NCOL, gather = GATHER, G = 256;
    DEV bool next(int i, Unit& u) const {
        const int L = i * G + c; if (L >= U) return false;
        const int id = xcd_remap(L, U), tile = id / ncol; u.pn = id % ncol;
        const LAS int* toff = (const LAS int*)(lds + 131072 + 256);
        const int e = (int)((const LAS unsigned char*)(lds + 131072 + 2048))[tile];
        u.e = e; u.row0 = (tile - toff[e]) * BM; u.cnt = toff[80 + e]; u.hmrow0 = tile * BM; return true;
    }
    DEV const char* abase(const Unit& u) const { return gather ? (const char*)ws + AOFF : (const char*)ws + AOFF + (size_t)u.hmrow0 * K * 2; }
    DEV const char* bbase(const Unit& u) const { return (const char*)ws + BOFF + (size_t)u.e * BSTRIDE + (size_t)(brow0 + u.pn * BM) * K * 2; }
    DEV void prefetch(const Unit& u, LAS unsigned char* lds_, int wid, int lane) const {
        if (gather) __builtin_amdgcn_global_load_lds((const unsigned*)(ws + WS_LISTA) + (size_t)u.e * CAP + u.row0 + lane * 4, (LAS unsigned*)(lds_ + 131072 + 2048 + wid * 3712 + 2048), 16, 0, 0);
    }
    DEV void aoffs(const Unit& u, int tid, unsigned (&v)[2][2], LAS unsigned char* lds_, int wid, bool from_lds) const {
        asm volatile("" : "+v"(tid));
        const int* lista = (const int*)(ws + WS_LISTA);
        const LAS int* sp = (const LAS int*)(lds_ + 131072 + 2048 + wid * 3712 + 2048);
#pragma unroll
        for (int i = 0; i < 2; ++i) { int Rr, C; stage_rc(tid * 16 + i * 8192, Rr, C);
#pragma unroll
            for (int h = 0; h < 2; ++h) {
                const int lr = h * HALF + Rr;
                if (gather) { const int rr = u.row0 + lr; const int aid = from_lds ? sp[lr] : ((rr < u.cnt) ? lista[(size_t)u.e * CAP + rr] : 0);
                    const int tok = (rr < u.cnt) ? (aid >> 3) : 0; v[h][i] = (unsigned)(tok * K + C) * 2u; }
                else v[h][i] = (unsigned)(lr * K + C) * 2u;
            } }
    }
};

typedef f32x4 Acc[2][2][4][2];
#define EPI_ROWS(ai, m) for (int ai = 0; ai < 2; ++ai) _Pragma("unroll") for (int m = 0; m < 4; ++m)

struct EpiZ {
    static constexpr int PID = 10; static constexpr bool HAS_MID = false; static constexpr int MID_T = 0;
    unsigned char* ws;
    DEV void mid(Acc&, const UnitD&, int, int, int, int) const {}
    DEV void unit_begin(const UnitD&, LAS unsigned char*, int, int) const {}
    DEV void operator()(const Acc& acc, const UnitD& u, int wr, int wc, int fr, int fq) const {
        bf16_t* Z = (bf16_t*)(ws + WS_Z);
        const int act = (u.pn < 4) ? 1 : (u.pn < 6 ? 0 : (u.pn < 8 ? 1 : 2));
        const int row0 = u.pm * BM + wr * 64 + fr, col0 = u.pn * BM + wc * 32 + 8 * fq;
#pragma unroll
        EPI_ROWS(ai, m) { bf16_t* rowp = Z + (size_t)(row0 + ai * HALF + m * 16) * 4096 + col0;
#pragma unroll
            for (int bj = 0; bj < 2; ++bj) { f32x4 v0 = acc[ai][bj][m][0], v1 = acc[ai][bj][m][1];
                if (act == 1) {
#pragma unroll
                    for (int i = 0; i < 4; ++i) { v0[i] = fgelu(v0[i]); v1[i] = fgelu(v1[i]); }
                } else if (act == 2) {
                    unsigned w0 = 0, w1 = 0;
#pragma unroll
                    for (int i = 0; i < 4; ++i) { w0 |= (unsigned)__builtin_rintf(fsigmoid(v0[i]) * 255.f) << (8 * i); w1 |= (unsigned)__builtin_rintf(fsigmoid(v1[i]) * 255.f) << (8 * i); }
                    *(u32x2*)((unsigned char*)(Z + (size_t)(row0 + ai * HALF + m * 16) * 4096) + 4096 + (col0 - 2048) + bj * HALF) = (u32x2){w0, w1};
                    continue;
                }
                *(u32x4*)(rowp + bj * HALF) = pack8(v0, v1); } }
    }
};
struct EpiAB {
    static constexpr int PID = 11; static constexpr bool HAS_MID = true; static constexpr int MID_T = 8;
    unsigned char* ws;
    DEV void unit_begin(const UnitD&, LAS unsigned char*, int, int) const {}
    DEV void mid(Acc& acc, const UnitD& u, int wr, int wc, int fr, int fq) const {
        const bf16_t* Z = (const bf16_t*)(ws + WS_Z);
        int oz = 0; asm volatile("" : "+v"(oz));
        const int row0 = u.pm * BM + wr * 64 + fr + oz, col0 = u.pn * BM + wc * 32 + 8 * fq;
#pragma unroll
        for (int ai = 0; ai < 2; ++ai) {
            u32x2 ga[4][2], gr[4][2];
#pragma unroll
            for (int m = 0; m < 4; ++m) { const unsigned char* zr = (const unsigned char*)(Z + (size_t)(row0 + ai * HALF + m * 16) * 4096) + 4096 + col0;
#pragma unroll
                for (int bj = 0; bj < 2; ++bj) { ga[m][bj] = *(const u32x2*)(zr + bj * HALF); gr[m][bj] = *(const u32x2*)(zr + 1024 + bj * HALF); } }
#pragma unroll
            for (int m = 0; m < 4; ++m)
#pragma unroll
                for (int bj = 0; bj < 2; ++bj) {
#pragma unroll
                    for (int i = 0; i < 4; ++i) {
                        const float a0 = (float)((ga[m][bj].x >> (8 * i)) & 255u), a1 = (float)((ga[m][bj].y >> (8 * i)) & 255u);
                        const float r0 = fmaxf((float)((gr[m][bj].x >> (8 * i)) & 255u), 0.5f), r1 = fmaxf((float)((gr[m][bj].y >> (8 * i)) & 255u), 0.5f);
                        acc[ai][bj][m][0][i] *= a0 * __builtin_amdgcn_rcpf(r0); acc[ai][bj][m][1][i] *= a1 * __builtin_amdgcn_rcpf(r1); } }
            asm volatile("" ::: "memory"); }
    }
    DEV void operator()(const Acc& acc, const UnitD& u, int wr, int wc, int fr, int fq) const {
        const bf16_t* Z = (const bf16_t*)(ws + WS_Z); bf16_t* M = (bf16_t*)(ws + WS_RA);
        const int row0 = u.pm * BM + wr * 64 + fr, col0 = u.pn * BM + wc * 32 + 8 * fq;
        u32x2 gr[2][4][2];
#pragma unroll
        EPI_ROWS(ai, m) { const unsigned char* zr = (const unsigned char*)(Z + (size_t)(row0 + ai * HALF + m * 16) * 4096) + 4096 + 1024 + col0;
#pragma unroll
            for (int bj = 0; bj < 2; ++bj) gr[ai][m][bj] = *(const u32x2*)(zr + bj * HALF); }
#pragma unroll
        EPI_ROWS(ai, m) { bf16_t* rowp = M + (size_t)(row0 + ai * HALF + m * 16) * D + col0;
#pragma unroll
            for (int bj = 0; bj < 2; ++bj) { f32x4 r0, r1;
#pragma unroll
                for (int i = 0; i < 4; ++i) { r0[i] = fmaxf((float)((gr[ai][m][bj].x >> (8 * i)) & 255u), 0.5f) * (1.f / 255.f); r1[i] = fmaxf((float)((gr[ai][m][bj].y >> (8 * i)) & 255u), 0.5f) * (1.f / 255.f); }
                *(u32x4*)(rowp + bj * HALF) = pack8(acc[ai][bj][m][0] * r0, acc[ai][bj][m][1] * r1); } }
    }
};
template <size_t COFF> struct EpiPlain {
    static constexpr int PID = 12; static constexpr bool HAS_MID = false; static constexpr int MID_T = 0;
    unsigned char* ws;
    DEV void mid(Acc&, const UnitD&, int, int, int, int) const {}
    DEV void unit_begin(const UnitD&, LAS unsigned char*, int, int) const {}
    DEV void operator()(const Acc& acc, const UnitD& u, int wr, int wc, int fr, int fq) const {
        bf16_t* C = (bf16_t*)(ws + COFF); constexpr int ldc = D;
        const int row0 = u.pm * BM + wr * 64 + fr, col0 = u.pn * BM + wc * 32 + 8 * fq;
#pragma unroll
        EPI_ROWS(ai, m) { bf16_t* rowp = C + (size_t)(row0 + ai * HALF + m * 16) * ldc + col0;
#pragma unroll
            for (int bj = 0; bj < 2; ++bj) *(u32x4*)(rowp + bj * HALF) = pack8(acc[ai][bj][m][0], acc[ai][bj][m][1]); }
    }
};
struct EpiSR {
    static constexpr int PID = 13; static constexpr bool HAS_MID = false; static constexpr int MID_T = 0;
    unsigned char* ws;
    DEV void mid(Acc&, const UnitD&, int, int, int, int) const {}
    DEV void unit_begin(const UnitD&, LAS unsigned char*, int, int) const {}
    DEV void operator()(const Acc& acc, const UnitD& u, int wr, int wc, int fr, int fq) const {
        float* LOG = (float*)(ws + WS_LOG); bf16_t* SH = (bf16_t*)(ws + WS_SH);
        const int row0 = u.pm * BM + wr * 64 + fr;
        if (u.pn == 0) {
            if (wc < 2) {
#pragma unroll
                EPI_ROWS(ai, m) { float* rowp = LOG + (size_t)(row0 + ai * HALF + m * 16) * 64 + wc * 32 + 8 * fq;
                    *(f32x4*)(rowp) = acc[ai][0][m][0]; *(f32x4*)(rowp + 4) = acc[ai][0][m][1]; }
            }
        } else {
            const int j0 = (u.pn - 1) * HALF + wc * 32 + 8 * fq;
#pragma unroll
            EPI_ROWS(ai, m) { f32x4 v0, v1;
#pragma unroll
                for (int i = 0; i < 4; ++i) { v0[i] = fsilu(acc[ai][0][m][0][i]) * acc[ai][1][m][0][i]; v1[i] = fsilu(acc[ai][0][m][1][i]) * acc[ai][1][m][1][i]; }
#if GSD_FP8
                { u32x2 o; unsigned t = 0;
#pragma unroll
                  for (int i = 0; i < 4; ++i) { v0[i] = __builtin_amdgcn_fmed3f(v0[i] * 8.f, -440.f, 440.f); v1[i] = __builtin_amdgcn_fmed3f(v1[i] * 8.f, -440.f, 440.f); }
                  t = __builtin_amdgcn_cvt_pk_fp8_f32(v0[0], v0[1], t, false); t = __builtin_amdgcn_cvt_pk_fp8_f32(v0[2], v0[3], t, true); o.x = t;
                  t = __builtin_amdgcn_cvt_pk_fp8_f32(v1[0], v1[1], t, false); t = __builtin_amdgcn_cvt_pk_fp8_f32(v1[2], v1[3], t, true); o.y = t;
                  *(u32x2*)((unsigned char*)SH + (size_t)(row0 + ai * HALF + m * 16) * 256 + j0) = o; }
#else
                *(u32x4*)(SH + (size_t)(row0 + ai * HALF + m * 16) * 256 + j0) = pack8(v0, v1);
#endif
            }
        }
    }
};
template <int FP8S> struct EpiEG {
    static constexpr int PID = 14; static constexpr bool HAS_MID = false; static constexpr int MID_T = 0;
    unsigned char* ws;
    DEV void mid(Acc&, const UnitE&, int, int, int, int) const {}
    DEV void unit_begin(const UnitE&, LAS unsigned char*, int, int) const {}
    DEV void operator()(const Acc& acc, const UnitE& u, int wr, int wc, int fr, int fq) const {
        bf16_t* HM = (bf16_t*)(ws + WS_HM);
        const int j0 = u.pn * HALF + wc * 32 + 8 * fq;
#pragma unroll
        EPI_ROWS(ai, m) { f32x4 v0, v1;
#pragma unroll
            for (int i = 0; i < 4; ++i) { constexpr float sc = FP8S ? (1.f / 1024.f) : 1.f; v0[i] = fsilu(acc[ai][0][m][0][i] * sc) * (acc[ai][1][m][0][i] * sc); v1[i] = fsilu(acc[ai][0][m][1][i] * sc) * (acc[ai][1][m][1][i] * sc); }
#if GED_FP8
            { u32x2 o; unsigned t = 0;
#pragma unroll
              for (int i = 0; i < 4; ++i) { v0[i] = __builtin_amdgcn_fmed3f(v0[i] * 8.f, -440.f, 440.f); v1[i] = __builtin_amdgcn_fmed3f(v1[i] * 8.f, -440.f, 440.f); }
              t = __builtin_amdgcn_cvt_pk_fp8_f32(v0[0], v0[1], t, false); t = __builtin_amdgcn_cvt_pk_fp8_f32(v0[2], v0[3], t, true); o.x = t;
              t = __builtin_amdgcn_cvt_pk_fp8_f32(v1[0], v1[1], t, false); t = __builtin_amdgcn_cvt_pk_fp8_f32(v1[2], v1[3], t, true); o.y = t;
              *(u32x2*)((unsigned char*)HM + (size_t)(u.hmrow0 + ai * HALF + wr * 64 + m * 16 + fr) * 256 + j0) = o; }
#else
            *(u32x4*)(HM + (size_t)(u.hmrow0 + ai * HALF + wr * 64 + m * 16 + fr) * 256 + j0) = pack8(v0, v1);
#endif
        }
    }
};
struct EpiED {
    static constexpr int PID = 15; static constexpr bool HAS_MID = false; static constexpr int MID_T = 0;
    unsigned char* ws;
    DEV void mid(Acc&, const UnitE&, int, int, int, int) const {}
    DEV void unit_begin(const UnitE& u, LAS unsigned char* lds, int wid, int lane) const {
        const int wr = wid >> 2; LAS unsigned char* sp = lds + 131072 + 2048 + wid * 3712 + 2048;
#pragma unroll
        for (int ai = 0; ai < 2; ++ai) { const size_t idx = (size_t)u.e * CAP + u.row0 + ai * HALF + wr * 64 + lane;
            __builtin_amdgcn_global_load_lds((const unsigned*)(ws + WS_LISTA) + idx, (LAS unsigned*)(sp + ai * 256), 4, 0, 0);
            __builtin_amdgcn_global_load_lds((const unsigned*)(ws + WS_LISTW) + idx, (LAS unsigned*)(sp + 512 + ai * 256), 4, 0, 0); }
    }
    DEV void operator()(const Acc& acc, const UnitE& u, int wr, int wc, int fr, int fq) const {
        unsigned char* SLOTS = ws + WS_SLOTS;
        const LAS unsigned* sp = (const LAS unsigned*)(lds_ + 131072 + 2048 + (wr * 4 + wc) * 3712 + 2048);
        const int col0 = u.pn * BM + wc * 32 + 8 * fq;
#pragma unroll
        EPI_ROWS(ai, m) { const int rr = u.row0 + ai * HALF + wr * 64 + m * 16 + fr;
            const int aid = (int)sp[ai * 64 + m * 16 + fr]; const float w = __uint_as_float(sp[128 + ai * 64 + m * 16 + fr]) * 16.0f;
            if (rr < u.cnt) { unsigned char* rowp = SLOTS + (size_t)aid * 1024 + col0;
#pragma unroll
                for (int bj = 0; bj < 2; ++bj) { f32x4 v0 = acc[ai][bj][m][0] * w, v1 = acc[ai][bj][m][1] * w; u32x2 o; unsigned t = 0;
#pragma unroll
                    for (int i = 0; i < 4; ++i) { v0[i] = __builtin_amdgcn_fmed3f(v0[i], -440.f, 440.f); v1[i] = __builtin_amdgcn_fmed3f(v1[i], -440.f, 440.f); }
                    t = __builtin_amdgcn_cvt_pk_fp8_f32(v0[0], v0[1], t, false); t = __builtin_amdgcn_cvt_pk_fp8_f32(v0[2], v0[3], t, true); o.x = t;
                    t = __builtin_amdgcn_cvt_pk_fp8_f32(v1[0], v1[1], t, false); t = __builtin_amdgcn_cvt_pk_fp8_f32(v1[2], v1[3], t, true); o.y = t;
                    *(u32x2*)(rowp + bj * HALF) = o; } } }
    }
    LAS unsigned char* lds_;
};

template <class Epi, class Sched, bool ALIGN_EPI, int FP8 = 0>
DEV void gemm_phase(LAS unsigned char* lds, const int tid, const Sched& S, const Epi& E) {
    typedef typename Sched::Unit Unit;
    const int wid = __builtin_amdgcn_readfirstlane(tid >> 6), lane = tid & 63, wr = wid >> 2, wc = wid & 3, fr = lane & 15, fq = lane >> 4;
    const int K = S.Krt, nt = K / BK;
    unsigned voffB[2];
#pragma unroll
    for (int i = 0; i < 2; ++i) { int Rr, C; stage_rc(tid * 16 + i * 8192, Rr, C); const int Rb = (Rr & ~31) + perm32(Rr & 31); voffB[i] = (unsigned)(Rb * K + C) * 2u; }
    const size_t kstep = (size_t)(BK * 2);
    const size_t hstepB = (size_t)HALF * K * 2;
    const unsigned ldsw = (unsigned)wid * 1024u;
    const int aoff = lds_byte(wr * 64 + fr, fq * 8), boff = lds_byte(wc * 32 + fr, fq * 8);
#define PG8_SA(b, h) (((b) * 2 + (h)) * HTB)
#define PG8_SB(b, h) ((4 + (b) * 2 + (h)) * HTB)
#define PG8_STAGE2(bufoff, gbase, o0, o1) do { unsigned o0_ = (o0), o1_ = (o1); asm volatile("" : "+v"(o0_), "+v"(o1_));     \
        __builtin_amdgcn_global_load_lds((const unsigned*)((const char*)(gbase) + o0_), (LAS unsigned*)(lds + (bufoff) + ldsw), 16, 0, 0); \
        __builtin_amdgcn_global_load_lds((const unsigned*)((const char*)(gbase) + o1_), (LAS unsigned*)(lds + (bufoff) + ldsw + 8192), 16, 0, 0); } while (0)
#define PG8_STAGEB(bufoff, gbase) PG8_STAGE2(bufoff, gbase, voffB[0], voffB[1])
#define PG8_LDA(dst, b, h) do { _Pragma("unroll") for (int m = 0; m < 4; ++m) _Pragma("unroll") for (int k = 0; k < 2; ++k) dst[m][k] = *(const LAS bf16x8*)(lds + PG8_SA(b, h) + aoff + m * 2048 + k * 1024); } while (0)
#define PG8_LDB(dst, b, h) do { _Pragma("unroll") for (int n = 0; n < 2; ++n) _Pragma("unroll") for (int k = 0; k < 2; ++k) dst[n][k] = *(const LAS bf16x8*)(lds + PG8_SB(b, h) + boff + n * 2048 + k * 1024); } while (0)
#define PG8_MMA(ai, bj, At, Bt) do { __builtin_amdgcn_s_setprio(1); _Pragma("unroll") for (int m = 0; m < 4; ++m) _Pragma("unroll") for (int n = 0; n < 2; ++n) _Pragma("unroll") for (int k = 0; k < 2; ++k) \
        acc[ai][bj][m][n] = __builtin_amdgcn_mfma_f32_16x16x32_bf16(Bt[n][k], At[m][k], acc[ai][bj][m][n], 0, 0, 0); __builtin_amdgcn_s_setprio(0); } while (0)
typedef int i32x8_t __attribute__((ext_vector_type(8)));
struct Frag2 { bf16x8 lo, hi; };
#define PG8_MMA8(ai, bj, At, Bt) do { __builtin_amdgcn_s_setprio(1); _Pragma("unroll") for (int m = 0; m < 4; ++m) _Pragma("unroll") for (int n = 0; n < 2; ++n) { \
        const Frag2 fb_{Bt[n][0], Bt[n][1]}, fa_{At[m][0], At[m][1]}; \
        acc[ai][bj][m][n] = __builtin_amdgcn_mfma_scale_f32_16x16x128_f8f6f4(__builtin_bit_cast(i32x8_t, fb_), __builtin_bit_cast(i32x8_t, fa_), acc[ai][bj][m][n], 0, 0, 0, 0x79797979, 0, FP8 * 0x01010101); } __builtin_amdgcn_s_setprio(0); } while (0)
#define PG8_MM(ai, bj, At, Bt) do { if constexpr (FP8) PG8_MMA8(ai, bj, At, Bt); else PG8_MMA(ai, bj, At, Bt); } while (0)
#define PG8_WAIT_V(n) asm volatile("s_waitcnt vmcnt(" #n ")" ::: "memory")
#define PG8_WAIT_L(n) asm volatile("s_waitcnt lgkmcnt(" #n ")" ::: "memory")
#define PG8_BAR __builtin_amdgcn_s_barrier()
#define PG8_SCHED __builtin_amdgcn_sched_barrier(0)
    Unit cur, nxt; int ui = 0;
    if (!S.next(0, cur)) return;
    Acc acc;
#pragma unroll
    for (int a = 0; a < 2; ++a)
#pragma unroll
        for (int b = 0; b < 2; ++b)
#pragma unroll
            for (int m = 0; m < 4; ++m)
#pragma unroll
                for (int n = 0; n < 2; ++n) acc[a][b][m][n] = (f32x4){0.f, 0.f, 0.f, 0.f};
    bf16x8 At[4][2], B0[2][2], B1[2][2];
    unsigned vA[2][2];
    S.aoffs(cur, tid, vA, lds, wid, false);
    const char* cA = S.abase(cur); const char* cB = S.bbase(cur);
    PG8_STAGEB(PG8_SB(0, 0), cB); PG8_STAGEB(PG8_SB(0, 1), cB + hstepB); PG8_STAGE2(PG8_SA(0, 0), cA, vA[0][0], vA[0][1]); PG8_STAGE2(PG8_SA(0, 1), cA, vA[1][0], vA[1][1]);
    if (wr == 1) PG8_BAR;
    PG8_WAIT_V(2); PG8_BAR;
    PG8_STAGEB(PG8_SB(1, 0), cB + kstep); PG8_STAGE2(PG8_SA(1, 0), cA + kstep, vA[0][0], vA[0][1]); PG8_STAGEB(PG8_SB(1, 1), cB + hstepB + kstep);
    PG8_WAIT_V(6); PG8_BAR;
    for (;;) {
        E.unit_begin(cur, lds, wid, lane);
        const bool has_next = S.next(ui + 1, nxt);
        const char* nA = cA; const char* nB = cB;
        if (has_next) { nA = S.abase(nxt); nB = S.bbase(nxt); S.prefetch(nxt, lds, wid, lane); }
#ifdef PROBE_REGION
        unsigned long long tk0_ = 0; if (Epi::PID + 100 == PROBE_REGION) tk0_ = __builtin_amdgcn_s_memrealtime();
#endif
        for (int t = 0; t < nt; t += 2) {
            const bool last = (t == nt - 2);
            if constexpr (Epi::HAS_MID) { if (t == Epi::MID_T) E.mid(acc, cur, wr, wc, fr, fq); }
            const char* a1 = cA + (size_t)(t + 1) * kstep;
            const char* a2 = last ? nA : cA + (size_t)(t + 2) * kstep; const char* b2 = last ? nB : cB + (size_t)(t + 2) * kstep;
            const char* a3 = a2 + kstep; const char* b3 = b2 + kstep;
            PG8_LDB(B0, 0, 0); PG8_LDB(B1, 0, 1); PG8_SCHED; PG8_LDA(At, 0, 0); PG8_STAGE2(PG8_SA(1, 1), a1, vA[1][0], vA[1][1]);
            if (last && has_next) S.aoffs(nxt, tid, vA, lds, wid, true);
            PG8_WAIT_V(8); PG8_WAIT_L(0); PG8_BAR; PG8_MM(0, 0, At, B0); PG8_MM(0, 1, At, B1); PG8_BAR; PG8_SCHED;
            PG8_LDA(At, 0, 1); PG8_STAGEB(PG8_SB(0, 0), b2); PG8_STAGEB(PG8_SB(0, 1), b2 + hstepB); PG8_STAGE2(PG8_SA(0, 0), a2, vA[0][0], vA[0][1]);
            PG8_WAIT_V(8); PG8_WAIT_L(0); PG8_BAR; PG8_MM(1, 0, At, B0); PG8_MM(1, 1, At, B1); PG8_BAR; PG8_SCHED;
            PG8_LDB(B0, 1, 0); PG8_LDB(B1, 1, 1); PG8_SCHED; PG8_LDA(At, 1, 0); PG8_STAGE2(PG8_SA(0, 1), a2, vA[1][0], vA[1][1]);
            PG8_WAIT_V(8); PG8_WAIT_L(0); PG8_BAR; PG8_MM(0, 0, At, B0); PG8_MM(0, 1, At, B1); PG8_BAR; PG8_SCHED;
            PG8_LDA(At, 1, 1); PG8_STAGEB(PG8_SB(1, 0), b3); PG8_STAGEB(PG8_SB(1, 1), b3 + hstepB); PG8_STAGE2(PG8_SA(1, 0), a3, vA[0][0], vA[0][1]);
            PG8_WAIT_V(8); PG8_WAIT_L(0); PG8_BAR; PG8_MM(1, 0, At, B0); PG8_MM(1, 1, At, B1); PG8_BAR; PG8_SCHED;
        }
        if constexpr (ALIGN_EPI) { if (wr == 0) PG8_BAR; }
#ifdef PROBE_REGION
        if (Epi::PID + 100 == PROBE_REGION && tid == 0) { volatile LAS unsigned* m_ = (volatile LAS unsigned*)(lds + 131072); m_[16] += (unsigned)(__builtin_amdgcn_s_memrealtime() - tk0_); }
        { unsigned long long t0_ = 0; if (Epi::PID == PROBE_REGION) t0_ = __builtin_amdgcn_s_memrealtime();
          unsigned z_ = 0; asm volatile("" : "+v"(z_)); const int l2 = (int)__builtin_amdgcn_mbcnt_hi(~0u, __builtin_amdgcn_mbcnt_lo(~0u, z_));
          E(acc, cur, wr, wc, l2 & 15, l2 >> 4);
          if (Epi::PID == PROBE_REGION && wid == 0 && l2 == 0) { asm volatile("s_waitcnt vmcnt(0)" ::: "memory"); volatile LAS unsigned* m_ = (volatile LAS unsigned*)(lds + 131072); m_[16] += (unsigned)(__builtin_amdgcn_s_memrealtime() - t0_); } }
#else
        { unsigned z_ = 0; asm volatile("" : "+v"(z_)); const int l2 = (int)__builtin_amdgcn_mbcnt_hi(~0u, __builtin_amdgcn_mbcnt_lo(~0u, z_));
          E(acc, cur, wr, wc, l2 & 15, l2 >> 4); }
#endif
        if (!has_next) break;
#pragma unroll
        for (int a = 0; a < 2; ++a)
#pragma unroll
            for (int b = 0; b < 2; ++b)
#pragma unroll
                for (int m = 0; m < 4; ++m)
#pragma unroll
                    for (int n = 0; n < 2; ++n) acc[a][b][m][n] = (f32x4){0.f, 0.f, 0.f, 0.f};
        cur = nxt; cA = nA; cB = nB; ++ui;
        if constexpr (ALIGN_EPI) { if (wr == 1) PG8_BAR; }
    }
    PG8_WAIT_V(0);
    if constexpr (!ALIGN_EPI) { if (wr == 0) PG8_BAR; }
    PG8_BAR;
#undef PG8_SA
#undef PG8_SB
#undef PG8_STAGE2
#undef PG8_STAGEB
#undef PG8_LDA
#undef PG8_LDB
#undef PG8_MMA
#undef PG8_MMA8
#undef PG8_MM
#undef PG8_WAIT_V
#undef PG8_WAIT_L
#undef PG8_BAR
#undef PG8_SCHED
}
}
constexpr int NWAVES = 8;
constexpr int RING_BYTES = 131072;
constexpr int MISC_OFF = RING_BYTES;
constexpr int LDS_BYTES = 163840;
constexpr int PARAMS_OFF = MISC_OFF + 1024;
constexpr int SPW_OFF = MISC_OFF + 2048, SPW_BYTES = 3712, STATS_OFF = SPW_OFF + 8 * SPW_BYTES;

#define XB_TMO      128
#define XB_XCNT(j)  (256  + 64 * (j))
#define XB_XSUB(j)  (1280 + 64 * (j))
#define XB_XGEN(j)  (2304 + 64 * (j))
#define XB_TOP      3328
#define XB_TOPGEN   3392
#define XCD_BAR_WORDS 3456
#define XB_SPIN_CAP (1u << 22)
DEV unsigned xb_ld(GAS unsigned* p) { return __hip_atomic_load(p, __ATOMIC_RELAXED, __HIP_MEMORY_SCOPE_AGENT); }
DEV unsigned xb_add(GAS unsigned* p, unsigned v) { return __hip_atomic_fetch_add(p, v, __ATOMIC_RELAXED, __HIP_MEMORY_SCOPE_AGENT); }
DEV unsigned xb_xcc_id() { return (unsigned)__builtin_amdgcn_s_getreg((3 << 11) | 20) & 0xFu; }
#define XB_SPIN(cond, bar) do { unsigned _sp = 0; while (cond) { __builtin_amdgcn_s_sleep(1); \
    if ((++_sp & 255u) == 0u) { if (xb_ld(&(bar)[XB_TMO])) break; if (_sp > XB_SPIN_CAP) { xb_add(&(bar)[XB_TMO], 1u); break; } } } } while (0)
struct XcdBarrier { GAS unsigned* bar; unsigned x; volatile LAS unsigned* st; };
DEV XcdBarrier xcd_barrier_post(GAS unsigned* bar, volatile LAS unsigned* st) {
    XcdBarrier b; b.bar = bar; b.x = xb_xcc_id(); b.st = st;
    if (threadIdx.x == 0) (void)xb_add(&bar[XB_XCNT(b.x)], 1u);
    return b;
}
DEV void xcd_barrier_complete(GAS unsigned* bar, unsigned x, unsigned& nloc, unsigned& nx) {
    const unsigned G = gridDim.x * gridDim.y * gridDim.z;
    unsigned sum, cnt, mine, sp = 0u;
    for (;;) {
        sum = 0u; cnt = 0u; mine = 0u;
#pragma unroll
        for (unsigned j = 0; j < 16; ++j) { const unsigned c = xb_ld(&bar[XB_XCNT(j)]); sum += c; cnt += (c > 0u) ? 1u : 0u; mine = (j == x) ? c : mine; }
        if (sum == G) break;
        __builtin_amdgcn_s_sleep(1);
        if ((++sp & 255u) == 0u) { if (xb_ld(&bar[XB_TMO])) break; if (sp > XB_SPIN_CAP) { xb_add(&bar[XB_TMO], 1u); break; } }
    }
    nloc = mine > 0u ? mine : 1u; nx = cnt > 0u ? cnt : 1u;
}
DEV void xcd_barrier(const XcdBarrier& b) {
    asm volatile("s_waitcnt vmcnt(0)" ::: "memory");
    __syncthreads();
    if (threadIdx.x == 0) {
        GAS unsigned* bar = b.bar; asm volatile("" : "+s"(bar));
        __builtin_amdgcn_s_waitcnt(0);
        unsigned nloc = b.st[0], nx = b.st[1];
        if (nloc == 0u) { xcd_barrier_complete(bar, b.x, nloc, nx); b.st[0] = nloc; b.st[1] = nx; }
        const unsigned old = xb_add(&bar[XB_XSUB(b.x)], 1u);
        const unsigned gen = old / nloc;
        if (old + 1u == (gen + 1u) * nloc) {
            __builtin_amdgcn_fence(__ATOMIC_RELEASE, "agent");
            asm volatile("s_waitcnt vmcnt(0)" ::: "memory");
            const unsigned og = xb_add(&bar[XB_TOP], 1u);
            const unsigned tg = og / nx;
            if (og + 1u == (tg + 1u) * nx) xb_add(&bar[XB_TOPGEN], 1u);
            else XB_SPIN(xb_ld(&bar[XB_TOPGEN]) == tg, bar);
            __builtin_amdgcn_fence(__ATOMIC_ACQUIRE, "agent");
            xb_add(&bar[XB_XGEN(b.x)], 1u);
            asm volatile("s_waitcnt vmcnt(0)" ::: "memory");
        } else {
            XB_SPIN(xb_ld(&bar[XB_XGEN(b.x)]) == gen, bar);
            __builtin_amdgcn_fence(__ATOMIC_ACQUIRE, "agent");
            asm volatile("s_waitcnt vmcnt(0)" ::: "memory");
        }
    }
    __syncthreads();
}

#ifdef PROBE_REGION
#define TREG_BEGIN(k) unsigned long long _treg##k = 0; if ((k) == PROBE_REGION) _treg##k = __builtin_amdgcn_s_memrealtime()
#define TREG_END(k, F) do { if ((k) == PROBE_REGION && (F).tid == 0) { volatile LAS unsigned* _m = (volatile LAS unsigned*)((F).lds + MISC_OFF); _m[16] += (unsigned)(__builtin_amdgcn_s_memrealtime() - _treg##k); } } while (0)
#else
#define TREG_BEGIN(k) do {} while (0)
#define TREG_END(k, F) do {} while (0)
#endif
struct Frame { LAS unsigned char* lds; unsigned char* ldsg; int tid, lane, wave, G, bx; };
DEV unsigned long long ldp64(const LAS unsigned* q, int i) { const unsigned lo = __builtin_amdgcn_readfirstlane(q[2 * i]), hi = __builtin_amdgcn_readfirstlane(q[2 * i + 1]); return ((unsigned long long)hi << 32) | lo; }
DEV Params load_params(const Frame& F) {
    unsigned off_ = PARAMS_OFF; asm volatile("" : "+v"(off_));
    Params p; const LAS unsigned* q = (const LAS unsigned*)(F.lds + off_);
    p.x = (const float*)(const GAS float*)ldp64(q, 0);
    p.c = (const float*)(const GAS float*)ldp64(q, 1);
    p.ctx = (const float*)(const GAS float*)ldp64(q, 2);
    p.c_ctx = (const float*)(const GAS float*)ldp64(q, 3);
    p.w_mod = (const float*)(const GAS float*)ldp64(q, 4);
    p.b_mod = (const float*)(const GAS float*)ldp64(q, 5);
    p.g_pre_mix = (const float*)(const GAS float*)ldp64(q, 6);
    p.g_post_mix = (const float*)(const GAS float*)ldp64(q, 7);
    p.g_pre_ffn = (const float*)(const GAS float*)ldp64(q, 8);
    p.g_post_ffn = (const float*)(const GAS float*)ldp64(q, 9);
    p.w_in = (const float*)(const GAS float*)ldp64(q, 10);
    p.ln_g = (const float*)(const GAS float*)ldp64(q, 11);
    p.ln_b = (const float*)(const GAS float*)ldp64(q, 12);
    p.gws = (const float*)(const GAS float*)ldp64(q, 13);
    p.gbs = (const float*)(const GAS float*)ldp64(q, 14);
    p.conv_w = (const float*)(const GAS float*)ldp64(q, 15);
    p.conv_b = (const float*)(const GAS float*)ldp64(q, 16);
    p.lru_wa = (const float*)(const GAS float*)ldp64(q, 17);
    p.lru_ba = (const float*)(const GAS float*)ldp64(q, 18);
    p.lru_wx = (const float*)(const GAS float*)ldp64(q, 19);
    p.lru_bx = (const float*)(const GAS float*)ldp64(q, 20);
    p.lru_lam = (const float*)(const GAS float*)ldp64(q, 21);
    p.w_out_a = (const float*)(const GAS float*)ldp64(q, 22);
    p.w_out_b = (const float*)(const GAS float*)ldp64(q, 23);
    p.w_out = (const float*)(const GAS float*)ldp64(q, 24);
    p.router_w = (const float*)(const GAS float*)ldp64(q, 25);
    p.router_b = (const float*)(const GAS float*)ldp64(q, 26);
    p.e_g = (const float*)(const GAS float*)ldp64(q, 27);
    p.e_u = (const float*)(const GAS float*)ldp64(q, 28);
    p.e_d = (const float*)(const GAS float*)ldp64(q, 29);
    p.s_g = (const float*)(const GAS float*)ldp64(q, 30);
    p.s_u = (const float*)(const GAS float*)ldp64(q, 31);
    p.s_d = (const float*)(const GAS float*)ldp64(q, 32);
    p.out = (float*)(GAS float*)ldp64(q, 33); p.ws = (unsigned char*)(GAS unsigned char*)ldp64(q, 34);
    return p;
}
DEV void store_params(const Frame& F, const Params& a) {
    if (F.tid == 0) { LAS unsigned long long* q = (LAS unsigned long long*)(F.lds + PARAMS_OFF);
        q[0] = (unsigned long long)a.x;
        q[1] = (unsigned long long)a.c;
        q[2] = (unsigned long long)a.ctx;
        q[3] = (unsigned long long)a.c_ctx;
        q[4] = (unsigned long long)a.w_mod;
        q[5] = (unsigned long long)a.b_mod;
        q[6] = (unsigned long long)a.g_pre_mix;
        q[7] = (unsigned long long)a.g_post_mix;
        q[8] = (unsigned long long)a.g_pre_ffn;
        q[9] = (unsigned long long)a.g_post_ffn;
        q[10] = (unsigned long long)a.w_in;
        q[11] = (unsigned long long)a.ln_g;
        q[12] = (unsigned long long)a.ln_b;
        q[13] = (unsigned long long)a.gws;
        q[14] = (unsigned long long)a.gbs;
        q[15] = (unsigned long long)a.conv_w;
        q[16] = (unsigned long long)a.conv_b;
        q[17] = (unsigned long long)a.lru_wa;
        q[18] = (unsigned long long)a.lru_ba;
        q[19] = (unsigned long long)a.lru_wx;
        q[20] = (unsigned long long)a.lru_bx;
        q[21] = (unsigned long long)a.lru_lam;
        q[22] = (unsigned long long)a.w_out_a;
        q[23] = (unsigned long long)a.w_out_b;
        q[24] = (unsigned long long)a.w_out;
        q[25] = (unsigned long long)a.router_w;
        q[26] = (unsigned long long)a.router_b;
        q[27] = (unsigned long long)a.e_g;
        q[28] = (unsigned long long)a.e_u;
        q[29] = (unsigned long long)a.e_d;
        q[30] = (unsigned long long)a.s_g;
        q[31] = (unsigned long long)a.s_u;
        q[32] = (unsigned long long)a.s_d;
        q[33] = (unsigned long long)a.out; q[34] = (unsigned long long)a.ws; }
}

DEV void transpose_item(const float* W, int N, bf16_t* WT, int dK, int koff, int rbase, int rhi, LAS float* scr, int kb, int nb, int lane, float scale = 1.0f) {
    const int k0 = 64 * kb, n0 = 32 * nb;
    float4 ld[8];
#pragma unroll
    for (int i = 0; i < 8; ++i) ld[i] = *(const float4*)(W + (size_t)(k0 + 8 * i + (lane >> 3)) * N + n0 + (lane & 7) * 4);
#pragma unroll
    for (int i = 0; i < 8; ++i) { LAS float* d = scr + (8 * i + (lane >> 3)) * 33 + (lane & 7) * 4; d[0] = ld[i].x; d[1] = ld[i].y; d[2] = ld[i].z; d[3] = ld[i].w; }
    asm volatile("s_waitcnt lgkmcnt(0)" ::: "memory");
    const int cc = lane & 7;
#pragma unroll
    for (int j = 0; j < 4; ++j) { const int nl = (lane >> 3) + 8 * j, n = n0 + nl; const LAS float* s = scr + (8 * cc) * 33 + nl;
        u32x4 o; o.x = pk2(s[0 * 33] * scale, s[1 * 33] * scale); o.y = pk2(s[2 * 33] * scale, s[3 * 33] * scale); o.z = pk2(s[4 * 33] * scale, s[5 * 33] * scale); o.w = pk2(s[6 * 33] * scale, s[7 * 33] * scale);
        const int drow = rbase + (n >> 7) * rhi + (n & 127);
        *(u32x4*)(WT + (size_t)drow * dK + koff + k0 + 8 * cc) = o; }
    asm volatile("s_waitcnt lgkmcnt(0)" ::: "memory");
}
DEV void transpose_item8(const float* W, int N, unsigned char* WT, int dK, int rbase, int rhi, LAS float* scr, int kb, int nb, int lane) {
    const int k0 = 64 * kb, n0 = 32 * nb;
    float4 ld[8];
#pragma unroll
    for (int i = 0; i < 8; ++i) ld[i] = *(const float4*)(W + (size_t)(k0 + 8 * i + (lane >> 3)) * N + n0 + (lane & 7) * 4);
#pragma unroll
    for (int i = 0; i < 8; ++i) { LAS float* d = scr + (8 * i + (lane >> 3)) * 33 + (lane & 7) * 4; d[0] = ld[i].x; d[1] = ld[i].y; d[2] = ld[i].z; d[3] = ld[i].w; }
    asm volatile("s_waitcnt lgkmcnt(0)" ::: "memory");
    const int cc = lane & 7;
#pragma unroll
    for (int j = 0; j < 4; ++j) { const int nl = (lane >> 3) + 8 * j, n = n0 + nl; const LAS float* s = scr + (8 * cc) * 33 + nl;
        unsigned lo = 0, hi = 0;
        lo = __builtin_amdgcn_cvt_pk_fp8_f32(s[0 * 33] * 64.f, s[1 * 33] * 64.f, lo, false); lo = __builtin_amdgcn_cvt_pk_fp8_f32(s[2 * 33] * 64.f, s[3 * 33] * 64.f, lo, true);
        hi = __builtin_amdgcn_cvt_pk_fp8_f32(s[4 * 33] * 64.f, s[5 * 33] * 64.f, hi, false); hi = __builtin_amdgcn_cvt_pk_fp8_f32(s[6 * 33] * 64.f, s[7 * 33] * 64.f, hi, true);
        const int drow = rbase + (n >> 7) * rhi + (n & 127);
        *(u32x2*)(WT + (size_t)drow * dK + k0 + 8 * cc) = (u32x2){lo, hi}; }
    asm volatile("s_waitcnt lgkmcnt(0)" ::: "memory");
}
struct T8Item { const float* W; unsigned char* WT; int N, dK, rbase, rhi, kb, nb; };
DEV void t8_load(const T8Item& t, int lane, float4 (&ld)[8]) {
    const int k0 = 64 * t.kb, n0 = 32 * t.nb;
#pragma unroll
    for (int i = 0; i < 8; ++i) { const f32x4 t4_ = __builtin_nontemporal_load((const f32x4*)(t.W + (size_t)(k0 + 8 * i + (lane >> 3)) * t.N + n0 + (lane & 7) * 4)); ld[i] = make_float4(t4_[0], t4_[1], t4_[2], t4_[3]); }
}
DEV void t8_store(const T8Item& t, int lane, const float4 (&ld)[8], LAS float* scr) {
    const int k0 = 64 * t.kb, n0 = 32 * t.nb;
#pragma unroll
    for (int i = 0; i < 8; ++i) { LAS float* d = scr + (8 * i + (lane >> 3)) * 33 + (lane & 7) * 4; d[0] = ld[i].x; d[1] = ld[i].y; d[2] = ld[i].z; d[3] = ld[i].w; }
    asm volatile("s_waitcnt lgkmcnt(0)" ::: "memory");
    const int cc = lane & 7;
#pragma unroll
    for (int j = 0; j < 4; ++j) { const int nl = (lane >> 3) + 8 * j, n = n0 + nl; const LAS float* s = scr + (8 * cc) * 33 + nl;
        unsigned lo = 0, hi = 0;
        lo = __builtin_amdgcn_cvt_pk_fp8_f32(s[0 * 33] * 64.f, s[1 * 33] * 64.f, lo, false); lo = __builtin_amdgcn_cvt_pk_fp8_f32(s[2 * 33] * 64.f, s[3 * 33] * 64.f, lo, true);
        hi = __builtin_amdgcn_cvt_pk_fp8_f32(s[4 * 33] * 64.f, s[5 * 33] * 64.f, hi, false); hi = __builtin_amdgcn_cvt_pk_fp8_f32(s[6 * 33] * 64.f, s[7 * 33] * 64.f, hi, true);
        const int drow = t.rbase + (n >> 7) * t.rhi + (n & 127);
        *(u32x2*)(t.WT + (size_t)drow * t.dK + k0 + 8 * cc) = (u32x2){lo, hi}; }
    asm volatile("s_waitcnt lgkmcnt(0)" ::: "memory");
}
template <class Desc> DEV void t8_run(const Desc& desc, int I, int vw, int nvw, int lane, LAS float* scr) {
    float4 A[8], B[8]; int it = vw; if (it >= I) return;
    T8Item da = desc(it), db = da; t8_load(da, lane, A);
    for (;;) {
        const int i1 = it + nvw; const bool h1 = i1 < I;
        if (h1) { db = desc(i1); t8_load(db, lane, B); }
        t8_store(da, lane, A, scr);
        if (!h1) break;
        const int i2 = i1 + nvw; const bool h2 = i2 < I;
        if (h2) { da = desc(i2); t8_load(da, lane, A); }
        t8_store(db, lane, B, scr);
        if (!h2) break;
        it = i2;
    }
}
DEV void convert_weights(const Params& p, const Frame& F, int l, int part, int vw, int nvw) {
    LAS float* scr = (LAS float*)(F.lds + F.wave * 16384);
    unsigned char* W = p.ws + WS_W;
    const int lane = F.lane;
    constexpr int I_IN = 16 * 128, I_OA = 8 * 32, I_OUT = 16 * 32, I_RT = 16 * 2, I_SG = 16 * 8, I_SD = 4 * 32, I_EG = NE * 16 * 8, I_ED = NE * 4 * 32, I_LRU = 32 * 2;
    if (part == 0) {
        constexpr int NITEMS = I_IN + 2 * I_OA + I_OUT + I_RT + 2 * I_SG + I_SD + I_LRU;
        for (int it = vw; it < NITEMS; it += nvw) {
            int r = it;
#if GIN_FP8
            if (r < I_IN) { transpose_item8(p.w_in + (size_t)l * D * 4096, 4096, W + WO_IN, D, 0, 128, scr, r / 128, r % 128, lane); continue; } r -= I_IN;
#else
            if (r < I_IN) { transpose_item(p.w_in + (size_t)l * D * 4096, 4096, (bf16_t*)(W + WO_IN), D, 0, 0, 128, scr, r / 128, r % 128, lane); continue; } r -= I_IN;
#endif
            if (r < I_OA) { transpose_item(p.w_out_a + (size_t)l * 512 * D, D, (bf16_t*)(W + WO_AB), D, 0, 0, 128, scr, r / 32, r % 32, lane); continue; } r -= I_OA;
            if (r < I_OA) { transpose_item(p.w_out_b + (size_t)l * 512 * D, D, (bf16_t*)(W + WO_AB), D, 512, 0, 128, scr, r / 32, r % 32, lane); continue; } r -= I_OA;
            if (r < I_OUT) { transpose_item(p.w_out + (size_t)l * D * D, D, (bf16_t*)(W + WO_OUT), D, 0, 0, 128, scr, r / 32, r % 32, lane); continue; } r -= I_OUT;
            if (r < I_RT) { transpose_item(p.router_w + (size_t)l * D * 64, 64, (bf16_t*)(W + WO_SR), D, 0, 0, 128, scr, r / 2, r % 2, lane); continue; } r -= I_RT;
            if (r < I_SG) { transpose_item(p.s_g + (size_t)l * D * 256, 256, (bf16_t*)(W + WO_SR), D, 0, 256, 256, scr, r / 8, r % 8, lane); continue; } r -= I_SG;
            if (r < I_SG) { transpose_item(p.s_u + (size_t)l * D * 256, 256, (bf16_t*)(W + WO_SR), D, 0, 256 + 128, 256, scr, r / 8, r % 8, lane); continue; } r -= I_SG;
#if GSD_FP8
            if (r < I_SD) { transpose_item8(p.s_d + (size_t)l * 256 * D, D, W + WO_SD, 256, 0, 128, scr, r / 32, r % 32, lane); continue; } r -= I_SD;
#else
            if (r < I_SD) { transpose_item(p.s_d + (size_t)l * 256 * D, D, (bf16_t*)(W + WO_SD), 256, 0, 0, 128, scr, r / 32, r % 32, lane); continue; } r -= I_SD;
#endif
            { const int mat = r / 2, nb = r % 2, type = mat >> 4, dh = mat & 15;
              const float* src = (type ? p.lru_wx : p.lru_wa) + (size_t)((l * 2) * 8 + dh) * 4096;
              transpose_item(src, 64, (bf16_t*)(W + WO_LRU) + (size_t)mat * 4096, 64, 0, 0, 128, scr, 0, nb, lane, -1.4426950408889634f); }
        }
        const int gt = vw * 64 + lane, NT = nvw * 64;
        for (int i = gt; i < 192 * D / 8; i += NT) *(u32x4*)((bf16_t*)(W + WO_SR) + (size_t)64 * D + (size_t)i * 8) = (u32x4){0u, 0u, 0u, 0u};
        for (int i = gt; i < 8 * 128 * 128 / 4; i += NT) { const float4 v = *(const float4*)(p.gws + (size_t)l * 8 * 128 * 128 + (size_t)i * 4);
            u32x2 o; o.x = pk2(v.x, v.y); o.y = pk2(v.z, v.w); *(u32x2*)((bf16_t*)(W + WO_GWS) + (size_t)i * 4) = o; }
    } else if (part == 2) {
#if GED_FP8
        t8_run([&](int it) { const int e = it / 128, q = it % 128;
            return T8Item{p.e_d + ((size_t)(l * NE + e) * 256) * D, W + WO_ED + (size_t)l * WL_ED + (size_t)e * D * 256, D, 256, 0, 128, q / 32, q % 32}; }, I_ED, vw, nvw, lane, scr);
#else
        for (int it = vw; it < I_ED; it += nvw) { const int e = it / 128, q = it % 128; transpose_item(p.e_d + ((size_t)(l * NE + e) * 256) * D, D, (bf16_t*)(W + WO_ED) + (size_t)e * D * 256, 256, 0, 0, 128, scr, q / 32, q % 32, lane); }
#endif
    } else {
        t8_run([&](int it) { const int up = it >= I_EG, r = it - up * I_EG, e = r / 128, q = r % 128;
            return T8Item{(up ? p.e_u : p.e_g) + ((size_t)(l * NE + e) * D) * 256, W + WO_EG + (size_t)l * WL_EG + (size_t)e * 512 * D, 256, D, up * 128, 256, q / 8, q % 8}; }, 2 * I_EG, vw, nvw, lane, scr);
    }
}
DEV void pe_table(const Params& p, const Frame& F, int idx) {
    const int pos = idx >> 9, half = (idx >> 8) & 1, q = idx & 255;
    const float omega = 1.0f / powf(10000.0f, (float)q / 256.0f);
    const float ang = (float)pos * omega;
    ((float*)(p.ws + WS_PE))[idx] = half ? cosf(ang) : sinf(ang);
}
DEV void mod_items(const Params& p, const Frame& F) {
    LAS float* part = (LAS float*)(F.lds);
    LAS float* sc = (LAS float*)(F.lds + 16384);
    if (F.bx < 2 * 96) {
        for (int i = F.tid; i < 5 * D; i += NWAVES * 64) { const int cnd = i >> 10, d = i & (D - 1); sc[d * 8 + cnd] = siluf_(cnd < 4 ? p.c[cnd * D + d] : p.c_ctx[d]); }
        __syncthreads();
    }
    for (int it = F.bx; it < 2 * 96; it += F.G) {
        const int l = it / 96, e = (it % 96) * 64 + F.lane;
        const float* w = p.w_mod + (size_t)l * D * 6 * D + e;
        float acc[5] = {0.f, 0.f, 0.f, 0.f, 0.f};
        const int d0 = F.wave * 128;
#pragma unroll 32
        for (int d = d0; d < d0 + 128; ++d) { const float wv = __builtin_nontemporal_load(w + (size_t)d * 6 * D); const f32x4 s4 = *(const LAS f32x4*)(sc + d * 8); const float s5 = sc[d * 8 + 4];
            acc[0] += s4[0] * wv; acc[1] += s4[1] * wv; acc[2] += s4[2] * wv; acc[3] += s4[3] * wv; acc[4] += s5 * wv; }
#pragma unroll
        for (int cnd = 0; cnd < 5; ++cnd) part[(F.wave * 5 + cnd) * 64 + F.lane] = acc[cnd];
        __syncthreads();
        if (F.tid < 320) { const int cnd = F.tid >> 6, ln = F.tid & 63; float s = p.b_mod[l * 6 * D + (it % 96) * 64 + ln];
#pragma unroll
            for (int w8 = 0; w8 < 8; ++w8) s += part[(w8 * 5 + cnd) * 64 + ln];
            ((float*)(p.ws + WS_MOD))[(size_t)(l * 5 + cnd) * 6 * D + (it % 96) * 64 + ln] = s; }
        __syncthreads();
    }
}

DEV bf16_t* xl16_row(const Params& p, int r) { return (bf16_t*)((unsigned char*)p.out + (size_t)r * 4096 + 2048); }
DEV void load_xl(const Params& p, int r, int lane, float (&v)[16]) {
    if (r < TL) { const bf16_t* x = xl16_row(p, r);
#pragma unroll
        for (int j = 0; j < 4; ++j) { const ushort4 t = *(const ushort4*)(x + (j * 64 + lane) * 4); v[4 * j] = bf2f(t.x); v[4 * j + 1] = bf2f(t.y); v[4 * j + 2] = bf2f(t.z); v[4 * j + 3] = bf2f(t.w); } }
    else { const float* x = (const float*)(p.ws + WS_XC) + (size_t)(r - TL) * D;
#pragma unroll
        for (int j = 0; j < 4; ++j) { const float4 t = *(const float4*)(x + (j * 64 + lane) * 4); v[4 * j] = t.x; v[4 * j + 1] = t.y; v[4 * j + 2] = t.z; v[4 * j + 3] = t.w; } }
}
DEV void store_xl(const Params& p, int r, int lane, const float (&v)[16], bool final_f32) {
    if (r < TL && !final_f32) { bf16_t* x = xl16_row(p, r);
#pragma unroll
        for (int j = 0; j < 4; ++j) { u32x2 o; o.x = pk2(v[4 * j], v[4 * j + 1]); o.y = pk2(v[4 * j + 2], v[4 * j + 3]); *(u32x2*)(x + (j * 64 + lane) * 4) = o; } }
    else { float* x = r < TL ? p.out + (size_t)r * D : (float*)(p.ws + WS_XC) + (size_t)(r - TL) * D;
#pragma unroll
        for (int j = 0; j < 4; ++j) *(float4*)(x + (j * 64 + lane) * 4) = make_float4(v[4 * j], v[4 * j + 1], v[4 * j + 2], v[4 * j + 3]); }
}
DEV void row_pass_A(const Params& p, int l, int rlo, int rhi, int wave, int nw, int lane) {
    const bf16_t* FL = (const bf16_t*)(p.ws + WS_RY);
    for (int r = rlo + wave; r < rhi; r += nw) {
        const int cond = r < TL ? (r >> 13) : 4;
        float v[16];
        if (l == 0) {
            const float* src = r < TL ? p.x + (size_t)r * D : p.ctx + (size_t)(r - TL) * D;
#pragma unroll
            for (int j = 0; j < 4; ++j) { const float4 t = *(const float4*)(src + (j * 64 + lane) * 4); v[4 * j] = t.x; v[4 * j + 1] = t.y; v[4 * j + 2] = t.z; v[4 * j + 3] = t.w; }
            if (r < TL) {
                const int t = r & (SEQ - 1); const float* PE = (const float*)(p.ws + WS_PE);
#pragma unroll
                for (int j = 0; j < 4; ++j) { const float4 e = *(const float4*)(PE + ((j < 2) ? (t >> 6) : (t & 63)) * 512 + (j & 1) * 256 + lane * 4);
                    v[4 * j] += e.x; v[4 * j + 1] += e.y; v[4 * j + 2] += e.z; v[4 * j + 3] += e.w; }
            }
        } else {
            float f[16]; float ss = 0.f;
            load_xl(p, r, lane, v);
#pragma unroll
            for (int j = 0; j < 4; ++j) {
                const ushort4 fb = *(const ushort4*)(FL + (size_t)r * D + (j * 64 + lane) * 4);
                f[4 * j] = bf2f(fb.x); f[4 * j + 1] = bf2f(fb.y); f[4 * j + 2] = bf2f(fb.z); f[4 * j + 3] = bf2f(fb.w);
            }
            { const unsigned char* SL = p.ws + WS_SLOTS + (size_t)r * 8 * 1024;
                unsigned sv[8][4];
#pragma unroll
                for (int s = 0; s < 8; ++s)
#pragma unroll
                    for (int j = 0; j < 4; ++j) sv[s][j] = *(const unsigned*)(SL + (size_t)s * 1024 + (j * 64 + lane) * 4);
#pragma unroll
                for (int j = 0; j < 4; ++j) { float a0 = 0.f, a1 = 0.f, a2 = 0.f, a3 = 0.f;
#pragma unroll
                    for (int s = 0; s < 8; ++s) { a0 += __builtin_amdgcn_cvt_f32_fp8(sv[s][j], 0); a1 += __builtin_amdgcn_cvt_f32_fp8(sv[s][j], 1); a2 += __builtin_amdgcn_cvt_f32_fp8(sv[s][j], 2); a3 += __builtin_amdgcn_cvt_f32_fp8(sv[s][j], 3); }
                    f[4 * j] += a0 * 0.0625f; f[4 * j + 1] += a1 * 0.0625f; f[4 * j + 2] += a2 * 0.0625f; f[4 * j + 3] += a3 * 0.0625f; } }
#pragma unroll
            for (int i = 0; i < 16; ++i) ss += f[i] * f[i];
            const float rstd = rsqrtf(wave_sum(ss) * (1.f / D) + 1e-6f);
            const float* gt = mod_ptr(p, l - 1, cond, 5); const float* g = p.g_post_ffn + (l - 1) * D;
#pragma unroll
            for (int j = 0; j < 4; ++j) { const float4 gt4 = *(const float4*)(gt + (j * 64 + lane) * 4), g4 = *(const float4*)(g + (j * 64 + lane) * 4);
                v[4 * j] += gt4.x * (f[4 * j] * rstd * g4.x); v[4 * j + 1] += gt4.y * (f[4 * j + 1] * rstd * g4.y); v[4 * j + 2] += gt4.z * (f[4 * j + 2] * rstd * g4.z); v[4 * j + 3] += gt4.w * (f[4 * j + 3] * rstd * g4.w); }
        }
        store_xl(p, r, lane, v, l == 2);
        if (l < 2) {
            float ss = 0.f;
#pragma unroll
            for (int i = 0; i < 16; ++i) ss += v[i] * v[i];
            const float rstd = rsqrtf(wave_sum(ss) * (1.f / D) + 1e-6f);
            const float* sh = mod_ptr(p, l, cond, 0); const float* sc = mod_ptr(p, l, cond, 1); const float* g = p.g_pre_mix + l * D;
#pragma unroll
            for (int j = 0; j < 4; ++j) { const int d = (j * 64 + lane) * 4; const float4 sh4 = *(const float4*)(sh + d), sc4 = *(const float4*)(sc + d), g4 = *(const float4*)(g + d);
                u32x2 o; o.x = pk2(v[4 * j] * rstd * g4.x * (1.f + sc4.x) + sh4.x, v[4 * j + 1] * rstd * g4.y * (1.f + sc4.y) + sh4.y);
                o.y = pk2(v[4 * j + 2] * rstd * g4.z * (1.f + sc4.z) + sh4.z, v[4 * j + 3] * rstd * g4.w * (1.f + sc4.w) + sh4.w);
#if GIN_FP8
                { const float h0 = __uint_as_float(o.x << 16) * 16.f, h1 = __uint_as_float(o.x & 0xffff0000u) * 16.f, h2 = __uint_as_float(o.y << 16) * 16.f, h3 = __uint_as_float(o.y & 0xffff0000u) * 16.f;
                  unsigned t = 0; t = __builtin_amdgcn_cvt_pk_fp8_f32(__builtin_amdgcn_fmed3f(h0, -440.f, 440.f), __builtin_amdgcn_fmed3f(h1, -440.f, 440.f), t, false);
                  t = __builtin_amdgcn_cvt_pk_fp8_f32(__builtin_amdgcn_fmed3f(h2, -440.f, 440.f), __builtin_amdgcn_fmed3f(h3, -440.f, 440.f), t, true);
                  *(unsigned*)(p.ws + WS_H8 + (size_t)r * D + d) = t; }
#else
                *(u32x2*)((bf16_t*)(p.ws + WS_RY) + (size_t)r * D + d) = o;
#endif
            }
        }
    }
}
DEV void row_pass_H(const Params& p, int l, int rlo, int rhi, int wave, int nw, int lane) {
    const bf16_t* YL = (const bf16_t*)(p.ws + WS_Z);
    bf16_t* H = (bf16_t*)(p.ws + WS_RA);
    for (int r = rlo + wave; r < rhi; r += nw) {
        const int cond = r < TL ? (r >> 13) : 4;
        float v[16], f[16]; float ss = 0.f;
        load_xl(p, r, lane, v);
#pragma unroll
        for (int j = 0; j < 4; ++j) {
            const ushort4 fb = *(const ushort4*)(YL + (size_t)r * D + (j * 64 + lane) * 4);
            f[4 * j] = bf2f(fb.x); f[4 * j + 1] = bf2f(fb.y); f[4 * j + 2] = bf2f(fb.z); f[4 * j + 3] = bf2f(fb.w);
        }
#pragma unroll
        for (int i = 0; i < 16; ++i) ss += f[i] * f[i];
        const float rstd = rsqrtf(wave_sum(ss) * (1.f / D) + 1e-6f);
        const float* gt = mod_ptr(p, l, cond, 2); const float* g = p.g_post_mix + l * D;
#pragma unroll
        for (int j = 0; j < 4; ++j) { const float4 gt4 = *(const float4*)(gt + (j * 64 + lane) * 4), g4 = *(const float4*)(g + (j * 64 + lane) * 4);
            v[4 * j] += gt4.x * (f[4 * j] * rstd * g4.x); v[4 * j + 1] += gt4.y * (f[4 * j + 1] * rstd * g4.y); v[4 * j + 2] += gt4.z * (f[4 * j + 2] * rstd * g4.z); v[4 * j + 3] += gt4.w * (f[4 * j + 3] * rstd * g4.w); }
        store_xl(p, r, lane, v, false);
        float s2 = 0.f;
#pragma unroll
        for (int i = 0; i < 16; ++i) s2 += v[i] * v[i];
        const float rstd2 = rsqrtf(wave_sum(s2) * (1.f / D) + 1e-6f);
        const float* sh = mod_ptr(p, l, cond, 3); const float* sc = mod_ptr(p, l, cond, 4); const float* g2 = p.g_pre_ffn + l * D;
#pragma unroll
        for (int j = 0; j < 4; ++j) { const int d = (j * 64 + lane) * 4; const float4 sh4 = *(const float4*)(sh + d), sc4 = *(const float4*)(sc + d), g4 = *(const float4*)(g2 + d);
            u32x2 o; o.x = pk2(v[4 * j] * rstd2 * g4.x * (1.f + sc4.x) + sh4.x, v[4 * j + 1] * rstd2 * g4.y * (1.f + sc4.y) + sh4.y);
            o.y = pk2(v[4 * j + 2] * rstd2 * g4.z * (1.f + sc4.z) + sh4.z, v[4 * j + 3] * rstd2 * g4.w * (1.f + sc4.w) + sh4.w);
            *(u32x2*)(H + (size_t)r * D + d) = o;
            { const float h0 = __uint_as_float(o.x << 16) * 16.f, h1 = __uint_as_float(o.x & 0xffff0000u) * 16.f, h2 = __uint_as_float(o.y << 16) * 16.f, h3 = __uint_as_float(o.y & 0xffff0000u) * 16.f;
              unsigned t = 0; t = __builtin_amdgcn_cvt_pk_fp8_f32(__builtin_amdgcn_fmed3f(h0, -440.f, 440.f), __builtin_amdgcn_fmed3f(h1, -440.f, 440.f), t, false);
              t = __builtin_amdgcn_cvt_pk_fp8_f32(__builtin_amdgcn_fmed3f(h2, -440.f, 440.f), __builtin_amdgcn_fmed3f(h3, -440.f, 440.f), t, true);
              *(unsigned*)(p.ws + WS_H2E + (size_t)r * D + d) = t; } }
    }
}

DEV void cvt4(const u32x2 w, float* o) { o[0] = __uint_as_float(w.x << 16); o[1] = __uint_as_float(w.x & 0xffff0000u); o[2] = __uint_as_float(w.y << 16); o[3] = __uint_as_float(w.y & 0xffff0000u); }
DEV unsigned e4m3x4_x16(const u32x2 o) {
    const float h0 = __uint_as_float(o.x << 16) * 16.f, h1 = __uint_as_float(o.x & 0xffff0000u) * 16.f, h2 = __uint_as_float(o.y << 16) * 16.f, h3 = __uint_as_float(o.y & 0xffff0000u) * 16.f;
    unsigned t = 0; t = __builtin_amdgcn_cvt_pk_fp8_f32(__builtin_amdgcn_fmed3f(h0, -440.f, 440.f), __builtin_amdgcn_fmed3f(h1, -440.f, 440.f), t, false);
    return __builtin_amdgcn_cvt_pk_fp8_f32(__builtin_amdgcn_fmed3f(h2, -440.f, 440.f), __builtin_amdgcn_fmed3f(h3, -440.f, 440.f), t, true);
}
DEV void load_prod(const float* a, const float* b, int lane, float* o) {
#pragma unroll
    for (int j = 0; j < 4; ++j) { const float4 x = *(const float4*)(a + (j * 64 + lane) * 4), y = *(const float4*)(b + (j * 64 + lane) * 4); o[4 * j] = x.x * y.x; o[4 * j + 1] = x.y * y.y; o[4 * j + 2] = x.z * y.z; o[4 * j + 3] = x.w * y.w; }
}
DEV void load_affine(const float* g, const float* sc, const float* sh, int lane, float* am, float* bm) {
#pragma unroll
    for (int j = 0; j < 4; ++j) { const int d = (j * 64 + lane) * 4; const float4 g4 = *(const float4*)(g + d), s4 = *(const float4*)(sc + d), h4 = *(const float4*)(sh + d);
        am[4 * j] = g4.x * (1.f + s4.x); am[4 * j + 1] = g4.y * (1.f + s4.y); am[4 * j + 2] = g4.z * (1.f + s4.z); am[4 * j + 3] = g4.w * (1.f + s4.w);
        bm[4 * j] = h4.x; bm[4 * j + 1] = h4.y; bm[4 * j + 2] = h4.z; bm[4 * j + 3] = h4.w; }
}
DEV float sumsq16(const float* v) { float s = 0.f;
#pragma unroll
    for (int i = 0; i < 16; ++i) s += v[i] * v[i];
    return s; }
DEV void emit_h(const float* v, float rstd2, const float* am, const float* bm, int lane, bf16_t* dst16, unsigned char* dst8) {
#pragma unroll
    for (int j = 0; j < 4; ++j) { const int d = (j * 64 + lane) * 4;
        u32x2 o; o.x = pk2(v[4 * j] * rstd2 * am[4 * j] + bm[4 * j], v[4 * j + 1] * rstd2 * am[4 * j + 1] + bm[4 * j + 1]);
        o.y = pk2(v[4 * j + 2] * rstd2 * am[4 * j + 2] + bm[4 * j + 2], v[4 * j + 3] * rstd2 * am[4 * j + 3] + bm[4 * j + 3]);
        if (dst16) __builtin_nontemporal_store(o, (u32x2*)(dst16 + d));
        if (dst8) __builtin_nontemporal_store(e4m3x4_x16(o), (unsigned*)(dst8 + d)); }
}
DEV void store_xl16(const Params& p, int r, int lane, const float* v) { bf16_t* x = xl16_row(p, r);
#pragma unroll
    for (int j = 0; j < 4; ++j) { u32x2 o; o.x = pk2(v[4 * j], v[4 * j + 1]); o.y = pk2(v[4 * j + 2], v[4 * j + 3]); __builtin_nontemporal_store(o, (u32x2*)(x + (j * 64 + lane) * 4)); }
}
DEV void row_lat_A0(const Params& p, int wave, int nw, int lane) {
    const float* PE = (const float*)(p.ws + WS_PE);
    float am[16], bm[16]; int condp = -1;
    float4 xr[2][4], pr[2][4];
    int r = wave; if (r >= TL) return;
#define ROWA0_LOAD(q, rr) do { const int t_ = (rr) & (SEQ - 1); \
        _Pragma("unroll") for (int j = 0; j < 4; ++j) { { const f32x4 t4_ = __builtin_nontemporal_load((const f32x4*)(p.x + (size_t)(rr) * D + (j * 64 + lane) * 4)); xr[q][j] = make_float4(t4_[0], t4_[1], t4_[2], t4_[3]); } pr[q][j] = *(const float4*)(PE + ((j < 2) ? (t_ >> 6) : (t_ & 63)) * 512 + (j & 1) * 256 + lane * 4); } } while (0)
    ROWA0_LOAD(0, r); ROWA0_LOAD(1, r + nw);
    for (; r < TL; r += 2 * nw) {
        float v[2][16];
#pragma unroll
        for (int q = 0; q < 2; ++q)
#pragma unroll
            for (int j = 0; j < 4; ++j) { v[q][4 * j] = xr[q][j].x + pr[q][j].x; v[q][4 * j + 1] = xr[q][j].y + pr[q][j].y; v[q][4 * j + 2] = xr[q][j].z + pr[q][j].z; v[q][4 * j + 3] = xr[q][j].w + pr[q][j].w; }
        const int rl = (r + 2 * nw < TL) ? r + 2 * nw : r;
        ROWA0_LOAD(0, rl); ROWA0_LOAD(1, rl + nw);
        const int cond = r >> 13;
        if (cond != condp) { condp = cond; load_affine(p.g_pre_mix, mod_ptr(p, 0, cond, 1), mod_ptr(p, 0, cond, 0), lane, am, bm); }
#pragma unroll
        for (int q = 0; q < 2; ++q) { const int rq = r + q * nw;
            store_xl16(p, rq, lane, v[q]);
            const float rstd2 = rsqrtf(wave_sum(sumsq16(v[q])) * (1.f / D) + 1e-6f);
#if GIN_FP8
            emit_h(v[q], rstd2, am, bm, lane, nullptr, p.ws + WS_H8 + (size_t)rq * D);
#else
            emit_h(v[q], rstd2, am, bm, lane, (bf16_t*)(p.ws + WS_RY) + (size_t)rq * D, nullptr);
#endif
        }
    }
#undef ROWA0_LOAD
}
DEV void row_lat_A(const Params& p, int l, int wave, int nw, int lane) {
    const bf16_t* FL = (const bf16_t*)(p.ws + WS_RY);
    float gtg[16], am[16], bm[16]; int condp = -1;
    u32x2 xr[4], fr[4]; unsigned sr[8][4];
    int r = wave; if (r >= TL) return;
#define ROWA_LOAD(rr) do { const bf16_t* x_ = xl16_row(p, (rr)); const unsigned char* SL_ = p.ws + WS_SLOTS + (size_t)(rr) * 8 * 1024; \
        _Pragma("unroll") for (int j = 0; j < 4; ++j) { xr[j] = __builtin_nontemporal_load((const u32x2*)(x_ + (j * 64 + lane) * 4)); fr[j] = __builtin_nontemporal_load((const u32x2*)(FL + (size_t)(rr) * D + (j * 64 + lane) * 4)); } \
        _Pragma("unroll") for (int s_ = 0; s_ < 8; ++s_) _Pragma("unroll") for (int j = 0; j < 4; ++j) sr[s_][j] = __builtin_nontemporal_load((const unsigned*)(SL_ + (size_t)s_ * 1024 + (j * 64 + lane) * 4)); } while (0)
    ROWA_LOAD(r);
    for (; r < TL; r += nw) {
        float v[16], f[16];
#pragma unroll
        for (int j = 0; j < 4; ++j) { cvt4(xr[j], v + 4 * j); cvt4(fr[j], f + 4 * j);
            float a0 = 0.f, a1 = 0.f, a2 = 0.f, a3 = 0.f;
#pragma unroll
            for (int s8 = 0; s8 < 8; ++s8) { a0 += __builtin_amdgcn_cvt_f32_fp8(sr[s8][j], 0); a1 += __builtin_amdgcn_cvt_f32_fp8(sr[s8][j], 1); a2 += __builtin_amdgcn_cvt_f32_fp8(sr[s8][j], 2); a3 += __builtin_amdgcn_cvt_f32_fp8(sr[s8][j], 3); }
            f[4 * j] += a0 * 0.0625f; f[4 * j + 1] += a1 * 0.0625f; f[4 * j + 2] += a2 * 0.0625f; f[4 * j + 3] += a3 * 0.0625f; }
        const int rl = (r + nw < TL) ? r + nw : r;
        ROWA_LOAD(rl);
        const int cond = r >> 13;
        if (cond != condp) { condp = cond; load_prod(mod_ptr(p, l - 1, cond, 5), p.g_post_ffn + (l - 1) * D, lane, gtg);
            if (l < 2) load_affine(p.g_pre_mix + l * D, mod_ptr(p, l, cond, 1), mod_ptr(p, l, cond, 0), lane, am, bm); }
        const float rstd = rsqrtf(wave_sum(sumsq16(f)) * (1.f / D) + 1e-6f);
#pragma unroll
        for (int i = 0; i < 16; ++i) v[i] += gtg[i] * (f[i] * rstd);
        if (l == 2) { float* x = p.out + (size_t)r * D;
#pragma unroll
            for (int j = 0; j < 4; ++j) __builtin_nontemporal_store((f32x4){v[4 * j], v[4 * j + 1], v[4 * j + 2], v[4 * j + 3]}, (f32x4*)(x + (j * 64 + lane) * 4));
        } else {
            store_xl16(p, r, lane, v);
            const float rstd2 = rsqrtf(wave_sum(sumsq16(v)) * (1.f / D) + 1e-6f);
#if GIN_FP8
            emit_h(v, rstd2, am, bm, lane, nullptr, p.ws + WS_H8 + (size_t)r * D);
#else
            emit_h(v, rstd2, am, bm, lane, (bf16_t*)(p.ws + WS_RY) + (size_t)r * D, nullptr);
#endif
        }
    }
#undef ROWA_LOAD
}
DEV void row_lat_H(const Params& p, int l, int wave, int nw, int lane) {
    const bf16_t* YL = (const bf16_t*)(p.ws + WS_Z);
    float gtg[16], am[16], bm[16]; int condp = -1;
    u32x2 xr[2][4], yr[2][4];
    int r = wave; if (r >= TL) return;
#define ROWH_LOAD(q, rr) do { _Pragma("unroll") for (int j = 0; j < 4; ++j) { xr[q][j] = __builtin_nontemporal_load((const u32x2*)(xl16_row(p, (rr)) + (j * 64 + lane) * 4)); yr[q][j] = __builtin_nontemporal_load((const u32x2*)(YL + (size_t)(rr) * D + (j * 64 + lane) * 4)); } } while (0)
    ROWH_LOAD(0, r); ROWH_LOAD(1, r + nw);
    for (; r < TL; r += 2 * nw) {
        float v[2][16], f[2][16];
#pragma unroll
        for (int q = 0; q < 2; ++q)
#pragma unroll
            for (int j = 0; j < 4; ++j) { cvt4(xr[q][j], v[q] + 4 * j); cvt4(yr[q][j], f[q] + 4 * j); }
        const int rl = (r + 2 * nw < TL) ? r + 2 * nw : r;
        ROWH_LOAD(0, rl); ROWH_LOAD(1, rl + nw);
        const int cond = r >> 13;
        if (cond != condp) { condp = cond; load_prod(mod_ptr(p, l, cond, 2), p.g_post_mix + l * D, lane, gtg); load_affine(p.g_pre_ffn + l * D, mod_ptr(p, l, cond, 4), mod_ptr(p, l, cond, 3), lane, am, bm); }
#pragma unroll
        for (int q = 0; q < 2; ++q) { const int rq = r + q * nw;
            const float rstd = rsqrtf(wave_sum(sumsq16(f[q])) * (1.f / D) + 1e-6f);
#pragma unroll
            for (int i = 0; i < 16; ++i) v[q][i] += gtg[i] * (f[q][i] * rstd);
            store_xl16(p, rq, lane, v[q]);
            const float rstd2 = rsqrtf(wave_sum(sumsq16(v[q])) * (1.f / D) + 1e-6f);
            emit_h(v[q], rstd2, am, bm, lane, (bf16_t*)(p.ws + WS_RA) + (size_t)rq * D, p.ws + WS_H2E + (size_t)rq * D); }
    }
#undef ROWH_LOAD
}

DEV void route_token(const Params& p, int l, float logit, int lane, int& myi, float& myw) {
    const float s = sigmoidf_(logit);
    const float sel = s + p.router_b[l * 64 + lane];
    int rank = 0;
#pragma unroll
    for (int k = 1; k < 8; ++k) { const float o = __shfl_xor(sel, k); const int ol = lane ^ k; rank += (o > sel || (o == sel && ol < lane)) ? 1 : 0; }
    float gs = rank < 2 ? sel : 0.f;
    gs += __shfl_xor(gs, 1); gs += __shfl_xor(gs, 2); gs += __shfl_xor(gs, 4);
    const int g = lane >> 3; int grank = 0;
#pragma unroll
    for (int k = 1; k < 8; ++k) { const float o = __shfl_xor(gs, 8 * k); const int og = g ^ k; grank += (o > gs || (o == gs && og < g)) ? 1 : 0; }
    float mv = grank < 4 ? sel : -INFINITY;
    float wsum = 0.f; myw = 0.f; myi = 0;
    for (int s8 = 0; s8 < 8; ++s8) {
        float mx = mv;
#pragma unroll
        for (int o = 32; o >= 1; o >>= 1) mx = fmaxf(mx, __shfl_xor(mx, o));
        const unsigned long long bal = __ballot(mv == mx);
        const int win = __ffsll((long long)bal) - 1;
        const float sw = __shfl(s, win);
        if (lane == s8) { myi = win; myw = sw; }
        wsum += sw;
        if (lane == win) mv = -INFINITY;
    }
    myw = myw / wsum * 2.5f;
}
DEV void route_rows(const Params& p, const Frame& F, int l, int r0) {
    int* hist = (int*)(F.ldsg); int* base = hist + 64; int* loc = hist + 128; float* locw = (float*)(hist + 128 + 2048);
    int* LISTA = (int*)(p.ws + WS_LISTA); float* LISTW = (float*)(p.ws + WS_LISTW);
    unsigned* CNT = (unsigned*)(p.ws + WS_CTL) + CW_CNT + l * 64;
    constexpr int rpw = 256;
    if (F.tid < 64) hist[F.tid] = 0;
    __syncthreads();
    const int ti = F.wave * 64 + F.lane;
    if (F.wave < 4) {
        const float* LOG = (const float*)(p.ws + WS_LOG) + (size_t)(r0 + ti) * 64;
        float sv[64], sel[64];
#pragma unroll
        for (int q = 0; q < 16; ++q) { const float4 t = *(const float4*)(LOG + 4 * q); sv[4 * q] = t.x; sv[4 * q + 1] = t.y; sv[4 * q + 2] = t.z; sv[4 * q + 3] = t.w; }
#pragma unroll
        for (int e = 0; e < 64; ++e) { sv[e] = fsigmoid(sv[e]); sel[e] = sv[e] + p.router_b[l * 64 + e]; }
        float gs[8];
#pragma unroll
        for (int g = 0; g < 8; ++g) { float m1 = fmaxf(sel[8 * g], sel[8 * g + 1]), m2 = fminf(sel[8 * g], sel[8 * g + 1]);
#pragma unroll
            for (int k = 2; k < 8; ++k) { const float x = sel[8 * g + k]; m2 = fmaxf(m2, fminf(m1, x)); m1 = fmaxf(m1, x); }
            gs[g] = m1 + m2; }
#pragma unroll
        for (int g = 0; g < 8; ++g) { int rank = 0;
#pragma unroll
            for (int k = 0; k < 8; ++k) if (k != g) rank += (gs[k] > gs[g] || (gs[k] == gs[g] && k < g)) ? 1 : 0;
            if (rank >= 4) {
#pragma unroll
                for (int k = 0; k < 8; ++k) sel[8 * g + k] = -INFINITY; } }
        float wsum = 0.f; int bi8[8]; float bw8[8];
#pragma unroll
        for (int s8 = 0; s8 < 8; ++s8) { float best = sel[0], bs = sv[0]; int bi = 0;
#pragma unroll
            for (int e = 1; e < 64; ++e) { const bool gt = sel[e] > best; best = gt ? sel[e] : best; bs = gt ? sv[e] : bs; bi = gt ? e : bi; }
#pragma unroll
            for (int e = 0; e < 64; ++e) sel[e] = (e == bi) ? -INFINITY : sel[e];
            bi8[s8] = bi; bw8[s8] = bs; wsum += bs; }
        const float sc = 2.5f / wsum;
#pragma unroll
        for (int s8 = 0; s8 < 8; ++s8) { const int rk = atomicAdd(&hist[bi8[s8]], 1); loc[ti * 8 + s8] = (bi8[s8] << 16) | rk; locw[ti * 8 + s8] = bw8[s8] * sc; }
    }
    __syncthreads();
    if (F.tid < 64) base[F.tid] = (int)__hip_atomic_fetch_add(CNT + F.tid, (unsigned)hist[F.tid], __ATOMIC_RELAXED, __HIP_MEMORY_SCOPE_AGENT);
    __syncthreads();
    for (int idx = F.tid; idx < rpw * 8; idx += NWAVES * 64) { const int v = loc[idx], e = v >> 16, rk = v & 0xffff; const int within = base[e] + rk;
        if (within < CAP) { const size_t pos = (size_t)e * CAP + within; LISTA[pos] = (r0 + (idx >> 3)) * 8 + (idx & 7); LISTW[pos] = locw[idx]; } }
    __syncthreads();
}
DEV void combine_pass(const Params& p, int hf, int nrows, int wave, int nw, int lane) {
    bf16_t* FS = (bf16_t*)(p.ws + WS_RY); const bf16_t* SL = (const bf16_t*)(p.ws + WS_SLOTS);
    for (int r = wave; r < nrows; r += nw) {
        bf16_t* fp = FS + (size_t)r * D + hf * 512 + lane * 8;
        f32x4 a0, a1; pg8::unpack8(*(const u32x4*)fp, a0, a1);
        u32x4 sv[8];
#pragma unroll
        for (int s = 0; s < 8; ++s) sv[s] = *(const u32x4*)(SL + ((size_t)r * 8 + s) * 512 + lane * 8);
#pragma unroll
        for (int s = 0; s < 8; ++s) { f32x4 b0, b1; pg8::unpack8(sv[s], b0, b1); a0 += b0; a1 += b1; }
        *(u32x4*)fp = pg8::pack8(a0, a1);
    }
}
DEV size_t summ_idx(int dir, int b, int pos, int which, int ch) { return ((((size_t)dir * 4 + b) * 66 + pos) * 2 + which) * 512 + ch; }
DEV f32x4 mfma16(bf16x8 a, bf16x8 b, f32x4 c) { return __builtin_amdgcn_mfma_f32_16x16x32_bf16(a, b, c, 0, 0, 0); }

template <int PASS>
DEV void chunk_pass(const Params& p, const Frame& F, int l_in, int c, bool do_gmlp, int ct_lo = 0, int ct_hi = 4) {
    int oz = 0; asm volatile("" : "+s"(oz));
    const int l = l_in + oz;
    const int lane = F.lane, h = F.wave, fr = lane & 15, fq = lane >> 4;
    const bf16_t* Z = (const bf16_t*)(p.ws + WS_Z); bf16_t* Y = (bf16_t*)(p.ws + WS_RY); float* SUMM = (float*)(p.ws + WS_SUMM);
    const unsigned char* W = p.ws + WS_W + oz;
    int r0, t0, n, b, posf, posb;
    if (c < 256) { b = c >> 6; const int k = c & 63; r0 = b * SEQ + k * 128; t0 = k * 128; n = SEQ; posf = 2 + k; posb = 2 + (63 - k); }
    else { const int cc = c - 256; b = cc >> 1; const int k = cc & 1; r0 = TL + b * CTXL + k * 128; t0 = k * 128; n = CTXL; posf = k; posb = 1 - k; }
    if (ct_lo < ct_hi) {
        LAS bf16_t* xcs = (LAS bf16_t*)(F.lds + h * 16384);
        TREG_BEGIN(1);
        bf16_t* XCT = (bf16_t*)(p.ws + WS_XCT) + ((size_t)c * 8 + h) * 8192;
        if (PASS == 1) {
            u32x4 t[16];
#pragma unroll
            for (int k = 0; k < 16; ++k) t[k] = *(const u32x4*)(XCT + (k * 64 + lane) * 8);
#pragma unroll
            for (int k = 0; k < 16; ++k) *(LAS u32x4*)(xcs + (k * 64 + lane) * 8) = t[k];
        } else {
            const int cg = lane & 7, rsub = lane >> 3, ch0 = h * 64 + cg * 8;
            float w[4][8], cb[8];
#pragma unroll
            for (int k = 0; k < 4; ++k) { const float4 a = *(const float4*)(p.conv_w + (size_t)(l * 4 + k) * 512 + ch0), bb = *(const float4*)(p.conv_w + (size_t)(l * 4 + k) * 512 + ch0 + 4);
                w[k][0] = a.x; w[k][1] = a.y; w[k][2] = a.z; w[k][3] = a.w; w[k][4] = bb.x; w[k][5] = bb.y; w[k][6] = bb.z; w[k][7] = bb.w; }
            { const float4 a = *(const float4*)(p.conv_b + l * 512 + ch0), bb = *(const float4*)(p.conv_b + l * 512 + ch0 + 4);
                cb[0] = a.x; cb[1] = a.y; cb[2] = a.z; cb[3] = a.w; cb[4] = bb.x; cb[5] = bb.y; cb[6] = bb.z; cb[7] = bb.w; }
            const bf16_t* Zx = Z + (size_t)r0 * 4096 + 1024 + ch0;
#pragma unroll 1
            for (int it = 0; it < 2; ++it) {
                const int tb = (it * 8 + rsub) * 8;
                u32x4 raw[11];
#pragma unroll
                for (int k = 0; k < 11; ++k) { const int tt = t0 + tb + k - 2; const int rowc = (tt >= 0 && tt < n) ? (tb + k - 2) : tb;
                    raw[k] = *(const u32x4*)(Zx + (long)rowc * 4096); }
#pragma unroll
                for (int k = 0; k < 11; ++k) { const int tt = t0 + tb + k - 2; if (!(tt >= 0 && tt < n)) raw[k] = (u32x4){0u, 0u, 0u, 0u}; }
#pragma unroll
                for (int o = 0; o < 8; ++o) {
                    float y[8];
#pragma unroll
                    for (int j = 0; j < 8; ++j) y[j] = cb[j];
#pragma unroll
                    for (int k = 0; k < 4; ++k) { f32x4 x0, x1; pg8::unpack8(raw[o + k], x0, x1);
#pragma unroll
                        for (int j = 0; j < 4; ++j) { y[j] += w[k][j] * x0[j]; y[4 + j] += w[k][4 + j] * x1[j]; } }
                    const u32x4 pk = pg8::pack8((f32x4){y[0], y[1], y[2], y[3]}, (f32x4){y[4], y[5], y[6], y[7]});
                    *(LAS u32x4*)(xcs + (tb + o) * 64 + cg * 8) = pk; *(u32x4*)(XCT + (tb + o) * 64 + cg * 8) = pk;
                }
            }
        }
        asm volatile("s_waitcnt lgkmcnt(0)" ::: "memory");
        TREG_END(1, F);
        TREG_BEGIN(2);
        float carry0 = 0.f, carry1 = 0.f;
        if (PASS == 1) {
            const int chl = h * 64 + lane;
#pragma unroll
            for (int dir = 0; dir < 2; ++dir) {
                const int np = dir ? posb : posf; float cr = 0.f;
                for (int q0 = 0; q0 < np; q0 += 16) { float a8[16], h8[16];
#pragma unroll
                    for (int j = 0; j < 16; ++j) { const int q = (q0 + j < np) ? q0 + j : np - 1; a8[j] = SUMM[summ_idx(dir, b, q, 0, chl)]; h8[j] = SUMM[summ_idx(dir, b, q, 1, chl)]; }
#pragma unroll
                    for (int j = 0; j < 16; ++j) if (q0 + j < np) cr = a8[j] * cr + h8[j]; }
                if (dir) carry1 = cr; else carry0 = cr;
            }
        }
        TREG_END(2, F);
        TREG_BEGIN(3);
#pragma unroll 1
        for (int ct = ct_lo; ct < ct_hi; ++ct) {
            const int chc = h * 64 + ct * 16 + fr;
            float hsum[8][4];
            u32x4 gbr[2][2];
            if (PASS == 1) {
#pragma unroll
                for (int hv = 0; hv < 2; ++hv) { const bf16_t* gp = Z + (size_t)(r0 + hv * 64 + lane) * 4096 + 1536 + h * 64 + ct * 16; gbr[hv][0] = *(const u32x4*)gp; gbr[hv][1] = *(const u32x4*)(gp + 8); }
            }
            bf16x8 wfr[2][4]; float bias_a2[2], bias_x2[2], spc2[2];
#pragma unroll
            for (int dir = 0; dir < 2; ++dir) {
                const bf16_t* wa = (const bf16_t*)(W + WO_LRU) + (size_t)(0 * 16 + dir * 8 + h) * 4096 + (size_t)(ct * 16 + fr) * 64 + 8 * fq;
                const bf16_t* wx = (const bf16_t*)(W + WO_LRU) + (size_t)(1 * 16 + dir * 8 + h) * 4096 + (size_t)(ct * 16 + fr) * 64 + 8 * fq;
                wfr[dir][0] = *(const bf16x8*)(wa); wfr[dir][1] = *(const bf16x8*)(wa + 32); wfr[dir][2] = *(const bf16x8*)(wx); wfr[dir][3] = *(const bf16x8*)(wx + 32);
                bias_a2[dir] = -1.4426950408889634f * p.lru_ba[(l * 2 + dir) * 512 + chc]; bias_x2[dir] = -1.4426950408889634f * p.lru_bx[(l * 2 + dir) * 512 + chc];
                spc2[dir] = -8.0f * log1pf(expf(-p.lru_lam[(l * 2 + dir) * 512 + chc])) * 1.4426950408889634f;
            }
#pragma unroll
            for (int dir = 0; dir < 2; ++dir) {
                const bf16x8 ba0 = wfr[dir][0], ba1 = wfr[dir][1], bx0 = wfr[dir][2], bx1 = wfr[dir][3];
                const float bias_a = bias_a2[dir], bias_x = bias_x2[dir], spc = spc2[dir];
                float Hrun = 0.f, Arun = 1.f;
                if (PASS == 1) Hrun = __shfl(dir ? carry1 : carry0, ct * 16 + fr);
                const int mypos = dir ? 3 - fq : fq;
#pragma unroll
                for (int grp = 0; grp < 2; ++grp) {
                    float av[4][4], dv[4][4], Ap[4], Hp[4], At[4], Ht[4];
#pragma unroll
                    for (int rq = 0; rq < 4; ++rq) {
                        const int rr = grp * 4 + rq, rt = dir ? 7 - rr : rr;
                        const bf16x8 f0 = *(const LAS bf16x8*)(xcs + (rt * 16 + fr) * 64 + 8 * fq), f1 = *(const LAS bf16x8*)(xcs + (rt * 16 + fr) * 64 + 32 + 8 * fq);
                        f32x4 aa = {bias_a, bias_a, bias_a, bias_a}, ax = {bias_x, bias_x, bias_x, bias_x};
                        aa = mfma16(f0, ba0, aa); aa = mfma16(f1, ba1, aa);
                        ax = mfma16(f0, bx0, ax); ax = mfma16(f1, bx1, ax);
#pragma unroll
                        for (int i = 0; i < 4; ++i) {
                            const float xc = bf2f(xcs[(rt * 16 + 4 * fq + i) * 64 + ct * 16 + fr]);
                            const float rg = __builtin_amdgcn_rcpf(1.f + __builtin_amdgcn_exp2f(aa[i])), ig = __builtin_amdgcn_rcpf(1.f + __builtin_amdgcn_exp2f(ax[i]));
                            const float a = __builtin_amdgcn_exp2f(spc * rg);
                            av[rq][i] = a; dv[rq][i] = __builtin_amdgcn_sqrtf(fmaxf(1.f - a * a, 0.f)) * (ig * xc);
                        }
                        float Al = 1.f, Hl = 0.f;
#pragma unroll
                        for (int s = 0; s < 4; ++s) { const int i = dir ? 3 - s : s; Hl = av[rq][i] * Hl + dv[rq][i]; Al = av[rq][i] * Al; }
                        float ap = 1.f, hp = 0.f, at = 1.f, ht = 0.f;
#pragma unroll
                        for (int s = 0; s < 4; ++s) { const int g = dir ? 3 - s : s; const float Ag = __shfl(Al, fr + 16 * g), Hg = __shfl(Hl, fr + 16 * g);
                            ht = Ag * ht + Hg; at = Ag * at;
                            const bool before = s < mypos; hp = before ? Ag * hp + Hg : hp; ap = before ? Ag * ap : ap; }
                        Ap[rq] = ap; Hp[rq] = hp; At[rq] = at; Ht[rq] = ht;
                    }
#pragma unroll
                    for (int rq = 0; rq < 4; ++rq) {
                        const int rr = grp * 4 + rq, rt = dir ? 7 - rr : rr;
                        if (PASS == 1) {
                            float hc = Ap[rq] * Hrun + Hp[rq];
#pragma unroll
                            for (int s = 0; s < 4; ++s) { const int i = dir ? 3 - s : s; hc = av[rq][i] * hc + dv[rq][i]; if (dir == 0) hsum[rt][i] = hc; else hsum[rt][i] += hc; }
                        }
                        Hrun = At[rq] * Hrun + Ht[rq]; Arun = At[rq] * Arun;
                    }
                    asm volatile("" ::: "memory");
                }
                if (PASS == 0 && fq == 0) { const int pos = dir ? posb : posf; SUMM[summ_idx(dir, b, pos, 0, chc)] = Arun; SUMM[summ_idx(dir, b, pos, 1, chc)] = Hrun; }
            }
            if (PASS == 1) {
                LAS bf16_t* sp = (LAS bf16_t*)(F.lds + SPW_OFF + h * SPW_BYTES);
#pragma unroll
                for (int hv = 0; hv < 2; ++hv) {
#pragma unroll
                    for (int j = 0; j < 4; ++j)
#pragma unroll
                        for (int i = 0; i < 4; ++i) sp[(j * 16 + 4 * fq + i) * 16 + fr] = f2bf(hsum[hv * 4 + j][i]);
                    asm volatile("s_waitcnt lgkmcnt(0)" ::: "memory");
                    const u32x4 s0 = *(const LAS u32x4*)(sp + lane * 16), s1 = *(const LAS u32x4*)(sp + lane * 16 + 8);
                    asm volatile("s_waitcnt lgkmcnt(0)" ::: "memory");
                    f32x4 a0, a1, b0, b1, g0, g1, g2, g3; pg8::unpack8(s0, a0, a1); pg8::unpack8(s1, b0, b1); pg8::unpack8(gbr[hv][0], g0, g1); pg8::unpack8(gbr[hv][1], g2, g3);
                    bf16_t* yp = Y + (size_t)(r0 + hv * 64 + lane) * D + 512 + h * 64 + ct * 16;
                    *(u32x4*)yp = pg8::pack8(a0 * g0, a1 * g1); *(u32x4*)(yp + 8) = pg8::pack8(b0 * g2, b1 * g3);
                }
            }
        }
        asm volatile("s_waitcnt vmcnt(0)" ::: "memory");
        TREG_END(3, F);
    }
    if (PASS == 0 && do_gmlp) {
        typedef float f32x2 __attribute__((ext_vector_type(2)));
        LAS f32x2* stats = (LAS f32x2*)(F.lds + STATS_OFF);
        TREG_BEGIN(4);
#pragma unroll 1
        for (int i0 = 0; i0 < 16; i0 += 8) {
            f32x4 v0[8], v1[8]; float mu[8], var[8];
#pragma unroll
            for (int j = 0; j < 8; ++j) pg8::unpack8(*(const u32x4*)(Z + (size_t)(r0 + F.wave * 16 + i0 + j) * 4096 + 512 + lane * 8), v0[j], v1[j]);
#pragma unroll
            for (int j = 0; j < 8; ++j) mu[j] = (v0[j][0] + v0[j][1]) + (v0[j][2] + v0[j][3]) + (v1[j][0] + v1[j][1]) + (v1[j][2] + v1[j][3]);
#pragma unroll
            for (int o = 1; o < 64; o <<= 1) {
#pragma unroll
                for (int j = 0; j < 8; ++j) mu[j] += __shfl_xor(mu[j], o); }
#pragma unroll
            for (int j = 0; j < 8; ++j) { mu[j] *= (1.f / 512.f); v0[j] -= mu[j]; v1[j] -= mu[j];
                var[j] = (v0[j][0] * v0[j][0] + v0[j][1] * v0[j][1]) + (v0[j][2] * v0[j][2] + v0[j][3] * v0[j][3]) + (v1[j][0] * v1[j][0] + v1[j][1] * v1[j][1]) + (v1[j][2] * v1[j][2] + v1[j][3] * v1[j][3]); }
#pragma unroll
            for (int o = 1; o < 64; o <<= 1) {
#pragma unroll
                for (int j = 0; j < 8; ++j) var[j] += __shfl_xor(var[j], o); }
            float m_ = mu[0], v_ = var[0];
#pragma unroll
            for (int j = 1; j < 8; ++j) { m_ = (lane == j) ? mu[j] : m_; v_ = (lane == j) ? var[j] : v_; }
            if (lane < 8) stats[F.wave * 16 + i0 + lane] = (f32x2){m_, rsqrtf(v_ * (1.f / 512.f) + 1e-5f)};
        }
        TREG_END(4, F);
        __syncthreads();
        TREG_BEGIN(5);
        const int g = F.wave;
        const bf16_t* Wg = (const bf16_t*)(W + WO_GWS) + (size_t)g * 128 * 128;
        LAS bf16_t* vn = (LAS bf16_t*)(F.lds + g * 16384);
        LAS bf16_t* sp = (LAS bf16_t*)(F.lds + SPW_OFF + g * SPW_BYTES);
        {
            const int cg = lane & 7, rsub = lane >> 3, ch0 = g * 64 + cg * 8;
            float lg[8], lb[8];
            { const float4 a = *(const float4*)(p.ln_g + l * 512 + ch0), bb = *(const float4*)(p.ln_g + l * 512 + ch0 + 4), c4 = *(const float4*)(p.ln_b + l * 512 + ch0), d4 = *(const float4*)(p.ln_b + l * 512 + ch0 + 4);
                lg[0] = a.x; lg[1] = a.y; lg[2] = a.z; lg[3] = a.w; lg[4] = bb.x; lg[5] = bb.y; lg[6] = bb.z; lg[7] = bb.w;
                lb[0] = c4.x; lb[1] = c4.y; lb[2] = c4.z; lb[3] = c4.w; lb[4] = d4.x; lb[5] = d4.y; lb[6] = d4.z; lb[7] = d4.w; }
            const bf16_t* Zv = Z + (size_t)r0 * 4096 + 512 + ch0;
#pragma unroll 1
            for (int i8 = 0; i8 < 16; i8 += 8) {
                u32x4 raw[8];
#pragma unroll
                for (int it = 0; it < 8; ++it) raw[it] = *(const u32x4*)(Zv + (long)((i8 + it) * 8 + rsub) * 4096);
#pragma unroll
                for (int it = 0; it < 8; ++it) { const int q = (i8 + it) * 8 + rsub; const f32x2 st = stats[q]; f32x4 x0, x1; pg8::unpack8(raw[it], x0, x1);
#pragma unroll
                    for (int j = 0; j < 4; ++j) { x0[j] = (x0[j] - st.x) * st.y * lg[j] + lb[j]; x1[j] = (x1[j] - st.x) * st.y * lg[4 + j] + lb[4 + j]; }
                    *(LAS u32x4*)(vn + q * 64 + cg * 8) = pg8::pack8(x0, x1); }
            }
        }
        asm volatile("s_waitcnt lgkmcnt(0)" ::: "memory");
        bf16x8 bfr[4][4];
#pragma unroll
        for (int ct = 0; ct < 4; ++ct)
#pragma unroll
            for (int ks = 0; ks < 4; ++ks) { unsigned wd[4];
#pragma unroll
                for (int j2 = 0; j2 < 4; ++j2) { const unsigned lo = vn[(ks * 32 + 8 * fq + 2 * j2) * 64 + ct * 16 + fr], hi = vn[(ks * 32 + 8 * fq + 2 * j2 + 1) * 64 + ct * 16 + fr]; wd[j2] = lo | (hi << 16); }
                bfr[ct][ks] = __builtin_bit_cast(bf16x8, (u32x4){wd[0], wd[1], wd[2], wd[3]}); }
        const bf16_t* Zu = Z + (size_t)r0 * 4096 + g * 64; bf16_t* Yu = Y + (size_t)r0 * D + g * 64;
        const int orow = lane >> 2, och = (lane & 3) * 16;
#pragma unroll 1
        for (int rt = 0; rt < 8; ++rt) {
            bf16x8 af[4];
#pragma unroll
            for (int ks = 0; ks < 4; ++ks) af[ks] = *(const bf16x8*)(Wg + (unsigned)((rt * 16 + fr) * 128 + ks * 32 + 8 * fq));
            const float4 bsv = *(const float4*)(p.gbs + (l * 8 + g) * 128 + rt * 16 + 4 * fq);
            const u32x4 u0 = *(const u32x4*)(Zu + (long)(rt * 16 + orow) * 4096 + och), u1 = *(const u32x4*)(Zu + (long)(rt * 16 + orow) * 4096 + och + 8);
            const float bs4[4] = {bsv.x, bsv.y, bsv.z, bsv.w};
#pragma unroll
            for (int ct = 0; ct < 4; ++ct) {
                f32x4 acc = {0.f, 0.f, 0.f, 0.f};
#pragma unroll
                for (int ks = 0; ks < 4; ++ks) acc = mfma16(af[ks], bfr[ct][ks], acc);
#pragma unroll
                for (int i = 0; i < 4; ++i) sp[(4 * fq + i) * 64 + ct * 16 + fr] = f2bf(acc[i] + bs4[i]);
            }
            asm volatile("s_waitcnt lgkmcnt(0)" ::: "memory");
            const u32x4 m0 = *(const LAS u32x4*)(sp + orow * 64 + och), m1 = *(const LAS u32x4*)(sp + orow * 64 + och + 8);
            asm volatile("s_waitcnt lgkmcnt(0)" ::: "memory");
            f32x4 a0, a1, b0, b1, c0, c1, d0, d1; pg8::unpack8(m0, a0, a1); pg8::unpack8(m1, b0, b1); pg8::unpack8(u0, c0, c1); pg8::unpack8(u1, d0, d1);
            bf16_t* yp = Yu + (long)(rt * 16 + orow) * D + och;
            *(u32x4*)yp = pg8::pack8(a0 * c0, a1 * c1); *(u32x4*)(yp + 8) = pg8::pack8(b0 * d0, b1 * d1);
        }
        asm volatile("s_waitcnt vmcnt(0)" ::: "memory"); TREG_END(5, F);
    }
    __syncthreads();
}
constexpr int NPL = 10, PH_FINAL = 1 + 2 * NPL, PH_END = PH_FINAL + 1;
struct Args { Params p; int ph_lo, ph_hi; };

DEV void build_toff(const Params& p, const Frame& F, int l, LAS int* toff) {
    if (F.tid < NE) { const unsigned* CNT = (const unsigned*)(p.ws + WS_CTL) + CW_CNT + l * 64;
        int cn = (int)__hip_atomic_load(CNT + F.tid, __ATOMIC_RELAXED, __HIP_MEMORY_SCOPE_AGENT); cn = cn < CAP ? cn : CAP;
        const int tiles = (cn + 255) >> 8; int incl = tiles;
#pragma unroll
        for (int o = 1; o < 64; o <<= 1) { const int t = __shfl_up(incl, o); if (F.lane >= o) incl += t; }
        const int excl = incl - tiles;
        toff[F.tid] = excl < 1120 ? excl : 1120; toff[80 + F.tid] = cn;
        if (F.tid == NE - 1) toff[64] = incl < 1120 ? incl : 1120; }
    __syncthreads();
    if (F.tid < NE) { LAS unsigned char* te = (LAS unsigned char*)(F.lds + SPW_OFF); for (int t = toff[F.tid]; t < toff[F.tid + 1]; ++t) te[t] = (unsigned char)F.tid; }
    __syncthreads();
}

template <int ph> DEV void run_phase(const Frame& F0) {
    Frame F = F0; { unsigned z_ = 0; asm volatile("" : "+v"(z_)); F.lane = (int)__builtin_amdgcn_mbcnt_hi(~0u, __builtin_amdgcn_mbcnt_lo(~0u, z_)); F.tid = F.wave * 64 + F.lane; }
    asm volatile("" : "+s"(F.G), "+s"(F.bx));
    const Params p = load_params(F);
    unsigned char* ws = p.ws; unsigned char* W = ws + WS_W;
    LAS int* toff = (LAS int*)(F.lds + MISC_OFF + 256);
    const int gw = F.bx * NWAVES + F.wave, NGW = F.G * NWAVES;
#ifndef NOPRO
    if (ph == 0) { if (F.bx == 0 && F.tid < 128) __hip_atomic_store((unsigned*)(p.ws + WS_CTL) + CW_CNT + F.tid, 0u, __ATOMIC_RELAXED, __HIP_MEMORY_SCOPE_AGENT);
        if (F.bx >= 192) { pe_table(p, F, (F.bx - 192) * 1024 + F.tid); pe_table(p, F, (F.bx - 192) * 1024 + 512 + F.tid); }
        mod_items(p, F); __syncthreads(); convert_weights(p, F, 0, 0, gw, NGW); return; }
    if (ph == PH_FINAL) { row_lat_A(p, 2, gw, NGW, F.lane); return; }
#endif
    constexpr int l = (ph - 1) / NPL, k = (ph - 1) % NPL;
    constexpr int nr = (l == 0) ? R : TL;
#ifndef PMASK
#define PMASK 0xffff
#endif
#define PON(k_) ((PMASK >> (k_)) & 1)
    switch (k) {
    case 0: if (PON(0)) { if (l > 0) convert_weights(p, F, l, 0, gw, NGW);
        if (l == 0) row_lat_A0(p, gw, NGW, F.lane); else row_lat_A(p, l, gw, NGW, F.lane);
        row_pass_A(p, l, TL, R, gw, NGW, F.lane); } break;
    case 1: if (PON(1)) {
#if GIN_FP8
        pg8::DenseSched<512, WS_H8, WS_W + WO_IN> S; S.init(ws, R, 4096, F.bx); pg8::EpiZ E{ws};
        pg8::gemm_phase<pg8::EpiZ, decltype(S), true, 0x7b>(F.lds, F.tid, S, E);
#else
        pg8::DenseSched<D, WS_RY, WS_W + WO_IN> S; S.init(ws, R, 4096, F.bx); pg8::EpiZ E{ws};
        pg8::gemm_phase<pg8::EpiZ, decltype(S), true>(F.lds, F.tid, S, E);
#endif
        } break;
    case 2: if (PON(2)) { chunk_pass<0>(p, F, l, F.bx, true);
        if (F.bx < 32) chunk_pass<0>(p, F, l, 256 + (F.bx >> 2), false, F.bx & 3, (F.bx & 3) + 1);
        else if (l == 0 && F.bx < 40) chunk_pass<0>(p, F, l, 256 + (F.bx - 32), true, 0, 0);
        else if (l == 0) { convert_weights(p, F, 0, 1, (F.bx - 40) * NWAVES + F.wave, 216 * NWAVES);
            convert_weights(p, F, 0, 2, (F.bx - 40) * NWAVES + F.wave, 216 * NWAVES); }
        else convert_weights(p, F, 1, 2, (F.bx - 32) * NWAVES + F.wave, 224 * NWAVES); } break;
    case 3: if (PON(3)) { chunk_pass<1>(p, F, l, F.bx, false);
        if (l == 0) { if (F.bx < 32) chunk_pass<1>(p, F, l, 256 + (F.bx >> 2), false, F.bx & 3, (F.bx & 3) + 1);
            else convert_weights(p, F, 1, 1, (F.bx - 32) * NWAVES + F.wave, 224 * NWAVES); } } break;
    case 4: if (PON(4)) { pg8::DenseSched<D, WS_RY, WS_W + WO_AB> S; S.init(ws, nr, D, F.bx); pg8::EpiAB E{ws};
        pg8::gemm_phase<pg8::EpiAB, decltype(S), true>(F.lds, F.tid, S, E); } break;
    case 5: if (PON(5)) { pg8::DenseSched<D, WS_RA, WS_W + WO_OUT> S; S.init(ws, nr, D, F.bx); pg8::EpiPlain<WS_Z> E{ws};
        pg8::gemm_phase<pg8::EpiPlain<WS_Z>, decltype(S), true>(F.lds, F.tid, S, E); } break;
    case 6: if (PON(6)) { row_lat_H(p, l, gw, NGW, F.lane); if (nr > TL) row_pass_H(p, l, TL, nr, gw, NGW, F.lane); } break;
    case 7: if (PON(7)) { pg8::DenseSched<D, WS_RA, WS_W + WO_SR> S; S.init(ws, nr, 768, F.bx); pg8::EpiSR E{ws};
        pg8::gemm_phase<pg8::EpiSR, decltype(S), true>(F.lds, F.tid, S, E);
        asm volatile("s_waitcnt vmcnt(0)" ::: "memory"); __syncthreads();
        for (int i = 0;; ++i) { pg8::UnitD u; if (!S.next(i, u)) break; if (u.pn == 0) route_rows(p, F, l, u.pm * 256); } } break;
    case 8: if (PON(8)) { build_toff(p, F, l, toff);
        { pg8::ExpSched<512, 1, 2, WS_H2E, WS_W + WO_EG + l * WL_EG, (size_t)512 * D> S; S.ws = ws; S.lds = F.lds; S.U = toff[64] * 2; S.c = F.bx; S.brow0 = 0; S.Krt = 512;
          pg8::EpiEG<0> E{ws};
          pg8::gemm_phase<pg8::EpiEG<0>, decltype(S), true, 0x7b>(F.lds, F.tid, S, E); }
#if GSD_FP8
        { pg8::DenseSched<128, WS_SH, WS_W + WO_SD> S; S.init(ws, nr, D, 255 - F.bx); pg8::EpiPlain<WS_RY> E{ws};
          pg8::gemm_phase<pg8::EpiPlain<WS_RY>, decltype(S), true, 0x7c>(F.lds, F.tid, S, E); } } break;
#else
        { pg8::DenseSched<256, WS_SH, WS_W + WO_SD> S; S.init(ws, nr, D, 255 - F.bx); pg8::EpiPlain<WS_RY> E{ws};
          pg8::gemm_phase<pg8::EpiPlain<WS_RY>, decltype(S), true>(F.lds, F.tid, S, E); } } break;
#endif
    case 9: if (PON(9)) { build_toff(p, F, l, toff);
#if GED_FP8
        pg8::ExpSched<128, 0, 4, WS_HM, WS_W + WO_ED + l * WL_ED, (size_t)D * 256> S; S.ws = ws; S.lds = F.lds; S.U = toff[64] * 4; S.c = F.bx; S.brow0 = 0; S.Krt = 128;
        pg8::EpiED E{ws, F.lds};
        pg8::gemm_phase<pg8::EpiED, decltype(S), true, 0x7c>(F.lds, F.tid, S, E); } break;
#else
        pg8::ExpSched<256, 0, 4, WS_HM, WS_W + WO_ED, (size_t)D * 256 * 2> S; S.ws = ws; S.lds = F.lds; S.U = toff[64] * 4; S.c = F.bx; S.brow0 = 0; S.Krt = 256;
        pg8::EpiED E{ws, F.lds};
        pg8::gemm_phase<pg8::EpiED, decltype(S), true>(F.lds, F.tid, S, E); } break;
#endif
    }
}

__global__ void __launch_bounds__(NWAVES * 64, 2) mk_fwd(Args a) {
    extern __shared__ __attribute__((aligned(16))) unsigned char lds_raw[];
    Frame F; F.lds = (LAS unsigned char*)lds_raw; F.ldsg = lds_raw; F.tid = threadIdx.x; F.lane = F.tid & 63; F.wave = __builtin_amdgcn_readfirstlane(F.tid >> 6); F.G = gridDim.x; F.bx = blockIdx.x;
    volatile LAS unsigned* MISC = (volatile LAS unsigned*)(F.lds + MISC_OFF);
    for (int u = F.tid; u < (LDS_BYTES - MISC_OFF) / 4; u += NWAVES * 64) MISC[u] = 0u;
    __syncthreads();
    store_params(F, a.p);
    __syncthreads();
    XcdBarrier bar; bar.bar = (GAS unsigned*)(a.p.ws + WS_CTL) + CW_BAR; bar.x = 0; bar.st = nullptr;
    const bool multi = a.ph_hi - a.ph_lo > 1;
    if (multi) bar = xcd_barrier_post((GAS unsigned*)(a.p.ws + WS_CTL) + CW_BAR, MISC);
#ifdef DELAYMASK
#define MK_PH(k_) if (a.ph_lo <= (k_) && (k_) < a.ph_hi) { const unsigned long long t0_ = __builtin_amdgcn_s_memrealtime(); run_phase<(k_)>(F); \
        { constexpr int kind = ((k_) == 0) ? 15 : ((k_) == PH_FINAL ? 0 : ((k_) - 1) % NPL); \
          if ((DELAYMASK >> kind) & 1) { __syncthreads(); const unsigned long long t1_ = __builtin_amdgcn_s_memrealtime(); while (__builtin_amdgcn_s_memrealtime() - t1_ < t1_ - t0_) __builtin_amdgcn_s_sleep(8); } } \
        if ((k_) + 1 < a.ph_hi) xcd_barrier(bar); }
#elif defined(PROBE_REGION)
#define MK_PH(k_) if (a.ph_lo <= (k_) && (k_) < a.ph_hi) { run_phase<(k_)>(F); \
        { __syncthreads(); const unsigned long long t1_ = __builtin_amdgcn_s_memrealtime(); const unsigned long long dt_ = MISC[16]; while (__builtin_amdgcn_s_memrealtime() - t1_ < dt_) __builtin_amdgcn_s_sleep(8); __syncthreads(); if (F.tid == 0) MISC[16] = 0u; } \
        if ((k_) + 1 < a.ph_hi) xcd_barrier(bar); }
#else
#define MK_PH(k_) if (a.ph_lo <= (k_) && (k_) < a.ph_hi) { run_phase<(k_)>(F); if ((k_) + 1 < a.ph_hi) xcd_barrier(bar); }
#endif
    MK_PH(0) MK_PH(1) MK_PH(2) MK_PH(3) MK_PH(4) MK_PH(5) MK_PH(6) MK_PH(7) MK_PH(8) MK_PH(9) MK_PH(10)
    MK_PH(11) MK_PH(12) MK_PH(13) MK_PH(14) MK_PH(15) MK_PH(16) MK_PH(17) MK_PH(18) MK_PH(19) MK_PH(20) MK_PH(21)
#undef MK_PH
}
#ifndef FAST
#define FAST 0x1ff
#endif
#if FAST != 0x1ff
constexpr size_t WS_NV1 = 538 * MiB;
constexpr size_t WS_NSG = 291 * MiB, WS_NFLS = 324 * MiB;
__global__ void __launch_bounds__(256) k_mod(Params p) {
    const int e = blockIdx.x * 256 + threadIdx.x, cond = blockIdx.y, l = blockIdx.z;
    const float* cv = cond < 4 ? p.c + cond * D : p.c_ctx;
    const float* w = p.w_mod + (size_t)l * D * 6 * D;
    float acc = p.b_mod[l * 6 * D + e];
    for (int d = 0; d < D; ++d) acc += siluf_(cv[d]) * w[(size_t)d * 6 * D + e];
    ((float*)(p.ws + WS_MOD))[(size_t)(l * 5 + cond) * 6 * D + e] = acc;
}
__global__ void __launch_bounds__(256) k_rowA(Params p, int l) { row_pass_A(p, l, (blockIdx.x * 256 + threadIdx.x) >> 6, (gridDim.x * 256) >> 6, threadIdx.x & 63); }
__global__ void __launch_bounds__(256) k_rowH(Params p, int l, int nrows) { row_pass_H(p, l, nrows, (blockIdx.x * 256 + threadIdx.x) >> 6, (gridDim.x * 256) >> 6, threadIdx.x & 63); }
struct ABf16 { const bf16_t* A; int lda, coff; DEV float operator()(int m, int k) const { return bf2f(A[(size_t)m * lda + coff + k]); } };
struct BF32 { const float* B; int ldb, pad; DEV float operator()(int k, int n) const { return B[(size_t)k * ldb + n]; } };
struct BAB { const float* Ba; const float* Bb; DEV float operator()(int k, int n) const { return k < 512 ? Ba[(size_t)k * D + n] : Bb[(size_t)(k - 512) * D + n]; } };
struct NEpiZ { bf16_t* Z; DEV void operator()(int m, int n, float v, float) const {
    float o; if (n < 1024) o = gelu_tanh(v); else if (n < 1536) o = v; else if (n < 2048) o = gelu_tanh(v); else o = sigmoidf_(v);
    Z[(size_t)m * 4096 + n] = f2bf(o); } };
struct NEpiF32 { float* C; int ldc, pad; DEV void operator()(int m, int n, float v, float) const { C[(size_t)m * ldc + n] = v; } };
struct NEpiBf { bf16_t* C; int ldc, pad; DEV void operator()(int m, int n, float v, float) const { C[(size_t)m * ldc + n] = f2bf(v); } };
struct NEpiMerge { const bf16_t* Z; bf16_t* M; DEV void operator()(int m, int n, float vb, float va) const {
    const float ga = bf2f(Z[(size_t)m * 4096 + 2048 + n]), gr = bf2f(Z[(size_t)m * 4096 + 3072 + n]);
    M[(size_t)m * D + n] = f2bf(ga * va + gr * vb); } };
struct NEpiSwi { const float* SG; bf16_t* SH; DEV void operator()(int m, int n, float v, float) const { SH[(size_t)m * 256 + n] = f2bf(siluf_(SG[(size_t)m * 256 + n]) * v); } };
template <class AL, class BL, class EP, int SPLIT>
__global__ void __launch_bounds__(256) k_gemm(AL al, BL bl, EP ep, int K) {
    __shared__ __attribute__((aligned(16))) float As[16][68];
    __shared__ __attribute__((aligned(16))) float Bs[16][68];
    const int tid = threadIdx.x, tx = tid & 15, ty = tid >> 4, m0 = blockIdx.y * 64, n0 = blockIdx.x * 64;
    float acc[4][4], acc2[4][4];
#pragma unroll
    for (int i = 0; i < 4; ++i)
#pragma unroll
        for (int j = 0; j < 4; ++j) { acc[i][j] = 0.f; acc2[i][j] = 0.f; }
    for (int k0 = 0; k0 < K; k0 += 16) {
        if (SPLIT && k0 == SPLIT) {
#pragma unroll
            for (int i = 0; i < 4; ++i)
#pragma unroll
                for (int j = 0; j < 4; ++j) { acc2[i][j] = acc[i][j]; acc[i][j] = 0.f; }
        }
#pragma unroll
        for (int i = 0; i < 4; ++i) { const int e = tid + 256 * i, kk = e & 15, mm = e >> 4; As[kk][mm] = al(m0 + mm, k0 + kk); }
#pragma unroll
        for (int i = 0; i < 4; ++i) { const int e = tid + 256 * i, nn = e & 63, kk = e >> 6; Bs[kk][nn] = bl(k0 + kk, n0 + nn); }
        __syncthreads();
#pragma unroll
        for (int kk = 0; kk < 16; ++kk) {
            const float4 a = *(const float4*)&As[kk][ty * 4]; const float4 b = *(const float4*)&Bs[kk][tx * 4];
            const float av[4] = {a.x, a.y, a.z, a.w}, bv[4] = {b.x, b.y, b.z, b.w};
#pragma unroll
            for (int i = 0; i < 4; ++i)
#pragma unroll
                for (int j = 0; j < 4; ++j) acc[i][j] += av[i] * bv[j];
        }
        __syncthreads();
    }
#pragma unroll
    for (int i = 0; i < 4; ++i)
#pragma unroll
        for (int j = 0; j < 4; ++j) ep(m0 + ty * 4 + i, n0 + tx * 4 + j, acc[i][j], acc2[i][j]);
}
__global__ void __launch_bounds__(256) k_conv(Params p, int l) {
    const size_t idx = (size_t)blockIdx.x * 256 + threadIdx.x; const int r = (int)(idx >> 9), ch = (int)(idx & 511);
    const bf16_t* Z = (const bf16_t*)(p.ws + WS_Z); float* XCONV = (float*)(p.ws + WS_NV1);
    int t, n; if (r < TL) { t = r & (SEQ - 1); n = SEQ; } else { t = (r - TL) & (CTXL - 1); n = CTXL; }
    const int base = r - t;
    float y = p.conv_b[l * 512 + ch];
#pragma unroll
    for (int k = 0; k < 4; ++k) { const int tt = t + k - 2; if (tt >= 0 && tt < n) y += p.conv_w[(l * 4 + k) * 512 + ch] * bf2f(Z[(size_t)(base + tt) * 4096 + 1024 + ch]); }
    XCONV[(size_t)r * 512 + ch] = y;
}
__global__ void __launch_bounds__(64) k_scan(Params p, int l, int dir) {
    const int b = blockIdx.x >> 3, h = blockIdx.x & 7, j = threadIdx.x, ch = h * 64 + j;
    const float* XCONV = (const float*)(p.ws + WS_NV1); float* HS = (float*)(p.ws + WS_RA);
    const float* wa = p.lru_wa + (size_t)((l * 2 + dir) * 8 + h) * 4096; const float* wx = p.lru_wx + (size_t)((l * 2 + dir) * 8 + h) * 4096;
    float wac[64], wxc[64];
#pragma unroll
    for (int i = 0; i < 64; ++i) { wac[i] = wa[i * 64 + j]; wxc[i] = wx[i * 64 + j]; }
    const float ba = p.lru_ba[(l * 2 + dir) * 512 + ch], bx = p.lru_bx[(l * 2 + dir) * 512 + ch];
    const float sp = log1pf(expf(-p.lru_lam[(l * 2 + dir) * 512 + ch]));
    float hst = 0.f;
    for (int step = 0; step < CTXL + SEQ; ++step) {
        int r;
        if (dir == 0) r = step < CTXL ? TL + b * CTXL + step : b * SEQ + (step - CTXL);
        else r = step < CTXL ? TL + b * CTXL + (CTXL - 1 - step) : b * SEQ + (SEQ - 1 - (step - CTXL));
        const float* xr = XCONV + (size_t)r * 512 + h * 64;
        float pr = ba, px = bx;
#pragma unroll
        for (int i = 0; i < 16; ++i) { const float4 xv = *(const float4*)(xr + 4 * i);
            pr += xv.x * wac[4 * i] + xv.y * wac[4 * i + 1] + xv.z * wac[4 * i + 2] + xv.w * wac[4 * i + 3];
            px += xv.x * wxc[4 * i] + xv.y * wxc[4 * i + 1] + xv.z * wxc[4 * i + 2] + xv.w * wxc[4 * i + 3]; }
        const float rg = sigmoidf_(pr), ig = sigmoidf_(px);
        const float log_a = -8.0f * rg * sp;
        const float a = expf(log_a), drv = sqrtf(-expm1f(2.0f * log_a)) * (ig * xr[j]);
        hst = a * hst + drv;
        if (dir == 0) HS[(size_t)r * 512 + ch] = hst; else HS[(size_t)r * 512 + ch] += hst;
    }
}
__global__ void __launch_bounds__(256) k_yb(Params p) {
    const size_t idx = (size_t)blockIdx.x * 256 + threadIdx.x; const int r = (int)(idx >> 9), ch = (int)(idx & 511);
    const bf16_t* Z = (const bf16_t*)(p.ws + WS_Z); const float* HS = (const float*)(p.ws + WS_RA); bf16_t* Y = (bf16_t*)(p.ws + WS_RY);
    Y[(size_t)r * D + 512 + ch] = f2bf(HS[(size_t)r * 512 + ch] * bf2f(Z[(size_t)r * 4096 + 1536 + ch]));
}
__global__ void __launch_bounds__(256) k_ln(Params p, int l, int nrows) {
    const int lane = threadIdx.x & 63, wave = (blockIdx.x * 256 + threadIdx.x) >> 6, nw = (gridDim.x * 256) >> 6;
    const bf16_t* Z = (const bf16_t*)(p.ws + WS_Z); float* VN = (float*)(p.ws + WS_NV1);
    for (int r = wave; r < nrows; r += nw) {
        float v[8]; float s = 0.f;
#pragma unroll
        for (int i = 0; i < 8; ++i) { v[i] = bf2f(Z[(size_t)r * 4096 + 512 + i * 64 + lane]); s += v[i]; }
        const float mu = wave_sum(s) * (1.f / 512.f); float q = 0.f;
#pragma unroll
        for (int i = 0; i < 8; ++i) { v[i] -= mu; q += v[i] * v[i]; }
        const float rstd = rsqrtf(wave_sum(q) * (1.f / 512.f) + 1e-5f);
#pragma unroll
        for (int i = 0; i < 8; ++i) { const int cch = i * 64 + lane; VN[(size_t)r * 512 + cch] = v[i] * rstd * p.ln_g[l * 512 + cch] + p.ln_b[l * 512 + cch]; }
    }
}
__global__ void __launch_bounds__(256) k_mix(Params p, int l) {
    const size_t idx = (size_t)blockIdx.x * 256 + threadIdx.x; const int r = (int)(idx >> 9), ch = (int)(idx & 511), g = ch >> 6;
    const bf16_t* Z = (const bf16_t*)(p.ws + WS_Z); const float* VN = (const float*)(p.ws + WS_NV1); bf16_t* Y = (bf16_t*)(p.ws + WS_RY);
    const int base = r & ~127, pp = r & 127;
    const float* w = p.gws + ((size_t)(l * 8 + g) * 128 + pp) * 128;
    float acc = p.gbs[(l * 8 + g) * 128 + pp];
    for (int q = 0; q < 128; ++q) acc += w[q] * VN[(size_t)(base + q) * 512 + ch];
    Y[(size_t)r * D + ch] = f2bf(bf2f(Z[(size_t)r * 4096 + ch]) * acc);
}
__global__ void __launch_bounds__(256) k_route(Params p, int l, int nrows) {
    const int lane = threadIdx.x & 63, wave = (blockIdx.x * 256 + threadIdx.x) >> 6, nw = (gridDim.x * 256) >> 6;
    int* TOPI = (int*)(p.ws + WS_TOPI); float* TOPW = (float*)(p.ws + WS_TOPW);
    for (int r = wave; r < nrows; r += nw) { int myi; float myw; route_token(p, l, ((const float*)(p.ws + WS_LOG))[(size_t)r * 64 + lane], lane, myi, myw);
        if (lane < 8) { TOPI[(size_t)r * 8 + lane] = myi; TOPW[(size_t)r * 8 + lane] = myw; } }
}
__global__ void __launch_bounds__(256) k_routed(Params p, int l) {
    __shared__ float hs[D]; __shared__ float hm[256];
    const int r = blockIdx.x, tid = threadIdx.x;
    const bf16_t* H2 = (const bf16_t*)(p.ws + WS_RA); const int* TOPI = (const int*)(p.ws + WS_TOPI); const float* TOPW = (const float*)(p.ws + WS_TOPW);
    const float* FLs = (const float*)(p.ws + WS_NFLS); bf16_t* FL = (bf16_t*)(p.ws + WS_RY);
#pragma unroll
    for (int i = 0; i < 4; ++i) hs[tid + 256 * i] = bf2f(H2[(size_t)r * D + tid + 256 * i]);
    float acc[4] = {0.f, 0.f, 0.f, 0.f};
    __syncthreads();
    for (int s = 0; s < 8; ++s) {
        const int e = TOPI[(size_t)r * 8 + s]; const float w = TOPW[(size_t)r * 8 + s];
        const float* wg = p.e_g + ((size_t)(l * NE + e) * D) * 256; const float* wu = p.e_u + ((size_t)(l * NE + e) * D) * 256;
        float g = 0.f, u = 0.f;
        for (int k = 0; k < D; ++k) { const float hv = hs[k]; g += hv * wg[(size_t)k * 256 + tid]; u += hv * wu[(size_t)k * 256 + tid]; }
        hm[tid] = siluf_(g) * u;
        __syncthreads();
        const float* wd = p.e_d + ((size_t)(l * NE + e) * 256) * D;
        float o[4] = {0.f, 0.f, 0.f, 0.f};
        for (int j = 0; j < 256; ++j) { const float hv = hm[j];
#pragma unroll
            for (int i = 0; i < 4; ++i) o[i] += hv * wd[(size_t)j * D + tid + 256 * i]; }
#pragma unroll
        for (int i = 0; i < 4; ++i) acc[i] += w * o[i];
        __syncthreads();
    }
#pragma unroll
    for (int i = 0; i < 4; ++i) FL[(size_t)r * D + tid + 256 * i] = f2bf(FLs[(size_t)r * D + tid + 256 * i] + acc[i]);
}
template <int SPLIT, class AL, class BL, class EP>
static void ngemm(hipStream_t st, int M, int N, int K, AL al, BL bl, EP ep) { hipLaunchKernelGGL((k_gemm<AL, BL, EP, SPLIT>), dim3(N / 64, M / 64), dim3(256), 0, st, al, bl, ep, K); }
#endif

static void mk(hipStream_t st, const Params& p, int lo, int hi) { Args a{}; a.p = p; a.ph_lo = lo; a.ph_hi = hi; hipLaunchKernelGGL(mk_fwd, dim3(256), dim3(NWAVES * 64), LDS_BYTES, st, a); }

extern "C" void kernel_launch(void* const* d_in, const int* in_sizes, int n_in, void* d_out, int out_size, void* d_ws, size_t ws_size, hipStream_t stream) {
    static int ready = 0;
    if (ready == 0) {
        ready = -1;
        if (n_in != 33 || ws_size < WS_END || out_size != TL * D) return;
        int dev = 0, cus = 0;
        if (hipGetDevice(&dev) != hipSuccess || hipDeviceGetAttribute(&cus, hipDeviceAttributeMultiprocessorCount, dev) != hipSuccess || cus < 256) return;
        if (hipFuncSetAttribute((const void*)mk_fwd, hipFuncAttributeMaxDynamicSharedMemorySize, LDS_BYTES) != hipSuccess) return;
        ready = 1;
    }
    if (ready < 0) return;
    Params p{};
    const float** pp = (const float**)&p;
    for (int i = 0; i < 33; ++i) pp[i] = (const float*)d_in[i];
    p.out = (float*)d_out; p.ws = (unsigned char*)d_ws;
    (void)hipMemsetAsync((char*)d_ws + WS_CTL, 0, 1 * MiB, stream);
#if FAST == 0x1ff && !defined(MK_PER_PHASE)
    mk(stream, p, 0, PH_END);
#elif FAST == 0x1ff
    for (int ph = 0; ph < PH_END; ++ph) mk(stream, p, ph, ph + 1);
#else
    unsigned char* ws = p.ws;
    bf16_t* RA = (bf16_t*)(ws + WS_RA); bf16_t* Z = (bf16_t*)(ws + WS_Z); bf16_t* RY = (bf16_t*)(ws + WS_RY);
    float* LOG = (float*)(ws + WS_LOG); float* SG = (float*)(ws + WS_NSG); bf16_t* SH = (bf16_t*)(ws + WS_SH); float* FLs = (float*)(ws + WS_NFLS);
    mk(stream, p, 0, 1);
    if (!(FAST & 1)) hipLaunchKernelGGL(k_mod, dim3(24, 5, 2), dim3(256), 0, stream, p);
    for (int l = 0; l < 2; ++l) {
        const int nr = (l == 0) ? R : TL, b0 = 1 + l * NPL;
        if (FAST & 2) mk(stream, p, b0 + 0, b0 + 1); else { if (l > 0) mk(stream, p, 100 + l, 101 + l); hipLaunchKernelGGL(k_rowA, dim3(2048), dim3(256), 0, stream, p, l); }
        if (FAST & 4) mk(stream, p, b0 + 1, b0 + 2); else ngemm<0>(stream, R, 4096, D, ABf16{RA, D, 0}, BF32{p.w_in + (size_t)l * D * 4096, 4096, 0}, NEpiZ{Z});
        if (FAST & 8) { mk(stream, p, b0 + 2, b0 + 3); mk(stream, p, b0 + 3, b0 + 4); }
        else {
            hipLaunchKernelGGL(k_conv, dim3(R * 512 / 256), dim3(256), 0, stream, p, l);
            for (int dir = 0; dir < 2; ++dir) hipLaunchKernelGGL(k_scan, dim3(NBATCH * 8), dim3(64), 0, stream, p, l, dir);
            hipLaunchKernelGGL(k_yb, dim3(nr * 512 / 256), dim3(256), 0, stream, p);
            hipLaunchKernelGGL(k_ln, dim3(2048), dim3(256), 0, stream, p, l, nr);
            hipLaunchKernelGGL(k_mix, dim3(nr * 512 / 256), dim3(256), 0, stream, p, l);
        }
        if (FAST & 16) mk(stream, p, b0 + 4, b0 + 5); else ngemm<512>(stream, nr, D, D, ABf16{RY, D, 0}, BAB{p.w_out_a + (size_t)l * 512 * D, p.w_out_b + (size_t)l * 512 * D}, NEpiMerge{Z, RA});
        if (FAST & 32) mk(stream, p, b0 + 5, b0 + 6); else ngemm<0>(stream, nr, D, D, ABf16{RA, D, 0}, BF32{p.w_out + (size_t)l * D * D, D, 0}, NEpiBf{Z, D, 0});
        if (FAST & 64) mk(stream, p, b0 + 6, b0 + 7); else hipLaunchKernelGGL(k_rowH, dim3(2048), dim3(256), 0, stream, p, l, nr);
        if (FAST & 128) { mk(stream, p, b0 + 7, b0 + 8); mk(stream, p, b0 + 8, b0 + 9); }
        else {
            ngemm<0>(stream, nr, 64, D, ABf16{RA, D, 0}, BF32{p.router_w + (size_t)l * D * 64, 64, 0}, NEpiF32{LOG, 64, 0});
            hipLaunchKernelGGL(k_route, dim3(2048), dim3(256), 0, stream, p, l, nr);
            ngemm<0>(stream, nr, 256, D, ABf16{RA, D, 0}, BF32{p.s_g + (size_t)l * D * 256, 256, 0}, NEpiF32{SG, 256, 0});
            ngemm<0>(stream, nr, 256, D, ABf16{RA, D, 0}, BF32{p.s_u + (size_t)l * D * 256, 256, 0}, NEpiSwi{SG, SH});
        }
        if (FAST & 256) { for (int k = 9; k < NPL; ++k) mk(stream, p, b0 + k, b0 + k + 1); }
        else {
            ngemm<0>(stream, nr, D, 256, ABf16{SH, 256, 0}, BF32{p.s_d + (size_t)l * 256 * D, D, 0}, NEpiF32{FLs, D, 0});
            hipLaunchKernelGGL(k_routed, dim3(nr), dim3(256), 0, stream, p, l);
        }
    }
    if (FAST & 2) mk(stream, p, PH_FINAL, PH_END); else hipLaunchKernelGGL(k_rowA, dim3(2048), dim3(256), 0, stream, p, 2);
#endif
}
```
